# Optimizing an MI355X kernel written in HIP

```python
import jax, jax.numpy as jnp
from jax import lax
import numpy as np

D_MODEL = 2048
BATCH = 8
SEQ = 2048
DEPTH = 2

GRID_W = 64
CTX_LEN = 256
D_FOURIER = D_MODEL // 2
FOURIER_GROUPS = 4
D_LRU = D_MODEL // 2
LRU_HEADS = 8
LRU_HEAD_DIM = D_LRU // LRU_HEADS
CONV_WIDTH = 4
CONV_LEFT = 2
LRU_C = 8.0
N_IN = D_FOURIER + 2 * D_LRU + 2 * D_MODEL
D_FF = 5632
N_EXPERTS = 8
TOP_K = 2
D_EXPERT = 7168
N_DENSE = (DEPTH + 1) // 2
N_MOE = DEPTH // 2
NORM_EPS = 1e-6

kernel_name = "hybrid_fnet_rglru_moe_diffusion_trunk"


def rmsnorm(h, g):
    hf = h.astype(jnp.float32)
    y = hf * lax.rsqrt(jnp.mean(hf * hf, axis=-1, keepdims=True) + NORM_EPS)
    return (y * g.astype(jnp.float32)).astype(h.dtype)


def modulate(h, shift, scale):
    return h * (1.0 + scale) + shift


def ada_mod(cvec, w, b):
    m = jax.nn.silu(cvec) @ w + b
    return jnp.split(m, 6, axis=-1)


def fourier_mix(u):
    B, L, _ = u.shape
    ug = u.astype(jnp.float32).reshape(B, L, FOURIER_GROUPS, D_FOURIER // FOURIER_GROUPS)
    y = jnp.fft.fftn(ug, axes=(1, 3), norm="ortho").real
    return y.reshape(B, L, D_FOURIER).astype(u.dtype)


def dwconv(u, w, b):
    L = u.shape[-2]
    pad = [(0, 0)] * (u.ndim - 2) + [(CONV_LEFT, CONV_WIDTH - 1 - CONV_LEFT), (0, 0)]
    up = jnp.pad(u, pad)
    y = up[..., 0:L, :] * w[0]
    for k in range(1, CONV_WIDTH):
        y = y + up[..., k:k + L, :] * w[k]
    return y + b


def lru_conv_input(ur, conv_w, conv_b, grid):
    if grid:
        B, L, C = ur.shape
        rows = L // GRID_W
        return dwconv(ur.reshape(B, rows, GRID_W, C), conv_w, conv_b).reshape(B, L, C)
    return dwconv(ur, conv_w, conv_b)


def _lin_combine(e1, e2):
    a1, b1 = e1
    a2, b2 = e2
    return a1 * a2, a2 * b1 + b2


def rglru(v, wa, ba, wx, bx, lam, h0, reverse):
    B, L, _ = v.shape
    vf = v.astype(jnp.float32)
    vh = vf.reshape(B, L, LRU_HEADS, LRU_HEAD_DIM)
    r = jax.nn.sigmoid(jnp.einsum('blhi,hij->blhj', vh, wa.astype(jnp.float32)).reshape(B, L, D_LRU) + ba.astype(jnp.float32))
    i = jax.nn.sigmoid(jnp.einsum('blhi,hij->blhj', vh, wx.astype(jnp.float32)).reshape(B, L, D_LRU) + bx.astype(jnp.float32))
    log_a = -LRU_C * r * jax.nn.softplus(-lam.astype(jnp.float32))
    a = jnp.exp(log_a)
    bterm = jnp.sqrt(-jnp.expm1(2.0 * log_a)) * (i * vf)
    A, Bc = lax.associative_scan(_lin_combine, (a, bterm), axis=1, reverse=reverse)
    h = Bc + A * h0[:, None, :]
    h_last = h[:, 0] if reverse else h[:, -1]
    return h, h_last


def mixer(h, w_in, conv_w, conv_b, wa, ba, wx, bx, lam, w_fo, w_ro, w_o, h0f, h0b, grid):
    proj = h @ w_in
    o1 = D_FOURIER
    o2 = o1 + D_LRU
    o3 = o2 + D_LRU
    o4 = o3 + D_MODEL
    uf, ur, ug, gf, gr = proj[..., :o1], proj[..., o1:o2], proj[..., o2:o3], proj[..., o3:o4], proj[..., o4:]
    y_f = fourier_mix(uf) @ w_fo
    v = lru_conv_input(ur, conv_w, conv_b, grid)
    hf, hTf = rglru(v, wa[0], ba[0], wx[0], bx[0], lam[0], h0f, False)
    hb, hTb = rglru(v, wa[1], ba[1], wx[1], bx[1], lam[1], h0b, True)
    y_r = ((hf + hb).astype(h.dtype) * jax.nn.gelu(ug)) @ w_ro
    merged = jax.nn.sigmoid(gf) * y_f + jax.nn.sigmoid(gr) * y_r
    return merged @ w_o, hTf, hTb


def context_lru_states(h, w_in, conv_w, conv_b, wa, ba, wx, bx, lam, h0):
    ur = h @ w_in[:, D_FOURIER:D_FOURIER + D_LRU]
    v = lru_conv_input(ur, conv_w, conv_b, False)
    _, hTf = rglru(v, wa[0], ba[0], wx[0], bx[0], lam[0], h0, False)
    _, hTb = rglru(v, wa[1], ba[1], wx[1], bx[1], lam[1], h0, True)
    return hTf, hTb


def swiglu(h, wg, wu, wd):
    return (jax.nn.silu(h @ wg) * (h @ wu)) @ wd


def moe_swiglu(h, router, wg, wu, wd):
    B, L, D = h.shape
    t = h.reshape(B * L, D)
    logits = (t @ router).astype(jnp.float32)
    top_v, top_i = lax.top_k(logits, TOP_K)
    gates = jax.nn.softmax(top_v, axis=-1)
    combine = jnp.sum(jax.nn.one_hot(top_i, N_EXPERTS, dtype=jnp.float32) * gates[..., None], axis=1)
    out = jnp.zeros_like(t)
    for e in range(N_EXPERTS):
        out = out + combine[:, e:e + 1].astype(t.dtype) * swiglu(t, wg[e], wu[e], wd[e])
    return out.reshape(B, L, D)


def channel_mixer(h, l, ffn_w_gate, ffn_w_up, ffn_w_down, moe_router, moe_w_gate, moe_w_up, moe_w_down):
    if l % 2 == 0:
        j = l // 2
        return swiglu(h, ffn_w_gate[j], ffn_w_up[j], ffn_w_down[j])
    j = l // 2
    return moe_swiglu(h, moe_router[j], moe_w_gate[j], moe_w_up[j], moe_w_down[j])


def setup_inputs(seed: int = 0) -> dict:
    key = jax.random.key(seed)
    ks = jax.random.split(key, 32)
    f32 = jnp.float32
    nrm = lambda k, shape, s: jax.random.normal(k, shape, f32) * s
    u = jax.random.uniform(ks[15], (DEPTH, 2, D_LRU), f32, 0.9, 0.999)
    s = u ** (1.0 / LRU_C)
    lam = jnp.log(s) - jnp.log1p(-s)
    return {
        "x": nrm(ks[0], (BATCH, SEQ, D_MODEL), 1.0),
        "c": nrm(ks[1], (BATCH, D_MODEL), 1.0),
        "ctx": nrm(ks[2], (BATCH, CTX_LEN, D_MODEL), 1.0),
        "c_ctx": nrm(ks[3], (D_MODEL,), 1.0),
        "ada_w": nrm(ks[4], (DEPTH, D_MODEL, 6 * D_MODEL), 0.5 * D_MODEL ** -0.5),
        "ada_b": nrm(ks[5], (DEPTH, 6 * D_MODEL), 0.02),
        "norm1_g": 1.0 + nrm(ks[6], (DEPTH, D_MODEL), 0.02),
        "norm2_g": 1.0 + nrm(ks[7], (DEPTH, D_MODEL), 0.02),
        "w_in": nrm(ks[8], (DEPTH, D_MODEL, N_IN), D_MODEL ** -0.5),
        "conv_w": nrm(ks[9], (DEPTH, CONV_WIDTH, D_LRU), CONV_WIDTH ** -0.5),
        "conv_b": nrm(ks[10], (DEPTH, D_LRU), 0.02),
        "lru_wa": nrm(ks[11], (DEPTH, 2, LRU_HEADS, LRU_HEAD_DIM, LRU_HEAD_DIM), LRU_HEAD_DIM ** -0.5),
        "lru_ba": nrm(ks[12], (DEPTH, 2, D_LRU), 0.02),
        "lru_wx": nrm(ks[13], (DEPTH, 2, LRU_HEADS, LRU_HEAD_DIM, LRU_HEAD_DIM), LRU_HEAD_DIM ** -0.5),
        "lru_bx": nrm(ks[14], (DEPTH, 2, D_LRU), 0.02),
        "lru_lambda": lam,
        "w_fourier_out": nrm(ks[16], (DEPTH, D_FOURIER, D_MODEL), D_FOURIER ** -0.5),
        "w_lru_out": nrm(ks[17], (DEPTH, D_LRU, D_MODEL), D_LRU ** -0.5),
        "w_out": nrm(ks[18], (DEPTH, D_MODEL, D_MODEL), D_MODEL ** -0.5),
        "ffn_w_gate": nrm(ks[19], (N_DENSE, D_MODEL, D_FF), D_MODEL ** -0.5),
        "ffn_w_up": nrm(ks[20], (N_DENSE, D_MODEL, D_FF), D_MODEL ** -0.5),
        "ffn_w_down": nrm(ks[21], (N_DENSE, D_FF, D_MODEL), D_FF ** -0.5),
        "moe_router": nrm(ks[22], (N_MOE, D_MODEL, N_EXPERTS), D_MODEL ** -0.5),
        "moe_w_gate": nrm(ks[23], (N_MOE, N_EXPERTS, D_MODEL, D_EXPERT), D_MODEL ** -0.5),
        "moe_w_up": nrm(ks[24], (N_MOE, N_EXPERTS, D_MODEL, D_EXPERT), D_MODEL ** -0.5),
        "moe_w_down": nrm(ks[25], (N_MOE, N_EXPERTS, D_EXPERT, D_MODEL), D_EXPERT ** -0.5),
        "final_norm_g": 1.0 + nrm(ks[26], (D_MODEL,), 0.02),
    }


def reference(x, c, ctx, c_ctx, ada_w, ada_b, norm1_g, norm2_g, w_in, conv_w, conv_b,
              lru_wa, lru_ba, lru_wx, lru_bx, lru_lambda, w_fourier_out, w_lru_out, w_out,
              ffn_w_gate, ffn_w_up, ffn_w_down, moe_router, moe_w_gate, moe_w_up, moe_w_down,
              final_norm_g):
    lat = x
    cx = ctx
    B = x.shape[0]
    h_zero = jnp.zeros((B, D_LRU), jnp.float32)
    for l in range(DEPTH):
        last = l == DEPTH - 1
        sh1, sc1, g1, sh2, sc2, g2 = [m[:, None, :] for m in ada_mod(c, ada_w[l], ada_b[l])]
        csh1, csc1, cg1, csh2, csc2, cg2 = ada_mod(c_ctx, ada_w[l], ada_b[l])
        lp = (w_in[l], conv_w[l], conv_b[l], lru_wa[l], lru_ba[l], lru_wx[l], lru_bx[l], lru_lambda[l])
        hc = modulate(rmsnorm(cx, norm1_g[l]), csh1, csc1)
        if last:
            hTf, hTb = context_lru_states(hc, *lp, h_zero)
        else:
            oc, hTf, hTb = mixer(hc, *lp, w_fourier_out[l], w_lru_out[l], w_out[l], h_zero, h_zero, False)
            cx = cx + cg1 * oc
        hl = modulate(rmsnorm(lat, norm1_g[l]), sh1, sc1)
        ol, _, _ = mixer(hl, *lp, w_fourier_out[l], w_lru_out[l], w_out[l], hTf, hTb, True)
        lat = lat + g1 * ol
        fp = (ffn_w_gate, ffn_w_up, ffn_w_down, moe_router, moe_w_gate, moe_w_up, moe_w_down)
        if not last:
            cx = cx + cg2 * channel_mixer(modulate(rmsnorm(cx, norm2_g[l]), csh2, csc2), l, *fp)
        lat = lat + g2 * channel_mixer(modulate(rmsnorm(lat, norm2_g[l]), sh2, sc2), l, *fp)
    return rmsnorm(lat, final_norm_g)
```

```cpp
#include <hip/hip_runtime.h>
#include <cstdio>
#include <cstdint>
namespace fk {
#define GAS __attribute__((address_space(1)))
#define LAS __attribute__((address_space(3)))
typedef unsigned short bf16;
typedef short bf16x8 __attribute__((ext_vector_type(8)));
typedef float f32x4 __attribute__((ext_vector_type(4)));
typedef float f32x2 __attribute__((ext_vector_type(2)));
typedef unsigned u32x4 __attribute__((ext_vector_type(4)));
typedef unsigned u32x2 __attribute__((ext_vector_type(2)));
#define LDS_WAIT() asm volatile("s_waitcnt lgkmcnt(0)" ::: "memory")
#define VM_WAIT() asm volatile("s_waitcnt vmcnt(0)" ::: "memory")

__device__ __forceinline__ unsigned cvt_pk_bf16(float lo, float hi) { unsigned r; asm volatile("v_cvt_pk_bf16_f32 %0, %1, %2" : "=v"(r) : "v"(lo), "v"(hi)); return r; }
__device__ __forceinline__ float bf_lo(unsigned w) { return __uint_as_float(w << 16); }
__device__ __forceinline__ float bf_hi(unsigned w) { return __uint_as_float(w & 0xffff0000u); }
__device__ __forceinline__ float fexp(float x) { return __builtin_amdgcn_exp2f(x * 1.4426950408889634f); }
__device__ __forceinline__ float frcp(float x) { return __builtin_amdgcn_rcpf(x); }
__device__ __forceinline__ float fsigm(float x) { return frcp(1.f + fexp(-x)); }
__device__ __forceinline__ float fsilu(float x) { return x * frcp(1.f + fexp(-x)); }
__device__ __forceinline__ float fgelu(float x) { const float u = 1.5957691216057308f * (x + 0.044715f * x * x * x); return x * frcp(1.f + fexp(-u)); }
__device__ __forceinline__ int opq(int v) { asm volatile("" : "+v"(v)); return v; }
__device__ __forceinline__ float wave_sum(float v) {
#pragma unroll
    for (int o = 1; o < 64; o <<= 1) v += __shfl_xor(v, o);
    return v;
}

constexpr int BM = 256, BK = 64, HALF = 128, HTB = HALF * BK * 2, STAGE_BYTES = 8 * HTB, NXCD = 8, WGM = 8;
__device__ __forceinline__ int lds_byte(int r, int c) { const int st = (r >> 4) * 2 + (c >> 5), rr = r & 15, cc = c & 31, ob = rr * 64 + cc * 2; return st * 1024 + (ob ^ (((ob >> 9) & 1) << 5)); }
__device__ __forceinline__ void stage_rc(int b, int& R, int& C) { const int st = b / 1024, sb = b % 1024, swz = sb ^ (((sb >> 9) & 1) << 5); R = (st >> 1) * 16 + swz / 64; C = (st & 1) * 32 + (swz % 64) / 2; }
__device__ __forceinline__ int perm32(int rho) { const int n = rho >> 4, i = rho & 15; return 8 * (i >> 2) + 4 * n + (i & 3); }

struct Unit { const char* A; const char* B; int pm, pn, kind, nt, x; };

__device__ __forceinline__ void tile_of(int wgid, int nM, int nN, int& pm, int& pn) {
    const int nwg = nM * nN; { const int q = nwg / NXCD, r = nwg % NXCD, xcd = wgid % NXCD, off = wgid / NXCD; wgid = (xcd < r ? xcd * (q + 1) : r * (q + 1) + (xcd - r) * q) + off; }
    const int nig = WGM * nN, gid = wgid / nig, fm = gid * WGM, gsz = (nM - fm) < WGM ? (nM - fm) : WGM;
    pm = fm + ((wgid % nig) % gsz); pn = (wgid % nig) / gsz;
}

#ifndef G_ALIGN
#define G_ALIGN true
#endif
#ifndef G_SP2
#define G_SP2 true
#endif
template <class Epi, class Sched, bool ALIGN_EPI = G_ALIGN, bool SP2 = G_SP2>
__device__ __forceinline__ void gemm_phase(LAS unsigned char* lds, const int lda, const int ldb, const Sched& S, const Epi& E) {
    int tid = threadIdx.x; asm volatile("" : "+v"(tid));
    const int wid = __builtin_amdgcn_readfirstlane(tid >> 6), lane = tid & 63, wr = wid >> 2, wc = wid & 3, fr = lane & 15, fq = lane >> 4;
    unsigned voffA[2], voffB[2];
#pragma unroll
    for (int i = 0; i < 2; ++i) { int R, C; stage_rc(tid * 16 + i * 8192, R, C); const int Rb = Epi::PERM ? ((R & ~31) + perm32(R & 31)) : R;
        voffA[i] = (unsigned)(R * lda + C) * 2u; voffB[i] = (unsigned)(Rb * ldb + C) * 2u; }
    const size_t kstep = (size_t)(BK * 2);
    const size_t hstepA = (size_t)HALF * lda * 2, hstepB = (size_t)HALF * ldb * 2;
    const unsigned ldsw = (unsigned)wid * 1024u;
    const int aoff = lds_byte(wr * 64 + fr, fq * 8), boff = lds_byte(wc * 32 + fr, fq * 8);
#define PG8_SA(b, h) (((b) * 2 + (h)) * HTB)
#define PG8_SB(b, h) ((4 + (b) * 2 + (h)) * HTB)
#define PG8_STAGE(bufoff, gbase, voff) do { _Pragma("unroll") for (int _i = 0; _i < 2; ++_i) \
        __builtin_amdgcn_global_load_lds((const unsigned*)((const char*)(gbase) + (voff)[_i]), (LAS unsigned*)(lds + (bufoff) + ldsw + _i * 8192), 16, 0, 0); } while (0)
#define PG8_LDA(dst, b, h) do { _Pragma("unroll") for (int m = 0; m < 4; ++m) _Pragma("unroll") for (int k = 0; k < 2; ++k) dst[m][k] = *(const LAS bf16x8*)(lds + PG8_SA(b, h) + aoff + m * 2048 + k * 1024); } while (0)
#define PG8_LDB(dst, b, h) do { _Pragma("unroll") for (int n = 0; n < 2; ++n) _Pragma("unroll") for (int k = 0; k < 2; ++k) dst[n][k] = *(const LAS bf16x8*)(lds + PG8_SB(b, h) + boff + n * 2048 + k * 1024); } while (0)
#define PG8_MMA(ai, bj, At, Bt) do { __builtin_amdgcn_s_setprio(1); _Pragma("unroll") for (int m = 0; m < 4; ++m) _Pragma("unroll") for (int n = 0; n < 2; ++n) _Pragma("unroll") for (int k = 0; k < 2; ++k) \
        acc[ai][bj][m][n] = __builtin_amdgcn_mfma_f32_16x16x32_bf16(Bt[n][k], At[m][k], acc[ai][bj][m][n], 0, 0, 0); __builtin_amdgcn_s_setprio(0); } while (0)
#define PG8_WAIT_V(n) asm volatile("s_waitcnt vmcnt(" #n ")" ::: "memory")
#define PG8_WAIT_L(n) asm volatile("s_waitcnt lgkmcnt(" #n ")" ::: "memory")
#define PG8_BAR __builtin_amdgcn_s_barrier()
#define PG8_SCHED __builtin_amdgcn_sched_barrier(0)
    Unit cur, nxt; int ui = 0;
    if (!S.next(0, cur)) return;
    f32x4 acc[2][2][4][2];
#pragma unroll
    for (int a = 0; a < 2; ++a)
#pragma unroll
        for (int b = 0; b < 2; ++b)
#pragma unroll
            for (int m = 0; m < 4; ++m)
#pragma unroll
                for (int n = 0; n < 2; ++n) acc[a][b][m][n] = (f32x4){0.f, 0.f, 0.f, 0.f};
    bf16x8 At[4][2], B0[2][2], B1[2][2];
    const char* cA = cur.A; const char* cB = cur.B;
    if constexpr (SP2) {
        PG8_STAGE(PG8_SB(0, 0), cB, voffB); PG8_STAGE(PG8_SB(0, 1), cB + hstepB, voffB); PG8_STAGE(PG8_SA(0, 0), cA, voffA); PG8_STAGE(PG8_SA(0, 1), cA + hstepA, voffA);
        if (wr == 1) PG8_BAR;
        PG8_WAIT_V(2); PG8_BAR;
        PG8_STAGE(PG8_SB(1, 0), cB + kstep, voffB); PG8_STAGE(PG8_SA(1, 0), cA + kstep, voffA); PG8_STAGE(PG8_SB(1, 1), cB + hstepB + kstep, voffB);
        PG8_WAIT_V(6); PG8_BAR;
    } else {
        PG8_STAGE(PG8_SB(0, 0), cB, voffB); PG8_STAGE(PG8_SA(0, 0), cA, voffA); PG8_STAGE(PG8_SB(0, 1), cB + hstepB, voffB); PG8_STAGE(PG8_SA(0, 1), cA + hstepA, voffA);
        if (wr == 1) PG8_BAR;
        PG8_WAIT_V(4); PG8_BAR;
        PG8_STAGE(PG8_SB(1, 0), cB + kstep, voffB); PG8_STAGE(PG8_SA(1, 0), cA + kstep, voffA); PG8_STAGE(PG8_SB(1, 1), cB + hstepB + kstep, voffB);
        PG8_WAIT_V(6); PG8_BAR;
    }
    for (;;) {
        const bool has_next = S.next(ui + 1, nxt);
        const char* nA = has_next ? nxt.A : cA; const char* nB = has_next ? nxt.B : cB;
        const int nt = cur.nt;
        for (int t = 0; t < nt; t += 2) {
            const bool last = (t == nt - 2);
            const char* a1 = cA + (size_t)(t + 1) * kstep;
            const char* a2 = last ? nA : cA + (size_t)(t + 2) * kstep; const char* b2 = last ? nB : cB + (size_t)(t + 2) * kstep;
            const char* a3 = a2 + kstep; const char* b3 = b2 + kstep;
            if constexpr (SP2) {
            PG8_LDB(B0, 0, 0); PG8_LDB(B1, 0, 1); PG8_SCHED; PG8_LDA(At, 0, 0); PG8_STAGE(PG8_SA(1, 1), a1 + hstepA, voffA);
            PG8_WAIT_V(8); PG8_WAIT_L(0); PG8_BAR; PG8_MMA(0, 0, At, B0); PG8_MMA(0, 1, At, B1); PG8_BAR; PG8_SCHED;
            PG8_LDA(At, 0, 1); PG8_STAGE(PG8_SB(0, 0), b2, voffB); PG8_STAGE(PG8_SB(0, 1), b2 + hstepB, voffB); PG8_STAGE(PG8_SA(0, 0), a2, voffA);
            PG8_WAIT_V(8); PG8_WAIT_L(0); PG8_BAR; PG8_MMA(1, 0, At, B0); PG8_MMA(1, 1, At, B1); PG8_BAR; PG8_SCHED;
            PG8_LDB(B0, 1, 0); PG8_LDB(B1, 1, 1); PG8_SCHED; PG8_LDA(At, 1, 0); PG8_STAGE(PG8_SA(0, 1), a2 + hstepA, voffA);
            PG8_WAIT_V(8); PG8_WAIT_L(0); PG8_BAR; PG8_MMA(0, 0, At, B0); PG8_MMA(0, 1, At, B1); PG8_BAR; PG8_SCHED;
            PG8_LDA(At, 1, 1); PG8_STAGE(PG8_SB(1, 0), b3, voffB); PG8_STAGE(PG8_SB(1, 1), b3 + hstepB, voffB); PG8_STAGE(PG8_SA(1, 0), a3, voffA);
            PG8_WAIT_V(8); PG8_WAIT_L(0); PG8_BAR; PG8_MMA(1, 0, At, B0); PG8_MMA(1, 1, At, B1); PG8_BAR; PG8_SCHED;
            } else {
            PG8_LDB(B0, 0, 0); PG8_SCHED; PG8_LDA(At, 0, 0); PG8_STAGE(PG8_SA(1, 1), a1 + hstepA, voffA);
            PG8_WAIT_L(8); PG8_BAR; PG8_WAIT_L(0); PG8_MMA(0, 0, At, B0); PG8_BAR; PG8_SCHED;
            PG8_LDB(B1, 0, 1); PG8_STAGE(PG8_SB(0, 0), b2, voffB);
            PG8_BAR; PG8_WAIT_L(0); PG8_MMA(0, 1, At, B1); PG8_BAR;
            PG8_LDA(At, 0, 1); PG8_STAGE(PG8_SA(0, 0), a2, voffA);
            PG8_BAR; PG8_WAIT_L(0); PG8_MMA(1, 0, At, B0); PG8_BAR; PG8_SCHED;
            PG8_STAGE(PG8_SB(0, 1), b2 + hstepB, voffB);
            PG8_WAIT_V(6); PG8_BAR; PG8_MMA(1, 1, At, B1); PG8_BAR;
            PG8_LDB(B0, 1, 0); PG8_SCHED; PG8_LDA(At, 1, 0); PG8_STAGE(PG8_SA(0, 1), a2 + hstepA, voffA);
            PG8_WAIT_L(8); PG8_BAR; PG8_WAIT_L(0); PG8_MMA(0, 0, At, B0); PG8_BAR; PG8_SCHED;
            PG8_LDB(B1, 1, 1); PG8_STAGE(PG8_SB(1, 0), b3, voffB);
            PG8_BAR; PG8_WAIT_L(0); PG8_MMA(0, 1, At, B1); PG8_BAR;
            PG8_LDA(At, 1, 1); PG8_STAGE(PG8_SA(1, 0), a3, voffA);
            PG8_BAR; PG8_WAIT_L(0); PG8_MMA(1, 0, At, B0); PG8_BAR; PG8_SCHED;
            PG8_STAGE(PG8_SB(1, 1), b3 + hstepB, voffB);
            PG8_WAIT_V(6); PG8_BAR; PG8_MMA(1, 1, At, B1); PG8_BAR;
            }
        }
        if constexpr (ALIGN_EPI) { if (wr == 0) PG8_BAR; }
        E(acc, cur, wr, wc, fr, fq);
        if (!has_next) break;
#pragma unroll
        for (int a = 0; a < 2; ++a)
#pragma unroll
            for (int b = 0; b < 2; ++b)
#pragma unroll
                for (int m = 0; m < 4; ++m)
#pragma unroll
                    for (int n = 0; n < 2; ++n) acc[a][b][m][n] = (f32x4){0.f, 0.f, 0.f, 0.f};
        cur = nxt; cA = nA; cB = nB; ++ui;
        if constexpr (ALIGN_EPI) { if (wr == 1) PG8_BAR; }
    }
    PG8_WAIT_V(0);
    if constexpr (!ALIGN_EPI) { if (wr == 0) PG8_BAR; }
    PG8_BAR;
#undef PG8_SA
#undef PG8_SB
#undef PG8_STAGE
#undef PG8_LDA
#undef PG8_LDB
#undef PG8_MMA
#undef PG8_WAIT_V
#undef PG8_WAIT_L
#undef PG8_BAR
#undef PG8_SCHED
}

#define XB_TMO      128
#define XB_XCNT(j)  (256  + 64 * (j))
#define XB_XSUB(j)  (1280 + 64 * (j))
#define XB_XGEN(j)  (2304 + 64 * (j))
#define XB_TOP      3328
#define XB_TOPGEN   3392
#define XCD_BAR_WORDS 3456
#define XB_SPIN_CAP (1u << 18)
__device__ __forceinline__ unsigned xb_ld(unsigned* p)              { return __hip_atomic_load(p, __ATOMIC_RELAXED, __HIP_MEMORY_SCOPE_AGENT); }
__device__ __forceinline__ unsigned xb_add(unsigned* p, unsigned v) { return __hip_atomic_fetch_add(p, v, __ATOMIC_RELAXED, __HIP_MEMORY_SCOPE_AGENT); }
__device__ __forceinline__ unsigned xb_xcc_id() { return (unsigned)__builtin_amdgcn_s_getreg((3 << 11) | 20) & 0xFu; }
#define XB_SPIN(cond, bar) do { unsigned _sp = 0; while (cond) { __builtin_amdgcn_s_sleep(1); \
    if ((++_sp & 255u) == 0u) { if (xb_ld(&(bar)[XB_TMO])) break; if (_sp > XB_SPIN_CAP) { atomicAdd(&(bar)[XB_TMO], 1u); break; } } } } while (0)
struct XcdBarrier { unsigned* bar; unsigned x; volatile LAS unsigned* st; };
__device__ __forceinline__ XcdBarrier xcd_barrier_post(unsigned* bar, volatile LAS unsigned* st) {
    XcdBarrier b; b.bar = bar; b.x = xb_xcc_id(); b.st = st;
    if (threadIdx.x == 0) (void)xb_add(&bar[XB_XCNT(b.x)], 1u);
    return b;
}
__device__ __forceinline__ void xcd_barrier_complete(unsigned* bar, unsigned x, unsigned& nloc, unsigned& nx) {
    const unsigned G = gridDim.x * gridDim.y * gridDim.z;
    unsigned sum, cnt, mine, sp = 0u;
    for (;;) {
        sum = 0u; cnt = 0u; mine = 0u;
#pragma unroll
        for (unsigned j = 0; j < 16; ++j) { const unsigned c = xb_ld(&bar[XB_XCNT(j)]); sum += c; cnt += (c > 0u) ? 1u : 0u; mine = (j == x) ? c : mine; }
        if (sum == G) break;
        __builtin_amdgcn_s_sleep(1);
        if ((++sp & 255u) == 0u) { if (xb_ld(&bar[XB_TMO])) break; if (sp > XB_SPIN_CAP) { atomicAdd(&bar[XB_TMO], 1u); break; } }
    }
    nloc = mine > 0u ? mine : 1u; nx = cnt > 0u ? cnt : 1u;
}
__device__ __forceinline__ void xcd_barrier(const XcdBarrier& b) {
    asm volatile("s_waitcnt vmcnt(0)" ::: "memory");
    __syncthreads();
    if (threadIdx.x == 0) {
        unsigned* bar = b.bar;
        __builtin_amdgcn_s_waitcnt(0);
        unsigned nloc = b.st[0], nx = b.st[1];
        if (nloc == 0u) { xcd_barrier_complete(bar, b.x, nloc, nx); b.st[0] = nloc; b.st[1] = nx; }
        const unsigned old = xb_add(&bar[XB_XSUB(b.x)], 1u);
        const unsigned gen = old / nloc;
        if (old + 1u == (gen + 1u) * nloc) {
            __builtin_amdgcn_fence(__ATOMIC_RELEASE, "agent");
            asm volatile("s_waitcnt vmcnt(0)" ::: "memory");
            const unsigned og = xb_add(&bar[XB_TOP], 1u);
            const unsigned tg = og / nx;
            if (og + 1u == (tg + 1u) * nx) xb_add(&bar[XB_TOPGEN], 1u);
            else XB_SPIN(xb_ld(&bar[XB_TOPGEN]) == tg, bar);
            __builtin_amdgcn_fence(__ATOMIC_ACQUIRE, "agent");
            xb_add(&bar[XB_XGEN(b.x)], 1u);
            asm volatile("s_waitcnt vmcnt(0)" ::: "memory");
        } else {
            XB_SPIN(xb_ld(&bar[XB_XGEN(b.x)]) == gen, bar);
            __builtin_amdgcn_fence(__ATOMIC_ACQUIRE, "agent");
            asm volatile("s_waitcnt vmcnt(0)" ::: "memory");
        }
    }
    __syncthreads();
}
constexpr int D = 2048, NB = 8, L = 2048, LC = 256, RL = 16384, RC = 2048, R = 18432, NIN = 7168, GW = 64;
constexpr int DFF = 5632, NE = 8, DE = 7168, NH = 8, HD = 128, DL = 1024;
constexpr int WIN_ROWS = 7168;
constexpr int UT_LD = 36864;
constexpr int MAXSLOT = 34816;
constexpr int NCHUNK = 288;
constexpr int NWAVES = 8, NTHREADS = 512;
constexpr int LDS_BYTES = 147456;
constexpr int MISC_OFF = 140000;

constexpr size_t al256(size_t x) { return (x + 255) & ~(size_t)255; }
constexpr size_t O_CTL = 0, CTL_BYTES = 1u << 20, CTL_ZERO_BYTES = 65536;
constexpr size_t O_MOD = O_CTL + CTL_BYTES;
constexpr size_t O_MISC = O_MOD + al256((size_t)2 * 9 * 12288 * 4);
constexpr size_t O_LAT = O_MISC + (1u << 20);
constexpr size_t O_HN = O_LAT + (size_t)R * D * 4;
constexpr size_t O_WIN = O_HN + (size_t)R * D * 2;
constexpr size_t O_WFO = O_WIN + (size_t)2 * 8192 * 2048 * 2;
constexpr size_t O_WRO = O_WFO + (size_t)2 * 2048 * 1024 * 2;
constexpr size_t O_WO = O_WRO + (size_t)2 * 2048 * 1024 * 2;
constexpr size_t O_WAX = O_WO + (size_t)2 * 2048 * 2048 * 2;
constexpr size_t O_WUF = O_WAX + (size_t)2 * 2 * 2 * 8 * 128 * 128 * 2;
constexpr size_t O_DG = O_WUF + (size_t)2 * 2048 * 1024 * 2;
constexpr size_t O_FL = O_DG + (size_t)512 * 256 * 2;
constexpr size_t O_FLC = O_FL + (size_t)2048 * 4096 * 2;
constexpr size_t O_FGU = O_FLC + (size_t)256 * 4096 * 2;
constexpr size_t O_FD = O_FGU + (size_t)11264 * 2048 * 2;
constexpr size_t O_MGU = O_FD + (size_t)2048 * 5632 * 2;
constexpr size_t O_MD = O_MGU + (size_t)8 * 14336 * 2048 * 2;
constexpr size_t O_SCR = O_MD + (size_t)8 * 2048 * 7168 * 2;
constexpr size_t O_UT = O_SCR;
constexpr size_t O_UR = O_UT + (size_t)1024 * UT_LD * 2;
constexpr size_t O_GG = O_UR + (size_t)R * 1024 * 2;
constexpr size_t O_SGF = O_GG + (size_t)R * 1024 * 2;
constexpr size_t O_SGR = O_SGF + (size_t)R * 2048 * 2;
constexpr size_t O_Y = O_SGR + (size_t)R * 2048 * 2;
constexpr size_t O_T1 = O_Y + (size_t)R * 1024 * 2;
constexpr size_t O_HR = O_T1 + (size_t)R * 2048 * 2;
constexpr size_t O_MG = O_HR + (size_t)R * 1024 * 2;
constexpr size_t O_TOT = O_MG + (size_t)R * 2048 * 2;
constexpr size_t O_CAR = O_TOT + (size_t)NCHUNK * 2 * 1024 * 8;
constexpr size_t O_MIXEND = O_CAR + (size_t)NCHUNK * 2 * 1024 * 4;
constexpr size_t O_HID = O_SCR;
constexpr size_t O_XG = O_SCR;
constexpr size_t O_HIDM = O_XG + (size_t)MAXSLOT * 2048 * 2;
constexpr size_t O_OS = O_HIDM + (size_t)MAXSLOT * 7168 * 2;
constexpr size_t O_END = O_OS + (size_t)2 * MAXSLOT * 2048 * 2;
static_assert(O_MIXEND <= O_END && O_HID + (size_t)R * DFF * 2 <= O_END, "scratch overlay");
static_assert(O_END <= (size_t)2085 * 1000 * 1000, "workspace budget");
constexpr size_t M_SEL = 0;
constexpr size_t M_GWT = 131072;
constexpr size_t M_SLOT = 262144;
constexpr size_t M_CNTB = 393216;
constexpr size_t M_TOT = 401408;
constexpr int CW_BAR = 4096, CW_MOEC = 8192;

struct Args { const float* in[27]; float* out; unsigned char* ws; int ph_lo, ph_hi, bar_region, pad; };
typedef const __attribute__((address_space(4))) Args* AP;
__device__ __forceinline__ AP kargs() { AP p = (AP)__builtin_amdgcn_kernarg_segment_ptr(); asm volatile("" : "+s"(p)); return p; }

__device__ __forceinline__ void p0_ada(AP a, LAS unsigned char* lds, int vcu, int G) {
    const int tid = threadIdx.x, lane = tid & 63, w = tid >> 6;
    LAS float* sc = (LAS float*)lds;
    LAS float* red = (LAS float*)(lds + 73728);
    const float* c = a->in[1]; const float* c_ctx = a->in[3];
    for (int i = tid; i < 9 * 2048; i += NTHREADS) { const int r = i >> 11, k = i & 2047; const float v = r < 8 ? c[r * 2048 + k] : c_ctx[k]; sc[i] = v / (1.f + expf(-v)); }
    __syncthreads();
    float* MOD = (float*)(a->ws + O_MOD);
    for (int item = vcu; item < 256; item += G) {
        const int l = item >> 7, cg = item & 127, col = cg * 96 + (lane < 48 ? lane : 0) * 2;
        const float* W = a->in[4] + (size_t)l * 2048 * 12288 + col;
        float acc[9][2];
#pragma unroll
        for (int r = 0; r < 9; ++r) { acc[r][0] = 0.f; acc[r][1] = 0.f; }
#pragma unroll 8
        for (int k = w * 256; k < w * 256 + 256; ++k) {
            const f32x2 wv = *(const f32x2*)(W + (size_t)k * 12288);
#pragma unroll
            for (int r = 0; r < 9; ++r) { const float s = sc[r * 2048 + k]; acc[r][0] = fmaf(s, wv.x, acc[r][0]); acc[r][1] = fmaf(s, wv.y, acc[r][1]); }
        }
#pragma unroll
        for (int r = 0; r < 9; ++r) if (lane < 48) { red[(w * 9 + r) * 128 + lane * 2] = acc[r][0]; red[(w * 9 + r) * 128 + lane * 2 + 1] = acc[r][1]; }
        __syncthreads();
        for (int i = tid; i < 9 * 128; i += NTHREADS) { const int r = i >> 7, cc = i & 127; if (cc >= 96) continue; float s = a->in[5][(size_t)l * 12288 + cg * 96 + cc];
#pragma unroll
            for (int ww = 0; ww < 8; ++ww) s += red[(ww * 9 + r) * 128 + cc];
            MOD[((size_t)l * 9 + r) * 12288 + cg * 96 + cc] = s; }
        __syncthreads();
    }
}

#ifndef CVT_NT
#define CVT_NT 0
#endif
#if CVT_NT
#define CVT_LOAD(p) __builtin_nontemporal_load(p)
#define CVT_STORE(v, p) __builtin_nontemporal_store(v, p)
#else
#define CVT_LOAD(p) (*(p))
#define CVT_STORE(v, p) (*(p) = (v))
#endif
__device__ __forceinline__ void cvt_item(const float* src, int ldsrc, bf16* dst, int dpitch, int k0, int n0, int drow0, LAS float* scr, int lane) {
    const float* s = src + (size_t)(k0 + (lane >> 4)) * ldsrc + n0 + (lane & 15) * 4;
    f32x4 v[16];
#pragma unroll
    for (int i = 0; i < 16; ++i) v[i] = CVT_LOAD((const f32x4*)(s + (size_t)(4 * i) * ldsrc));
#pragma unroll
    for (int i = 0; i < 16; ++i) { LAS float* q = scr + (4 * i + (lane >> 4)) * 65 + (lane & 15) * 4; q[0] = v[i].x; q[1] = v[i].y; q[2] = v[i].z; q[3] = v[i].w; }
    LDS_WAIT(); asm volatile("" ::: "memory");
    const int c = lane & 7;
#pragma unroll
    for (int jj = 0; jj < 8; ++jj) { const int n = (lane >> 3) + 8 * jj; const LAS float* q = scr + (8 * c) * 65 + n;
        u32x4 o; o.x = cvt_pk_bf16(q[0 * 65], q[1 * 65]); o.y = cvt_pk_bf16(q[2 * 65], q[3 * 65]); o.z = cvt_pk_bf16(q[4 * 65], q[5 * 65]); o.w = cvt_pk_bf16(q[6 * 65], q[7 * 65]);
        CVT_STORE(o, (u32x4*)(dst + (size_t)(drow0 + n) * dpitch + k0 + 8 * c)); }
    LDS_WAIT(); asm volatile("" ::: "memory");
}
constexpr int I_WIN = 32 * 96, I_FO = 16 * 32, I_O = 32 * 32, I_AX = 4, I_FG = 32 * 88, I_FD = 88 * 32, I_MG = 32 * 112, I_MD = 112 * 32;
constexpr int N_WIN = 2 * I_WIN, N_FO = 2 * I_FO, N_RO = N_FO, N_O = 2 * I_O, N_AX = 64 * I_AX, N_FG = I_FG, N_FU = I_FG, N_FD = I_FD, N_MG = 8 * I_MG, N_MU = N_MG, N_MD = 8 * I_MD;
constexpr int N_NONMOE = N_WIN + N_FO + N_RO + N_O + N_AX + N_FG + N_FU + N_FD, N_MOE = N_MG + N_MU + N_MD;
__device__ __forceinline__ void p0_convert(AP a, LAS unsigned char* lds, int gw, int NGW) {
    const int lane = threadIdx.x & 63, w = threadIdx.x >> 6;
    LAS float* scr = (LAS float*)(lds + w * 16640);
    unsigned char* ws = a->ws;
    for (int it = gw; it < N_NONMOE; it += NGW) {
        int r = it;
        if (r < N_WIN) { const int l = r / I_WIN, q = r % I_WIN, kb = q / 96, nb = q % 96;
            cvt_item(a->in[8] + (size_t)l * 2048 * NIN, NIN, (bf16*)(ws + O_WIN) + (size_t)l * WIN_ROWS * 2048, 2048, kb * 64, 1024 + nb * 64, 1024 + nb * 64, scr, lane); continue; } r -= N_WIN;
        if (r < N_FO) { const int l = r / I_FO, q = r % I_FO, kb = q / 32, nb = q % 32;
            cvt_item(a->in[16] + (size_t)l * 1024 * 2048, 2048, (bf16*)(ws + O_WFO) + (size_t)l * 2048 * 1024, 1024, kb * 64, nb * 64, nb * 64, scr, lane); continue; } r -= N_FO;
        if (r < N_RO) { const int l = r / I_FO, q = r % I_FO, kb = q / 32, nb = q % 32;
            cvt_item(a->in[17] + (size_t)l * 1024 * 2048, 2048, (bf16*)(ws + O_WRO) + (size_t)l * 2048 * 1024, 1024, kb * 64, nb * 64, nb * 64, scr, lane); continue; } r -= N_RO;
        if (r < N_O) { const int l = r / I_O, q = r % I_O, kb = q / 32, nb = q % 32;
            cvt_item(a->in[18] + (size_t)l * 2048 * 2048, 2048, (bf16*)(ws + O_WO) + (size_t)l * 2048 * 2048, 2048, kb * 64, nb * 64, nb * 64, scr, lane); continue; } r -= N_O;
        if (r < N_AX) { const int m = r / I_AX, q = r % I_AX, kb = q / 2, nb = q % 2;
            const int h = m & 7, gate = (m >> 3) & 1, ld = m >> 4;
            const float* src = (gate ? a->in[13] : a->in[11]) + ((size_t)ld * 8 + h) * 128 * 128;
            cvt_item(src, 128, (bf16*)(ws + O_WAX) + (size_t)m * 128 * 128, 128, kb * 64, nb * 64, nb * 64, scr, lane); continue; } r -= N_AX;
        if (r < N_FG) { const int kb = r / 88, nb = r % 88, n = nb * 64;
            cvt_item(a->in[19], DFF, (bf16*)(ws + O_FGU), 2048, kb * 64, n, (n >> 7) * 256 + (n & 127), scr, lane); continue; } r -= N_FG;
        if (r < N_FU) { const int kb = r / 88, nb = r % 88, n = nb * 64;
            cvt_item(a->in[20], DFF, (bf16*)(ws + O_FGU), 2048, kb * 64, n, (n >> 7) * 256 + 128 + (n & 127), scr, lane); continue; } r -= N_FU;
        { const int kb = r / 32, nb = r % 32;
            cvt_item(a->in[21], 2048, (bf16*)(ws + O_FD), DFF, kb * 64, nb * 64, nb * 64, scr, lane); }
    }
}
__device__ __forceinline__ void cvt_moe_range(AP a, LAS unsigned char* lds, int lo, int hi, int rank, int nrank) {
    const int lane = threadIdx.x & 63, w = threadIdx.x >> 6;
    LAS float* scr = (LAS float*)(lds + w * 16640);
    unsigned char* ws = a->ws;
    for (int it = lo + rank; it < hi; it += nrank) {
        int r = it;
        if (r < N_MG) { const int e = r / I_MG, q = r % I_MG, kb = q / 112, nb = q % 112, n = nb * 64;
            cvt_item(a->in[23] + (size_t)e * 2048 * DE, DE, (bf16*)(ws + O_MGU) + (size_t)e * 14336 * 2048, 2048, kb * 64, n, (n >> 7) * 256 + (n & 127), scr, lane); continue; } r -= N_MG;
        if (r < N_MU) { const int e = r / I_MG, q = r % I_MG, kb = q / 112, nb = q % 112, n = nb * 64;
            cvt_item(a->in[24] + (size_t)e * 2048 * DE, DE, (bf16*)(ws + O_MGU) + (size_t)e * 14336 * 2048, 2048, kb * 64, n, (n >> 7) * 256 + 128 + (n & 127), scr, lane); continue; } r -= N_MU;
        { const int e = r / I_MD, q = r % I_MD, kb = q / 32, nb = q % 32;
            cvt_item(a->in[25] + (size_t)e * DE * 2048, 2048, (bf16*)(ws + O_MD) + (size_t)e * 2048 * DE, DE, kb * 64, nb * 64, nb * 64, scr, lane); }
    }
}
__device__ __forceinline__ void p0_elementwise(AP a, size_t gt, size_t NGT, const LAS f32x2* tab) {
    unsigned char* ws = a->ws;
    for (size_t i = gt; i < (size_t)2 * 2048 * 128; i += NGT) { const int l = (int)(i / (2048 * 128)), d = (int)((i / 128) % 2048), j8 = (int)(i % 128) * 8;
        const float* s = a->in[8] + ((size_t)l * 2048 + d) * NIN + j8; const f32x4 v0 = *(const f32x4*)s, v1 = *(const f32x4*)(s + 4);
        u32x4 o; o.x = cvt_pk_bf16(v0.x, v0.y); o.y = cvt_pk_bf16(v0.z, v0.w); o.z = cvt_pk_bf16(v1.x, v1.y); o.w = cvt_pk_bf16(v1.z, v1.w);
        *(u32x4*)((bf16*)(ws + O_WUF) + ((size_t)l * 2048 + d) * 1024 + j8) = o; }
    for (size_t i = gt; i < (size_t)2048 * 512; i += NGT) { const int k = (int)(i / 512), j8 = (int)(i % 512) * 8; float v[8];
#pragma unroll
        for (int e = 0; e < 8; ++e) { const int j = j8 + e, t = j & 2047; const int m = (k * t) & 2047; const f32x2 cs = tab[m]; v[e] = (j < 2048 ? cs.x : -cs.y); }
        u32x4 o; o.x = cvt_pk_bf16(v[0], v[1]); o.y = cvt_pk_bf16(v[2], v[3]); o.z = cvt_pk_bf16(v[4], v[5]); o.w = cvt_pk_bf16(v[6], v[7]);
        *(u32x4*)((bf16*)(ws + O_FL) + (size_t)k * 4096 + j8) = o; }
    for (size_t i = gt; i < (size_t)256 * 64; i += NGT) { const int k = (int)(i / 64), j8 = (int)(i % 64) * 8; float v[8];
#pragma unroll
        for (int e = 0; e < 8; ++e) { const int j = j8 + e, t = j & 255; const int m = (k * t) & 255; float s, c; sincospif((float)m * (1.f / 128.f), &s, &c); v[e] = (j < 256 ? c : -s) * 0.0625f; }
        u32x4 o; o.x = cvt_pk_bf16(v[0], v[1]); o.y = cvt_pk_bf16(v[2], v[3]); o.z = cvt_pk_bf16(v[4], v[5]); o.w = cvt_pk_bf16(v[6], v[7]);
        *(u32x4*)((bf16*)(ws + O_FLC) + (size_t)k * 4096 + j8) = o; }
    for (size_t i = gt; i < (size_t)256 * 32; i += NGT) { const int row = (int)(i / 32), j8 = (int)(i % 32) * 8, s_ = row > 128 ? 1 : 0, c_ = s_ ? row - 128 : row; float v[8];
#pragma unroll
        for (int e = 0; e < 8; ++e) { const int m = (c_ * (j8 + e)) & 255; float s, c; sincospif((float)m * (1.f / 128.f), &s, &c); v[e] = (s_ ? s : c) * 0.0625f; }
        u32x4 o; o.x = cvt_pk_bf16(v[0], v[1]); o.y = cvt_pk_bf16(v[2], v[3]); o.z = cvt_pk_bf16(v[4], v[5]); o.w = cvt_pk_bf16(v[6], v[7]);
        *(u32x4*)((bf16*)(ws + O_DG) + (size_t)row * 256 + j8) = o; }
}

__device__ __forceinline__ int mod_row(int r) { return r < RL ? (r >> 11) : 8; }
template <bool ROUTER>
__device__ __forceinline__ int norm_row(const float* src, const float* g, const float* modl, int shift_chunk, int scale_chunk, bf16* dst, int row, int lane,
                                         const LAS float* rt, int* sel, float* gwt) {
    int picked = 0;
    const f32x4* xr = (const f32x4*)src;
    f32x4 v[8]; float s = 0.f;
#pragma unroll
    for (int j = 0; j < 8; ++j) { v[j] = xr[lane + 64 * j]; s += (v[j].x * v[j].x + v[j].y * v[j].y) + (v[j].z * v[j].z + v[j].w * v[j].w); }
    const float rstd = rsqrtf(wave_sum(s) * (1.f / D) + 1e-6f);
    const float* mr = modl + (size_t)mod_row(row) * 12288;
    float lg[8];
    if (ROUTER) {
#pragma unroll
        for (int e = 0; e < 8; ++e) lg[e] = 0.f; }
#pragma unroll
    for (int j = 0; j < 8; ++j) {
        const int c = (lane + 64 * j) * 4;
        const f32x4 gg = *(const f32x4*)(g + c), sh = *(const f32x4*)(mr + shift_chunk * D + c), sc = *(const f32x4*)(mr + scale_chunk * D + c);
        f32x4 o = v[j] * rstd * gg; o = o * (sc + 1.f) + sh;
        u32x2 w; w.x = cvt_pk_bf16(o.x, o.y); w.y = cvt_pk_bf16(o.z, o.w);
        *(u32x2*)(dst + (size_t)row * D + c) = w;
        if (ROUTER) {
#pragma unroll
            for (int q = 0; q < 4; ++q) { const f32x4 r0 = *(const LAS f32x4*)(rt + (c + q) * 8), r1 = *(const LAS f32x4*)(rt + (c + q) * 8 + 4); const float x = o[q];
                lg[0] = fmaf(x, r0.x, lg[0]); lg[1] = fmaf(x, r0.y, lg[1]); lg[2] = fmaf(x, r0.z, lg[2]); lg[3] = fmaf(x, r0.w, lg[3]);
                lg[4] = fmaf(x, r1.x, lg[4]); lg[5] = fmaf(x, r1.y, lg[5]); lg[6] = fmaf(x, r1.z, lg[6]); lg[7] = fmaf(x, r1.w, lg[7]); } }
    }
    if (ROUTER) {
#pragma unroll
        for (int e = 0; e < 8; ++e) lg[e] = wave_sum(lg[e]);
        if (lane == 0) {
            int i1 = 0; float v1 = lg[0];
#pragma unroll
            for (int e = 1; e < 8; ++e) if (lg[e] > v1) { v1 = lg[e]; i1 = e; }
            int i2 = -1; float v2 = -3.0e38f;
#pragma unroll
            for (int e = 0; e < 8; ++e) if (e != i1 && lg[e] > v2) { v2 = lg[e]; i2 = e; }
            const float w1 = 1.f / (1.f + expf(v2 - v1));
            sel[row * 2] = i1; sel[row * 2 + 1] = i2; gwt[row * 2] = w1; gwt[row * 2 + 1] = 1.f - w1; picked = i1 | (i2 << 8);
        }
    }
    return picked;
}

__device__ __forceinline__ float one_minus_exp(float x, float a2) {
    const float t = -x; return t < 0.0625f ? t * (1.f - t * (0.5f - t * (0.16666667f - t * (0.041666668f - t * 0.0083333338f)))) : 1.f - a2; }
template <int PASS>
__device__ __forceinline__ void scan_unit(AP a, LAS unsigned char* lds, int l, int q, int h) {
    int tid = threadIdx.x; asm volatile("" : "+v"(tid));
    const int lane = tid & 63, w = __builtin_amdgcn_readfirstlane(tid >> 6), fr = lane & 15, fq = lane >> 4;
    LAS float* VS = (LAS float*)lds; LAS bf16* V16 = (LAS bf16*)(lds + 33792); LAS float* AS = (LAS float*)(lds + 51200); LAS float* BS = (LAS float*)(lds + 84992); LAS float* SEG = (LAS float*)(lds + 118784);
    unsigned char* ws = a->ws;
    const bool isctx = q >= 256;
    const int row0 = isctx ? RL + (q - 256) * 64 : q * 64;
    const int cpos0 = isctx ? ((q - 256) & 3) * 64 : 0;
    const int seglen = isctx ? LC : GW;
    const int t = tid >> 3, c16 = (tid & 7) * 16;
    {
        const bf16* UR = (const bf16*)(ws + O_UR);
        const float* cw = a->in[9] + (size_t)l * 4 * DL + h * HD + c16; const float* cb = a->in[10] + (size_t)l * DL + h * HD + c16;
        float v[16];
#pragma unroll
        for (int i = 0; i < 16; i += 4) { const f32x4 b4 = *(const f32x4*)(cb + i); v[i] = b4.x; v[i + 1] = b4.y; v[i + 2] = b4.z; v[i + 3] = b4.w; }
#pragma unroll
        for (int k = 0; k < 4; ++k) { const int p = cpos0 + t + k - 2;
            if (p >= 0 && p < seglen) { const bf16* src = UR + (size_t)(row0 + t + k - 2) * 1024 + h * HD + c16; const u32x4 u0 = *(const u32x4*)src, u1 = *(const u32x4*)(src + 8);
                const unsigned uu[8] = {u0.x, u0.y, u0.z, u0.w, u1.x, u1.y, u1.z, u1.w};
#pragma unroll
                for (int i = 0; i < 8; ++i) { const f32x2 wv = *(const f32x2*)(cw + (size_t)k * DL + 2 * i); v[2 * i] = fmaf(wv.x, bf_lo(uu[i]), v[2 * i]); v[2 * i + 1] = fmaf(wv.y, bf_hi(uu[i]), v[2 * i + 1]); } } }
#pragma unroll
        for (int i = 0; i < 16; i += 4) *(LAS f32x4*)(VS + t * 132 + c16 + i) = (f32x4){v[i], v[i + 1], v[i + 2], v[i + 3]};
        u32x4 o0, o1; o0.x = cvt_pk_bf16(v[0], v[1]); o0.y = cvt_pk_bf16(v[2], v[3]); o0.z = cvt_pk_bf16(v[4], v[5]); o0.w = cvt_pk_bf16(v[6], v[7]);
        o1.x = cvt_pk_bf16(v[8], v[9]); o1.y = cvt_pk_bf16(v[10], v[11]); o1.z = cvt_pk_bf16(v[12], v[13]); o1.w = cvt_pk_bf16(v[14], v[15]);
        *(LAS u32x4*)(V16 + t * 136 + c16) = o0; *(LAS u32x4*)(V16 + t * 136 + c16 + 8) = o1;
    }
    __syncthreads();
    float hsum[16];
#pragma unroll
    for (int i = 0; i < 16; ++i) hsum[i] = 0.f;
    const int ch = 16 * w + fr;
#pragma unroll 1
    for (int dir = 0; dir < 2; ++dir) {
        f32x4 acc[2][4];
#pragma unroll
        for (int g = 0; g < 2; ++g)
#pragma unroll
            for (int m = 0; m < 4; ++m) acc[g][m] = (f32x4){0.f, 0.f, 0.f, 0.f};
        const bf16* WT = (const bf16*)(ws + O_WAX) + ((size_t)((l * 2 + dir) * 2) * 8 + h) * 128 * 128;
#pragma unroll
        for (int ks = 0; ks < 4; ++ks) {
            const bf16x8 b0 = *(const bf16x8*)(WT + (size_t)ch * 128 + ks * 32 + fq * 8), b1 = *(const bf16x8*)(WT + (size_t)8 * 128 * 128 + (size_t)ch * 128 + ks * 32 + fq * 8);
#pragma unroll
            for (int m = 0; m < 4; ++m) { const bf16x8 af = *(const LAS bf16x8*)(V16 + (16 * m + fr) * 136 + ks * 32 + fq * 8);
                acc[0][m] = __builtin_amdgcn_mfma_f32_16x16x32_bf16(af, b0, acc[0][m], 0, 0, 0); acc[1][m] = __builtin_amdgcn_mfma_f32_16x16x32_bf16(af, b1, acc[1][m], 0, 0, 0); }
        }
        {
            const int gch = h * HD + ch;
            const float bia = a->in[12][(size_t)(l * 2 + dir) * DL + gch], bix = a->in[14][(size_t)(l * 2 + dir) * DL + gch], lm = a->in[15][(size_t)(l * 2 + dir) * DL + gch];
            const float sp8 = 8.f * log1pf(expf(-lm));
#pragma unroll
            for (int m = 0; m < 4; ++m)
#pragma unroll
                for (int j = 0; j < 4; ++j) { const int tok = 16 * m + 4 * fq + j;
                    const float rr = fsigm(acc[0][m][j] + bia), ii = fsigm(acc[1][m][j] + bix), vv = VS[tok * 132 + ch];
                    const float la = -sp8 * rr, av = fexp(la), a2 = av * av;
                    AS[tok * 132 + ch] = av; BS[tok * 132 + ch] = sqrtf(one_minus_exp(2.f * la, a2)) * (ii * vv); }
        }
        __syncthreads();
        {
            const int sg = tid >> 7, sc = tid & 127;
            float av[16], bv[16];
#pragma unroll
            for (int i = 0; i < 16; ++i) { const int tok = dir ? 63 - (16 * sg + i) : 16 * sg + i; av[i] = AS[tok * 132 + sc]; bv[i] = BS[tok * 132 + sc]; }
            float P = 1.f, hl = 0.f;
#pragma unroll
            for (int i = 0; i < 16; ++i) { hl = fmaf(av[i], hl, bv[i]); P *= av[i]; }
            SEG[(sg * 128 + sc) * 2] = P; SEG[(sg * 128 + sc) * 2 + 1] = hl;
            __syncthreads();
            if (PASS == 1) {
                if (sg == 0) { float A = 1.f, B = 0.f;
#pragma unroll
                    for (int s2 = 0; s2 < 4; ++s2) { const float p2 = SEG[(s2 * 128 + sc) * 2], h2 = SEG[(s2 * 128 + sc) * 2 + 1]; B = fmaf(p2, B, h2); A *= p2; }
                    *(f32x2*)((float*)(ws + O_TOT) + (((size_t)q * 2 + dir) * 1024 + h * HD + sc) * 2) = (f32x2){A, B}; }
            } else {
                float hc = ((const float*)(ws + O_CAR))[((size_t)q * 2 + dir) * 1024 + h * HD + sc];
#pragma unroll
                for (int s2 = 0; s2 < 3; ++s2) if (s2 < sg) { const float p2 = SEG[(s2 * 128 + sc) * 2], h2 = SEG[(s2 * 128 + sc) * 2 + 1]; hc = fmaf(p2, hc, h2); }
#pragma unroll
                for (int i = 0; i < 16; ++i) { const int tok = dir ? 63 - (16 * sg + i) : 16 * sg + i; hc = fmaf(av[i], hc, bv[i]); BS[tok * 132 + sc] = hc; }
            }
        }
        __syncthreads();
        if (PASS == 2) {
#pragma unroll
            for (int i = 0; i < 16; i += 4) { const f32x4 x = *(const LAS f32x4*)(BS + t * 132 + c16 + i); hsum[i] += x.x; hsum[i + 1] += x.y; hsum[i + 2] += x.z; hsum[i + 3] += x.w; }
            __syncthreads();
        }
    }
    if (PASS == 2) {
        const bf16* GGp = (const bf16*)(ws + O_GG) + (size_t)(row0 + t) * 1024 + h * HD + c16; const u32x4 g0 = *(const u32x4*)GGp, g1 = *(const u32x4*)(GGp + 8);
        const unsigned gu[8] = {g0.x, g0.y, g0.z, g0.w, g1.x, g1.y, g1.z, g1.w}; unsigned o[8];
#pragma unroll
        for (int i = 0; i < 8; ++i) o[i] = cvt_pk_bf16(hsum[2 * i] * bf_lo(gu[i]), hsum[2 * i + 1] * bf_hi(gu[i]));
        bf16* dst = (bf16*)(ws + O_HR) + (size_t)(row0 + t) * 1024 + h * HD + c16;
        *(u32x4*)dst = (u32x4){o[0], o[1], o[2], o[3]}; *(u32x4*)(dst + 8) = (u32x4){o[4], o[5], o[6], o[7]};
    }
}
template <int PASS>
__device__ __forceinline__ void scan_phase(AP a, LAS unsigned char* lds, const int l, const int nunits, const int vcu, const int G) {
    int tid0 = threadIdx.x; asm volatile("" : "+v"(tid0));
    const int w = __builtin_amdgcn_readfirstlane(tid0 >> 6);
    LAS float* VS = (LAS float*)lds; LAS bf16* V16 = (LAS bf16*)(lds + 33792); LAS float* AS = (LAS float*)(lds + 51200); LAS float* BS = (LAS float*)(lds + 84992); LAS float* SEG = (LAS float*)(lds + 118784);
    LAS float* CW = (LAS float*)(lds + 122880); LAS float* CB = (LAS float*)(lds + 124928);
    unsigned char* ws = a->ws;
    const bf16* UR = (const bf16*)(ws + O_UR);
#define SCAN_LANE_VARS(tid) const int lane = (tid) & 63, fr = lane & 15, fq = lane >> 4, t = (tid) >> 3, c16 = ((tid) & 7) * 16, ch = 16 * w + fr, sg = (tid) >> 7, sc = (tid) & 127; \
    (void)fq; (void)sg; (void)sc; (void)ch; (void)t; (void)c16
    int hcur = -1;
    bf16x8 wf[2][2][4]; float bia[2], bix[2], sp8[2];
    u32x4 ur[4][2];
#define SCAN_PREFETCH(uu) do { const int q_ = (uu) >> 3, h_ = (uu) & 7; const bool ic_ = q_ >= 256; const int r0_ = ic_ ? RL + (q_ - 256) * 64 : q_ * 64; \
        const int cp_ = ic_ ? ((q_ - 256) & 3) * 64 : 0, sl_ = ic_ ? LC : GW; \
        _Pragma("unroll") for (int k = 0; k < 4; ++k) { const int p_ = cp_ + t + k - 2; \
            if (p_ >= 0 && p_ < sl_) { const bf16* src_ = UR + (size_t)(r0_ + t + k - 2) * 1024 + h_ * HD + c16; ur[k][0] = *(const u32x4*)src_; ur[k][1] = *(const u32x4*)(src_ + 8); } \
            else { ur[k][0] = (u32x4){0u, 0u, 0u, 0u}; ur[k][1] = (u32x4){0u, 0u, 0u, 0u}; } } } while (0)
    if (vcu < nunits) { SCAN_LANE_VARS(tid0); SCAN_PREFETCH(vcu); }
    for (int u = vcu; u < nunits; u += G) {
        const int q = u >> 3, h = u & 7;
        const int tid = opq(tid0); SCAN_LANE_VARS(tid);
        const bool isctx = q >= 256; const int row0 = isctx ? RL + (q - 256) * 64 : q * 64;
        if (h != hcur) {
            hcur = h;
            __syncthreads();
            if (tid < 128) { CB[tid] = a->in[10][(size_t)l * DL + h * HD + tid];
#pragma unroll
                for (int k = 0; k < 4; ++k) CW[k * 128 + tid] = a->in[9][((size_t)l * 4 + k) * DL + h * HD + tid]; }
#pragma unroll
            for (int dir = 0; dir < 2; ++dir) {
                const bf16* WT = (const bf16*)(ws + O_WAX) + ((size_t)((l * 2 + dir) * 2) * 8 + h) * 128 * 128;
#pragma unroll
                for (int g = 0; g < 2; ++g)
#pragma unroll
                    for (int ks = 0; ks < 4; ++ks) wf[dir][g][ks] = *(const bf16x8*)(WT + (size_t)g * 8 * 128 * 128 + (size_t)ch * 128 + ks * 32 + fq * 8);
                const int gch = h * HD + ch;
                bia[dir] = a->in[12][(size_t)(l * 2 + dir) * DL + gch]; bix[dir] = a->in[14][(size_t)(l * 2 + dir) * DL + gch];
                sp8[dir] = 8.f * log1pf(expf(-a->in[15][(size_t)(l * 2 + dir) * DL + gch]));
            }
            __syncthreads();
        }
        float car[2]; u32x4 gg0, gg1;
        if (PASS == 2) {
            car[0] = ((const float*)(ws + O_CAR))[((size_t)q * 2 + 0) * 1024 + h * HD + sc]; car[1] = ((const float*)(ws + O_CAR))[((size_t)q * 2 + 1) * 1024 + h * HD + sc];
            const bf16* GGp = (const bf16*)(ws + O_GG) + (size_t)(row0 + t) * 1024 + h * HD + c16; gg0 = *(const u32x4*)GGp; gg1 = *(const u32x4*)(GGp + 8);
        }
        {
            float v[16];
#pragma unroll
            for (int i = 0; i < 16; i += 4) { const f32x4 b4 = *(const LAS f32x4*)(CB + c16 + i); v[i] = b4.x; v[i + 1] = b4.y; v[i + 2] = b4.z; v[i + 3] = b4.w; }
#pragma unroll
            for (int k = 0; k < 4; ++k) { const unsigned uu[8] = {ur[k][0].x, ur[k][0].y, ur[k][0].z, ur[k][0].w, ur[k][1].x, ur[k][1].y, ur[k][1].z, ur[k][1].w};
#pragma unroll
                for (int i = 0; i < 16; i += 4) { const f32x4 wv = *(const LAS f32x4*)(CW + k * 128 + c16 + i);
                    v[i] = fmaf(wv.x, bf_lo(uu[i / 2]), v[i]); v[i + 1] = fmaf(wv.y, bf_hi(uu[i / 2]), v[i + 1]); v[i + 2] = fmaf(wv.z, bf_lo(uu[i / 2 + 1]), v[i + 2]); v[i + 3] = fmaf(wv.w, bf_hi(uu[i / 2 + 1]), v[i + 3]); } }
#pragma unroll
            for (int i = 0; i < 16; i += 4) *(LAS f32x4*)(VS + t * 132 + c16 + i) = (f32x4){v[i], v[i + 1], v[i + 2], v[i + 3]};
            u32x4 o0, o1; o0.x = cvt_pk_bf16(v[0], v[1]); o0.y = cvt_pk_bf16(v[2], v[3]); o0.z = cvt_pk_bf16(v[4], v[5]); o0.w = cvt_pk_bf16(v[6], v[7]);
            o1.x = cvt_pk_bf16(v[8], v[9]); o1.y = cvt_pk_bf16(v[10], v[11]); o1.z = cvt_pk_bf16(v[12], v[13]); o1.w = cvt_pk_bf16(v[14], v[15]);
            *(LAS u32x4*)(V16 + t * 136 + c16) = o0; *(LAS u32x4*)(V16 + t * 136 + c16 + 8) = o1;
        }
        if (u + G < nunits) SCAN_PREFETCH(u + G);
        __syncthreads();
        float hsum[16];
#pragma unroll
        for (int i = 0; i < 16; ++i) hsum[i] = 0.f;
#pragma unroll
        for (int dir = 0; dir < 2; ++dir) {
            f32x4 acc[2][4];
#pragma unroll
            for (int g = 0; g < 2; ++g)
#pragma unroll
                for (int m = 0; m < 4; ++m) acc[g][m] = (f32x4){0.f, 0.f, 0.f, 0.f};
#pragma unroll
            for (int ks = 0; ks < 4; ++ks)
#pragma unroll
                for (int m = 0; m < 4; ++m) { const bf16x8 af = *(const LAS bf16x8*)(V16 + (16 * m + fr) * 136 + ks * 32 + fq * 8);
                    acc[0][m] = __builtin_amdgcn_mfma_f32_16x16x32_bf16(af, wf[dir][0][ks], acc[0][m], 0, 0, 0); acc[1][m] = __builtin_amdgcn_mfma_f32_16x16x32_bf16(af, wf[dir][1][ks], acc[1][m], 0, 0, 0); }
#pragma unroll
            for (int m = 0; m < 4; ++m)
#pragma unroll
                for (int j = 0; j < 4; ++j) { const int tok = 16 * m + 4 * fq + j;
                    const float rr = fsigm(acc[0][m][j] + bia[dir]), ii = fsigm(acc[1][m][j] + bix[dir]), vv = VS[tok * 132 + ch];
                    const float la = -sp8[dir] * rr, av = fexp(la), a2 = av * av;
                    AS[tok * 132 + ch] = av; BS[tok * 132 + ch] = sqrtf(one_minus_exp(2.f * la, a2)) * (ii * vv); }
            __syncthreads();
            {
                float av[16], bv[16];
#pragma unroll
                for (int i = 0; i < 16; ++i) { const int tok = dir ? 63 - (16 * sg + i) : 16 * sg + i; av[i] = AS[tok * 132 + sc]; bv[i] = BS[tok * 132 + sc]; }
                float P = 1.f, hl = 0.f;
#pragma unroll
                for (int i = 0; i < 16; ++i) { hl = fmaf(av[i], hl, bv[i]); P *= av[i]; }
                SEG[(sg * 128 + sc) * 2] = P; SEG[(sg * 128 + sc) * 2 + 1] = hl;
                __syncthreads();
                if (PASS == 1) {
                    if (sg == 0) { float A = 1.f, B = 0.f;
#pragma unroll
                        for (int s2 = 0; s2 < 4; ++s2) { const float p2 = SEG[(s2 * 128 + sc) * 2], h2 = SEG[(s2 * 128 + sc) * 2 + 1]; B = fmaf(p2, B, h2); A *= p2; }
                        *(f32x2*)((float*)(ws + O_TOT) + (((size_t)q * 2 + dir) * 1024 + h * HD + sc) * 2) = (f32x2){A, B}; }
                } else {
                    float hc = car[dir];
#pragma unroll
                    for (int s2 = 0; s2 < 3; ++s2) if (s2 < sg) { const float p2 = SEG[(s2 * 128 + sc) * 2], h2 = SEG[(s2 * 128 + sc) * 2 + 1]; hc = fmaf(p2, hc, h2); }
#pragma unroll
                    for (int i = 0; i < 16; ++i) { const int tok = dir ? 63 - (16 * sg + i) : 16 * sg + i; hc = fmaf(av[i], hc, bv[i]); BS[tok * 132 + sc] = hc; }
                }
            }
            __syncthreads();
            if (PASS == 2) {
#pragma unroll
                for (int i = 0; i < 16; i += 4) { const f32x4 x = *(const LAS f32x4*)(BS + t * 132 + c16 + i); hsum[i] += x.x; hsum[i + 1] += x.y; hsum[i + 2] += x.z; hsum[i + 3] += x.w; }
                __syncthreads();
            }
        }
        if (PASS == 2) {
            const unsigned gu[8] = {gg0.x, gg0.y, gg0.z, gg0.w, gg1.x, gg1.y, gg1.z, gg1.w}; unsigned o[8];
#pragma unroll
            for (int i = 0; i < 8; ++i) o[i] = cvt_pk_bf16(hsum[2 * i] * bf_lo(gu[i]), hsum[2 * i + 1] * bf_hi(gu[i]));
            bf16* dst = (bf16*)(ws + O_HR) + (size_t)(row0 + t) * 1024 + h * HD + c16;
            *(u32x4*)dst = (u32x4){o[0], o[1], o[2], o[3]}; *(u32x4*)(dst + 8) = (u32x4){o[4], o[5], o[6], o[7]};
        }
    }
#undef SCAN_PREFETCH
#undef SCAN_LANE_VARS
}
template <int PASS, int SKIP = 0>
__device__ __forceinline__ void scan_phase2(AP a, LAS unsigned char* lds, const int l, const int nunits, const int vcu, const int G) {
    int tid0 = threadIdx.x; asm volatile("" : "+v"(tid0));
    const int w = __builtin_amdgcn_readfirstlane(tid0 >> 6);
    LAS bf16* V16 = (LAS bf16*)lds; LAS float* HST = (LAS float*)(lds + 34816) + w * (64 * 17); LAS float* CW = (LAS float*)(lds + 69632); LAS float* CB = (LAS float*)(lds + 71680);
    unsigned char* ws = a->ws;
    const bf16* UR = (const bf16*)(ws + O_UR);
#define SCAN_LANE_VARS(tid) const int lane = (tid) & 63, fr = lane & 15, fq = lane >> 4, t = (tid) >> 3, c16 = ((tid) & 7) * 16, ch = 16 * w + fr; (void)fq; (void)ch; (void)t; (void)c16
    int hcur = -1;
    bf16x8 wf[2][2][4]; float nbia[2], nbix[2], nsp8[2];
    u32x4 ur[4][2];
#define SCAN_PREFETCH(uu) do { const int q_ = (uu) >> 3, h_ = (uu) & 7; const bool ic_ = q_ >= 256; const int r0_ = ic_ ? RL + (q_ - 256) * 64 : q_ * 64; \
        const int cp_ = ic_ ? ((q_ - 256) & 3) * 64 : 0, sl_ = ic_ ? LC : GW; \
        _Pragma("unroll") for (int k = 0; k < 4; ++k) { const int p_ = cp_ + t + k - 2; \
            if (p_ >= 0 && p_ < sl_) { const bf16* src_ = UR + (size_t)(r0_ + t + k - 2) * 1024 + h_ * HD + c16; ur[k][0] = *(const u32x4*)src_; ur[k][1] = *(const u32x4*)(src_ + 8); } \
            else { ur[k][0] = (u32x4){0u, 0u, 0u, 0u}; ur[k][1] = (u32x4){0u, 0u, 0u, 0u}; } } } while (0)
    if (vcu < nunits) { SCAN_LANE_VARS(tid0); SCAN_PREFETCH(vcu); }
    int par = 0;
    for (int u = vcu; u < nunits; u += G, par ^= 1) {
        const int q = u >> 3, h = u & 7;
        const int tid = opq(tid0); SCAN_LANE_VARS(tid);
        const bool isctx = q >= 256; const int row0 = isctx ? RL + (q - 256) * 64 : q * 64;
        LAS bf16* Vb = V16 + par * (64 * 136);
        if (h != hcur) {
            hcur = h;
            __syncthreads();
            if (tid < 128) { CB[tid] = a->in[10][(size_t)l * DL + h * HD + tid];
#pragma unroll
                for (int k = 0; k < 4; ++k) CW[k * 128 + tid] = a->in[9][((size_t)l * 4 + k) * DL + h * HD + tid]; }
#pragma unroll
            for (int dir = 0; dir < 2; ++dir) {
                const bf16* WT = (const bf16*)(ws + O_WAX) + ((size_t)((l * 2 + dir) * 2) * 8 + h) * 128 * 128;
#pragma unroll
                for (int g = 0; g < 2; ++g)
#pragma unroll
                    for (int ks = 0; ks < 4; ++ks) wf[dir][g][ks] = *(const bf16x8*)(WT + (size_t)g * 8 * 128 * 128 + (size_t)ch * 128 + ks * 32 + fq * 8);
                const int gch = h * HD + ch;
                nbia[dir] = -1.4426950408889634f * a->in[12][(size_t)(l * 2 + dir) * DL + gch]; nbix[dir] = -1.4426950408889634f * a->in[14][(size_t)(l * 2 + dir) * DL + gch];
                nsp8[dir] = -8.f * 1.4426950408889634f * log1pf(expf(-a->in[15][(size_t)(l * 2 + dir) * DL + gch]));
            }
            __syncthreads();
        }
        float car[2]; u32x4 gg0, gg1;
        if (PASS == 2) {
            car[0] = ((const float*)(ws + O_CAR))[((size_t)q * 2 + 0) * 1024 + h * HD + ch]; car[1] = ((const float*)(ws + O_CAR))[((size_t)q * 2 + 1) * 1024 + h * HD + ch];
            const bf16* GGp = (const bf16*)(ws + O_GG) + (size_t)(row0 + lane) * 1024 + h * HD + 16 * w; gg0 = *(const u32x4*)GGp; gg1 = *(const u32x4*)(GGp + 8);
        }
        {
            float v[16];
#pragma unroll
            for (int i = 0; i < 16; i += 4) { const f32x4 b4 = *(const LAS f32x4*)(CB + c16 + i); v[i] = b4.x; v[i + 1] = b4.y; v[i + 2] = b4.z; v[i + 3] = b4.w; }
#pragma unroll
            for (int k = 0; k < 4; ++k) { const unsigned uu[8] = {ur[k][0].x, ur[k][0].y, ur[k][0].z, ur[k][0].w, ur[k][1].x, ur[k][1].y, ur[k][1].z, ur[k][1].w};
#pragma unroll
                for (int i = 0; i < 16; i += 4) { const f32x4 wv = *(const LAS f32x4*)(CW + k * 128 + c16 + i);
                    v[i] = fmaf(wv.x, bf_lo(uu[i / 2]), v[i]); v[i + 1] = fmaf(wv.y, bf_hi(uu[i / 2]), v[i + 1]); v[i + 2] = fmaf(wv.z, bf_lo(uu[i / 2 + 1]), v[i + 2]); v[i + 3] = fmaf(wv.w, bf_hi(uu[i / 2 + 1]), v[i + 3]); } }
            u32x4 o0, o1; o0.x = cvt_pk_bf16(v[0], v[1]); o0.y = cvt_pk_bf16(v[2], v[3]); o0.z = cvt_pk_bf16(v[4], v[5]); o0.w = cvt_pk_bf16(v[6], v[7]);
            o1.x = cvt_pk_bf16(v[8], v[9]); o1.y = cvt_pk_bf16(v[10], v[11]); o1.z = cvt_pk_bf16(v[12], v[13]); o1.w = cvt_pk_bf16(v[14], v[15]);
            *(LAS u32x4*)(Vb + t * 136 + c16) = o0; *(LAS u32x4*)(Vb + t * 136 + c16 + 8) = o1;
        }
        if (u + G < nunits) SCAN_PREFETCH(u + G);
        __syncthreads();
        if (SKIP == 1) continue;
        float vv[4][4];
#pragma unroll
        for (int m = 0; m < 4; ++m)
#pragma unroll
            for (int j = 0; j < 4; ++j) vv[m][j] = __uint_as_float(((unsigned)Vb[(16 * m + 4 * fq + j) * 136 + ch]) << 16);
#pragma unroll
        for (int dir = 0; dir < 2; ++dir) {
            f32x4 acc[2][4];
#pragma unroll
            for (int g = 0; g < 2; ++g)
#pragma unroll
                for (int m = 0; m < 4; ++m) acc[g][m] = (f32x4){0.f, 0.f, 0.f, 0.f};
#pragma unroll
            for (int ks = 0; ks < 4; ++ks)
#pragma unroll
                for (int m = 0; m < 4; ++m) { const bf16x8 af = *(const LAS bf16x8*)(Vb + (16 * m + fr) * 136 + ks * 32 + fq * 8);
                    acc[0][m] = __builtin_amdgcn_mfma_f32_16x16x32_bf16(af, wf[dir][0][ks], acc[0][m], 0, 0, 0); acc[1][m] = __builtin_amdgcn_mfma_f32_16x16x32_bf16(af, wf[dir][1][ks], acc[1][m], 0, 0, 0); }
            float av[4][4], bv[4][4];
#pragma unroll
            for (int m = 0; m < 4; ++m)
#pragma unroll
                for (int j = 0; j < 4; ++j) {
                    if (SKIP == 3) { av[m][j] = acc[0][m][j]; bv[m][j] = acc[1][m][j] * vv[m][j]; continue; }
                    const float ex = __builtin_amdgcn_exp2f(fminf(fmaf(acc[0][m][j], -1.4426950408889634f, nbia[dir]), 60.f)), ey = __builtin_amdgcn_exp2f(fminf(fmaf(acc[1][m][j], -1.4426950408889634f, nbix[dir]), 60.f));
                    const float dx = 1.f + ex, dy = 1.f + ey, qq = frcp(dx * dy), rr = qq * dy, ii = qq * dx;
                    const float aa = __builtin_amdgcn_exp2f(nsp8[dir] * rr);
                    av[m][j] = aa; bv[m][j] = __builtin_amdgcn_sqrtf(fmaf(-aa, aa, 1.f)) * (ii * vv[m][j]); }
            float P[4], H[4];
#pragma unroll
            for (int m = 0; m < 4; ++m) { float p = 1.f, hh = 0.f;
#pragma unroll
                for (int i = 0; i < 4; ++i) { const int jj = dir ? 3 - i : i; hh = fmaf(av[m][jj], hh, bv[m][jj]); p *= av[m][jj]; }
                P[m] = p; H[m] = hh; }
            const int pred1 = dir ? lane + 16 : lane - 16, pred2 = dir ? lane + 32 : lane - 32;
            const bool has1 = dir ? (fq <= 2) : (fq >= 1), has2 = dir ? (fq <= 1) : (fq >= 2);
            const int lastl = dir ? fr : fr + 48;
            float Ae[4], He[4], TA[4], TB[4];
#pragma unroll
            for (int m = 0; m < 4; ++m) {
                float pa = __shfl(P[m], pred1 & 63), ph = __shfl(H[m], pred1 & 63);
                if (has1) { H[m] = fmaf(P[m], ph, H[m]); P[m] *= pa; }
                pa = __shfl(P[m], pred2 & 63); ph = __shfl(H[m], pred2 & 63);
                if (has2) { H[m] = fmaf(P[m], ph, H[m]); P[m] *= pa; }
                pa = __shfl(P[m], pred1 & 63); ph = __shfl(H[m], pred1 & 63);
                Ae[m] = has1 ? pa : 1.f; He[m] = has1 ? ph : 0.f;
                TA[m] = __shfl(P[m], lastl); TB[m] = __shfl(H[m], lastl);
            }
            if (PASS == 1) {
                float A = 1.f, B = 0.f;
#pragma unroll
                for (int i = 0; i < 4; ++i) { const int m = dir ? 3 - i : i; B = fmaf(TA[m], B, TB[m]); A *= TA[m]; }
                if (fq == 0) *(f32x2*)((float*)(ws + (SKIP ? O_CAR : O_TOT)) + (((size_t)(SKIP ? 0 : q) * 2 + dir) * 1024 + h * HD + ch) * 2) = (f32x2){A, B};
            } else {
                float C = car[dir];
#pragma unroll
                for (int i = 0; i < 4; ++i) { const int m = dir ? 3 - i : i;
                    float hh = fmaf(Ae[m], C, He[m]);
#pragma unroll
                    for (int i2 = 0; i2 < 4; ++i2) { const int jj = dir ? 3 - i2 : i2; hh = fmaf(av[m][jj], hh, bv[m][jj]); LAS float* hp = HST + (16 * m + 4 * fq + jj) * 17 + fr; if (dir == 0) *hp = hh; else *hp += hh; }
                    C = fmaf(TA[m], C, TB[m]); }
            }
        }
        if (PASS == 2) {
            LDS_WAIT(); asm volatile("" ::: "memory");
            const unsigned gu[8] = {gg0.x, gg0.y, gg0.z, gg0.w, gg1.x, gg1.y, gg1.z, gg1.w}; unsigned o[8];
#pragma unroll
            for (int i = 0; i < 8; ++i) o[i] = cvt_pk_bf16(HST[lane * 17 + 2 * i] * bf_lo(gu[i]), HST[lane * 17 + 2 * i + 1] * bf_hi(gu[i]));
            bf16* dst = (bf16*)(ws + O_HR) + (size_t)(row0 + lane) * 1024 + h * HD + 16 * w;
            *(u32x4*)dst = (u32x4){o[0], o[1], o[2], o[3]}; *(u32x4*)(dst + 8) = (u32x4){o[4], o[5], o[6], o[7]};
            LDS_WAIT(); asm volatile("" ::: "memory");
        }
    }
#undef SCAN_PREFETCH
#undef SCAN_LANE_VARS
}
__device__ __forceinline__ void carry_phase(AP a, int gw, int NGW) {
    const int lane = opq(threadIdx.x) & 63; unsigned char* ws = a->ws;
    const f32x2* TOT = (const f32x2*)(ws + O_TOT); float* CAR = (float*)(ws + O_CAR);
    for (int item = gw; item < NB * 2 * 16; item += NGW) {
        const int cgp = item & 15, dir = (item >> 4) & 1, b = item >> 5, chn = cgp * 64 + lane;
        float hc = 0.f;
#pragma unroll 4
        for (int s = 0; s < 36; ++s) {
            int q; if (dir == 0) q = s < 4 ? 256 + b * 4 + s : b * 32 + (s - 4); else q = s < 4 ? 256 + b * 4 + (3 - s) : b * 32 + (31 - (s - 4));
            const size_t o = ((size_t)q * 2 + dir) * 1024 + chn;
            CAR[o] = hc; const f32x2 ab = TOT[o]; hc = fmaf(ab.x, hc, ab.y);
        }
    }
}
#ifndef MOE_TAILSPLIT
#define MOE_TAILSPLIT 1
#endif
#ifndef SCANV
#define SCANV 2
#endif
#ifndef MOE_KSPLIT
#define MOE_KSPLIT 1
#endif
struct GridSched {
    int G, c, nM, nN, nt; const char* A; const char* B; size_t atile, btile;
    __device__ __forceinline__ bool next(int i, Unit& u) const {
        const int Lx = i * G + c; if (Lx >= nM * nN) return false;
        tile_of(Lx, nM, nN, u.pm, u.pn); u.A = A + (size_t)u.pm * atile; u.B = B + (size_t)u.pn * btile; u.nt = nt; u.kind = 0; u.x = 0; return true; }
};
struct FoldSched { int G, c; const char* DGp; const char* WUF;
    __device__ __forceinline__ bool next(int i, Unit& u) const {
        const int Lx = i * G + c; if (Lx >= 64) return false;
        const int pn = Lx & 7, g = (Lx >> 3) & 3, l = Lx >> 5;
        u.pm = 0; u.pn = pn; u.kind = g; u.x = l; { int n4 = 4; asm volatile("" : "+s"(n4)); u.nt = n4; }
        u.A = DGp; u.B = WUF + ((size_t)l * 2048 + pn * 256) * 1024 * 2 + (size_t)g * 256 * 2; return true; }
};
struct EpiFold { static constexpr bool PERM = true; bf16* WIN;
    __device__ __forceinline__ void operator()(const f32x4 (&acc)[2][2][4][2], const Unit& u, int wr, int wc, int fr, int fq) const { fr = opq(fr);
        bf16* base = WIN + (size_t)u.x * WIN_ROWS * 2048;
#pragma unroll
        for (int ai = 0; ai < 2; ++ai)
#pragma unroll
            for (int m = 0; m < 4; ++m) { const int row = u.kind * 256 + ai * HALF + wr * 64 + m * 16 + fr; bf16* rp = base + (size_t)row * 2048 + u.pn * 256 + wc * 32 + 8 * fq;
#pragma unroll
                for (int bj = 0; bj < 2; ++bj) { const f32x4 v0 = acc[ai][bj][m][0], v1 = acc[ai][bj][m][1];
                    u32x4 w; w.x = cvt_pk_bf16(v0[0], v0[1]); w.y = cvt_pk_bf16(v0[2], v0[3]); w.z = cvt_pk_bf16(v1[0], v1[1]); w.w = cvt_pk_bf16(v1[2], v1[3]); *(u32x4*)(rp + bj * HALF) = w; } __builtin_amdgcn_sched_barrier(0); }
    }
};
struct WinSched { int G, c, l; const char* HNp; const char* WINl;
    __device__ __forceinline__ bool next(int i, Unit& u) const {
        int Lx = i * G + c; const int ntok = l == 0 ? 72 : 64; const int n0 = 4 * ntok, n1 = ntok * 24, n2 = l == 0 ? 0 : 32;
        if (Lx >= n0 + n1 + n2) return false;
        u.nt = 32; u.x = 0;
        if (Lx < n0) { tile_of(Lx, 4, ntok, u.pm, u.pn); u.kind = 0; u.A = WINl + (size_t)u.pm * 256 * 2048 * 2; u.B = HNp + (size_t)u.pn * 256 * 2048 * 2; return true; }
        Lx -= n0;
        if (Lx < n1) tile_of(Lx, ntok, 24, u.pm, u.pn); else { Lx -= n1; u.pm = 64 + (Lx & 7); u.pn = Lx >> 3; }
        u.kind = 1; u.A = HNp + (size_t)u.pm * 256 * 2048 * 2; u.B = WINl + (size_t)(1024 + u.pn * 256) * 2048 * 2; return true; }
};
struct EpiWin { static constexpr bool PERM = true; bf16 *UT, *UR, *GG, *SGF, *SGR;
    __device__ __forceinline__ void operator()(const f32x4 (&acc)[2][2][4][2], const Unit& u, int wr, int wc, int fr, int fq) const { fr = opq(fr);
        if (u.kind == 0) {
#pragma unroll
            for (int ai = 0; ai < 2; ++ai)
#pragma unroll
                for (int m = 0; m < 4; ++m) { const int rho = ai * HALF + wr * 64 + m * 16 + fr, sn = rho > 128 ? 1 : 0, c = sn ? rho - 128 : rho, cm = (256 - c) & 255;
                    const int ch = u.pm * 256 + c, chm = u.pm * 256 + cm;
#pragma unroll
                    for (int bj = 0; bj < 2; ++bj) { const int r = u.pn * 256 + bj * HALF + wc * 32 + 8 * fq;
                        const size_t tof = r < RL ? (size_t)(r >> 11) * 4096 + (r & 2047) : (size_t)32768 + ((r - RL) >> 8) * 512 + ((r - RL) & 255);
                        const size_t sof = r < RL ? 2048 : 256;
                        const f32x4 v0 = acc[ai][bj][m][0], v1 = acc[ai][bj][m][1];
                        u32x4 w; w.x = cvt_pk_bf16(v0[0], v0[1]); w.y = cvt_pk_bf16(v0[2], v0[3]); w.z = cvt_pk_bf16(v1[0], v1[1]); w.w = cvt_pk_bf16(v1[2], v1[3]);
                        if (sn == 0) { *(u32x4*)(UT + (size_t)ch * UT_LD + tof) = w;
                            if (cm != c) *(u32x4*)(UT + (size_t)chm * UT_LD + tof) = w;
                            else *(u32x4*)(UT + (size_t)ch * UT_LD + tof + sof) = (u32x4){0u, 0u, 0u, 0u}; }
                        else { *(u32x4*)(UT + (size_t)ch * UT_LD + tof + sof) = w;
                            const u32x4 wn = (u32x4){w.x ^ 0x80008000u, w.y ^ 0x80008000u, w.z ^ 0x80008000u, w.w ^ 0x80008000u}; *(u32x4*)(UT + (size_t)chm * UT_LD + tof + sof) = wn; } }
                    __builtin_amdgcn_sched_barrier(0); }
        } else {
            const int pn = u.pn; bf16* base; int ldc, ct, act;
            if (pn < 4) { base = UR; ldc = 1024; ct = pn; act = 0; } else if (pn < 8) { base = GG; ldc = 1024; ct = pn - 4; act = 1; }
            else if (pn < 16) { base = SGF; ldc = 2048; ct = pn - 8; act = 2; } else { base = SGR; ldc = 2048; ct = pn - 16; act = 2; }
#pragma unroll
            for (int ai = 0; ai < 2; ++ai)
#pragma unroll
                for (int m = 0; m < 4; ++m) { const int r = u.pm * 256 + ai * HALF + wr * 64 + m * 16 + fr; bf16* rp = base + (size_t)r * ldc + ct * 256 + wc * 32 + 8 * fq;
#pragma unroll
                    for (int bj = 0; bj < 2; ++bj) { f32x4 v0 = acc[ai][bj][m][0], v1 = acc[ai][bj][m][1];
                        if (act == 1) {
#pragma unroll
                            for (int j = 0; j < 4; ++j) { v0[j] = fgelu(v0[j]); v1[j] = fgelu(v1[j]); } }
                        else if (act == 2) {
#pragma unroll
                            for (int j = 0; j < 4; ++j) { v0[j] = fsigm(v0[j]); v1[j] = fsigm(v1[j]); } }
                        u32x4 w; w.x = cvt_pk_bf16(v0[0], v0[1]); w.y = cvt_pk_bf16(v0[2], v0[3]); w.z = cvt_pk_bf16(v1[0], v1[1]); w.w = cvt_pk_bf16(v1[2], v1[3]); *(u32x4*)(rp + bj * HALF) = w; } __builtin_amdgcn_sched_barrier(0); }
        }
    }
};
struct DftSched { int G, c, l; const char* FLp; const char* FLCp; const char* UTp;
    __device__ __forceinline__ bool next(int i, Unit& u) const {
        int Lx = i * G + c; const int n0 = 256, n1 = l == 0 ? 32 : 0;
        if (Lx >= n0 + n1) return false;
        if (Lx < n0) { const int b = Lx & 7, rest = Lx >> 3, pn = rest & 3, pm = rest >> 2; u.pm = pm; u.pn = pn; u.kind = 0; u.x = b; u.nt = 64;
            u.A = FLp + (size_t)pm * 256 * 4096 * 2; u.B = UTp + ((size_t)pn * 256 * UT_LD + (size_t)b * 4096) * 2; return true; }
        Lx -= n0; { const int b = Lx & 7, pn = Lx >> 3; u.pm = 0; u.pn = pn; u.kind = 1; u.x = b; u.nt = 8;
            u.A = FLCp; u.B = UTp + ((size_t)pn * 256 * UT_LD + 32768 + (size_t)b * 512) * 2; return true; }
    }
};
struct EpiBf16Rows { static constexpr bool PERM = true; bf16* O; int ldc;
    bool dft;
    __device__ __forceinline__ void operator()(const f32x4 (&acc)[2][2][4][2], const Unit& u, int wr, int wc, int fr, int fq) const { fr = opq(fr);
        const int row0 = dft ? (u.kind == 0 ? u.x * 2048 + u.pm * 256 : RL + u.x * 256) : u.pm * 256 + u.x * MAXSLOT;
#pragma unroll
        for (int ai = 0; ai < 2; ++ai)
#pragma unroll
            for (int m = 0; m < 4; ++m) { bf16* rp = O + (size_t)(row0 + ai * HALF + wr * 64 + m * 16 + fr) * ldc + u.pn * 256 + wc * 32 + 8 * fq;
#pragma unroll
                for (int bj = 0; bj < 2; ++bj) { const f32x4 v0 = acc[ai][bj][m][0], v1 = acc[ai][bj][m][1];
                    u32x4 w; w.x = cvt_pk_bf16(v0[0], v0[1]); w.y = cvt_pk_bf16(v0[2], v0[3]); w.z = cvt_pk_bf16(v1[0], v1[1]); w.w = cvt_pk_bf16(v1[2], v1[3]); *(u32x4*)(rp + bj * HALF) = w; } __builtin_amdgcn_sched_barrier(0); }
    }
};
template <bool ADD> struct EpiGate { static constexpr bool PERM = true; bf16* O; const bf16* gate; const bf16* addend;
    __device__ __forceinline__ void operator()(const f32x4 (&acc)[2][2][4][2], const Unit& u, int wr, int wc, int fr, int fq) const { fr = opq(fr);
#pragma unroll
        for (int ai = 0; ai < 2; ++ai) {
            u32x4 g[4][2], t[4][2];
#pragma unroll
            for (int m = 0; m < 4; ++m) { const size_t off = (size_t)(u.pm * 256 + ai * HALF + wr * 64 + m * 16 + fr) * 2048 + u.pn * 256 + wc * 32 + 8 * fq;
#pragma unroll
                for (int bj = 0; bj < 2; ++bj) { g[m][bj] = *(const u32x4*)(gate + off + bj * HALF); if (ADD) t[m][bj] = *(const u32x4*)(addend + off + bj * HALF); } }
#pragma unroll
            for (int m = 0; m < 4; ++m) { const size_t off = (size_t)(u.pm * 256 + ai * HALF + wr * 64 + m * 16 + fr) * 2048 + u.pn * 256 + wc * 32 + 8 * fq;
#pragma unroll
                for (int bj = 0; bj < 2; ++bj) { const f32x4 v0 = acc[ai][bj][m][0], v1 = acc[ai][bj][m][1]; const u32x4 gg = g[m][bj];
                    float o[8] = {v0[0] * bf_lo(gg.x), v0[1] * bf_hi(gg.x), v0[2] * bf_lo(gg.y), v0[3] * bf_hi(gg.y), v1[0] * bf_lo(gg.z), v1[1] * bf_hi(gg.z), v1[2] * bf_lo(gg.w), v1[3] * bf_hi(gg.w)};
                    if (ADD) { const u32x4 tt = t[m][bj];
                        o[0] += bf_lo(tt.x); o[1] += bf_hi(tt.x); o[2] += bf_lo(tt.y); o[3] += bf_hi(tt.y); o[4] += bf_lo(tt.z); o[5] += bf_hi(tt.z); o[6] += bf_lo(tt.w); o[7] += bf_hi(tt.w); }
                    u32x4 w; w.x = cvt_pk_bf16(o[0], o[1]); w.y = cvt_pk_bf16(o[2], o[3]); w.z = cvt_pk_bf16(o[4], o[5]); w.w = cvt_pk_bf16(o[6], o[7]); *(u32x4*)(O + off + bj * HALF) = w; } }
            asm volatile("" ::: "memory"); __builtin_amdgcn_sched_barrier(0); }
    }
};
template <bool FIRST> struct EpiResid { static constexpr bool PERM = false; float* lat; const float* modl; int gate_chunk; const float* x0; const float* c0;
    __device__ __forceinline__ void operator()(const f32x4 (&acc)[2][2][4][2], const Unit& u, int wr, int wc, int fr, int fq) const { fr = opq(fr);
        const int bi = u.pm < 64 ? (u.pm >> 3) : 8; const int col0 = u.pn * 256 + wc * 32 + 4 * fq;
        const float* gp = modl + (size_t)bi * 12288 + gate_chunk * D + col0;
        f32x4 gv[2][2];
#pragma unroll
        for (int bj = 0; bj < 2; ++bj)
#pragma unroll
            for (int n = 0; n < 2; ++n) gv[bj][n] = *(const f32x4*)(gp + bj * HALF + n * 16);
#pragma unroll
        for (int ai = 0; ai < 2; ++ai) {
            f32x4 bsv[4][2][2];
#pragma unroll
            for (int m = 0; m < 4; ++m) { const int row = u.pm * 256 + ai * HALF + wr * 64 + m * 16 + fr; const float* rp = lat + (size_t)row * D + col0;
                const float* bp = FIRST ? (u.pm < 64 ? x0 + (size_t)row * D + col0 : c0 + (size_t)(row - RL) * D + col0) : rp;
#pragma unroll
                for (int bj = 0; bj < 2; ++bj)
#pragma unroll
                    for (int n = 0; n < 2; ++n) bsv[m][bj][n] = *(const f32x4*)(bp + bj * HALF + n * 16); }
#pragma unroll
            for (int m = 0; m < 4; ++m) { const int row = u.pm * 256 + ai * HALF + wr * 64 + m * 16 + fr; float* rp = lat + (size_t)row * D + col0;
#pragma unroll
                for (int bj = 0; bj < 2; ++bj)
#pragma unroll
                    for (int n = 0; n < 2; ++n) *(f32x4*)(rp + bj * HALF + n * 16) = bsv[m][bj][n] + gv[bj][n] * acc[ai][bj][m][n]; }
            asm volatile("" ::: "memory"); __builtin_amdgcn_sched_barrier(0); }
    }
};
struct EpiSwiglu { static constexpr bool PERM = true; bf16* O; int ldc;
    __device__ __forceinline__ void operator()(const f32x4 (&acc)[2][2][4][2], const Unit& u, int wr, int wc, int fr, int fq) const { fr = opq(fr);
#pragma unroll
        for (int ai = 0; ai < 2; ++ai)
#pragma unroll
            for (int m = 0; m < 4; ++m) { bf16* rp = O + (size_t)(u.pm * 256 + ai * HALF + wr * 64 + m * 16 + fr) * ldc + u.pn * 128 + wc * 32 + 8 * fq;
                const f32x4 g0 = acc[ai][0][m][0], g1 = acc[ai][0][m][1], u0 = acc[ai][1][m][0], u1 = acc[ai][1][m][1];
                u32x4 w; w.x = cvt_pk_bf16(fsilu(g0[0]) * u0[0], fsilu(g0[1]) * u0[1]); w.y = cvt_pk_bf16(fsilu(g0[2]) * u0[2], fsilu(g0[3]) * u0[3]);
                w.z = cvt_pk_bf16(fsilu(g1[0]) * u1[0], fsilu(g1[1]) * u1[1]); w.w = cvt_pk_bf16(fsilu(g1[2]) * u1[2], fsilu(g1[3]) * u1[3]); *(u32x4*)rp = w; __builtin_amdgcn_sched_barrier(0); }
    }
};
struct MoeSched { int G, c, nN, nt; const LAS int* tbl; const char* A; const char* B; size_t atile, btile, bexp; int ksplit; size_t khalf;
    __device__ __forceinline__ bool next(int i, Unit& u) const {
        int Lx = i * G + c; const int total = tbl[8] * nN; if (Lx >= total * ksplit) return false;
        int kh = 0; if (ksplit == 2) { kh = Lx >= total ? 1 : 0; Lx -= kh * total; }
        int e = 0;
#pragma unroll
        for (int k = 1; k < 8; ++k) e += (Lx >= tbl[k] * nN) ? 1 : 0;
        const int t0 = tbl[e], te = tbl[e + 1] - t0, lx = Lx - t0 * nN;
        { int pml, pnl; tile_of(lx, te, nN, pml, pnl); u.pm = t0 + pml; u.pn = pnl; }
        u.kind = e; u.x = kh; u.nt = nt;
        u.A = A + (size_t)u.pm * atile + (size_t)kh * khalf; u.B = B + (size_t)e * bexp + (size_t)u.pn * btile + (size_t)kh * khalf; return true; }
};


struct MoeDownSched { int G, c, sp; const LAS int* tbl; const char* A; const char* B; size_t atile, btile, bexp;
    __device__ __forceinline__ bool next(int i, Unit& u) const {
        const int U = tbl[8] * 8, full = U / G, R = U - full * G;
        int Lx = i * G + c, k = 0, rr = -1;
        if (i > full) return false;
        if (i == full) { if (sp > 1) { if (c >= R * sp) return false; rr = c / sp; k = c - rr * sp; Lx = full * G + rr; } else if (c >= R) return false; }
        int e = 0;
#pragma unroll
        for (int kk = 1; kk < 8; ++kk) e += (Lx >= tbl[kk] * 8) ? 1 : 0;
        const int t0 = tbl[e], te = tbl[e + 1] - t0, lx = Lx - t0 * 8;
        { int pml, pnl; tile_of(lx, te, 8, pml, pnl); u.pm = t0 + pml; u.pn = pnl; }
        u.kind = e; const int nts = rr < 0 ? 112 : 112 / sp; u.nt = nts; u.x = rr < 0 ? 0 : 1 + rr * 16 + k;
        u.A = A + (size_t)u.pm * atile + (size_t)k * nts * 128; u.B = B + (size_t)e * bexp + (size_t)u.pn * btile + (size_t)k * nts * 128; return true; }
};
struct EpiMoeDown { static constexpr bool PERM = true; bf16* O; float* part; unsigned* cnt; int sp;
    __device__ __forceinline__ void store_rows(const f32x4 (&v)[2][2][4][2], const Unit& u, int wr, int wc, int fr, int fq) const {
#pragma unroll
        for (int ai = 0; ai < 2; ++ai)
#pragma unroll
            for (int m = 0; m < 4; ++m) { bf16* rp = O + (size_t)(u.pm * 256 + ai * HALF + wr * 64 + m * 16 + fr) * 2048 + u.pn * 256 + wc * 32 + 8 * fq;
#pragma unroll
                for (int bj = 0; bj < 2; ++bj) { const f32x4 v0 = v[ai][bj][m][0], v1 = v[ai][bj][m][1];
                    u32x4 w; w.x = cvt_pk_bf16(v0[0], v0[1]); w.y = cvt_pk_bf16(v0[2], v0[3]); w.z = cvt_pk_bf16(v1[0], v1[1]); w.w = cvt_pk_bf16(v1[2], v1[3]); *(u32x4*)(rp + bj * HALF) = w; } __builtin_amdgcn_sched_barrier(0); }
    }
    template <int SP> __device__ __forceinline__ void reduce_store(const float* P0, const Unit& u, int wr, int wc, int fr, int fq) const {
        constexpr int NPB = SP <= 4 ? 4 : (SP <= 8 ? 2 : 1);
#pragma unroll
        for (int ai = 0; ai < 2; ++ai)
#pragma unroll
            for (int m = 0; m < 4; ++m) { bf16* rp = O + (size_t)(u.pm * 256 + ai * HALF + wr * 64 + m * 16 + fr) * 2048 + u.pn * 256 + wc * 32 + 8 * fq;
                f32x4 v[4];
#pragma unroll
                for (int p0 = 0; p0 < 4; p0 += NPB) { f32x4 t[NPB][SP];
#pragma unroll
                    for (int pp = 0; pp < NPB; ++pp) { const int idx = (ai * 4 + m) * 4 + p0 + pp;
#pragma unroll
                        for (int kk = 0; kk < SP; ++kk) t[pp][kk] = *(const f32x4*)(P0 + ((size_t)kk << 16) + idx * 2048); }
#pragma unroll
                    for (int pp = 0; pp < NPB; ++pp) { f32x4 a4 = t[pp][0];
#pragma unroll
                        for (int kk = 1; kk < SP; ++kk) a4 += t[pp][kk];
                        v[p0 + pp] = a4; }
                    asm volatile("" ::: "memory"); }
#pragma unroll
                for (int bj = 0; bj < 2; ++bj) { u32x4 w; w.x = cvt_pk_bf16(v[2 * bj][0], v[2 * bj][1]); w.y = cvt_pk_bf16(v[2 * bj][2], v[2 * bj][3]); w.z = cvt_pk_bf16(v[2 * bj + 1][0], v[2 * bj + 1][1]); w.w = cvt_pk_bf16(v[2 * bj + 1][2], v[2 * bj + 1][3]);
                    *(u32x4*)(rp + bj * HALF) = w; }
                __builtin_amdgcn_sched_barrier(0); }
    }
    __device__ __forceinline__ void operator()(const f32x4 (&acc)[2][2][4][2], const Unit& u, int wr, int wc, int fr, int fq) const { fr = opq(fr);
        if (u.x == 0) { store_rows(acc, u, wr, wc, fr, fq); return; }
        const int rr = (u.x - 1) >> 4, k = (u.x - 1) & 15, wid = wr * 4 + wc, tl = wid * 64 + fq * 16 + fr;
        float* P = part + ((size_t)(rr * sp + k) << 16) + (size_t)tl * 4;
#pragma unroll
        for (int ai = 0; ai < 2; ++ai)
#pragma unroll
            for (int m = 0; m < 4; ++m)
#pragma unroll
                for (int bj = 0; bj < 2; ++bj)
#pragma unroll
                    for (int n = 0; n < 2; ++n) { const int idx = ((ai * 4 + m) * 2 + bj) * 2 + n; float* q = P + idx * 2048; const f32x4 vv = acc[ai][bj][m][n];
                        asm volatile("global_store_dwordx4 %0, %1, off sc1" :: "v"(q), "v"(vv) : "memory"); }
        asm volatile("s_waitcnt vmcnt(0)" ::: "memory");
        unsigned tk = 0u; if (fq * 16 + fr == 0) tk = __hip_atomic_fetch_add(cnt + rr * 8 + wid, 1u, __ATOMIC_RELAXED, __HIP_MEMORY_SCOPE_AGENT);
        tk = (unsigned)__builtin_amdgcn_readfirstlane((int)tk);
        if (tk + 1u == (unsigned)sp) {
            __builtin_amdgcn_fence(__ATOMIC_ACQUIRE, "agent"); asm volatile("s_waitcnt vmcnt(0)" ::: "memory");
            const float* P0 = part + ((size_t)(rr * sp) << 16) + (size_t)tl * 4;
            switch (sp) { case 2: reduce_store<2>(P0, u, wr, wc, fr, fq); break; case 4: reduce_store<4>(P0, u, wr, wc, fr, fq); break; case 7: reduce_store<7>(P0, u, wr, wc, fr, fq); break;
                          case 8: reduce_store<8>(P0, u, wr, wc, fr, fq); break; default: reduce_store<14>(P0, u, wr, wc, fr, fq); break; }
        }
    }
};

__device__ __forceinline__ void moe_gather(AP a, LAS unsigned char* lds, int vcu, int G) {
    const int tid = opq(threadIdx.x), lane = tid & 63, w = tid >> 6; unsigned char* ws = a->ws;
    LAS int* cl = (LAS int*)lds;
    LAS int* pre = cl + 2048;
    LAS int* off = pre + 8;
    LAS int* tot = off + 24;
    LAS int* sl = tot + 8;
    const int* cntb = (const int*)(ws + O_MISC + M_CNTB); const int* sel = (const int*)(ws + O_MISC + M_SEL);
    int* slot_of = (int*)(ws + O_MISC + M_SLOT);
    const bf16* HN = (const bf16*)(ws + O_HN); bf16* XG = (bf16*)(ws + O_XG);
    for (int i = tid; i < 2048; i += NTHREADS) cl[i] = cntb[i];
    __syncthreads();
    for (int g = vcu; g < 256; g += G) {
        if (tid < 8) { int s = 0, p = 0;
#pragma unroll 8
            for (int j = 0; j < 256; ++j) { const int v = cl[j * 8 + tid]; p += (j < g) ? v : 0; s += v; }
            pre[tid] = p; tot[tid] = s; }
        __syncthreads();
        if (tid == 0) { int o = 0; for (int e = 0; e < 8; ++e) { off[e] = o * 256; off[8 + e] = o; o += (tot[e] + 255) >> 8; } off[16] = o;
            if (g == 0) { int* T = (int*)(ws + O_MISC + M_TOT); for (int e = 0; e < 8; ++e) T[e] = tot[e]; for (int e = 0; e < 9; ++e) T[16 + e] = off[8 + e]; } }
        __syncthreads();
        if (w == 0) { const int tkn = g * 64 + lane; const int s0 = sel[tkn * 2], s1 = sel[tkn * 2 + 1]; int slot0 = 0, slot1 = 0;
            const unsigned long long lt = (1ull << lane) - 1ull;
#pragma unroll
            for (int e = 0; e < 8; ++e) { const unsigned long long mk = __ballot(s0 == e || s1 == e); const int rk = __popcll(mk & lt);
                if (s0 == e) slot0 = off[e] + pre[e] + rk; if (s1 == e) slot1 = off[e] + pre[e] + rk; }
            slot_of[tkn * 2] = slot0; slot_of[tkn * 2 + 1] = slot1; sl[lane * 2] = slot0; sl[lane * 2 + 1] = slot1; }
        __syncthreads();
        for (int p0 = w * 16; p0 < w * 16 + 16; p0 += 4) { u32x4 v[4][4];
#pragma unroll
            for (int r = 0; r < 4; ++r) { const int tkn = g * 64 + ((p0 + r) >> 1); const u32x4* sp_ = (const u32x4*)(HN + (size_t)tkn * D) + lane;
#pragma unroll
                for (int j = 0; j < 4; ++j) v[r][j] = sp_[64 * j]; }
#pragma unroll
            for (int r = 0; r < 4; ++r) { const int slot = sl[p0 + r]; u32x4* d = (u32x4*)(XG + (size_t)slot * D) + lane;
#pragma unroll
                for (int j = 0; j < 4; ++j) d[64 * j] = v[r][j]; } }
        if (g < 8) { const int r0 = off[g] + tot[g], r1 = off[g] + (((tot[g] + 255) >> 8) << 8);
            for (int r = r0 + w; r < r1; r += NWAVES) { u32x4* d = (u32x4*)(XG + (size_t)r * D) + lane;
#pragma unroll
                for (int j = 0; j < 4; ++j) d[64 * j] = (u32x4){0u, 0u, 0u, 0u}; } }
        __syncthreads();
    }
}
__device__ __forceinline__ void moe_combine_row(AP a, int row, int lane) {
    unsigned char* ws = a->ws;
    const int* slot_of = (const int*)(ws + O_MISC + M_SLOT); const float* gwt = (const float*)(ws + O_MISC + M_GWT);
    const int s0 = slot_of[row * 2], s1 = slot_of[row * 2 + 1]; const float w0 = gwt[row * 2], w1 = gwt[row * 2 + 1];
    const float* g2 = (const float*)(ws + O_MOD) + ((size_t)9 + (row >> 11)) * 12288 + 5 * D;
    const f32x4* xr = (const f32x4*)((const float*)(ws + O_LAT) + (size_t)row * D);
    const u32x2* o0 = (const u32x2*)((const bf16*)(ws + O_OS) + (size_t)s0 * D); const u32x2* o1 = (const u32x2*)((const bf16*)(ws + O_OS) + (size_t)s1 * D);
    const u32x2* q0 = o0 + (size_t)MAXSLOT * D / 4; const u32x2* q1 = o1 + (size_t)MAXSLOT * D / 4;
    f32x4 v[8]; float s = 0.f;
#pragma unroll
    for (int j = 0; j < 8; ++j) { const int i4 = lane + 64 * j; const u32x2 p0 = o0[i4], p1 = o1[i4], zz = (u32x2){0u, 0u}, r0 = MOE_KSPLIT == 2 ? q0[i4] : zz, r1 = MOE_KSPLIT == 2 ? q1[i4] : zz; const f32x4 gg = *(const f32x4*)(g2 + i4 * 4);
        f32x4 m; m.x = w0 * (bf_lo(p0.x) + bf_lo(r0.x)) + w1 * (bf_lo(p1.x) + bf_lo(r1.x)); m.y = w0 * (bf_hi(p0.x) + bf_hi(r0.x)) + w1 * (bf_hi(p1.x) + bf_hi(r1.x));
        m.z = w0 * (bf_lo(p0.y) + bf_lo(r0.y)) + w1 * (bf_lo(p1.y) + bf_lo(r1.y)); m.w = w0 * (bf_hi(p0.y) + bf_hi(r0.y)) + w1 * (bf_hi(p1.y) + bf_hi(r1.y));
        v[j] = xr[i4] + gg * m; s += (v[j].x * v[j].x + v[j].y * v[j].y) + (v[j].z * v[j].z + v[j].w * v[j].w); }
    const float rstd = rsqrtf(wave_sum(s) * (1.f / D) + 1e-6f);
    f32x4* out = (f32x4*)(a->out + (size_t)row * D);
#pragma unroll
    for (int j = 0; j < 8; ++j) { const int i4 = lane + 64 * j; out[i4] = v[j] * rstd * *(const f32x4*)(a->in[26] + i4 * 4); }
}

constexpr int NPHASE = 26;
constexpr int l_min(int a, int b) { return a < b ? a : b; }
#ifndef PROBE_PHASE
#define PROBE_PHASE (-1)
#endif
#define REPS(k) (((k) == PROBE_PHASE) ? 2 : 1)
#ifndef CVB
#define CVB 100
#endif
constexpr int cvb(int n) { return (int)((long long)n * CVB / 100); }
#ifndef CVQ
#define CVQ 5000, 5000, 11000, 9000, 30000, 10000
#endif
constexpr int cvq[6] = {CVQ};
constexpr int CV_T10 = 0, CV_T11 = CV_T10 + cvb(cvq[0]), CV_MG0 = CV_T11, CV_MG1 = CV_MG0 + cvb(cvq[1]), CV_OUT0 = CV_MG1, CV_OUT1 = CV_OUT0 + cvb(cvq[2]), CV_FG0 = CV_OUT1, CV_FG1 = CV_FG0 + cvb(cvq[3]),
              CV_FD0 = CV_FG1, CV_FD1 = CV_FD0 + cvb(cvq[4]), CV_WI0 = CV_FD1, CV_WI1 = CV_WI0 + cvb(cvq[5]), CV_FLUSH = l_min(CV_WI1, N_MOE);
#define TAILCVT(total, c0, c1) do { const int rem_ = (total) % G; if (l == 0 || (c0) == CV_WI0) { if (rem_ != 0 && bx >= rem_ && (c0) < N_MOE) cvt_moe_range(argp, lds, (c0), l_min((c1), N_MOE), (bx - rem_) * NWAVES + wave, (G - rem_) * NWAVES); __syncthreads(); } } while (0)
template <int l>
__device__ __forceinline__ void layer_phases(LAS unsigned char* lds, unsigned char* ws, const int lo, const int hi, const XcdBarrier& bar, const int G, const int bx, const int vcu, const int gw, const int NGW, const int tid, const int lane, const int wave) {
#define args (*kargs())
#define argp (kargs())
#define IN(k) (lo <= (k) && (k) < hi)
#define SEAM(k) do { if (IN(k) && IN((k) + 1)) xcd_barrier(bar); } while (0)
    const char* HNp = (const char*)(ws + O_HN);
    float* LAT = (float*)(ws + O_LAT);
        const int pb = 2 + 12 * l;
        const float* modl = (const float*)(ws + O_MOD) + (size_t)l * 9 * 12288;
        const int ntok = l == 0 ? 72 : 64;
        if (IN(pb + 0)) for (int rep = 0; rep < REPS(pb + 0); ++rep) { WinSched S{G, bx, l, HNp, (const char*)(ws + O_WIN) + (size_t)l * WIN_ROWS * 2048 * 2};
            EpiWin E{(bf16*)(ws + O_UT), (bf16*)(ws + O_UR), (bf16*)(ws + O_GG), (bf16*)(ws + O_SGF), (bf16*)(ws + O_SGR)}; gemm_phase<EpiWin, WinSched>(lds, 2048, 2048, S, E); if (l == 1) TAILCVT(1824, CV_WI0, CV_WI1); }
        SEAM(pb + 0);
        if (IN(pb + 1)) for (int rep = 0; rep < REPS(pb + 1); ++rep) {
#if defined(PROBE_SKIP)
            if (rep == 1) scan_phase2<1, PROBE_SKIP>(argp, lds, l, NCHUNK * 8, vcu, G); else
#endif
            if (SCANV == 2) scan_phase2<1>(argp, lds, l, NCHUNK * 8, vcu, G); else scan_phase<1>(argp, lds, l, NCHUNK * 8, vcu, G); }
        SEAM(pb + 1);
        if (IN(pb + 2)) for (int rep = 0; rep < REPS(pb + 2); ++rep) { DftSched S{G, bx, l, (const char*)(ws + O_FL), (const char*)(ws + O_FLC), (const char*)(ws + O_UT)}; EpiBf16Rows E{(bf16*)(ws + O_Y), 1024, true};
            gemm_phase<EpiBf16Rows, DftSched>(lds, 4096, UT_LD, S, E); carry_phase(argp, opq(gw), NGW); }
        SEAM(pb + 2);
        if (IN(pb + 3)) for (int rep = 0; rep < REPS(pb + 3); ++rep) { GridSched S{G, bx, ntok, 8, 16, (const char*)(ws + O_Y), (const char*)(ws + O_WFO) + (size_t)l * 2048 * 1024 * 2, (size_t)256 * 1024 * 2, (size_t)256 * 1024 * 2};
            EpiGate<false> E{(bf16*)(ws + O_T1), (const bf16*)(ws + O_SGF), nullptr}; gemm_phase<EpiGate<false>, GridSched>(lds, 1024, 1024, S, E); TAILCVT(ntok * 8, CV_T10, CV_T11);
            if (SCANV == 2) scan_phase2<2>(argp, lds, l, (l == 0 ? NCHUNK : 256) * 8, vcu, G); else scan_phase<2>(argp, lds, l, (l == 0 ? NCHUNK : 256) * 8, vcu, G); }
        SEAM(pb + 3);
        if (IN(pb + 4)) for (int rep = 0; rep < REPS(pb + 4); ++rep) { GridSched S{G, bx, ntok, 8, 16, (const char*)(ws + O_HR), (const char*)(ws + O_WRO) + (size_t)l * 2048 * 1024 * 2, (size_t)256 * 1024 * 2, (size_t)256 * 1024 * 2};
            EpiGate<true> E{(bf16*)(ws + O_MG), (const bf16*)(ws + O_SGR), (const bf16*)(ws + O_T1)}; gemm_phase<EpiGate<true>, GridSched>(lds, 1024, 1024, S, E); TAILCVT(ntok * 8, CV_MG0, CV_MG1); }
        SEAM(pb + 4);
        if (IN(pb + 5)) { GridSched S{G, bx, ntok, 8, 32, (const char*)(ws + O_MG), (const char*)(ws + O_WO) + (size_t)l * 2048 * 2048 * 2, (size_t)256 * 2048 * 2, (size_t)256 * 2048 * 2};
            EpiResid<l == 0> E{LAT, modl, 2, args.in[0], args.in[2]}; gemm_phase<EpiResid<l == 0>, GridSched>(lds, 2048, 2048, S, E); TAILCVT(ntok * 8, CV_OUT0, CV_OUT1); }
        SEAM(pb + 5);
        if (IN(pb + 6)) for (int rep = 0; rep < REPS(pb + 6); ++rep) {
            if (l == 0) { for (int r = gw; r < R; r += NGW) norm_row<false>(LAT + (size_t)r * D, args.in[7], modl, 3, 4, (bf16*)(ws + O_HN), r, opq(lane), nullptr, nullptr, nullptr); }
            else {
                LAS float* rt = (LAS float*)lds; for (int i = tid; i < 2048 * 8; i += NTHREADS) rt[i] = args.in[22][i];
                LAS int* gs = (LAS int*)(lds + 65536);
                __syncthreads();
                int* sel = (int*)(ws + O_MISC + M_SEL); float* gwt = (float*)(ws + O_MISC + M_GWT); int* cntb = (int*)(ws + O_MISC + M_CNTB);
                for (int g = vcu; g < 256; g += G) {
                    for (int k = 0; k < 8; ++k) { const int r = g * 64 + wave * 8 + k; const int pk = norm_row<true>(LAT + (size_t)r * D, args.in[7] + D, modl, 3, 4, (bf16*)(ws + O_HN), r, opq(lane), rt, sel, gwt);
                        if (lane == 0) { gs[(wave * 8 + k) * 2] = pk & 255; gs[(wave * 8 + k) * 2 + 1] = pk >> 8; } }
                    __syncthreads();
                    if (wave == 0) { const int s0 = gs[lane * 2], s1 = gs[lane * 2 + 1];
#pragma unroll
                        for (int e = 0; e < 8; ++e) { const unsigned long long mk = __ballot(s0 == e || s1 == e); if (lane == e) cntb[g * 8 + e] = __popcll(mk); } }
                    __syncthreads();
                }
            }
        }
        SEAM(pb + 6);
        if (l == 1) { if (IN(pb + 7)) { moe_gather(argp, lds, vcu, G); __syncthreads(); cvt_moe_range(argp, lds, CV_FLUSH, N_MOE, gw, NGW); } SEAM(pb + 7); }
        if (IN(pb + 8)) for (int rep = 0; rep < REPS(pb + 8); ++rep) {
            if (l == 0) { GridSched S{G, bx, 72, 44, 32, HNp, (const char*)(ws + O_FGU), (size_t)256 * 2048 * 2, (size_t)256 * 2048 * 2};
#if defined(PROBE_ALT)
#if PROBE_ALT == 2
                if (rep == 1) { EpiSwiglu E{(bf16*)(ws + O_HIDM + (size_t)80 * 1024 * 1024), DFF}; gemm_phase<EpiSwiglu, GridSched>(lds, 2048, 2048, S, E); } else
#else
                if (rep == 1) { EpiNull E{(float*)(ws + O_HIDM)}; gemm_phase<EpiNull, GridSched>(lds, 2048, 2048, S, E); } else
#endif
#endif
                { EpiSwiglu E{(bf16*)(ws + O_HID), DFF}; gemm_phase<EpiSwiglu, GridSched>(lds, 2048, 2048, S, E); TAILCVT(72 * 44, CV_FG0, CV_FG1); } }
            else { LAS int* tbl = (LAS int*)(lds + MISC_OFF + 256); if (tid < 9) tbl[tid] = ((const int*)(ws + O_MISC + M_TOT))[16 + tid]; __syncthreads();
                MoeSched S{G, bx, 56, 32, tbl, (const char*)(ws + O_XG), (const char*)(ws + O_MGU), (size_t)256 * 2048 * 2, (size_t)256 * 2048 * 2, (size_t)14336 * 2048 * 2, 1, 0};
                EpiSwiglu E{(bf16*)(ws + O_HIDM), DE}; gemm_phase<EpiSwiglu, MoeSched>(lds, 2048, 2048, S, E); }
        }
        SEAM(pb + 8);
        if (IN(pb + 9)) for (int rep = 0; rep < (l == 1 ? REPS(pb + 9) : 1); ++rep) {
            if (l == 0) { GridSched S{G, bx, 72, 8, 88, (const char*)(ws + O_HID), (const char*)(ws + O_FD), (size_t)256 * DFF * 2, (size_t)256 * DFF * 2};
                EpiResid<false> E{LAT, modl, 5, nullptr, nullptr}; gemm_phase<EpiResid<false>, GridSched>(lds, DFF, DFF, S, E); TAILCVT(72 * 8, CV_FD0, CV_FD1); }
            else { LAS int* tbl = (LAS int*)(lds + MISC_OFF + 256); if (tid < 9) tbl[tid] = ((const int*)(ws + O_MISC + M_TOT))[16 + tid]; __syncthreads();
#if MOE_TAILSPLIT
                int sp = 1; { const int U = tbl[8] * 8, R = U % G; if (R > 0) { if (R * 14 <= G) sp = 14; else if (R * 8 <= G) sp = 8; else if (R * 7 <= G) sp = 7; else if (R * 4 <= G) sp = 4; else if (R * 2 <= G) sp = 2; } }
                MoeDownSched S{G, bx, sp, tbl, (const char*)(ws + O_HIDM), (const char*)(ws + O_MD), (size_t)256 * DE * 2, (size_t)256 * DE * 2, (size_t)2048 * DE * 2};
                EpiMoeDown E{(bf16*)(ws + O_OS), (float*)(ws + O_XG), (unsigned*)(ws + O_CTL) + CW_MOEC, sp}; gemm_phase<EpiMoeDown, MoeDownSched>(lds, DE, DE, S, E); }
#else
                MoeSched S{G, bx, 8, 112 / MOE_KSPLIT, tbl, (const char*)(ws + O_HIDM), (const char*)(ws + O_MD), (size_t)256 * DE * 2, (size_t)256 * DE * 2, (size_t)2048 * DE * 2, MOE_KSPLIT, (size_t)3584 * 2};
                EpiBf16Rows E{(bf16*)(ws + O_OS), 2048, false}; gemm_phase<EpiBf16Rows, MoeSched>(lds, DE, DE, S, E); }
#endif
        }
        SEAM(pb + 9);
        if (IN(pb + 10)) for (int rep = 0; rep < REPS(pb + 10); ++rep) {
            if (l == 0) { for (int r = gw; r < R; r += NGW) norm_row<false>(LAT + (size_t)r * D, args.in[6] + D, (const float*)(ws + O_MOD) + (size_t)9 * 12288, 0, 1, (bf16*)(ws + O_HN), r, opq(lane), nullptr, nullptr, nullptr); }
            else { for (int r = gw; r < RL; r += NGW) moe_combine_row(argp, r, opq(lane)); }
        }
        if (l == 0) SEAM(pb + 11);
    #undef IN
#undef SEAM
#undef args
#undef argp
}
__global__ void __launch_bounds__(NTHREADS, 2) mega(Args args_unused) {
#define args (*kargs())
#define argp (kargs())
    extern __shared__ __attribute__((aligned(16))) unsigned char lds_raw[];
    LAS unsigned char* lds = (LAS unsigned char*)lds_raw;
    volatile LAS unsigned* MISC = (volatile LAS unsigned*)(lds + MISC_OFF);
    int tid = threadIdx.x; asm volatile("" : "+v"(tid));
    const int lane = tid & 63, wave = __builtin_amdgcn_readfirstlane(tid >> 6);
    const int G = gridDim.x, bx = blockIdx.x; const int vcu = (G % 8 == 0) ? (bx % 8) * (G / 8) + bx / 8 : bx;
    const int gw = vcu * NWAVES + wave, NGW = G * NWAVES;
    unsigned char* ws = args.ws;
    for (int u = tid; u < 128; u += NTHREADS) MISC[u] = 0u;
    __syncthreads();
    const int lo = args.ph_lo, hi = args.ph_hi;
    XcdBarrier bar; bar.bar = (unsigned*)(ws + O_CTL) + CW_BAR; bar.x = 0; bar.st = nullptr;
    if (hi - lo > 1) bar = xcd_barrier_post((unsigned*)(ws + O_CTL) + CW_BAR + args.bar_region * XCD_BAR_WORDS, MISC + 8);
#define IN(k) (lo <= (k) && (k) < hi)
#define SEAM(k) do { if (IN(k) && IN((k) + 1)) xcd_barrier(bar); } while (0)
    const char* HNp = (const char*)(ws + O_HN);
    float* LAT = (float*)(ws + O_LAT);

    if (IN(0)) for (int rep = 0; rep < REPS(0); ++rep) { __syncthreads(); p0_ada(argp, lds, vcu, G); __syncthreads(); p0_convert(argp, lds, gw, NGW); __syncthreads();
        { LAS f32x2* tab = (LAS f32x2*)lds; for (int m = tid; m < 2048; m += NTHREADS) { float sn, cs; sincospif((float)m * (1.f / 1024.f), &sn, &cs); tab[m] = (f32x2){cs * 0.022097086912079608f, sn * 0.022097086912079608f}; } __syncthreads();
          p0_elementwise(argp, (size_t)vcu * NTHREADS + tid, (size_t)G * NTHREADS, tab); } }
    SEAM(0);
    if (IN(1)) {
        for (int r = gw; r < R; r += NGW) norm_row<false>(r < RL ? args.in[0] + (size_t)r * D : args.in[2] + (size_t)(r - RL) * D, args.in[6], (const float*)(ws + O_MOD), 0, 1, (bf16*)(ws + O_HN), r, opq(lane), nullptr, nullptr, nullptr);
        { FoldSched S{G, bx, (const char*)(ws + O_DG), (const char*)(ws + O_WUF)}; EpiFold E{(bf16*)(ws + O_WIN)}; gemm_phase<EpiFold, FoldSched>(lds, 256, 1024, S, E); }
    }
    SEAM(1);
    layer_phases<0>(lds, ws, lo, hi, bar, G, bx, vcu, gw, NGW, tid, lane, wave);
    layer_phases<1>(lds, ws, lo, hi, bar, G, bx, vcu, gw, NGW, tid, lane, wave);
#undef IN
#undef SEAM
#undef args
#undef argp
}
}
#ifndef MK_MODE
#define MK_MODE 0
#endif
extern "C" void kernel_launch(void* const* d_in, const int* in_sizes, int n_in, void* d_out, int out_size, void* d_ws, size_t ws_size, hipStream_t stream) {
    static int grid = 0;
    if (grid == 0) {
        if (n_in != 27 || out_size != fk::RL * fk::D || ws_size < fk::O_END) { fprintf(stderr, "kernel_launch: unexpected problem (n_in %d out %d ws %zu need %zu)\n", n_in, out_size, ws_size, (size_t)fk::O_END); grid = -1; return; }
        int dev = 0, cus = 0, per_cu = 0;
        if (hipGetDevice(&dev) != hipSuccess || hipDeviceGetAttribute(&cus, hipDeviceAttributeMultiprocessorCount, dev) != hipSuccess) { grid = -1; return; }
        if (hipFuncSetAttribute((const void*)fk::mega, hipFuncAttributeMaxDynamicSharedMemorySize, fk::LDS_BYTES) != hipSuccess) { fprintf(stderr, "kernel_launch: hipFuncSetAttribute failed\n"); grid = -1; return; }
        if (hipOccupancyMaxActiveBlocksPerMultiprocessor(&per_cu, (const void*)fk::mega, fk::NTHREADS, fk::LDS_BYTES) != hipSuccess || per_cu < 1) fprintf(stderr, "kernel_launch: occupancy query says %d\n", per_cu);
        (void)hipGetLastError();
        grid = cus;
    }
    if (grid < 0) return;
    (void)hipMemsetAsync((char*)d_ws + fk::O_CTL, 0, fk::CTL_ZERO_BYTES, stream);
    fk::Args a{};
    for (int i = 0; i < 27; ++i) a.in[i] = (const float*)d_in[i];
    a.out = (float*)d_out; a.ws = (unsigned char*)d_ws; a.pad = 0;
#if MK_MODE == 0
    a.ph_lo = 0; a.ph_hi = fk::NPHASE; a.bar_region = 0;
    hipLaunchKernelGGL(fk::mega, dim3(grid), dim3(fk::NTHREADS), fk::LDS_BYTES, stream, a);
#else
    for (int p = 0; p < fk::NPHASE; ++p) { a.ph_lo = p; a.ph_hi = p + 1; a.bar_region = p;
        hipLaunchKernelGGL(fk::mega, dim3(grid), dim3(fk::NTHREADS), fk::LDS_BYTES, stream, a); }
#endif
}
```

```cpp
#include <hip/hip_runtime.h>
#include <cstdio>
#include <cstdint>
namespace fk {
#define GAS __attribute__((address_space(1)))
#define LAS __attribute__((address_space(3)))
typedef unsigned short bf16;
typedef short bf16x8 __attribute__((ext_vector_type(8)));
typedef float f32x4 __attribute__((ext_vector_type(4)));
typedef float f32x2 __attribute__((ext_vector_type(2)));
typedef unsigned u32x4 __attribute__((ext_vector_type(4)));
typedef unsigned u32x2 __attribute__((ext_vector_type(2)));
#define LDS_WAIT() asm volatile("s_waitcnt lgkmcnt(0)" ::: "memory")
#define VM_WAIT() asm volatile("s_waitcnt vmcnt(0)" ::: "memory")

__device__ __forceinline__ unsigned cvt_pk_bf16(float lo, float hi) { unsigned r; asm volatile("v_cvt_pk_bf16_f32 %0, %1, %2" : "=v"(r) : "v"(lo), "v"(hi)); return r; }
__device__ __forceinline__ float bf_lo(unsigned w) { return __uint_as_float(w << 16); }
__device__ __forceinline__ float bf_hi(unsigned w) { return __uint_as_float(w & 0xffff0000u); }
__device__ __forceinline__ float fexp(float x) { return __builtin_amdgcn_exp2f(x * 1.4426950408889634f); }
__device__ __forceinline__ float frcp(float x) { return __builtin_amdgcn_rcpf(x); }
__device__ __forceinline__ float fsigm(float x) { return frcp(1.f + fexp(-x)); }
__device__ __forceinline__ float fsilu(float x) { return x * frcp(1.f + fexp(-x)); }
__device__ __forceinline__ float fgelu(float x) { const float u = 1.5957691216057308f * (x + 0.044715f * x * x * x); return x * frcp(1.f + fexp(-u)); }
__device__ __forceinline__ int opq(int v) { asm volatile("" : "+v"(v)); return v; }
__device__ __forceinline__ float wave_sum(float v) {
#pragma unroll
    for (int o = 1; o < 64; o <<= 1) v += __shfl_xor(v, o);
    return v;
}

#ifndef G_WGM
#define G_WGM 4
#endif
constexpr int BM = 256, BK = 64, HALF = 128, HTB = HALF * BK * 2, STAGE_BYTES = 8 * HTB, NXCD = 8, WGM = G_WGM;
__device__ __forceinline__ int lds_byte(int r, int c) { const int st = (r >> 4) * 2 + (c >> 5), rr = r & 15, cc = c & 31, ob = rr * 64 + cc * 2; return st * 1024 + (ob ^ (((ob >> 9) & 1) << 5)); }
__device__ __forceinline__ void stage_rc(int b, int& R, int& C) { const int st = b / 1024, sb = b % 1024, swz = sb ^ (((sb >> 9) & 1) << 5); R = (st >> 1) * 16 + swz / 64; C = (st & 1) * 32 + (swz % 64) / 2; }
__device__ __forceinline__ int perm32(int rho) { const int n = rho >> 4, i = rho & 15; return 8 * (i >> 2) + 4 * n + (i & 3); }

struct Unit { const char* A; const char* B; int pm, pn, kind, nt, x; };

__device__ __forceinline__ void tile_of(int wgid, int nM, int nN, int& pm, int& pn, const int wgm = WGM) {
    const int nwg = nM * nN; { const int q = nwg / NXCD, r = nwg % NXCD, xcd = wgid % NXCD, off = wgid / NXCD; wgid = (xcd < r ? xcd * (q + 1) : r * (q + 1) + (xcd - r) * q) + off; }
    const int nig = wgm * nN, gid = wgid / nig, fm = gid * wgm, gsz = (nM - fm) < wgm ? (nM - fm) : wgm;
    pm = fm + ((wgid % nig) % gsz); pn = (wgid % nig) / gsz;
}

#ifndef G_ALIGN
#define G_ALIGN true
#endif
#ifndef G_SP2
#define G_SP2 true
#endif
template <class Epi, class Sched, bool ALIGN_EPI = G_ALIGN, bool SP2 = G_SP2, int BAUX = 0>
__device__ __forceinline__ void gemm_phase(LAS unsigned char* lds, const int lda, const int ldb, const Sched& S, const Epi& E, const size_t kpairA = 256, const size_t kpairB = 256) {
    int tid = threadIdx.x; asm volatile("" : "+v"(tid));
    const int wid = __builtin_amdgcn_readfirstlane(tid >> 6), lane = tid & 63, wr = wid >> 2, wc = wid & 3, fr = lane & 15, fq = lane >> 4;
    unsigned voffA[2], voffB[2];
#pragma unroll
    for (int i = 0; i < 2; ++i) { int R, C; stage_rc(tid * 16 + i * 8192, R, C); const int Rb = Epi::PERM ? ((R & ~31) + perm32(R & 31)) : R;
        voffA[i] = (unsigned)(R * lda + C) * 2u; voffB[i] = (unsigned)(Rb * ldb + C) * 2u; }
    const size_t kstep = (size_t)(BK * 2);
    const size_t hstepA = (size_t)HALF * lda * 2, hstepB = (size_t)HALF * ldb * 2;
    const unsigned ldsw = (unsigned)wid * 1024u;
    const int aoff = lds_byte(wr * 64 + fr, fq * 8), boff = lds_byte(wc * 32 + fr, fq * 8);
#define PG8_SA(b, h) (((b) * 2 + (h)) * HTB)
#define PG8_SB(b, h) ((4 + (b) * 2 + (h)) * HTB)
#define PG8_STAGE(bufoff, gbase, voff) do { _Pragma("unroll") for (int _i = 0; _i < 2; ++_i) \
        __builtin_amdgcn_global_load_lds((const unsigned*)((const char*)(gbase) + (voff)[_i]), (LAS unsigned*)(lds + (bufoff) + ldsw + _i * 8192), 16, 0, 0); } while (0)
#define PG8_STAGEB(bufoff, gbase, voff) do { _Pragma("unroll") for (int _i = 0; _i < 2; ++_i) \
        __builtin_amdgcn_global_load_lds((const unsigned*)((const char*)(gbase) + (voff)[_i]), (LAS unsigned*)(lds + (bufoff) + ldsw + _i * 8192), 16, 0, BAUX); } while (0)
#define PG8_LDA(dst, b, h) do { _Pragma("unroll") for (int m = 0; m < 4; ++m) _Pragma("unroll") for (int k = 0; k < 2; ++k) dst[m][k] = *(const LAS bf16x8*)(lds + PG8_SA(b, h) + aoff + m * 2048 + k * 1024); } while (0)
#define PG8_LDB(dst, b, h) do { _Pragma("unroll") for (int n = 0; n < 2; ++n) _Pragma("unroll") for (int k = 0; k < 2; ++k) dst[n][k] = *(const LAS bf16x8*)(lds + PG8_SB(b, h) + boff + n * 2048 + k * 1024); } while (0)
#ifndef G_PRIO
#define G_PRIO 1
#endif
#ifndef G_KOUT
#define G_KOUT 0
#endif
#if G_KOUT
#define PG8_MMA(ai, bj, At, Bt) do { if (G_PRIO) __builtin_amdgcn_s_setprio(G_PRIO); _Pragma("unroll") for (int k = 0; k < 2; ++k) _Pragma("unroll") for (int m = 0; m < 4; ++m) _Pragma("unroll") for (int n = 0; n < 2; ++n) \
        acc[ai][bj][m][n] = __builtin_amdgcn_mfma_f32_16x16x32_bf16(Bt[n][k], At[m][k], acc[ai][bj][m][n], 0, 0, 0); if (G_PRIO) __builtin_amdgcn_s_setprio(0); } while (0)
#else
#define PG8_MMA(ai, bj, At, Bt) do { if (G_PRIO) __builtin_amdgcn_s_setprio(G_PRIO); _Pragma("unroll") for (int m = 0; m < 4; ++m) _Pragma("unroll") for (int n = 0; n < 2; ++n) _Pragma("unroll") for (int k = 0; k < 2; ++k) \
        acc[ai][bj][m][n] = __builtin_amdgcn_mfma_f32_16x16x32_bf16(Bt[n][k], At[m][k], acc[ai][bj][m][n], 0, 0, 0); if (G_PRIO) __builtin_amdgcn_s_setprio(0); } while (0)
#endif
#ifndef G_MMA2
#define G_MMA2 0
#endif
#if G_MMA2
#define PG8_MMA2(ai, At, Ba, Bb) do { __builtin_amdgcn_s_setprio(1); _Pragma("unroll") for (int m = 0; m < 4; ++m) _Pragma("unroll") for (int n = 0; n < 2; ++n) _Pragma("unroll") for (int k = 0; k < 2; ++k) \
        acc[ai][0][m][n] = __builtin_amdgcn_mfma_f32_16x16x32_bf16(Ba[n][k], At[m][k], acc[ai][0][m][n], 0, 0, 0); \
        _Pragma("unroll") for (int m = 0; m < 4; ++m) _Pragma("unroll") for (int n = 0; n < 2; ++n) _Pragma("unroll") for (int k = 0; k < 2; ++k) \
        acc[ai][1][m][n] = __builtin_amdgcn_mfma_f32_16x16x32_bf16(Bb[n][k], At[m][k], acc[ai][1][m][n], 0, 0, 0); __builtin_amdgcn_s_setprio(0); } while (0)
#else
#define PG8_MMA2(ai, At, Ba, Bb) do { PG8_MMA(ai, 0, At, Ba); PG8_MMA(ai, 1, At, Bb); } while (0)
#endif
#define PG8_WAIT_V(n) asm volatile("s_waitcnt vmcnt(" #n ")" ::: "memory")
#define PG8_WAIT_L(n) asm volatile("s_waitcnt lgkmcnt(" #n ")" ::: "memory")
#define PG8_BAR __builtin_amdgcn_s_barrier()
#define PG8_SCHED __builtin_amdgcn_sched_barrier(0)
    Unit cur, nxt; int ui = 0;
    if (!S.next(0, cur)) return;
    f32x4 acc[2][2][4][2];
#pragma unroll
    for (int a = 0; a < 2; ++a)
#pragma unroll
        for (int b = 0; b < 2; ++b)
#pragma unroll
            for (int m = 0; m < 4; ++m)
#pragma unroll
                for (int n = 0; n < 2; ++n) acc[a][b][m][n] = (f32x4){0.f, 0.f, 0.f, 0.f};
    bf16x8 At[4][2], B0[2][2], B1[2][2];
    const char* cA = cur.A; const char* cB = cur.B;
    if constexpr (SP2) {
        PG8_STAGEB(PG8_SB(0, 0), cB, voffB); PG8_STAGEB(PG8_SB(0, 1), cB + hstepB, voffB); PG8_STAGE(PG8_SA(0, 0), cA, voffA); PG8_STAGE(PG8_SA(0, 1), cA + hstepA, voffA);
        if (wr == 1) PG8_BAR;
        PG8_WAIT_V(2); PG8_BAR;
        PG8_STAGEB(PG8_SB(1, 0), cB + kstep, voffB); PG8_STAGE(PG8_SA(1, 0), cA + kstep, voffA); PG8_STAGEB(PG8_SB(1, 1), cB + hstepB + kstep, voffB);
        PG8_WAIT_V(6); PG8_BAR;
    } else {
        PG8_STAGEB(PG8_SB(0, 0), cB, voffB); PG8_STAGE(PG8_SA(0, 0), cA, voffA); PG8_STAGEB(PG8_SB(0, 1), cB + hstepB, voffB); PG8_STAGE(PG8_SA(0, 1), cA + hstepA, voffA);
        if (wr == 1) PG8_BAR;
        PG8_WAIT_V(4); PG8_BAR;
        PG8_STAGEB(PG8_SB(1, 0), cB + kstep, voffB); PG8_STAGE(PG8_SA(1, 0), cA + kstep, voffA); PG8_STAGEB(PG8_SB(1, 1), cB + hstepB + kstep, voffB);
        PG8_WAIT_V(6); PG8_BAR;
    }
    for (;;) {
        const bool has_next = S.next(ui + 1, nxt);
        const char* nA = has_next ? nxt.A : cA; const char* nB = has_next ? nxt.B : cB;
        const int nt = cur.nt;
        for (int t = 0; t < nt; t += 2) {
            const bool last = (t == nt - 2);
            const char* a1 = cA + (size_t)(t >> 1) * kpairA + kstep;
            const char* a2 = last ? nA : cA + (size_t)((t >> 1) + 1) * kpairA; const char* b2 = last ? nB : cB + (size_t)((t >> 1) + 1) * kpairB;
            const char* a3 = a2 + kstep; const char* b3 = b2 + kstep;
            if constexpr (SP2) {
            PG8_LDB(B0, 0, 0); PG8_LDB(B1, 0, 1); PG8_SCHED; PG8_LDA(At, 0, 0); PG8_STAGE(PG8_SA(1, 1), a1 + hstepA, voffA);
            PG8_WAIT_V(8); PG8_WAIT_L(0); PG8_BAR; PG8_MMA2(0, At, B0, B1); PG8_BAR; PG8_SCHED;
            PG8_LDA(At, 0, 1); PG8_STAGEB(PG8_SB(0, 0), b2, voffB); PG8_STAGEB(PG8_SB(0, 1), b2 + hstepB, voffB); PG8_STAGE(PG8_SA(0, 0), a2, voffA);
            PG8_WAIT_V(8); PG8_WAIT_L(0); PG8_BAR; PG8_MMA2(1, At, B0, B1); PG8_BAR; PG8_SCHED;
            PG8_LDB(B0, 1, 0); PG8_LDB(B1, 1, 1); PG8_SCHED; PG8_LDA(At, 1, 0); PG8_STAGE(PG8_SA(0, 1), a2 + hstepA, voffA);
            PG8_WAIT_V(8); PG8_WAIT_L(0); PG8_BAR; PG8_MMA2(0, At, B0, B1); PG8_BAR; PG8_SCHED;
            PG8_LDA(At, 1, 1); PG8_STAGEB(PG8_SB(1, 0), b3, voffB); PG8_STAGEB(PG8_SB(1, 1), b3 + hstepB, voffB); PG8_STAGE(PG8_SA(1, 0), a3, voffA);
            PG8_WAIT_V(8); PG8_WAIT_L(0); PG8_BAR; PG8_MMA2(1, At, B0, B1); PG8_BAR; PG8_SCHED;
            } else {
            PG8_LDB(B0, 0, 0); PG8_SCHED; PG8_LDA(At, 0, 0); PG8_STAGE(PG8_SA(1, 1), a1 + hstepA, voffA);
            PG8_WAIT_L(8); PG8_BAR; PG8_WAIT_L(0); PG8_MMA(0, 0, At, B0); PG8_BAR; PG8_SCHED;
            PG8_LDB(B1, 0, 1); PG8_STAGEB(PG8_SB(0, 0), b2, voffB);
            PG8_BAR; PG8_WAIT_L(0); PG8_MMA(0, 1, At, B1); PG8_BAR;
            PG8_LDA(At, 0, 1); PG8_STAGE(PG8_SA(0, 0), a2, voffA);
            PG8_BAR; PG8_WAIT_L(0); PG8_MMA(1, 0, At, B0); PG8_BAR; PG8_SCHED;
            PG8_STAGEB(PG8_SB(0, 1), b2 + hstepB, voffB);
            PG8_WAIT_V(6); PG8_BAR; PG8_MMA(1, 1, At, B1); PG8_BAR;
            PG8_LDB(B0, 1, 0); PG8_SCHED; PG8_LDA(At, 1, 0); PG8_STAGE(PG8_SA(0, 1), a2 + hstepA, voffA);
            PG8_WAIT_L(8); PG8_BAR; PG8_WAIT_L(0); PG8_MMA(0, 0, At, B0); PG8_BAR; PG8_SCHED;
            PG8_LDB(B1, 1, 1); PG8_STAGEB(PG8_SB(1, 0), b3, voffB);
            PG8_BAR; PG8_WAIT_L(0); PG8_MMA(0, 1, At, B1); PG8_BAR;
            PG8_LDA(At, 1, 1); PG8_STAGE(PG8_SA(1, 0), a3, voffA);
            PG8_BAR; PG8_WAIT_L(0); PG8_MMA(1, 0, At, B0); PG8_BAR; PG8_SCHED;
            PG8_STAGEB(PG8_SB(1, 1), b3 + hstepB, voffB);
            PG8_WAIT_V(6); PG8_BAR; PG8_MMA(1, 1, At, B1); PG8_BAR;
            }
        }
        if constexpr (ALIGN_EPI) { if (wr == 0) PG8_BAR; }
        E(acc, cur, wr, wc, fr, fq);
        if (!has_next) break;
#pragma unroll
        for (int a = 0; a < 2; ++a)
#pragma unroll
            for (int b = 0; b < 2; ++b)
#pragma unroll
                for (int m = 0; m < 4; ++m)
#pragma unroll
                    for (int n = 0; n < 2; ++n) acc[a][b][m][n] = (f32x4){0.f, 0.f, 0.f, 0.f};
        cur = nxt; cA = nA; cB = nB; ++ui;
        if constexpr (ALIGN_EPI) { if (wr == 1) PG8_BAR; }
    }
    PG8_WAIT_V(0);
    if constexpr (!ALIGN_EPI) { if (wr == 0) PG8_BAR; }
    PG8_BAR;
#undef PG8_SA
#undef PG8_SB
#undef PG8_STAGE
#undef PG8_STAGEB
#undef PG8_LDA
#undef PG8_LDB
#undef PG8_MMA
#undef PG8_MMA2
#undef PG8_WAIT_V
#undef PG8_WAIT_L
#undef PG8_BAR
#undef PG8_SCHED
}

#define XB_TMO      128
#define XB_XCNT(j)  (256  + 64 * (j))
#define XB_XSUB(j)  (1280 + 64 * (j))
#define XB_XGEN(j)  (2304 + 64 * (j))
#define XB_TOP      3328
#define XB_TOPGEN   3392
#define XCD_BAR_WORDS 3456
#define XB_SPIN_CAP (1u << 18)
#ifndef XB_SLEEP
#define XB_SLEEP 1
#endif
__device__ __forceinline__ unsigned xb_ld(unsigned* p)              { return __hip_atomic_load(p, __ATOMIC_RELAXED, __HIP_MEMORY_SCOPE_AGENT); }
__device__ __forceinline__ unsigned xb_add(unsigned* p, unsigned v) { return __hip_atomic_fetch_add(p, v, __ATOMIC_RELAXED, __HIP_MEMORY_SCOPE_AGENT); }
__device__ __forceinline__ unsigned xb_xcc_id() { return (unsigned)__builtin_amdgcn_s_getreg((3 << 11) | 20) & 0xFu; }
#define XB_SPIN(cond, bar) do { unsigned _sp = 0; while (cond) { __builtin_amdgcn_s_sleep(XB_SLEEP); \
    if ((++_sp & 255u) == 0u) { if (xb_ld(&(bar)[XB_TMO])) break; if (_sp > XB_SPIN_CAP) { atomicAdd(&(bar)[XB_TMO], 1u); break; } } } } while (0)
struct XcdBarrier { unsigned* bar; unsigned x; volatile LAS unsigned* st; };
__device__ __forceinline__ XcdBarrier xcd_barrier_post(unsigned* bar, volatile LAS unsigned* st) {
    XcdBarrier b; b.bar = bar; b.x = xb_xcc_id(); b.st = st;
    if (threadIdx.x == 0) (void)xb_add(&bar[XB_XCNT(b.x)], 1u);
    return b;
}
__device__ __forceinline__ void xcd_barrier_complete(unsigned* bar, unsigned x, unsigned& nloc, unsigned& nx) {
    const unsigned G = gridDim.x * gridDim.y * gridDim.z;
    unsigned sum, cnt, mine, sp = 0u;
    for (;;) {
        sum = 0u; cnt = 0u; mine = 0u;
#pragma unroll
        for (unsigned j = 0; j < 16; ++j) { const unsigned c = xb_ld(&bar[XB_XCNT(j)]); sum += c; cnt += (c > 0u) ? 1u : 0u; mine = (j == x) ? c : mine; }
        if (sum == G) break;
        __builtin_amdgcn_s_sleep(1);
        if ((++sp & 255u) == 0u) { if (xb_ld(&bar[XB_TMO])) break; if (sp > XB_SPIN_CAP) { atomicAdd(&bar[XB_TMO], 1u); break; } }
    }
    nloc = mine > 0u ? mine : 1u; nx = cnt > 0u ? cnt : 1u;
}
__device__ __forceinline__ void xcd_barrier(const XcdBarrier& b) {
    asm volatile("s_waitcnt vmcnt(0)" ::: "memory");
    __syncthreads();
    if (threadIdx.x == 0) {
        unsigned* bar = b.bar;
        __builtin_amdgcn_s_waitcnt(0);
        unsigned nloc = b.st[0], nx = b.st[1];
        if (nloc == 0u) { xcd_barrier_complete(bar, b.x, nloc, nx); b.st[0] = nloc; b.st[1] = nx; }
        const unsigned old = xb_add(&bar[XB_XSUB(b.x)], 1u);
        const unsigned gen = old / nloc;
        if (old + 1u == (gen + 1u) * nloc) {
            __builtin_amdgcn_fence(__ATOMIC_RELEASE, "agent");
            asm volatile("s_waitcnt vmcnt(0)" ::: "memory");
            const unsigned og = xb_add(&bar[XB_TOP], 1u);
            const unsigned tg = og / nx;
            if (og + 1u == (tg + 1u) * nx) xb_add(&bar[XB_TOPGEN], 1u);
            else XB_SPIN(xb_ld(&bar[XB_TOPGEN]) == tg, bar);
            __builtin_amdgcn_fence(__ATOMIC_ACQUIRE, "agent");
            xb_add(&bar[XB_XGEN(b.x)], 1u);
            asm volatile("s_waitcnt vmcnt(0)" ::: "memory");
        } else {
            XB_SPIN(xb_ld(&bar[XB_XGEN(b.x)]) == gen, bar);
            __builtin_amdgcn_fence(__ATOMIC_ACQUIRE, "agent");
            asm volatile("s_waitcnt vmcnt(0)" ::: "memory");
        }
    }
    __syncthreads();
}
constexpr int D = 2048, NB = 8, L = 2048, LC = 256, RL = 16384, RC = 2048, R = 18432, NIN = 7168, GW = 64;
constexpr int DFF = 5632, NE = 8, DE = 7168, NH = 8, HD = 128, DL = 1024;
constexpr int WIN_ROWS = 7168;
constexpr int UT_LD = 36864;
constexpr int MAXSLOT = 34816;
constexpr int NCHUNK = 288;
constexpr int NWAVES = 8, NTHREADS = 512;
constexpr int LDS_BYTES = 147456;
constexpr int MISC_OFF = 140000;

constexpr size_t al256(size_t x) { return (x + 255) & ~(size_t)255; }
constexpr size_t O_CTL = 0, CTL_BYTES = 1u << 20, CTL_ZERO_BYTES = 65536;
constexpr size_t O_MOD = O_CTL + CTL_BYTES;
constexpr size_t O_MISC = O_MOD + al256((size_t)2 * 9 * 12288 * 4);
constexpr size_t O_LAT = O_MISC + (1u << 20);
constexpr size_t O_HN = O_LAT + (size_t)R * D * 4;
constexpr size_t O_WIN = O_HN + (size_t)R * D * 2;
constexpr size_t O_WFO = O_WIN + (size_t)2 * 8192 * 2048 * 2;
constexpr size_t O_WRO = O_WFO + (size_t)2 * 2048 * 1024 * 2;
constexpr size_t O_WO = O_WRO + (size_t)2 * 2048 * 1024 * 2;
constexpr size_t O_WAX = O_WO + (size_t)2 * 2048 * 2048 * 2;
constexpr size_t O_WUF = O_WAX + (size_t)2 * 2 * 2 * 8 * 128 * 128 * 2;
constexpr size_t O_DG = O_WUF + (size_t)2 * 2048 * 1024 * 2;
constexpr size_t O_FL = O_DG + (size_t)512 * 256 * 2;
constexpr size_t O_FLC = O_FL + (size_t)2048 * 4096 * 2;
constexpr size_t O_FGU = O_FLC + (size_t)256 * 4096 * 2;
constexpr size_t O_FD = O_FGU + (size_t)11264 * 2048 * 2;
constexpr size_t O_MGU = O_FD + (size_t)2048 * 5632 * 2;
constexpr size_t O_MD = O_MGU + (size_t)8 * 14336 * 2048 * 2;
constexpr size_t O_SCR = O_MD + (size_t)8 * 2048 * 7168 * 2;
constexpr size_t O_UT = O_SCR;
constexpr size_t O_UR = O_UT + (size_t)1024 * UT_LD * 2;
constexpr size_t O_GG = O_UR + (size_t)R * 1024 * 2;
constexpr size_t O_SGF = O_GG + (size_t)R * 1024 * 2;
constexpr size_t O_SGR = O_SGF + (size_t)R * 2048 * 2;
constexpr size_t O_Y = O_SGR + (size_t)R * 2048 * 2;
constexpr size_t O_T1 = O_Y + (size_t)R * 1024 * 2;
constexpr size_t O_HR = O_T1 + (size_t)R * 2048 * 2;
constexpr size_t O_MG = O_HR + (size_t)R * 1024 * 2;
constexpr size_t O_TOT = O_MG + (size_t)R * 2048 * 2;
constexpr size_t O_CAR = O_TOT + (size_t)NCHUNK * 2 * 1024 * 8;
constexpr size_t O_ZT = O_CAR + (size_t)NCHUNK * 2 * 1024 * 4;
constexpr size_t O_VV = O_ZT + (size_t)1024 * UT_LD * 2;
constexpr size_t O_MIXEND = O_VV + (size_t)R * 1024 * 2;
constexpr size_t O_HID = O_SCR;
constexpr size_t O_XG = O_SCR;
constexpr size_t O_HIDM = O_XG + (size_t)MAXSLOT * 2048 * 2;
constexpr size_t O_OS = O_HIDM + (size_t)MAXSLOT * 7168 * 2;
constexpr size_t O_END = O_OS + (size_t)2 * MAXSLOT * 2048 * 2;
static_assert(O_MIXEND <= O_END && O_HID + (size_t)R * DFF * 2 <= O_END, "scratch overlay");
static_assert(O_END <= (size_t)2085 * 1000 * 1000, "workspace budget");
constexpr size_t M_SEL = 0;
constexpr size_t M_GWT = 131072;
constexpr size_t M_SLOT = 262144;
constexpr size_t M_CNTB = 393216;
constexpr size_t M_TOT = 401408;
constexpr int CW_BAR = 4096, CW_MOEC = 8192;

struct Args { const float* in[27]; float* out; unsigned char* ws; int ph_lo, ph_hi, bar_region, pad; };
typedef const __attribute__((address_space(4))) Args* AP;
__device__ __forceinline__ AP kargs() { AP p = (AP)__builtin_amdgcn_kernarg_segment_ptr(); asm volatile("" : "+s"(p)); return p; }

__device__ __forceinline__ void p0_ada(AP a, LAS unsigned char* lds, int vcu, int G) {
    const int tid = threadIdx.x, lane = tid & 63, w = tid >> 6;
    LAS float* sc = (LAS float*)lds;
    LAS float* red = (LAS float*)(lds + 73728);
    const float* c = a->in[1]; const float* c_ctx = a->in[3];
    for (int i = tid; i < 9 * 2048; i += NTHREADS) { const int r = i >> 11, k = i & 2047; const float v = r < 8 ? c[r * 2048 + k] : c_ctx[k]; sc[i] = v / (1.f + expf(-v)); }
    __syncthreads();
    float* MOD = (float*)(a->ws + O_MOD);
    for (int item = vcu; item < 256; item += G) {
        const int l = item >> 7, cg = item & 127, col = cg * 96 + (lane < 48 ? lane : 0) * 2;
        const float* W = a->in[4] + (size_t)l * 2048 * 12288 + col;
        float acc[9][2];
#pragma unroll
        for (int r = 0; r < 9; ++r) { acc[r][0] = 0.f; acc[r][1] = 0.f; }
#pragma unroll 8
        for (int k = w * 256; k < w * 256 + 256; ++k) {
            const f32x2 wv = *(const f32x2*)(W + (size_t)k * 12288);
#pragma unroll
            for (int r = 0; r < 9; ++r) { const float s = sc[r * 2048 + k]; acc[r][0] = fmaf(s, wv.x, acc[r][0]); acc[r][1] = fmaf(s, wv.y, acc[r][1]); }
        }
#pragma unroll
        for (int r = 0; r < 9; ++r) if (lane < 48) { red[(w * 9 + r) * 128 + lane * 2] = acc[r][0]; red[(w * 9 + r) * 128 + lane * 2 + 1] = acc[r][1]; }
        __syncthreads();
        for (int i = tid; i < 9 * 128; i += NTHREADS) { const int r = i >> 7, cc = i & 127; if (cc >= 96) continue; float s = a->in[5][(size_t)l * 12288 + cg * 96 + cc];
#pragma unroll
            for (int ww = 0; ww < 8; ++ww) s += red[(ww * 9 + r) * 128 + cc];
            MOD[((size_t)l * 9 + r) * 12288 + cg * 96 + cc] = s; }
        __syncthreads();
    }
}

#ifndef SCAN_VV
#define SCAN_VV 1
#endif
#ifndef DFT2
#define DFT2 1
#endif
#ifndef MOE_BLK
#define MOE_BLK 1
#endif
#ifndef CVT_NT
#define CVT_NT 0
#endif
#if CVT_NT
#define CVT_LOAD(p) __builtin_nontemporal_load(p)
#define CVT_STORE(v, p) __builtin_nontemporal_store(v, p)
#else
#define CVT_LOAD(p) (*(p))
#define CVT_STORE(v, p) (*(p) = (v))
#endif
__device__ __forceinline__ void cvt_item(const float* src, int ldsrc, bf16* dst, int dpitch, int k0, int n0, int drow0, LAS float* scr, int lane, const int npairs = 0) {
    const float* s = src + (size_t)(k0 + (lane >> 4)) * ldsrc + n0 + (lane & 15) * 4;
    f32x4 v[16];
#pragma unroll
    for (int i = 0; i < 16; ++i) v[i] = CVT_LOAD((const f32x4*)(s + (size_t)(4 * i) * ldsrc));
#pragma unroll
    for (int i = 0; i < 16; ++i) { LAS float* q = scr + (4 * i + (lane >> 4)) * 65 + (lane & 15) * 4; q[0] = v[i].x; q[1] = v[i].y; q[2] = v[i].z; q[3] = v[i].w; }
    LDS_WAIT(); asm volatile("" ::: "memory");
    const int c = lane & 7;
#pragma unroll
    for (int jj = 0; jj < 8; ++jj) { const int n = (lane >> 3) + 8 * jj; const LAS float* q = scr + (8 * c) * 65 + n;
        u32x4 o; o.x = cvt_pk_bf16(q[0 * 65], q[1 * 65]); o.y = cvt_pk_bf16(q[2 * 65], q[3 * 65]); o.z = cvt_pk_bf16(q[4 * 65], q[5 * 65]); o.w = cvt_pk_bf16(q[6 * 65], q[7 * 65]);
        const int dr = drow0 + n; bf16* dp = npairs ? dst + ((size_t)(dr >> 8) * npairs + (k0 >> 7)) * 32768 + (size_t)(dr & 255) * 128 + (k0 & 127) + 8 * c : dst + (size_t)dr * dpitch + k0 + 8 * c;
        CVT_STORE(o, (u32x4*)dp); }
    LDS_WAIT(); asm volatile("" ::: "memory");
}
constexpr int I_WIN = 32 * 96, I_FO = 16 * 32, I_O = 32 * 32, I_AX = 4, I_FG = 32 * 88, I_FD = 88 * 32, I_MG = 32 * 112, I_MD = 112 * 32;
constexpr int N_WIN = 2 * I_WIN, N_FO = 2 * I_FO, N_RO = N_FO, N_O = 2 * I_O, N_AX = 64 * I_AX, N_FG = I_FG, N_FU = I_FG, N_FD = I_FD, N_MG = 8 * I_MG, N_MU = N_MG, N_MD = 8 * I_MD;
constexpr int N_NONMOE = N_WIN + N_FO + N_RO + N_O + N_AX + N_FG + N_FU + N_FD, N_MOE = N_MG + N_MU + N_MD;
__device__ __forceinline__ void p0_convert(AP a, LAS unsigned char* lds, int gw, int NGW) {
    const int lane = threadIdx.x & 63, w = threadIdx.x >> 6;
    LAS float* scr = (LAS float*)(lds + w * 16640);
    unsigned char* ws = a->ws;
    for (int it = gw; it < N_NONMOE; it += NGW) {
        int r = it;
        if (r < N_WIN) { const int l = r / I_WIN, q = r % I_WIN, kb = q / 96, nb = q % 96;
            cvt_item(a->in[8] + (size_t)l * 2048 * NIN, NIN, (bf16*)(ws + O_WIN) + (size_t)l * WIN_ROWS * 2048, 2048, kb * 64, 1024 + nb * 64, 1024 + nb * 64, scr, lane); continue; } r -= N_WIN;
        if (r < N_FO) { const int l = r / I_FO, q = r % I_FO, kb = q / 32, nb = q % 32;
            cvt_item(a->in[16] + (size_t)l * 1024 * 2048, 2048, (bf16*)(ws + O_WFO) + (size_t)l * 2048 * 1024, 1024, kb * 64, nb * 64, nb * 64, scr, lane); continue; } r -= N_FO;
        if (r < N_RO) { const int l = r / I_FO, q = r % I_FO, kb = q / 32, nb = q % 32;
            cvt_item(a->in[17] + (size_t)l * 1024 * 2048, 2048, (bf16*)(ws + O_WRO) + (size_t)l * 2048 * 1024, 1024, kb * 64, nb * 64, nb * 64, scr, lane); continue; } r -= N_RO;
        if (r < N_O) { const int l = r / I_O, q = r % I_O, kb = q / 32, nb = q % 32;
            cvt_item(a->in[18] + (size_t)l * 2048 * 2048, 2048, (bf16*)(ws + O_WO) + (size_t)l * 2048 * 2048, 2048, kb * 64, nb * 64, nb * 64, scr, lane); continue; } r -= N_O;
        if (r < N_AX) { const int m = r / I_AX, q = r % I_AX, kb = q / 2, nb = q % 2;
            const int h = m & 7, gate = (m >> 3) & 1, ld = m >> 4;
            const float* src = (gate ? a->in[13] : a->in[11]) + ((size_t)ld * 8 + h) * 128 * 128;
            cvt_item(src, 128, (bf16*)(ws + O_WAX) + (size_t)m * 128 * 128, 128, kb * 64, nb * 64, nb * 64, scr, lane); continue; } r -= N_AX;
        if (r < N_FG) { const int kb = r / 88, nb = r % 88, n = nb * 64;
            cvt_item(a->in[19], DFF, (bf16*)(ws + O_FGU), 2048, kb * 64, n, (n >> 7) * 256 + (n & 127), scr, lane); continue; } r -= N_FG;
        if (r < N_FU) { const int kb = r / 88, nb = r % 88, n = nb * 64;
            cvt_item(a->in[20], DFF, (bf16*)(ws + O_FGU), 2048, kb * 64, n, (n >> 7) * 256 + 128 + (n & 127), scr, lane); continue; } r -= N_FU;
        { const int kb = r / 32, nb = r % 32;
            cvt_item(a->in[21], 2048, (bf16*)(ws + O_FD), DFF, kb * 64, nb * 64, nb * 64, scr, lane); }
    }
}
__device__ __forceinline__ void cvt_moe_range(AP a, LAS unsigned char* lds, int lo, int hi, int rank, int nrank) {
    const int lane = threadIdx.x & 63, w = threadIdx.x >> 6;
    LAS float* scr = (LAS float*)(lds + w * 16640);
    unsigned char* ws = a->ws;
    for (int it = lo + rank; it < hi; it += nrank) {
        int r = it;
        if (r < N_MG) { const int e = r / I_MG, q = r % I_MG, kb = q / 112, nb = q % 112, n = nb * 64;
            cvt_item(a->in[23] + (size_t)e * 2048 * DE, DE, (bf16*)(ws + O_MGU) + (size_t)e * 14336 * 2048, 2048, kb * 64, n, (n >> 7) * 256 + (n & 127), scr, lane, MOE_BLK ? 16 : 0); continue; } r -= N_MG;
        if (r < N_MU) { const int e = r / I_MG, q = r % I_MG, kb = q / 112, nb = q % 112, n = nb * 64;
            cvt_item(a->in[24] + (size_t)e * 2048 * DE, DE, (bf16*)(ws + O_MGU) + (size_t)e * 14336 * 2048, 2048, kb * 64, n, (n >> 7) * 256 + 128 + (n & 127), scr, lane, MOE_BLK ? 16 : 0); continue; } r -= N_MU;
        { const int e = r / I_MD, q = r % I_MD, kb = q / 32, nb = q % 32;
            cvt_item(a->in[25] + (size_t)e * DE * 2048, 2048, (bf16*)(ws + O_MD) + (size_t)e * 2048 * DE, DE, kb * 64, nb * 64, nb * 64, scr, lane, MOE_BLK ? 56 : 0); }
    }
}
__device__ __forceinline__ void p0_elementwise(AP a, size_t gt, size_t NGT, const LAS f32x2* tab) {
    unsigned char* ws = a->ws;
    for (size_t i = gt; i < (size_t)2 * 2048 * 128; i += NGT) { const int l = (int)(i / (2048 * 128)), d = (int)((i / 128) % 2048), j8 = (int)(i % 128) * 8;
        const float* s = a->in[8] + ((size_t)l * 2048 + d) * NIN + j8; const f32x4 v0 = *(const f32x4*)s, v1 = *(const f32x4*)(s + 4);
        u32x4 o; o.x = cvt_pk_bf16(v0.x, v0.y); o.y = cvt_pk_bf16(v0.z, v0.w); o.z = cvt_pk_bf16(v1.x, v1.y); o.w = cvt_pk_bf16(v1.z, v1.w);
        *(u32x4*)((bf16*)(ws + O_WUF) + ((size_t)l * 2048 + d) * 1024 + j8) = o; }
#if DFT2
    for (size_t i = gt; i < (size_t)256 * 64; i += NGT) { const int k = (int)(i / 64), j8 = (int)(i % 64) * 8; float v[8];
#pragma unroll
        for (int e = 0; e < 8; ++e) { const int j = j8 + e, t = j & 255; const int m = (k * t) & 255; float sn, cs; sincospif((float)m * (1.f / 128.f), &sn, &cs); v[e] = (j < 256 ? cs : sn) * 0.022097086912079608f; }
        u32x4 o; o.x = cvt_pk_bf16(v[0], v[1]); o.y = cvt_pk_bf16(v[2], v[3]); o.z = cvt_pk_bf16(v[4], v[5]); o.w = cvt_pk_bf16(v[6], v[7]);
        *(u32x4*)((bf16*)(ws + O_FL) + (size_t)k * 4096 + j8) = o; }
    (void)tab;
#else
    for (size_t i = gt; i < (size_t)2048 * 512; i += NGT) { const int k = (int)(i / 512), j8 = (int)(i % 512) * 8; float v[8];
#pragma unroll
        for (int e = 0; e < 8; ++e) { const int j = j8 + e, t = j & 2047; const int m = (k * t) & 2047; const f32x2 cs = tab[m]; v[e] = (j < 2048 ? cs.x : -cs.y); }
        u32x4 o; o.x = cvt_pk_bf16(v[0], v[1]); o.y = cvt_pk_bf16(v[2], v[3]); o.z = cvt_pk_bf16(v[4], v[5]); o.w = cvt_pk_bf16(v[6], v[7]);
        *(u32x4*)((bf16*)(ws + O_FL) + (size_t)k * 4096 + j8) = o; }
#endif
    for (size_t i = gt; i < (size_t)256 * 64; i += NGT) { const int k = (int)(i / 64), j8 = (int)(i % 64) * 8; float v[8];
#pragma unroll
        for (int e = 0; e < 8; ++e) { const int j = j8 + e, t = j & 255; const int m = (k * t) & 255; float s, c; sincospif((float)m * (1.f / 128.f), &s, &c); v[e] = (j < 256 ? c : -s) * 0.0625f; }
        u32x4 o; o.x = cvt_pk_bf16(v[0], v[1]); o.y = cvt_pk_bf16(v[2], v[3]); o.z = cvt_pk_bf16(v[4], v[5]); o.w = cvt_pk_bf16(v[6], v[7]);
        *(u32x4*)((bf16*)(ws + O_FLC) + (size_t)k * 4096 + j8) = o; }
    for (size_t i = gt; i < (size_t)256 * 32; i += NGT) { const int row = (int)(i / 32), j8 = (int)(i % 32) * 8, s_ = row > 128 ? 1 : 0, c_ = s_ ? row - 128 : row; float v[8];
#pragma unroll
        for (int e = 0; e < 8; ++e) { const int m = (c_ * (j8 + e)) & 255; float s, c; sincospif((float)m * (1.f / 128.f), &s, &c); v[e] = (s_ ? s : c) * 0.0625f; }
        u32x4 o; o.x = cvt_pk_bf16(v[0], v[1]); o.y = cvt_pk_bf16(v[2], v[3]); o.z = cvt_pk_bf16(v[4], v[5]); o.w = cvt_pk_bf16(v[6], v[7]);
        *(u32x4*)((bf16*)(ws + O_DG) + (size_t)row * 256 + j8) = o; }
}

__device__ __forceinline__ int mod_row(int r) { return r < RL ? (r >> 11) : 8; }
__device__ __forceinline__ void norm_load(f32x4 (&v)[8], const float* src, int lane) {
#pragma unroll
    for (int j = 0; j < 8; ++j) v[j] = ((const f32x4*)src)[lane + 64 * j];
}
template <bool ROUTER>
__device__ __forceinline__ int norm_row(const f32x4 (&v)[8], const float* g, const float* modl, int shift_chunk, int scale_chunk, bf16* dst, int row, int lane,
                                         const LAS float* rt, int* sel, float* gwt) {
    int picked = 0;
    float s = 0.f;
#pragma unroll
    for (int j = 0; j < 8; ++j) s += (v[j].x * v[j].x + v[j].y * v[j].y) + (v[j].z * v[j].z + v[j].w * v[j].w);
    const float rstd = rsqrtf(wave_sum(s) * (1.f / D) + 1e-6f);
    const float* mr = modl + (size_t)mod_row(row) * 12288;
    float lg[8];
    if (ROUTER) {
#pragma unroll
        for (int e = 0; e < 8; ++e) lg[e] = 0.f; }
#pragma unroll
    for (int j = 0; j < 8; ++j) {
        const int c = (lane + 64 * j) * 4;
        const f32x4 gg = *(const f32x4*)(g + c), sh = *(const f32x4*)(mr + shift_chunk * D + c), sc = *(const f32x4*)(mr + scale_chunk * D + c);
        f32x4 o = v[j] * rstd * gg; o = o * (sc + 1.f) + sh;
        u32x2 w; w.x = cvt_pk_bf16(o.x, o.y); w.y = cvt_pk_bf16(o.z, o.w);
        *(u32x2*)(dst + (size_t)row * D + c) = w;
        if (ROUTER) {
#pragma unroll
            for (int q = 0; q < 4; ++q) { const f32x4 r0 = *(const LAS f32x4*)(rt + (c + q) * 8), r1 = *(const LAS f32x4*)(rt + (c + q) * 8 + 4); const float x = o[q];
                lg[0] = fmaf(x, r0.x, lg[0]); lg[1] = fmaf(x, r0.y, lg[1]); lg[2] = fmaf(x, r0.z, lg[2]); lg[3] = fmaf(x, r0.w, lg[3]);
                lg[4] = fmaf(x, r1.x, lg[4]); lg[5] = fmaf(x, r1.y, lg[5]); lg[6] = fmaf(x, r1.z, lg[6]); lg[7] = fmaf(x, r1.w, lg[7]); } }
    }
    if (ROUTER) {
#pragma unroll
        for (int e = 0; e < 8; ++e) lg[e] = wave_sum(lg[e]);
        if (lane == 0) {
            int i1 = 0; float v1 = lg[0];
#pragma unroll
            for (int e = 1; e < 8; ++e) if (lg[e] > v1) { v1 = lg[e]; i1 = e; }
            int i2 = -1; float v2 = -3.0e38f;
#pragma unroll
            for (int e = 0; e < 8; ++e) if (e != i1 && lg[e] > v2) { v2 = lg[e]; i2 = e; }
            const float w1 = 1.f / (1.f + expf(v2 - v1));
            sel[row * 2] = i1; sel[row * 2 + 1] = i2; gwt[row * 2] = w1; gwt[row * 2 + 1] = 1.f - w1; picked = i1 | (i2 << 8);
        }
    }
    return picked;
}

__device__ __forceinline__ float one_minus_exp(float x, float a2) {
    const float t = -x; return t < 0.0625f ? t * (1.f - t * (0.5f - t * (0.16666667f - t * (0.041666668f - t * 0.0083333338f)))) : 1.f - a2; }
template <int PASS>
__device__ __forceinline__ void scan_unit(AP a, LAS unsigned char* lds, int l, int q, int h) {
    int tid = threadIdx.x; asm volatile("" : "+v"(tid));
    const int lane = tid & 63, w = __builtin_amdgcn_readfirstlane(tid >> 6), fr = lane & 15, fq = lane >> 4;
    LAS float* VS = (LAS float*)lds; LAS bf16* V16 = (LAS bf16*)(lds + 33792); LAS float* AS = (LAS float*)(lds + 51200); LAS float* BS = (LAS float*)(lds + 84992); LAS float* SEG = (LAS float*)(lds + 118784);
    unsigned char* ws = a->ws;
    const bool isctx = q >= 256;
    const int row0 = isctx ? RL + (q - 256) * 64 : q * 64;
    const int cpos0 = isctx ? ((q - 256) & 3) * 64 : 0;
    const int seglen = isctx ? LC : GW;
    const int t = tid >> 3, c16 = (tid & 7) * 16;
    {
        const bf16* UR = (const bf16*)(ws + O_UR);
        const float* cw = a->in[9] + (size_t)l * 4 * DL + h * HD + c16; const float* cb = a->in[10] + (size_t)l * DL + h * HD + c16;
        float v[16];
#pragma unroll
        for (int i = 0; i < 16; i += 4) { const f32x4 b4 = *(const f32x4*)(cb + i); v[i] = b4.x; v[i + 1] = b4.y; v[i + 2] = b4.z; v[i + 3] = b4.w; }
#pragma unroll
        for (int k = 0; k < 4; ++k) { const int p = cpos0 + t + k - 2;
            if (p >= 0 && p < seglen) { const bf16* src = UR + (size_t)(row0 + t + k - 2) * 1024 + h * HD + c16; const u32x4 u0 = *(const u32x4*)src, u1 = *(const u32x4*)(src + 8);
                const unsigned uu[8] = {u0.x, u0.y, u0.z, u0.w, u1.x, u1.y, u1.z, u1.w};
#pragma unroll
                for (int i = 0; i < 8; ++i) { const f32x2 wv = *(const f32x2*)(cw + (size_t)k * DL + 2 * i); v[2 * i] = fmaf(wv.x, bf_lo(uu[i]), v[2 * i]); v[2 * i + 1] = fmaf(wv.y, bf_hi(uu[i]), v[2 * i + 1]); } } }
#pragma unroll
        for (int i = 0; i < 16; i += 4) *(LAS f32x4*)(VS + t * 132 + c16 + i) = (f32x4){v[i], v[i + 1], v[i + 2], v[i + 3]};
        u32x4 o0, o1; o0.x = cvt_pk_bf16(v[0], v[1]); o0.y = cvt_pk_bf16(v[2], v[3]); o0.z = cvt_pk_bf16(v[4], v[5]); o0.w = cvt_pk_bf16(v[6], v[7]);
        o1.x = cvt_pk_bf16(v[8], v[9]); o1.y = cvt_pk_bf16(v[10], v[11]); o1.z = cvt_pk_bf16(v[12], v[13]); o1.w = cvt_pk_bf16(v[14], v[15]);
        *(LAS u32x4*)(V16 + t * 136 + c16) = o0; *(LAS u32x4*)(V16 + t * 136 + c16 + 8) = o1;
    }
    __syncthreads();
    float hsum[16];
#pragma unroll
    for (int i = 0; i < 16; ++i) hsum[i] = 0.f;
    const int ch = 16 * w + fr;
#pragma unroll 1
    for (int dir = 0; dir < 2; ++dir) {
        f32x4 acc[2][4];
#pragma unroll
        for (int g = 0; g < 2; ++g)
#pragma unroll
            for (int m = 0; m < 4; ++m) acc[g][m] = (f32x4){0.f, 0.f, 0.f, 0.f};
        const bf16* WT = (const bf16*)(ws + O_WAX) + ((size_t)((l * 2 + dir) * 2) * 8 + h) * 128 * 128;
#pragma unroll
        for (int ks = 0; ks < 4; ++ks) {
            const bf16x8 b0 = *(const bf16x8*)(WT + (size_t)ch * 128 + ks * 32 + fq * 8), b1 = *(const bf16x8*)(WT + (size_t)8 * 128 * 128 + (size_t)ch * 128 + ks * 32 + fq * 8);
#pragma unroll
            for (int m = 0; m < 4; ++m) { const bf16x8 af = *(const LAS bf16x8*)(V16 + (16 * m + fr) * 136 + ks * 32 + fq * 8);
                acc[0][m] = __builtin_amdgcn_mfma_f32_16x16x32_bf16(af, b0, acc[0][m], 0, 0, 0); acc[1][m] = __builtin_amdgcn_mfma_f32_16x16x32_bf16(af, b1, acc[1][m], 0, 0, 0); }
        }
        {
            const int gch = h * HD + ch;
            const float bia = a->in[12][(size_t)(l * 2 + dir) * DL + gch], bix = a->in[14][(size_t)(l * 2 + dir) * DL + gch], lm = a->in[15][(size_t)(l * 2 + dir) * DL + gch];
            const float sp8 = 8.f * log1pf(expf(-lm));
#pragma unroll
            for (int m = 0; m < 4; ++m)
#pragma unroll
                for (int j = 0; j < 4; ++j) { const int tok = 16 * m + 4 * fq + j;
                    const float rr = fsigm(acc[0][m][j] + bia), ii = fsigm(acc[1][m][j] + bix), vv = VS[tok * 132 + ch];
                    const float la = -sp8 * rr, av = fexp(la), a2 = av * av;
                    AS[tok * 132 + ch] = av; BS[tok * 132 + ch] = sqrtf(one_minus_exp(2.f * la, a2)) * (ii * vv); }
        }
        __syncthreads();
        {
            const int sg = tid >> 7, sc = tid & 127;
            float av[16], bv[16];
#pragma unroll
            for (int i = 0; i < 16; ++i) { const int tok = dir ? 63 - (16 * sg + i) : 16 * sg + i; av[i] = AS[tok * 132 + sc]; bv[i] = BS[tok * 132 + sc]; }
            float P = 1.f, hl = 0.f;
#pragma unroll
            for (int i = 0; i < 16; ++i) { hl = fmaf(av[i], hl, bv[i]); P *= av[i]; }
            SEG[(sg * 128 + sc) * 2] = P; SEG[(sg * 128 + sc) * 2 + 1] = hl;
            __syncthreads();
            if (PASS == 1) {
                if (sg == 0) { float A = 1.f, B = 0.f;
#pragma unroll
                    for (int s2 = 0; s2 < 4; ++s2) { const float p2 = SEG[(s2 * 128 + sc) * 2], h2 = SEG[(s2 * 128 + sc) * 2 + 1]; B = fmaf(p2, B, h2); A *= p2; }
                    *(f32x2*)((float*)(ws + O_TOT) + (((size_t)q * 2 + dir) * 1024 + h * HD + sc) * 2) = (f32x2){A, B}; }
            } else {
                float hc = ((const float*)(ws + O_CAR))[((size_t)q * 2 + dir) * 1024 + h * HD + sc];
#pragma unroll
                for (int s2 = 0; s2 < 3; ++s2) if (s2 < sg) { const float p2 = SEG[(s2 * 128 + sc) * 2], h2 = SEG[(s2 * 128 + sc) * 2 + 1]; hc = fmaf(p2, hc, h2); }
#pragma unroll
                for (int i = 0; i < 16; ++i) { const int tok = dir ? 63 - (16 * sg + i) : 16 * sg + i; hc = fmaf(av[i], hc, bv[i]); BS[tok * 132 + sc] = hc; }
            }
        }
        __syncthreads();
        if (PASS == 2) {
#pragma unroll
            for (int i = 0; i < 16; i += 4) { const f32x4 x = *(const LAS f32x4*)(BS + t * 132 + c16 + i); hsum[i] += x.x; hsum[i + 1] += x.y; hsum[i + 2] += x.z; hsum[i + 3] += x.w; }
            __syncthreads();
        }
    }
    if (PASS == 2) {
        const bf16* GGp = (const bf16*)(ws + O_GG) + (size_t)(row0 + t) * 1024 + h * HD + c16; const u32x4 g0 = *(const u32x4*)GGp, g1 = *(const u32x4*)(GGp + 8);
        const unsigned gu[8] = {g0.x, g0.y, g0.z, g0.w, g1.x, g1.y, g1.z, g1.w}; unsigned o[8];
#pragma unroll
        for (int i = 0; i < 8; ++i) o[i] = cvt_pk_bf16(hsum[2 * i] * bf_lo(gu[i]), hsum[2 * i + 1] * bf_hi(gu[i]));
        bf16* dst = (bf16*)(ws + O_HR) + (size_t)(row0 + t) * 1024 + h * HD + c16;
        *(u32x4*)dst = (u32x4){o[0], o[1], o[2], o[3]}; *(u32x4*)(dst + 8) = (u32x4){o[4], o[5], o[6], o[7]};
    }
}
template <int PASS>
__device__ __forceinline__ void scan_phase(AP a, LAS unsigned char* lds, const int l, const int nunits, const int vcu, const int G) {
    int tid0 = threadIdx.x; asm volatile("" : "+v"(tid0));
    const int w = __builtin_amdgcn_readfirstlane(tid0 >> 6);
    LAS float* VS = (LAS float*)lds; LAS bf16* V16 = (LAS bf16*)(lds + 33792); LAS float* AS = (LAS float*)(lds + 51200); LAS float* BS = (LAS float*)(lds + 84992); LAS float* SEG = (LAS float*)(lds + 118784);
    LAS float* CW = (LAS float*)(lds + 122880); LAS float* CB = (LAS float*)(lds + 124928);
    unsigned char* ws = a->ws;
    const bf16* UR = (const bf16*)(ws + O_UR);
#define SCAN_LANE_VARS(tid) const int lane = (tid) & 63, fr = lane & 15, fq = lane >> 4, t = (tid) >> 3, c16 = ((tid) & 7) * 16, ch = 16 * w + fr, sg = (tid) >> 7, sc = (tid) & 127; \
    (void)fq; (void)sg; (void)sc; (void)ch; (void)t; (void)c16
    int hcur = -1;
    bf16x8 wf[2][2][4]; float bia[2], bix[2], sp8[2];
    u32x4 ur[4][2];
#define SCAN_PREFETCH(uu) do { const int q_ = (uu) >> 3, h_ = (uu) & 7; const bool ic_ = q_ >= 256; const int r0_ = ic_ ? RL + (q_ - 256) * 64 : q_ * 64; \
        const int cp_ = ic_ ? ((q_ - 256) & 3) * 64 : 0, sl_ = ic_ ? LC : GW; \
        _Pragma("unroll") for (int k = 0; k < 4; ++k) { const int p_ = cp_ + t + k - 2; \
            if (p_ >= 0 && p_ < sl_) { const bf16* src_ = UR + (size_t)(r0_ + t + k - 2) * 1024 + h_ * HD + c16; ur[k][0] = *(const u32x4*)src_; ur[k][1] = *(const u32x4*)(src_ + 8); } \
            else { ur[k][0] = (u32x4){0u, 0u, 0u, 0u}; ur[k][1] = (u32x4){0u, 0u, 0u, 0u}; } } } while (0)
    if (vcu < nunits) { SCAN_LANE_VARS(tid0); SCAN_PREFETCH(vcu); }
    for (int u = vcu; u < nunits; u += G) {
        const int q = u >> 3, h = u & 7;
        const int tid = opq(tid0); SCAN_LANE_VARS(tid);
        const bool isctx = q >= 256; const int row0 = isctx ? RL + (q - 256) * 64 : q * 64;
        if (h != hcur) {
            hcur = h;
            __syncthreads();
            if (tid < 128) { CB[tid] = a->in[10][(size_t)l * DL + h * HD + tid];
#pragma unroll
                for (int k = 0; k < 4; ++k) CW[k * 128 + tid] = a->in[9][((size_t)l * 4 + k) * DL + h * HD + tid]; }
#pragma unroll
            for (int dir = 0; dir < 2; ++dir) {
                const bf16* WT = (const bf16*)(ws + O_WAX) + ((size_t)((l * 2 + dir) * 2) * 8 + h) * 128 * 128;
#pragma unroll
                for (int g = 0; g < 2; ++g)
#pragma unroll
                    for (int ks = 0; ks < 4; ++ks) wf[dir][g][ks] = *(const bf16x8*)(WT + (size_t)g * 8 * 128 * 128 + (size_t)ch * 128 + ks * 32 + fq * 8);
                const int gch = h * HD + ch;
                bia[dir] = a->in[12][(size_t)(l * 2 + dir) * DL + gch]; bix[dir] = a->in[14][(size_t)(l * 2 + dir) * DL + gch];
                sp8[dir] = 8.f * log1pf(expf(-a->in[15][(size_t)(l * 2 + dir) * DL + gch]));
            }
            __syncthreads();
        }
        float car[2]; u32x4 gg0, gg1;
        if (PASS == 2) {
            car[0] = ((const float*)(ws + O_CAR))[((size_t)q * 2 + 0) * 1024 + h * HD + sc]; car[1] = ((const float*)(ws + O_CAR))[((size_t)q * 2 + 1) * 1024 + h * HD + sc];
            const bf16* GGp = (const bf16*)(ws + O_GG) + (size_t)(row0 + t) * 1024 + h * HD + c16; gg0 = *(const u32x4*)GGp; gg1 = *(const u32x4*)(GGp + 8);
        }
        {
            float v[16];
#pragma unroll
            for (int i = 0; i < 16; i += 4) { const f32x4 b4 = *(const LAS f32x4*)(CB + c16 + i); v[i] = b4.x; v[i + 1] = b4.y; v[i + 2] = b4.z; v[i + 3] = b4.w; }
#pragma unroll
            for (int k = 0; k < 4; ++k) { const unsigned uu[8] = {ur[k][0].x, ur[k][0].y, ur[k][0].z, ur[k][0].w, ur[k][1].x, ur[k][1].y, ur[k][1].z, ur[k][1].w};
#pragma unroll
                for (int i = 0; i < 16; i += 4) { const f32x4 wv = *(const LAS f32x4*)(CW + k * 128 + c16 + i);
                    v[i] = fmaf(wv.x, bf_lo(uu[i / 2]), v[i]); v[i + 1] = fmaf(wv.y, bf_hi(uu[i / 2]), v[i + 1]); v[i + 2] = fmaf(wv.z, bf_lo(uu[i / 2 + 1]), v[i + 2]); v[i + 3] = fmaf(wv.w, bf_hi(uu[i / 2 + 1]), v[i + 3]); } }
#pragma unroll
            for (int i = 0; i < 16; i += 4) *(LAS f32x4*)(VS + t * 132 + c16 + i) = (f32x4){v[i], v[i + 1], v[i + 2], v[i + 3]};
            u32x4 o0, o1; o0.x = cvt_pk_bf16(v[0], v[1]); o0.y = cvt_pk_bf16(v[2], v[3]); o0.z = cvt_pk_bf16(v[4], v[5]); o0.w = cvt_pk_bf16(v[6], v[7]);
            o1.x = cvt_pk_bf16(v[8], v[9]); o1.y = cvt_pk_bf16(v[10], v[11]); o1.z = cvt_pk_bf16(v[12], v[13]); o1.w = cvt_pk_bf16(v[14], v[15]);
            *(LAS u32x4*)(V16 + t * 136 + c16) = o0; *(LAS u32x4*)(V16 + t * 136 + c16 + 8) = o1;
        }
        if (u + G < nunits) SCAN_PREFETCH(u + G);
        __syncthreads();
        float hsum[16];
#pragma unroll
        for (int i = 0; i < 16; ++i) hsum[i] = 0.f;
#pragma unroll
        for (int dir = 0; dir < 2; ++dir) {
            f32x4 acc[2][4];
#pragma unroll
            for (int g = 0; g < 2; ++g)
#pragma unroll
                for (int m = 0; m < 4; ++m) acc[g][m] = (f32x4){0.f, 0.f, 0.f, 0.f};
#pragma unroll
            for (int ks = 0; ks < 4; ++ks)
#pragma unroll
                for (int m = 0; m < 4; ++m) { const bf16x8 af = *(const LAS bf16x8*)(V16 + (16 * m + fr) * 136 + ks * 32 + fq * 8);
                    acc[0][m] = __builtin_amdgcn_mfma_f32_16x16x32_bf16(af, wf[dir][0][ks], acc[0][m], 0, 0, 0); acc[1][m] = __builtin_amdgcn_mfma_f32_16x16x32_bf16(af, wf[dir][1][ks], acc[1][m], 0, 0, 0); }
#pragma unroll
            for (int m = 0; m < 4; ++m)
#pragma unroll
                for (int j = 0; j < 4; ++j) { const int tok = 16 * m + 4 * fq + j;
                    const float rr = fsigm(acc[0][m][j] + bia[dir]), ii = fsigm(acc[1][m][j] + bix[dir]), vv = VS[tok * 132 + ch];
                    const float la = -sp8[dir] * rr, av = fexp(la), a2 = av * av;
                    AS[tok * 132 + ch] = av; BS[tok * 132 + ch] = sqrtf(one_minus_exp(2.f * la, a2)) * (ii * vv); }
            __syncthreads();
            {
                float av[16], bv[16];
#pragma unroll
                for (int i = 0; i < 16; ++i) { const int tok = dir ? 63 - (16 * sg + i) : 16 * sg + i; av[i] = AS[tok * 132 + sc]; bv[i] = BS[tok * 132 + sc]; }
                float P = 1.f, hl = 0.f;
#pragma unroll
                for (int i = 0; i < 16; ++i) { hl = fmaf(av[i], hl, bv[i]); P *= av[i]; }
                SEG[(sg * 128 + sc) * 2] = P; SEG[(sg * 128 + sc) * 2 + 1] = hl;
                __syncthreads();
                if (PASS == 1) {
                    if (sg == 0) { float A = 1.f, B = 0.f;
#pragma unroll
                        for (int s2 = 0; s2 < 4; ++s2) { const float p2 = SEG[(s2 * 128 + sc) * 2], h2 = SEG[(s2 * 128 + sc) * 2 + 1]; B = fmaf(p2, B, h2); A *= p2; }
                        *(f32x2*)((float*)(ws + O_TOT) + (((size_t)q * 2 + dir) * 1024 + h * HD + sc) * 2) = (f32x2){A, B}; }
                } else {
                    float hc = car[dir];
#pragma unroll
                    for (int s2 = 0; s2 < 3; ++s2) if (s2 < sg) { const float p2 = SEG[(s2 * 128 + sc) * 2], h2 = SEG[(s2 * 128 + sc) * 2 + 1]; hc = fmaf(p2, hc, h2); }
#pragma unroll
                    for (int i = 0; i < 16; ++i) { const int tok = dir ? 63 - (16 * sg + i) : 16 * sg + i; hc = fmaf(av[i], hc, bv[i]); BS[tok * 132 + sc] = hc; }
                }
            }
            __syncthreads();
            if (PASS == 2) {
#pragma unroll
                for (int i = 0; i < 16; i += 4) { const f32x4 x = *(const LAS f32x4*)(BS + t * 132 + c16 + i); hsum[i] += x.x; hsum[i + 1] += x.y; hsum[i + 2] += x.z; hsum[i + 3] += x.w; }
                __syncthreads();
            }
        }
        if (PASS == 2) {
            const unsigned gu[8] = {gg0.x, gg0.y, gg0.z, gg0.w, gg1.x, gg1.y, gg1.z, gg1.w}; unsigned o[8];
#pragma unroll
            for (int i = 0; i < 8; ++i) o[i] = cvt_pk_bf16(hsum[2 * i] * bf_lo(gu[i]), hsum[2 * i + 1] * bf_hi(gu[i]));
            bf16* dst = (bf16*)(ws + O_HR) + (size_t)(row0 + t) * 1024 + h * HD + c16;
            *(u32x4*)dst = (u32x4){o[0], o[1], o[2], o[3]}; *(u32x4*)(dst + 8) = (u32x4){o[4], o[5], o[6], o[7]};
        }
    }
#undef SCAN_PREFETCH
#undef SCAN_LANE_VARS
}
template <int PASS, int SKIP = 0>
__device__ __forceinline__ void scan_phase2(AP a, LAS unsigned char* lds, const int l, const int nunits, const int vcu, const int G) {
    int tid0 = threadIdx.x; asm volatile("" : "+v"(tid0));
    const int w = __builtin_amdgcn_readfirstlane(tid0 >> 6);
    LAS bf16* V16 = (LAS bf16*)lds; LAS float* HST = (LAS float*)(lds + 34816) + w * (64 * 17); LAS float* CW = (LAS float*)(lds + 69632); LAS float* CB = (LAS float*)(lds + 71680);
    unsigned char* ws = a->ws;
    const bf16* UR = (const bf16*)(ws + O_UR);
#define SCAN_LANE_VARS(tid) const int lane = (tid) & 63, fr = lane & 15, fq = lane >> 4, t = (tid) >> 3, c16 = ((tid) & 7) * 16, ch = 16 * w + fr; (void)fq; (void)ch; (void)t; (void)c16
    int hcur = -1;
    bf16x8 wf[2][2][4]; float nbia[2], nbix[2], nsp8[2];
    u32x4 ur[4][2];
#define SCAN_PREFETCH(uu) do { const int q_ = (uu) >> 3, h_ = (uu) & 7; const bool ic_ = q_ >= 256; const int r0_ = ic_ ? RL + (q_ - 256) * 64 : q_ * 64; \
        if (PASS == 2 && SCAN_VV) { const bf16* src_ = (const bf16*)(ws + O_VV) + (size_t)(r0_ + t) * 1024 + h_ * HD + c16; ur[0][0] = *(const u32x4*)src_; ur[0][1] = *(const u32x4*)(src_ + 8); break; }     \
        const int cp_ = ic_ ? ((q_ - 256) & 3) * 64 : 0, sl_ = ic_ ? LC : GW; \
        _Pragma("unroll") for (int k = 0; k < 4; ++k) { const int p_ = cp_ + t + k - 2; \
            if (p_ >= 0 && p_ < sl_) { const bf16* src_ = UR + (size_t)(r0_ + t + k - 2) * 1024 + h_ * HD + c16; ur[k][0] = *(const u32x4*)src_; ur[k][1] = *(const u32x4*)(src_ + 8); } \
            else { ur[k][0] = (u32x4){0u, 0u, 0u, 0u}; ur[k][1] = (u32x4){0u, 0u, 0u, 0u}; } } } while (0)
    if (vcu < nunits) { SCAN_LANE_VARS(tid0); SCAN_PREFETCH(vcu); }
    int par = 0;
    for (int u = vcu; u < nunits; u += G, par ^= 1) {
        const int q = u >> 3, h = u & 7;
        const int tid = opq(tid0); SCAN_LANE_VARS(tid);
        const bool isctx = q >= 256; const int row0 = isctx ? RL + (q - 256) * 64 : q * 64;
        LAS bf16* Vb = V16 + par * (64 * 136);
        if (h != hcur) {
            hcur = h;
            __syncthreads();
            if (tid < 128) { CB[tid] = a->in[10][(size_t)l * DL + h * HD + tid];
#pragma unroll
                for (int k = 0; k < 4; ++k) CW[k * 128 + tid] = a->in[9][((size_t)l * 4 + k) * DL + h * HD + tid]; }
#pragma unroll
            for (int dir = 0; dir < 2; ++dir) {
                const bf16* WT = (const bf16*)(ws + O_WAX) + ((size_t)((l * 2 + dir) * 2) * 8 + h) * 128 * 128;
#pragma unroll
                for (int g = 0; g < 2; ++g)
#pragma unroll
                    for (int ks = 0; ks < 4; ++ks) wf[dir][g][ks] = *(const bf16x8*)(WT + (size_t)g * 8 * 128 * 128 + (size_t)ch * 128 + ks * 32 + fq * 8);
                const int gch = h * HD + ch;
                nbia[dir] = -1.4426950408889634f * a->in[12][(size_t)(l * 2 + dir) * DL + gch]; nbix[dir] = -1.4426950408889634f * a->in[14][(size_t)(l * 2 + dir) * DL + gch];
                nsp8[dir] = -8.f * 1.4426950408889634f * log1pf(expf(-a->in[15][(size_t)(l * 2 + dir) * DL + gch]));
            }
            __syncthreads();
        }
        float car[2]; u32x4 gg0, gg1;
        if (PASS == 2) {
            car[0] = ((const float*)(ws + O_CAR))[((size_t)q * 2 + 0) * 1024 + h * HD + ch]; car[1] = ((const float*)(ws + O_CAR))[((size_t)q * 2 + 1) * 1024 + h * HD + ch];
            const bf16* GGp = (const bf16*)(ws + O_GG) + (size_t)(row0 + lane) * 1024 + h * HD + 16 * w; gg0 = *(const u32x4*)GGp; gg1 = *(const u32x4*)(GGp + 8);
        }
        if (PASS == 2 && SCAN_VV) { *(LAS u32x4*)(Vb + t * 136 + c16) = ur[0][0]; *(LAS u32x4*)(Vb + t * 136 + c16 + 8) = ur[0][1]; }
        else {
            float v[16];
#pragma unroll
            for (int i = 0; i < 16; i += 4) { const f32x4 b4 = *(const LAS f32x4*)(CB + c16 + i); v[i] = b4.x; v[i + 1] = b4.y; v[i + 2] = b4.z; v[i + 3] = b4.w; }
#pragma unroll
            for (int k = 0; k < 4; ++k) { const unsigned uu[8] = {ur[k][0].x, ur[k][0].y, ur[k][0].z, ur[k][0].w, ur[k][1].x, ur[k][1].y, ur[k][1].z, ur[k][1].w};
#pragma unroll
                for (int i = 0; i < 16; i += 4) { const f32x4 wv = *(const LAS f32x4*)(CW + k * 128 + c16 + i);
                    v[i] = fmaf(wv.x, bf_lo(uu[i / 2]), v[i]); v[i + 1] = fmaf(wv.y, bf_hi(uu[i / 2]), v[i + 1]); v[i + 2] = fmaf(wv.z, bf_lo(uu[i / 2 + 1]), v[i + 2]); v[i + 3] = fmaf(wv.w, bf_hi(uu[i / 2 + 1]), v[i + 3]); } }
            u32x4 o0, o1; o0.x = cvt_pk_bf16(v[0], v[1]); o0.y = cvt_pk_bf16(v[2], v[3]); o0.z = cvt_pk_bf16(v[4], v[5]); o0.w = cvt_pk_bf16(v[6], v[7]);
            o1.x = cvt_pk_bf16(v[8], v[9]); o1.y = cvt_pk_bf16(v[10], v[11]); o1.z = cvt_pk_bf16(v[12], v[13]); o1.w = cvt_pk_bf16(v[14], v[15]);
            *(LAS u32x4*)(Vb + t * 136 + c16) = o0; *(LAS u32x4*)(Vb + t * 136 + c16 + 8) = o1;
            if (PASS == 1 && SCAN_VV) { bf16* vd = (bf16*)(ws + O_VV) + (size_t)(row0 + t) * 1024 + h * HD + c16; *(u32x4*)vd = o0; *(u32x4*)(vd + 8) = o1; }
        }
        if (u + G < nunits) SCAN_PREFETCH(u + G);
        __syncthreads();
        if (SKIP == 1) continue;
        float vv[4][4];
#pragma unroll
        for (int m = 0; m < 4; ++m)
#pragma unroll
            for (int j = 0; j < 4; ++j) vv[m][j] = __uint_as_float(((unsigned)Vb[(16 * m + 4 * fq + j) * 136 + ch]) << 16);
        f32x4 acc2[2][2][4];
#pragma unroll
        for (int d2 = 0; d2 < 2; ++d2)
#pragma unroll
            for (int g = 0; g < 2; ++g)
#pragma unroll
                for (int m = 0; m < 4; ++m) acc2[d2][g][m] = (f32x4){0.f, 0.f, 0.f, 0.f};
#pragma unroll
        for (int ks = 0; ks < 4; ++ks)
#pragma unroll
            for (int m = 0; m < 4; ++m) { const bf16x8 af = *(const LAS bf16x8*)(Vb + (16 * m + fr) * 136 + ks * 32 + fq * 8);
#pragma unroll
                for (int d2 = 0; d2 < 2; ++d2) { acc2[d2][0][m] = __builtin_amdgcn_mfma_f32_16x16x32_bf16(af, wf[d2][0][ks], acc2[d2][0][m], 0, 0, 0); acc2[d2][1][m] = __builtin_amdgcn_mfma_f32_16x16x32_bf16(af, wf[d2][1][ks], acc2[d2][1][m], 0, 0, 0); } }
#pragma unroll
        for (int dir = 0; dir < 2; ++dir) {
            f32x4 (&acc)[2][4] = acc2[dir];
            float av[4][4], bv[4][4];
#pragma unroll
            for (int m = 0; m < 4; ++m)
#pragma unroll
                for (int j = 0; j < 4; ++j) {
                    if (SKIP == 3) { av[m][j] = acc[0][m][j]; bv[m][j] = acc[1][m][j] * vv[m][j]; continue; }
                    const float ex = __builtin_amdgcn_exp2f(fminf(fmaf(acc[0][m][j], -1.4426950408889634f, nbia[dir]), 60.f)), ey = __builtin_amdgcn_exp2f(fminf(fmaf(acc[1][m][j], -1.4426950408889634f, nbix[dir]), 60.f));
                    const float dx = 1.f + ex, dy = 1.f + ey, qq = frcp(dx * dy), rr = qq * dy, ii = qq * dx;
                    const float aa = __builtin_amdgcn_exp2f(nsp8[dir] * rr);
                    av[m][j] = aa; bv[m][j] = __builtin_amdgcn_sqrtf(fmaf(-aa, aa, 1.f)) * (ii * vv[m][j]); }
            float P[4], H[4];
#pragma unroll
            for (int m = 0; m < 4; ++m) { float p = 1.f, hh = 0.f;
#pragma unroll
                for (int i = 0; i < 4; ++i) { const int jj = dir ? 3 - i : i; hh = fmaf(av[m][jj], hh, bv[m][jj]); p *= av[m][jj]; }
                P[m] = p; H[m] = hh; }
            float Ae[4], He[4], TA[4], TB[4];
#pragma unroll
            for (int m = 0; m < 4; ++m) {
                float Pk[4], Hk[4];
#pragma unroll
                for (int k = 0; k < 4; ++k) { Pk[k] = __shfl(P[m], fr + 16 * k); Hk[k] = __shfl(H[m], fr + 16 * k); }
                float A = 1.f, B = 0.f, ae = 1.f, he = 0.f;
#pragma unroll
                for (int i = 0; i < 4; ++i) { const int k = dir ? 3 - i : i; if (k == fq) { ae = A; he = B; } B = fmaf(Pk[k], B, Hk[k]); A *= Pk[k]; }
                Ae[m] = ae; He[m] = he; TA[m] = A; TB[m] = B;
            }
            if (PASS == 1) {
                float A = 1.f, B = 0.f;
#pragma unroll
                for (int i = 0; i < 4; ++i) { const int m = dir ? 3 - i : i; B = fmaf(TA[m], B, TB[m]); A *= TA[m]; }
                if (fq == 0) *(f32x2*)((float*)(ws + (SKIP ? O_CAR : O_TOT)) + (((size_t)(SKIP ? 0 : q) * 2 + dir) * 1024 + h * HD + ch) * 2) = (f32x2){A, B};
            } else {
                float C = car[dir];
#pragma unroll
                for (int i = 0; i < 4; ++i) { const int m = dir ? 3 - i : i;
                    float hh = fmaf(Ae[m], C, He[m]);
#pragma unroll
                    for (int i2 = 0; i2 < 4; ++i2) { const int jj = dir ? 3 - i2 : i2; hh = fmaf(av[m][jj], hh, bv[m][jj]); LAS float* hp = HST + (16 * m + 4 * fq + jj) * 17 + fr; if (dir == 0) *hp = hh; else *hp += hh; }
                    C = fmaf(TA[m], C, TB[m]); }
            }
        }
        if (PASS == 2) {
            LDS_WAIT(); asm volatile("" ::: "memory");
            const unsigned gu[8] = {gg0.x, gg0.y, gg0.z, gg0.w, gg1.x, gg1.y, gg1.z, gg1.w}; unsigned o[8];
#pragma unroll
            for (int i = 0; i < 8; ++i) o[i] = cvt_pk_bf16(HST[lane * 17 + 2 * i] * bf_lo(gu[i]), HST[lane * 17 + 2 * i + 1] * bf_hi(gu[i]));
            bf16* dst = (bf16*)(ws + O_HR) + (size_t)(row0 + lane) * 1024 + h * HD + 16 * w;
            *(u32x4*)dst = (u32x4){o[0], o[1], o[2], o[3]}; *(u32x4*)(dst + 8) = (u32x4){o[4], o[5], o[6], o[7]};
            LDS_WAIT(); asm volatile("" ::: "memory");
        }
    }
#undef SCAN_PREFETCH
#undef SCAN_LANE_VARS
}
__device__ __forceinline__ void dft_stage1(AP a, const LAS f32x2* tab, size_t gt, size_t NGT) {
    unsigned char* ws = a->ws; const bf16* UT = (const bf16*)(ws + O_UT); bf16* ZT = (bf16*)(ws + O_ZT);
    for (size_t it = gt; it < (size_t)1024 * 8 * 64; it += NGT) {
        const int t2b = (int)(it & 63), b = (int)((it >> 6) & 7), c = (int)(it >> 9);
        const bf16* src = UT + (size_t)c * UT_LD + (size_t)b * 4096 + t2b * 4;
        u32x2 uc[8], us[8];
#pragma unroll
        for (int t1 = 0; t1 < 8; ++t1) { uc[t1] = *(const u32x2*)(src + 256 * t1); us[t1] = *(const u32x2*)(src + 2048 + 256 * t1); }
        unsigned zo[8][2][2];
#pragma unroll
        for (int e = 0; e < 4; e += 2) {
            float Zr[2][8], Zi[2][8];
#pragma unroll
            for (int h = 0; h < 2; ++h) {
                float xr[8], xi[8];
#pragma unroll
                for (int t1 = 0; t1 < 8; ++t1) { const unsigned wc_ = uc[t1][e >> 1], ws_ = us[t1][e >> 1]; xr[t1] = h ? bf_hi(wc_) : bf_lo(wc_); xi[t1] = -(h ? bf_hi(ws_) : bf_lo(ws_)); }
                float ar[8], ai[8];
#pragma unroll
                for (int i = 0; i < 4; ++i) { ar[i] = xr[i] + xr[i + 4]; ai[i] = xi[i] + xi[i + 4]; ar[i + 4] = xr[i] - xr[i + 4]; ai[i + 4] = xi[i] - xi[i + 4]; }
                { const float r = 0.70710678118654752f; const float t5r = (ar[5] + ai[5]) * r, t5i = (ai[5] - ar[5]) * r; ar[5] = t5r; ai[5] = t5i;
                  const float t6r = ai[6], t6i = -ar[6]; ar[6] = t6r; ai[6] = t6i;
                  const float t7r = (ai[7] - ar[7]) * r, t7i = (-ar[7] - ai[7]) * r; ar[7] = t7r; ai[7] = t7i; }
                float Xr[8], Xi[8];
#pragma unroll
                for (int o = 0; o < 2; ++o) {
                    const float b0r = ar[4 * o] + ar[4 * o + 2], b0i = ai[4 * o] + ai[4 * o + 2], b1r = ar[4 * o] - ar[4 * o + 2], b1i = ai[4 * o] - ai[4 * o + 2];
                    const float b2r = ar[4 * o + 1] + ar[4 * o + 3], b2i = ai[4 * o + 1] + ai[4 * o + 3];
                    const float dr = ar[4 * o + 1] - ar[4 * o + 3], di = ai[4 * o + 1] - ai[4 * o + 3], b3r = di, b3i = -dr;
                    Xr[o] = b0r + b2r; Xi[o] = b0i + b2i; Xr[2 + o] = b1r + b3r; Xi[2 + o] = b1i + b3i; Xr[4 + o] = b0r - b2r; Xi[4 + o] = b0i - b2i; Xr[6 + o] = b1r - b3r; Xi[6 + o] = b1i - b3i; }
                const int t2 = t2b * 4 + e + h;
                Zr[h][0] = Xr[0]; Zi[h][0] = Xi[0];
#pragma unroll
                for (int k1 = 1; k1 < 8; ++k1) { const f32x2 cs = tab[t2 * k1]; Zr[h][k1] = Xr[k1] * cs.x + Xi[k1] * cs.y; Zi[h][k1] = Xi[k1] * cs.x - Xr[k1] * cs.y; }
            }
#pragma unroll
            for (int k1 = 0; k1 < 8; ++k1) { zo[k1][0][e >> 1] = cvt_pk_bf16(Zr[0][k1], Zr[1][k1]); zo[k1][1][e >> 1] = cvt_pk_bf16(Zi[0][k1], Zi[1][k1]); }
        }
        bf16* dst = ZT + (size_t)c * UT_LD + (size_t)b * 4096 + t2b * 4;
#pragma unroll
        for (int k1 = 0; k1 < 8; ++k1) { *(u32x2*)(dst + k1 * 512) = (u32x2){zo[k1][0][0], zo[k1][0][1]}; *(u32x2*)(dst + k1 * 512 + 256) = (u32x2){zo[k1][1][0], zo[k1][1][1]}; }
    }
}
__device__ __forceinline__ void carry_phase(AP a, int gw, int NGW) {
    const int lane = opq(threadIdx.x) & 63; unsigned char* ws = a->ws;
    const f32x2* TOT = (const f32x2*)(ws + O_TOT); float* CAR = (float*)(ws + O_CAR);
    for (int item = gw; item < NB * 2 * 16; item += NGW) {
        const int cgp = item & 15, dir = (item >> 4) & 1, b = item >> 5, chn = cgp * 64 + lane;
        float hc = 0.f;
#pragma unroll 4
        for (int s = 0; s < 36; ++s) {
            int q; if (dir == 0) q = s < 4 ? 256 + b * 4 + s : b * 32 + (s - 4); else q = s < 4 ? 256 + b * 4 + (3 - s) : b * 32 + (31 - (s - 4));
            const size_t o = ((size_t)q * 2 + dir) * 1024 + chn;
            CAR[o] = hc; const f32x2 ab = TOT[o]; hc = fmaf(ab.x, hc, ab.y);
        }
    }
}
#ifndef FFN_BLK
#define FFN_BLK 1
#endif
#ifndef NORM_REV
#define NORM_REV 0
#endif
#ifndef CODE_SHIFT
#define CODE_SHIFT 0
#endif
#ifndef WGM_FD
#define WGM_FD 2
#endif
#ifndef WGM_MD
#define WGM_MD WGM
#endif
#ifndef WGM_K1
#define WGM_K1 WGM
#endif
#ifndef MOE_WNT
#define MOE_WNT 0
#endif
#ifndef FFN_DOWN_REV
#define FFN_DOWN_REV 1
#endif
#ifndef MOE_DOWN_REV
#define MOE_DOWN_REV 1
#endif
#ifndef MOE_DOWN_XCD
#define MOE_DOWN_XCD 0
#endif
#ifndef PROBE_BAR
#define PROBE_BAR 0
#endif
#ifndef MOE_NT
#define MOE_NT 0
#endif
#ifndef MOE_STAGGER
#define MOE_STAGGER 0
#endif
#ifndef MOE_WGM
#define MOE_WGM 0
#endif
#ifndef MOE_TAILSPLIT
#define MOE_TAILSPLIT 1
#endif
#ifndef SCANV
#define SCANV 2
#endif
#ifndef MOE_KSPLIT
#define MOE_KSPLIT 1
#endif
struct GridSched {
    int G, c, nM, nN, nt; const char* A; const char* B; size_t atile, btile; int rev = 0; int wgm = WGM;
    __device__ __forceinline__ bool next(int i, Unit& u) const {
        const int Lx = i * G + c; if (Lx >= nM * nN) return false;
        tile_of(rev ? nM * nN - 1 - Lx : Lx, nM, nN, u.pm, u.pn, wgm); u.A = A + (size_t)u.pm * atile; u.B = B + (size_t)u.pn * btile; u.nt = nt; u.kind = 0; u.x = 0; return true; }
};
struct FoldSched { int G, c; const char* DGp; const char* WUF;
    __device__ __forceinline__ bool next(int i, Unit& u) const {
        const int Lx = i * G + c; if (Lx >= 64) return false;
        const int pn = Lx & 7, g = (Lx >> 3) & 3, l = Lx >> 5;
        u.pm = 0; u.pn = pn; u.kind = g; u.x = l; { int n4 = 4; asm volatile("" : "+s"(n4)); u.nt = n4; }
        u.A = DGp; u.B = WUF + ((size_t)l * 2048 + pn * 256) * 1024 * 2 + (size_t)g * 256 * 2; return true; }
};
struct EpiFold { static constexpr bool PERM = true; bf16* WIN;
    __device__ __forceinline__ void operator()(const f32x4 (&acc)[2][2][4][2], const Unit& u, int wr, int wc, int fr, int fq) const { fr = opq(fr);
        bf16* base = WIN + (size_t)u.x * WIN_ROWS * 2048;
#pragma unroll
        for (int ai = 0; ai < 2; ++ai)
#pragma unroll
            for (int m = 0; m < 4; ++m) { const int row = u.kind * 256 + ai * HALF + wr * 64 + m * 16 + fr; bf16* rp = base + (size_t)row * 2048 + u.pn * 256 + wc * 32 + 8 * fq;
#pragma unroll
                for (int bj = 0; bj < 2; ++bj) { const f32x4 v0 = acc[ai][bj][m][0], v1 = acc[ai][bj][m][1];
                    u32x4 w; w.x = cvt_pk_bf16(v0[0], v0[1]); w.y = cvt_pk_bf16(v0[2], v0[3]); w.z = cvt_pk_bf16(v1[0], v1[1]); w.w = cvt_pk_bf16(v1[2], v1[3]); *(u32x4*)(rp + bj * HALF) = w; } __builtin_amdgcn_sched_barrier(0); }
    }
};
#ifndef LANE_LIN
#define LANE_LIN 1
#endif
__device__ __forceinline__ size_t lin_off(int pm, int pn8, int ai, int m, int bj, int tl);
struct WinSched { int G, c, l; const char* HNp; const char* WINl;
    __device__ __forceinline__ bool next(int i, Unit& u) const {
        int Lx = i * G + c; const int ntok = l == 0 ? 72 : 64; const int n0 = 4 * ntok, n1 = ntok * 24, n2 = l == 0 ? 0 : 32;
        if (Lx >= n0 + n1 + n2) return false;
        u.nt = 32; u.x = 0;
        if (Lx < n0) { tile_of(Lx, 4, ntok, u.pm, u.pn); u.kind = 0; u.A = WINl + (size_t)u.pm * 256 * 2048 * 2; u.B = HNp + (size_t)u.pn * 256 * 2048 * 2; return true; }
        Lx -= n0;
        if (Lx < n1) tile_of(Lx, ntok, 24, u.pm, u.pn); else { Lx -= n1; u.pm = 64 + (Lx & 7); u.pn = Lx >> 3; }
        u.kind = 1; u.A = HNp + (size_t)u.pm * 256 * 2048 * 2; u.B = WINl + (size_t)(1024 + u.pn * 256) * 2048 * 2; return true; }
};
struct EpiWin { static constexpr bool PERM = true; bf16 *UT, *UR, *GG, *SGF, *SGR;
    __device__ __forceinline__ void operator()(const f32x4 (&acc)[2][2][4][2], const Unit& u, int wr, int wc, int fr, int fq) const { fr = opq(fr);
        if (u.kind == 0) {
#pragma unroll
            for (int ai = 0; ai < 2; ++ai)
#pragma unroll
                for (int m = 0; m < 4; ++m) { const int rho = ai * HALF + wr * 64 + m * 16 + fr, sn = rho > 128 ? 1 : 0, c = sn ? rho - 128 : rho, cm = (256 - c) & 255;
                    const int ch = u.pm * 256 + c, chm = u.pm * 256 + cm;
#pragma unroll
                    for (int bj = 0; bj < 2; ++bj) { const int r = u.pn * 256 + bj * HALF + wc * 32 + 8 * fq;
                        const size_t tof = r < RL ? (size_t)(r >> 11) * 4096 + (r & 2047) : (size_t)32768 + ((r - RL) >> 8) * 512 + ((r - RL) & 255);
                        const size_t sof = r < RL ? 2048 : 256;
                        const f32x4 v0 = acc[ai][bj][m][0], v1 = acc[ai][bj][m][1];
                        u32x4 w; w.x = cvt_pk_bf16(v0[0], v0[1]); w.y = cvt_pk_bf16(v0[2], v0[3]); w.z = cvt_pk_bf16(v1[0], v1[1]); w.w = cvt_pk_bf16(v1[2], v1[3]);
                        if (sn == 0) { *(u32x4*)(UT + (size_t)ch * UT_LD + tof) = w;
                            if (cm != c) *(u32x4*)(UT + (size_t)chm * UT_LD + tof) = w;
                            else *(u32x4*)(UT + (size_t)ch * UT_LD + tof + sof) = (u32x4){0u, 0u, 0u, 0u}; }
                        else { *(u32x4*)(UT + (size_t)ch * UT_LD + tof + sof) = w;
                            const u32x4 wn = (u32x4){w.x ^ 0x80008000u, w.y ^ 0x80008000u, w.z ^ 0x80008000u, w.w ^ 0x80008000u}; *(u32x4*)(UT + (size_t)chm * UT_LD + tof + sof) = wn; } }
                    __builtin_amdgcn_sched_barrier(0); }
        } else {
            const int pn = u.pn; bf16* base; int ldc, ct, act;
            if (pn < 4) { base = UR; ldc = 1024; ct = pn; act = 0; } else if (pn < 8) { base = GG; ldc = 1024; ct = pn - 4; act = 1; }
            else if (pn < 16) { base = SGF; ldc = 2048; ct = pn - 8; act = 2; } else { base = SGR; ldc = 2048; ct = pn - 16; act = 2; }
#pragma unroll
            for (int ai = 0; ai < 2; ++ai)
#pragma unroll
                for (int m = 0; m < 4; ++m) { const int r = u.pm * 256 + ai * HALF + wr * 64 + m * 16 + fr; bf16* rp = base + (size_t)r * ldc + ct * 256 + wc * 32 + 8 * fq;
                    const int tl = (wr * 4 + wc) * 64 + fq * 16 + fr;
#pragma unroll
                    for (int bj = 0; bj < 2; ++bj) { f32x4 v0 = acc[ai][bj][m][0], v1 = acc[ai][bj][m][1];
                        if (act == 1) {
#pragma unroll
                            for (int j = 0; j < 4; ++j) { v0[j] = fgelu(v0[j]); v1[j] = fgelu(v1[j]); } }
                        else if (act == 2) {
#pragma unroll
                            for (int j = 0; j < 4; ++j) { v0[j] = fsigm(v0[j]); v1[j] = fsigm(v1[j]); } }
                        u32x4 w; w.x = cvt_pk_bf16(v0[0], v0[1]); w.y = cvt_pk_bf16(v0[2], v0[3]); w.z = cvt_pk_bf16(v1[0], v1[1]); w.w = cvt_pk_bf16(v1[2], v1[3]);
                        *(u32x4*)((LANE_LIN && act == 2) ? base + lin_off(u.pm, ct, ai, m, bj, tl) : rp + bj * HALF) = w; } __builtin_amdgcn_sched_barrier(0); }
        }
    }
};
struct DftSched { int G, c, l; const char* FLp; const char* FLCp; const char* UTp; const char* ZTp;
    __device__ __forceinline__ bool next(int i, Unit& u) const {
        int Lx = i * G + c; const int n0 = 256, n1 = l == 0 ? 32 : 0;
        if (Lx >= n0 + n1) return false;
#if DFT2
        if (Lx < n0) { const int b = Lx & 7, rest = Lx >> 3, pn = rest & 3, k1 = rest >> 2; u.pm = k1; u.pn = pn; u.kind = 0; u.x = b; u.nt = 8;
            u.A = FLp; u.B = ZTp + ((size_t)pn * 256 * UT_LD + (size_t)(b * 8 + k1) * 512) * 2; return true; }
#else
        if (Lx < n0) { const int b = Lx & 7, rest = Lx >> 3, pn = rest & 3, pm = rest >> 2; u.pm = pm; u.pn = pn; u.kind = 0; u.x = b; u.nt = 64;
            u.A = FLp + (size_t)pm * 256 * 4096 * 2; u.B = UTp + ((size_t)pn * 256 * UT_LD + (size_t)b * 4096) * 2; return true; }
#endif
        Lx -= n0; { const int b = Lx & 7, pn = Lx >> 3; u.pm = 0; u.pn = pn; u.kind = 1; u.x = b; u.nt = 8;
            u.A = FLCp; u.B = UTp + ((size_t)pn * 256 * UT_LD + 32768 + (size_t)b * 512) * 2; return true; }
    }
};
struct EpiBf16Rows { static constexpr bool PERM = true; bf16* O; int ldc;
    bool dft;
    __device__ __forceinline__ void operator()(const f32x4 (&acc)[2][2][4][2], const Unit& u, int wr, int wc, int fr, int fq) const { fr = opq(fr);
        const int rs = (DFT2 && dft && u.kind == 0) ? 8 : 1;
        const int row0 = dft ? (u.kind == 0 ? (DFT2 ? u.x * 2048 + u.pm : u.x * 2048 + u.pm * 256) : RL + u.x * 256) : u.pm * 256 + u.x * MAXSLOT;
#pragma unroll
        for (int ai = 0; ai < 2; ++ai)
#pragma unroll
            for (int m = 0; m < 4; ++m) { bf16* rp = O + (size_t)(row0 + rs * (ai * HALF + wr * 64 + m * 16 + fr)) * ldc + u.pn * 256 + wc * 32 + 8 * fq;
#pragma unroll
                for (int bj = 0; bj < 2; ++bj) { const f32x4 v0 = acc[ai][bj][m][0], v1 = acc[ai][bj][m][1];
                    u32x4 w; w.x = cvt_pk_bf16(v0[0], v0[1]); w.y = cvt_pk_bf16(v0[2], v0[3]); w.z = cvt_pk_bf16(v1[0], v1[1]); w.w = cvt_pk_bf16(v1[2], v1[3]); *(u32x4*)(rp + bj * HALF) = w; } __builtin_amdgcn_sched_barrier(0); }
    }
};
#ifndef LANE_LIN
#define LANE_LIN 1
#endif
__device__ __forceinline__ size_t lin_off(int pm, int pn8, int ai, int m, int bj, int tl) { return ((size_t)(pm * 8 + pn8) << 16) + (size_t)((((ai * 4 + m) * 2 + bj) * 512 + tl) * 8); }
template <bool ADD> struct EpiGate { static constexpr bool PERM = true; bf16* O; const bf16* gate; const bf16* addend;
    __device__ __forceinline__ void operator()(const f32x4 (&acc)[2][2][4][2], const Unit& u, int wr, int wc, int fr, int fq) const { fr = opq(fr);
        const int tl = (wr * 4 + wc) * 64 + fq * 16 + fr;
#pragma unroll
        for (int ai = 0; ai < 2; ++ai) {
            u32x4 g[4][2], t[4][2];
#pragma unroll
            for (int m = 0; m < 4; ++m) { const size_t off = (size_t)(u.pm * 256 + ai * HALF + wr * 64 + m * 16 + fr) * 2048 + u.pn * 256 + wc * 32 + 8 * fq;
#pragma unroll
                for (int bj = 0; bj < 2; ++bj) { const size_t lo = LANE_LIN ? lin_off(u.pm, u.pn, ai, m, bj, tl) : off + bj * HALF; g[m][bj] = *(const u32x4*)(gate + lo); if (ADD) t[m][bj] = *(const u32x4*)(addend + lo); } }
#pragma unroll
            for (int m = 0; m < 4; ++m) { const size_t off = (size_t)(u.pm * 256 + ai * HALF + wr * 64 + m * 16 + fr) * 2048 + u.pn * 256 + wc * 32 + 8 * fq;
#pragma unroll
                for (int bj = 0; bj < 2; ++bj) { const f32x4 v0 = acc[ai][bj][m][0], v1 = acc[ai][bj][m][1]; const u32x4 gg = g[m][bj];
                    float o[8] = {v0[0] * bf_lo(gg.x), v0[1] * bf_hi(gg.x), v0[2] * bf_lo(gg.y), v0[3] * bf_hi(gg.y), v1[0] * bf_lo(gg.z), v1[1] * bf_hi(gg.z), v1[2] * bf_lo(gg.w), v1[3] * bf_hi(gg.w)};
                    if (ADD) { const u32x4 tt = t[m][bj];
                        o[0] += bf_lo(tt.x); o[1] += bf_hi(tt.x); o[2] += bf_lo(tt.y); o[3] += bf_hi(tt.y); o[4] += bf_lo(tt.z); o[5] += bf_hi(tt.z); o[6] += bf_lo(tt.w); o[7] += bf_hi(tt.w); }
                    u32x4 w; w.x = cvt_pk_bf16(o[0], o[1]); w.y = cvt_pk_bf16(o[2], o[3]); w.z = cvt_pk_bf16(o[4], o[5]); w.w = cvt_pk_bf16(o[6], o[7]);
                    *(u32x4*)(O + ((LANE_LIN && !ADD) ? lin_off(u.pm, u.pn, ai, m, bj, tl) : off + bj * HALF)) = w; } }
            asm volatile("" ::: "memory"); __builtin_amdgcn_sched_barrier(0); }
    }
};
template <bool FIRST> struct EpiResid { static constexpr bool PERM = false; float* lat; const float* modl; int gate_chunk; const float* x0; const float* c0;
    __device__ __forceinline__ void operator()(const f32x4 (&acc)[2][2][4][2], const Unit& u, int wr, int wc, int fr, int fq) const { fr = opq(fr);
        const int bi = u.pm < 64 ? (u.pm >> 3) : 8; const int col0 = u.pn * 256 + wc * 32 + 4 * fq;
        const float* gp = modl + (size_t)bi * 12288 + gate_chunk * D + col0;
        f32x4 gv[2][2];
#pragma unroll
        for (int bj = 0; bj < 2; ++bj)
#pragma unroll
            for (int n = 0; n < 2; ++n) gv[bj][n] = *(const f32x4*)(gp + bj * HALF + n * 16);
#pragma unroll
        for (int ai = 0; ai < 2; ++ai) {
            f32x4 bsv[4][2][2];
#pragma unroll
            for (int m = 0; m < 4; ++m) { const int row = u.pm * 256 + ai * HALF + wr * 64 + m * 16 + fr; const float* rp = lat + (size_t)row * D + col0;
                const float* bp = FIRST ? (u.pm < 64 ? x0 + (size_t)row * D + col0 : c0 + (size_t)(row - RL) * D + col0) : rp;
#pragma unroll
                for (int bj = 0; bj < 2; ++bj)
#pragma unroll
                    for (int n = 0; n < 2; ++n) bsv[m][bj][n] = *(const f32x4*)(bp + bj * HALF + n * 16); }
#pragma unroll
            for (int m = 0; m < 4; ++m) { const int row = u.pm * 256 + ai * HALF + wr * 64 + m * 16 + fr; float* rp = lat + (size_t)row * D + col0;
#pragma unroll
                for (int bj = 0; bj < 2; ++bj)
#pragma unroll
                    for (int n = 0; n < 2; ++n) *(f32x4*)(rp + bj * HALF + n * 16) = bsv[m][bj][n] + gv[bj][n] * acc[ai][bj][m][n]; }
            asm volatile("" ::: "memory"); __builtin_amdgcn_sched_barrier(0); }
    }
};
struct EpiNull { static constexpr bool PERM = true; float* sink;
    __device__ __forceinline__ void operator()(const f32x4 (&acc)[2][2][4][2], const Unit& u, int wr, int wc, int fr, int fq) const {
        float s = 0.f;
#pragma unroll
        for (int ai = 0; ai < 2; ++ai)
#pragma unroll
            for (int bj = 0; bj < 2; ++bj)
#pragma unroll
                for (int m = 0; m < 4; ++m)
#pragma unroll
                    for (int n = 0; n < 2; ++n) s += acc[ai][bj][m][n][0] + acc[ai][bj][m][n][1] + acc[ai][bj][m][n][2] + acc[ai][bj][m][n][3];
        if (s == 1.2345e30f) sink[u.pm] = s;
    }
};
template <bool NT> struct EpiSwigluT { static constexpr bool PERM = true; bf16* O; int ldc; int blk = 0;
    __device__ __forceinline__ void operator()(const f32x4 (&acc)[2][2][4][2], const Unit& u, int wr, int wc, int fr, int fq) const { fr = opq(fr);
#pragma unroll
        for (int ai = 0; ai < 2; ++ai)
#pragma unroll
            for (int m = 0; m < 4; ++m) { bf16* rp = blk ? O + ((size_t)u.pm * blk + u.pn) * 32768 + (size_t)(ai * HALF + wr * 64 + m * 16 + fr) * 128 + wc * 32 + 8 * fq : O + (size_t)(u.pm * 256 + ai * HALF + wr * 64 + m * 16 + fr) * ldc + u.pn * 128 + wc * 32 + 8 * fq;
                const f32x4 g0 = acc[ai][0][m][0], g1 = acc[ai][0][m][1], u0 = acc[ai][1][m][0], u1 = acc[ai][1][m][1];
                u32x4 w; w.x = cvt_pk_bf16(fsilu(g0[0]) * u0[0], fsilu(g0[1]) * u0[1]); w.y = cvt_pk_bf16(fsilu(g0[2]) * u0[2], fsilu(g0[3]) * u0[3]);
                w.z = cvt_pk_bf16(fsilu(g1[0]) * u1[0], fsilu(g1[1]) * u1[1]); w.w = cvt_pk_bf16(fsilu(g1[2]) * u1[2], fsilu(g1[3]) * u1[3]); if (NT) __builtin_nontemporal_store(w, (u32x4*)rp); else *(u32x4*)rp = w; __builtin_amdgcn_sched_barrier(0); }
    }
};
typedef EpiSwigluT<false> EpiSwiglu;
struct EpiSwigluWrap { static constexpr bool PERM = true; bf16* O; int ldc;
    __device__ __forceinline__ void operator()(const f32x4 (&acc)[2][2][4][2], const Unit& u, int wr, int wc, int fr, int fq) const { fr = opq(fr);
#pragma unroll
        for (int ai = 0; ai < 2; ++ai)
#pragma unroll
            for (int m = 0; m < 4; ++m) { bf16* rp = O + (size_t)((u.pm & 7) * 256 + ai * HALF + wr * 64 + m * 16 + fr) * ldc + u.pn * 128 + wc * 32 + 8 * fq;
                const f32x4 g0 = acc[ai][0][m][0], g1 = acc[ai][0][m][1], u0 = acc[ai][1][m][0], u1 = acc[ai][1][m][1];
                u32x4 w; w.x = cvt_pk_bf16(fsilu(g0[0]) * u0[0], fsilu(g0[1]) * u0[1]); w.y = cvt_pk_bf16(fsilu(g0[2]) * u0[2], fsilu(g0[3]) * u0[3]);
                w.z = cvt_pk_bf16(fsilu(g1[0]) * u1[0], fsilu(g1[1]) * u1[1]); w.w = cvt_pk_bf16(fsilu(g1[2]) * u1[2], fsilu(g1[3]) * u1[3]); *(u32x4*)rp = w; __builtin_amdgcn_sched_barrier(0); }
    }
};
struct MoeSched { int G, c, nN, nt; const LAS int* tbl; const char* A; const char* B; size_t atile, btile, bexp; int ksplit; size_t khalf;
    __device__ __forceinline__ bool next(int i, Unit& u) const {
        int Lx = i * G + c; const int total = tbl[8] * nN; if (Lx >= total * ksplit) return false;
        int kh = 0; if (ksplit == 2) { kh = Lx >= total ? 1 : 0; Lx -= kh * total; }
        int e = 0;
#pragma unroll
        for (int k = 1; k < 8; ++k) e += (Lx >= tbl[k] * nN) ? 1 : 0;
        const int t0 = tbl[e], te = tbl[e + 1] - t0, lx = Lx - t0 * nN;
        { int pml, pnl; tile_of(lx, te, nN, pml, pnl, MOE_WGM ? (MOE_WGM < te ? MOE_WGM : te) : WGM); u.pm = t0 + pml; u.pn = pnl; }
        u.kind = e; u.x = kh; u.nt = nt;
        u.A = A + (size_t)u.pm * atile + (size_t)kh * khalf; u.B = B + (size_t)e * bexp + (size_t)u.pn * btile + (size_t)kh * khalf; return true; }
};


struct MoeDownSched { int G, c, sp; const LAS int* tbl; const char* A; const char* B; size_t atile, btile, bexp;
    __device__ __forceinline__ bool next(int i, Unit& u) const {
        const int U = tbl[8] * 8, full = U / G, R = U - full * G;
        int Lx = i * G + c, k = 0, rr = -1;
        if (i > full) return false;
        if (i == full) { if (sp > 1) { if (c >= R * sp) return false; rr = c / sp; k = c - rr * sp; Lx = full * G + rr; } else if (c >= R) return false; }
        else if (MOE_DOWN_REV) Lx = full * G - 1 - Lx;
        int e = 0;
#pragma unroll
        for (int kk = 1; kk < 8; ++kk) e += (Lx >= tbl[kk] * 8) ? 1 : 0;
        const int t0 = tbl[e], te = tbl[e + 1] - t0, lx = Lx - t0 * 8;
#if MOE_DOWN_XCD
        { const int id = (lx & 7) * te + (lx >> 3); u.pm = t0 + (id >> 3); u.pn = id & 7; }
#else
        { int pml, pnl; tile_of(lx, te, 8, pml, pnl, WGM_MD); u.pm = t0 + pml; u.pn = pnl; }
#endif
        u.kind = e; const int nts = rr < 0 ? 112 : 112 / sp; u.nt = nts; u.x = rr < 0 ? 0 : 1 + rr * 16 + k;
        const size_t ko = MOE_BLK ? (size_t)k * (nts >> 1) * 65536 : (size_t)k * nts * 128;
        u.A = A + (size_t)u.pm * atile + ko; u.B = B + (size_t)e * bexp + (size_t)u.pn * btile + ko; return true; }
};
struct EpiMoeDown { static constexpr bool PERM = true; bf16* O; float* part; unsigned* cnt; int sp;
    __device__ __forceinline__ void store_rows(const f32x4 (&v)[2][2][4][2], const Unit& u, int wr, int wc, int fr, int fq) const {
#pragma unroll
        for (int ai = 0; ai < 2; ++ai)
#pragma unroll
            for (int m = 0; m < 4; ++m) { bf16* rp = O + (size_t)(u.pm * 256 + ai * HALF + wr * 64 + m * 16 + fr) * 2048 + u.pn * 256 + wc * 32 + 8 * fq;
#pragma unroll
                for (int bj = 0; bj < 2; ++bj) { const f32x4 v0 = v[ai][bj][m][0], v1 = v[ai][bj][m][1];
                    u32x4 w; w.x = cvt_pk_bf16(v0[0], v0[1]); w.y = cvt_pk_bf16(v0[2], v0[3]); w.z = cvt_pk_bf16(v1[0], v1[1]); w.w = cvt_pk_bf16(v1[2], v1[3]); *(u32x4*)(rp + bj * HALF) = w; } __builtin_amdgcn_sched_barrier(0); }
    }
    template <int SP> __device__ __forceinline__ void reduce_store(const float* P0, const Unit& u, int wr, int wc, int fr, int fq) const {
        constexpr int NPB = SP <= 4 ? 4 : (SP <= 8 ? 2 : 1);
#pragma unroll
        for (int ai = 0; ai < 2; ++ai)
#pragma unroll
            for (int m = 0; m < 4; ++m) { bf16* rp = O + (size_t)(u.pm * 256 + ai * HALF + wr * 64 + m * 16 + fr) * 2048 + u.pn * 256 + wc * 32 + 8 * fq;
                f32x4 v[4];
#pragma unroll
                for (int p0 = 0; p0 < 4; p0 += NPB) { f32x4 t[NPB][SP];
#pragma unroll
                    for (int pp = 0; pp < NPB; ++pp) { const int idx = (ai * 4 + m) * 4 + p0 + pp;
#pragma unroll
                        for (int kk = 0; kk < SP; ++kk) t[pp][kk] = *(const f32x4*)(P0 + ((size_t)kk << 16) + idx * 2048); }
#pragma unroll
                    for (int pp = 0; pp < NPB; ++pp) { f32x4 a4 = t[pp][0];
#pragma unroll
                        for (int kk = 1; kk < SP; ++kk) a4 += t[pp][kk];
                        v[p0 + pp] = a4; }
                    asm volatile("" ::: "memory"); }
#pragma unroll
                for (int bj = 0; bj < 2; ++bj) { u32x4 w; w.x = cvt_pk_bf16(v[2 * bj][0], v[2 * bj][1]); w.y = cvt_pk_bf16(v[2 * bj][2], v[2 * bj][3]); w.z = cvt_pk_bf16(v[2 * bj + 1][0], v[2 * bj + 1][1]); w.w = cvt_pk_bf16(v[2 * bj + 1][2], v[2 * bj + 1][3]);
                    *(u32x4*)(rp + bj * HALF) = w; }
                __builtin_amdgcn_sched_barrier(0); }
    }
    __device__ __forceinline__ void operator()(const f32x4 (&acc)[2][2][4][2], const Unit& u, int wr, int wc, int fr, int fq) const { fr = opq(fr);
        if (u.x == 0) { store_rows(acc, u, wr, wc, fr, fq); return; }
        const int rr = (u.x - 1) >> 4, k = (u.x - 1) & 15, wid = wr * 4 + wc, tl = wid * 64 + fq * 16 + fr;
        float* P = part + ((size_t)(rr * sp + k) << 16) + (size_t)tl * 4;
#pragma unroll
        for (int ai = 0; ai < 2; ++ai)
#pragma unroll
            for (int m = 0; m < 4; ++m)
#pragma unroll
                for (int bj = 0; bj < 2; ++bj)
#pragma unroll
                    for (int n = 0; n < 2; ++n) { const int idx = ((ai * 4 + m) * 2 + bj) * 2 + n; float* q = P + idx * 2048; const f32x4 vv = acc[ai][bj][m][n];
                        asm volatile("global_store_dwordx4 %0, %1, off sc1" :: "v"(q), "v"(vv) : "memory"); }
        asm volatile("s_waitcnt vmcnt(0)" ::: "memory");
        unsigned tk = 0u; if (fq * 16 + fr == 0) tk = __hip_atomic_fetch_add(cnt + rr * 8 + wid, 1u, __ATOMIC_RELAXED, __HIP_MEMORY_SCOPE_AGENT);
        tk = (unsigned)__builtin_amdgcn_readfirstlane((int)tk);
        if (tk + 1u == (unsigned)sp) {
            __builtin_amdgcn_fence(__ATOMIC_ACQUIRE, "agent"); asm volatile("s_waitcnt vmcnt(0)" ::: "memory");
            const float* P0 = part + ((size_t)(rr * sp) << 16) + (size_t)tl * 4;
            switch (sp) { case 2: reduce_store<2>(P0, u, wr, wc, fr, fq); break; case 4: reduce_store<4>(P0, u, wr, wc, fr, fq); break; case 7: reduce_store<7>(P0, u, wr, wc, fr, fq); break;
                          case 8: reduce_store<8>(P0, u, wr, wc, fr, fq); break; default: reduce_store<14>(P0, u, wr, wc, fr, fq); break; }
        }
    }
};

__device__ __forceinline__ void moe_gather(AP a, LAS unsigned char* lds, int vcu, int G) {
    const int tid = opq(threadIdx.x), lane = tid & 63, w = tid >> 6; unsigned char* ws = a->ws;
    LAS int* cl = (LAS int*)lds;
    LAS int* pre = cl + 2048;
    LAS int* off = pre + 8;
    LAS int* tot = off + 24;
    LAS int* sl = tot + 8;
    const int* cntb = (const int*)(ws + O_MISC + M_CNTB); const int* sel = (const int*)(ws + O_MISC + M_SEL);
    int* slot_of = (int*)(ws + O_MISC + M_SLOT);
    const bf16* HN = (const bf16*)(ws + O_HN); bf16* XG = (bf16*)(ws + O_XG);
    for (int i = tid; i < 2048; i += NTHREADS) cl[i] = cntb[i];
    __syncthreads();
    for (int g = vcu; g < 256; g += G) {
        if (tid < 8) { int s = 0, p = 0;
#pragma unroll 8
            for (int j = 0; j < 256; ++j) { const int v = cl[j * 8 + tid]; p += (j < g) ? v : 0; s += v; }
            pre[tid] = p; tot[tid] = s; }
        __syncthreads();
        if (tid == 0) { int o = 0; for (int e = 0; e < 8; ++e) { off[e] = o * 256; off[8 + e] = o; o += (tot[e] + 255) >> 8; } off[16] = o;
            if (g == 0) { int* T = (int*)(ws + O_MISC + M_TOT); for (int e = 0; e < 8; ++e) T[e] = tot[e]; for (int e = 0; e < 9; ++e) T[16 + e] = off[8 + e]; } }
        __syncthreads();
        if (w == 0) { const int tkn = g * 64 + lane; const int s0 = sel[tkn * 2], s1 = sel[tkn * 2 + 1]; int slot0 = 0, slot1 = 0;
            const unsigned long long lt = (1ull << lane) - 1ull;
#pragma unroll
            for (int e = 0; e < 8; ++e) { const unsigned long long mk = __ballot(s0 == e || s1 == e); const int rk = __popcll(mk & lt);
                if (s0 == e) slot0 = off[e] + pre[e] + rk; if (s1 == e) slot1 = off[e] + pre[e] + rk; }
            slot_of[tkn * 2] = slot0; slot_of[tkn * 2 + 1] = slot1; sl[lane * 2] = slot0; sl[lane * 2 + 1] = slot1; }
        __syncthreads();
        for (int p0 = w * 16; p0 < w * 16 + 16; p0 += 4) { u32x4 v[4][4];
#pragma unroll
            for (int r = 0; r < 4; ++r) { const int tkn = g * 64 + ((p0 + r) >> 1); const u32x4* sp_ = (const u32x4*)(HN + (size_t)tkn * D) + lane;
#pragma unroll
                for (int j = 0; j < 4; ++j) v[r][j] = sp_[64 * j]; }
#pragma unroll
            for (int r = 0; r < 4; ++r) { const int slot = sl[p0 + r]; u32x4* d = (u32x4*)(XG + (size_t)slot * D) + lane;
#pragma unroll
                for (int j = 0; j < 4; ++j) d[64 * j] = v[r][j]; } }
        if (g < 8) { const int r0 = off[g] + tot[g], r1 = off[g] + (((tot[g] + 255) >> 8) << 8);
            for (int r = r0 + w; r < r1; r += NWAVES) { u32x4* d = (u32x4*)(XG + (size_t)r * D) + lane;
#pragma unroll
                for (int j = 0; j < 4; ++j) d[64 * j] = (u32x4){0u, 0u, 0u, 0u}; } }
        __syncthreads();
    }
}
struct CombIdx { int s0, s1; float w0, w1; };
__device__ __forceinline__ CombIdx comb_idx(const unsigned char* ws, int row) { const int* slot_of = (const int*)(ws + O_MISC + M_SLOT); const float* gwt = (const float*)(ws + O_MISC + M_GWT);
    CombIdx c; c.s0 = slot_of[row * 2]; c.s1 = slot_of[row * 2 + 1]; c.w0 = gwt[row * 2]; c.w1 = gwt[row * 2 + 1]; return c; }
__device__ __forceinline__ void comb_load(const unsigned char* ws, int row, const CombIdx& c, int lane, f32x4 (&xv)[8], u32x2 (&p0)[8], u32x2 (&p1)[8]) {
    const f32x4* xr = (const f32x4*)((const float*)(ws + O_LAT) + (size_t)row * D);
    const u32x2* o0 = (const u32x2*)((const bf16*)(ws + O_OS) + (size_t)c.s0 * D); const u32x2* o1 = (const u32x2*)((const bf16*)(ws + O_OS) + (size_t)c.s1 * D);
#pragma unroll
    for (int j = 0; j < 8; ++j) { const int i4 = lane + 64 * j; xv[j] = xr[i4]; p0[j] = o0[i4]; p1[j] = o1[i4]; }
}
__device__ __forceinline__ void comb_row(AP a, int row, const CombIdx& c, int lane, const f32x4 (&xv)[8], const u32x2 (&p0)[8], const u32x2 (&p1)[8]) {
    const unsigned char* ws = a->ws; const float w0 = c.w0, w1 = c.w1;
    const float* g2 = (const float*)(ws + O_MOD) + ((size_t)9 + (row >> 11)) * 12288 + 5 * D;
    f32x4 v[8]; float s = 0.f;
#pragma unroll
    for (int j = 0; j < 8; ++j) { const int i4 = lane + 64 * j; const f32x4 gg = *(const f32x4*)(g2 + i4 * 4);
        f32x4 m; m.x = w0 * bf_lo(p0[j].x) + w1 * bf_lo(p1[j].x); m.y = w0 * bf_hi(p0[j].x) + w1 * bf_hi(p1[j].x); m.z = w0 * bf_lo(p0[j].y) + w1 * bf_lo(p1[j].y); m.w = w0 * bf_hi(p0[j].y) + w1 * bf_hi(p1[j].y);
        v[j] = xv[j] + gg * m; s += (v[j].x * v[j].x + v[j].y * v[j].y) + (v[j].z * v[j].z + v[j].w * v[j].w); }
    const float rstd = rsqrtf(wave_sum(s) * (1.f / D) + 1e-6f);
    f32x4* out = (f32x4*)(a->out + (size_t)row * D);
#pragma unroll
    for (int j = 0; j < 8; ++j) { const int i4 = lane + 64 * j; out[i4] = v[j] * rstd * *(const f32x4*)(a->in[26] + i4 * 4); }
}
__device__ __forceinline__ void moe_combine_phase(AP a, int gw, int NGW, int lane) {
    const unsigned char* ws = a->ws; int r = gw; if (r >= RL) return;
    CombIdx ci = comb_idx(ws, r), cn = ci; if (r + NGW < RL) cn = comb_idx(ws, r + NGW);
    f32x4 xv[8]; u32x2 p0[8], p1[8]; comb_load(ws, r, ci, lane, xv, p0, p1);
    for (; r < RL; r += NGW) {
        const int rn = r + NGW, rnn = rn + NGW; f32x4 xn[8]; u32x2 q0[8], q1[8]; CombIdx cnn = cn;
        if (rn < RL) comb_load(ws, rn, cn, lane, xn, q0, q1);
        if (rnn < RL) cnn = comb_idx(ws, rnn);
        comb_row(a, r, ci, lane, xv, p0, p1);
#pragma unroll
        for (int j = 0; j < 8; ++j) { xv[j] = xn[j]; p0[j] = q0[j]; p1[j] = q1[j]; }
        ci = cn; cn = cnn;
    }
}

constexpr int NPHASE = 26;
constexpr int l_min(int a, int b) { return a < b ? a : b; }
#ifndef PROBE_PHASE
#define PROBE_PHASE (-1)
#endif
#define REPS(k) (((k) == PROBE_PHASE) ? 2 : 1)
#ifndef CVB
#define CVB 125
#endif
constexpr int cvb(int n) { return (int)((long long)n * CVB / 100); }
#ifndef CVQ
#define CVQ 0, 5000, 5000, 11000, 9000, 30000, 10000, 0
#endif
constexpr int cvq[8] = {CVQ};
constexpr int CV_W00 = 0, CV_W01 = CV_W00 + cvb(cvq[0]), CV_T10 = CV_W01, CV_T11 = CV_T10 + cvb(cvq[1]), CV_MG0 = CV_T11, CV_MG1 = CV_MG0 + cvb(cvq[2]), CV_OUT0 = CV_MG1, CV_OUT1 = CV_OUT0 + cvb(cvq[3]),
              CV_FG0 = CV_OUT1, CV_FG1 = CV_FG0 + cvb(cvq[4]), CV_FD0 = CV_FG1, CV_FD1 = CV_FD0 + cvb(cvq[5]),
              CV_GU0 = N_MOE - cvb(cvq[7]), CV_GU1 = N_MOE,
              CV_WI0 = l_min(CV_FD1, CV_GU0), CV_WI1 = l_min(CV_WI0 + cvb(cvq[6]), CV_GU0), CV_FLUSH = CV_WI1;
static_assert(CV_GU0 >= N_MG + N_MU && CV_FD1 <= N_MOE, "conversion slices");
constexpr int CV_GUS = CV_GU0;
#define TAILCVT(total, c0, c1) do { const int rem_ = (total) % G; if (l == 0 || (c0) == CV_WI0 || (c0) == CV_GUS) { if (rem_ != 0 && bx >= rem_ && (c0) < N_MOE) cvt_moe_range(argp, lds, (c0), l_min((c1), N_MOE), (bx - rem_) * NWAVES + wave, (G - rem_) * NWAVES); __syncthreads(); } } while (0)
template <int l>
__device__ __forceinline__ void layer_phases(LAS unsigned char* lds, unsigned char* ws, const int lo, const int hi, const XcdBarrier& bar, const int G, const int bx, const int vcu, const int gw, const int NGW, const int tid, const int lane, const int wave) {
#define args (*kargs())
#define argp (kargs())
#define IN(k) (lo <= (k) && (k) < hi)
#define SEAM(k) do { if (IN(k) && IN((k) + 1)) { xcd_barrier(bar); if (PROBE_BAR) xcd_barrier(bar); } } while (0)
    const char* HNp = (const char*)(ws + O_HN);
    float* LAT = (float*)(ws + O_LAT);
        const int pb = 2 + 12 * l;
        const float* modl = (const float*)(ws + O_MOD) + (size_t)l * 9 * 12288;
        const int ntok = l == 0 ? 72 : 64;
        if (IN(pb + 0)) for (int rep = 0; rep < REPS(pb + 0); ++rep) { WinSched S{G, bx, l, HNp, (const char*)(ws + O_WIN) + (size_t)l * WIN_ROWS * 2048 * 2};
            EpiWin E{(bf16*)(ws + O_UT), (bf16*)(ws + O_UR), (bf16*)(ws + O_GG), (bf16*)(ws + O_SGF), (bf16*)(ws + O_SGR)}; gemm_phase<EpiWin, WinSched>(lds, 2048, 2048, S, E); if (l == 1) TAILCVT(1824, CV_WI0, CV_WI1); else TAILCVT(2016, CV_W00, CV_W01); }
        SEAM(pb + 0);
        if (IN(pb + 1)) for (int rep = 0; rep < REPS(pb + 1); ++rep) {
#if defined(PROBE_SKIP)
            if (rep == 1) scan_phase2<1, PROBE_SKIP>(argp, lds, l, NCHUNK * 8, vcu, G); else
#endif
            if (SCANV == 2) scan_phase2<1>(argp, lds, l, NCHUNK * 8, vcu, G); else scan_phase<1>(argp, lds, l, NCHUNK * 8, vcu, G);
#if DFT2
            { __syncthreads(); LAS f32x2* tab = (LAS f32x2*)lds;
              for (int m = opq(tid); m < 2048; m += NTHREADS) { float sn, cs; sincospif((float)m * (1.f / 1024.f), &sn, &cs); tab[m] = (f32x2){cs, sn}; }
              __syncthreads(); dft_stage1(argp, tab, (size_t)vcu * NTHREADS + opq(tid), (size_t)G * NTHREADS); __syncthreads(); }
#endif
            }
        SEAM(pb + 1);
        if (IN(pb + 2)) for (int rep = 0; rep < REPS(pb + 2); ++rep) { DftSched S{G, bx, l, (const char*)(ws + O_FL), (const char*)(ws + O_FLC), (const char*)(ws + O_UT), (const char*)(ws + O_ZT)}; EpiBf16Rows E{(bf16*)(ws + O_Y), 1024, true};
            gemm_phase<EpiBf16Rows, DftSched>(lds, 4096, UT_LD, S, E); carry_phase(argp, opq(gw), NGW); }
        SEAM(pb + 2);
        if (IN(pb + 3)) for (int rep = 0; rep < REPS(pb + 3); ++rep) { GridSched S{G, bx, ntok, 8, 16, (const char*)(ws + O_Y), (const char*)(ws + O_WFO) + (size_t)l * 2048 * 1024 * 2, (size_t)256 * 1024 * 2, (size_t)256 * 1024 * 2, 0, WGM_K1};
            EpiGate<false> E{(bf16*)(ws + O_T1), (const bf16*)(ws + O_SGF), nullptr}; gemm_phase<EpiGate<false>, GridSched>(lds, 1024, 1024, S, E); TAILCVT(ntok * 8, CV_T10, CV_T11);
            if (SCANV == 2) scan_phase2<2>(argp, lds, l, (l == 0 ? NCHUNK : 256) * 8, vcu, G); else scan_phase<2>(argp, lds, l, (l == 0 ? NCHUNK : 256) * 8, vcu, G); }
        SEAM(pb + 3);
        if (IN(pb + 4)) for (int rep = 0; rep < REPS(pb + 4); ++rep) { GridSched S{G, bx, ntok, 8, 16, (const char*)(ws + O_HR), (const char*)(ws + O_WRO) + (size_t)l * 2048 * 1024 * 2, (size_t)256 * 1024 * 2, (size_t)256 * 1024 * 2, 0, WGM_K1};
            EpiGate<true> E{(bf16*)(ws + O_MG), (const bf16*)(ws + O_SGR), (const bf16*)(ws + O_T1)}; gemm_phase<EpiGate<true>, GridSched>(lds, 1024, 1024, S, E); TAILCVT(ntok * 8, CV_MG0, CV_MG1); }
        SEAM(pb + 4);
        if (IN(pb + 5)) { GridSched S{G, bx, ntok, 8, 32, (const char*)(ws + O_MG), (const char*)(ws + O_WO) + (size_t)l * 2048 * 2048 * 2, (size_t)256 * 2048 * 2, (size_t)256 * 2048 * 2};
            EpiResid<l == 0> E{LAT, modl, 2, args.in[0], args.in[2]}; gemm_phase<EpiResid<l == 0>, GridSched>(lds, 2048, 2048, S, E); TAILCVT(ntok * 8, CV_OUT0, CV_OUT1); }
        SEAM(pb + 5);
        if (IN(pb + 6)) for (int rep = 0; rep < REPS(pb + 6); ++rep) {
            if (l == 0) { const int ln = opq(lane); f32x4 v[8]; int r = NORM_REV ? R - 1 - gw : gw; const int st = NORM_REV ? -NGW : NGW;
                if (r >= 0 && r < R) norm_load(v, LAT + (size_t)r * D, ln);
                for (; r >= 0 && r < R; r += st) { f32x4 vn[8]; const int rn = r + st; if (rn >= 0 && rn < R) norm_load(vn, LAT + (size_t)rn * D, ln);
                    norm_row<false>(v, args.in[7], modl, 3, 4, (bf16*)(ws + O_HN), r, ln, nullptr, nullptr, nullptr);
#pragma unroll
                    for (int j = 0; j < 8; ++j) v[j] = vn[j]; } }
            else {
                LAS float* rt = (LAS float*)lds; for (int i = tid; i < 2048 * 8; i += NTHREADS) rt[i] = args.in[22][i];
                LAS int* gs = (LAS int*)(lds + 65536);
                __syncthreads();
                int* sel = (int*)(ws + O_MISC + M_SEL); float* gwt = (float*)(ws + O_MISC + M_GWT); int* cntb = (int*)(ws + O_MISC + M_CNTB);
                for (int g = vcu; g < 256; g += G) {
                    { const int ln = opq(lane); f32x4 v[8]; norm_load(v, LAT + (size_t)(g * 64 + wave * 8) * D, ln);
                      for (int k = 0; k < 8; ++k) { const int r = g * 64 + wave * 8 + k; f32x4 vn[8]; if (k < 7) norm_load(vn, LAT + (size_t)(r + 1) * D, ln);
                        const int pk = norm_row<true>(v, args.in[7] + D, modl, 3, 4, (bf16*)(ws + O_HN), r, ln, rt, sel, gwt);
                        if (lane == 0) { gs[(wave * 8 + k) * 2] = pk & 255; gs[(wave * 8 + k) * 2 + 1] = pk >> 8; }
#pragma unroll
                        for (int j = 0; j < 8; ++j) v[j] = vn[j]; } }
                    __syncthreads();
                    if (wave == 0) { const int s0 = gs[lane * 2], s1 = gs[lane * 2 + 1];
#pragma unroll
                        for (int e = 0; e < 8; ++e) { const unsigned long long mk = __ballot(s0 == e || s1 == e); if (lane == e) cntb[g * 8 + e] = __popcll(mk); } }
                    __syncthreads();
                }
            }
        }
        SEAM(pb + 6);
        if (l == 1) { if (IN(pb + 7)) { moe_gather(argp, lds, vcu, G); __syncthreads(); cvt_moe_range(argp, lds, CV_FLUSH, CV_GUS, gw, NGW); } SEAM(pb + 7); }
        if (IN(pb + 8)) for (int rep = 0; rep < REPS(pb + 8); ++rep) {
            if (l == 0) { GridSched S{G, bx, 72, 44, 32, HNp, (const char*)(ws + O_FGU), (size_t)256 * 2048 * 2, (size_t)256 * 2048 * 2};
#if defined(PROBE_ALT)
#if PROBE_ALT == 2
                if (rep == 1) { EpiSwiglu E{(bf16*)(ws + O_HIDM + (size_t)80 * 1024 * 1024), DFF}; gemm_phase<EpiSwiglu, GridSched>(lds, 2048, 2048, S, E); } else
#else
                if (rep == 1) { EpiNull E{(float*)(ws + O_HIDM)}; gemm_phase<EpiNull, GridSched>(lds, 2048, 2048, S, E); } else
#endif
#endif
                { EpiSwiglu E{(bf16*)(ws + O_HID), DFF, FFN_BLK ? 44 : 0}; gemm_phase<EpiSwiglu, GridSched>(lds, 2048, 2048, S, E); TAILCVT(72 * 44, CV_FG0, CV_FG1); } }
            else { LAS int* tbl = (LAS int*)(lds + MISC_OFF + 256); if (tid < 9) tbl[tid] = ((const int*)(ws + O_MISC + M_TOT))[16 + tid]; __syncthreads();
                MoeSched S{G, bx, 56, 32, tbl, (const char*)(ws + O_XG), (const char*)(ws + O_MGU), (size_t)256 * 2048 * 2, (size_t)256 * 2048 * 2, (size_t)14336 * 2048 * 2, 1, 0};
                if (MOE_STAGGER) {
                    const unsigned long long t0 = __builtin_amdgcn_s_memrealtime(), dl = (unsigned long long)(((bx >> 3) & 3) * MOE_STAGGER);
                    while (__builtin_amdgcn_s_memrealtime() - t0 < dl) __builtin_amdgcn_s_sleep(8); }
#if defined(PROBE_MOE)
                if (rep == 1 && PROBE_MOE == 3) { EpiSwigluWrap E3{(bf16*)(ws + O_OS), DE}; gemm_phase<EpiSwigluWrap, MoeSched>(lds, 2048, 2048, S, E3); } else
                if (rep == 1) { MoeSched S2 = S; if (PROBE_MOE == 2) S2.bexp = 0; EpiNull E2{(float*)(ws + O_OS)}; gemm_phase<EpiNull, MoeSched>(lds, 2048, MOE_BLK ? 128 : 2048, S2, E2, 256, MOE_BLK ? 65536 : 256); } else
#endif
                { EpiSwigluT<MOE_NT != 0> E{(bf16*)(ws + O_HIDM), DE, MOE_BLK ? 56 : 0}; gemm_phase<EpiSwigluT<MOE_NT != 0>, MoeSched, G_ALIGN, G_SP2, MOE_WNT>(lds, 2048, MOE_BLK ? 128 : 2048, S, E, 256, MOE_BLK ? 65536 : 256);
                  { const int rem2 = (tbl[8] * 56) % G;
                    if (rem2 == 0 || G - rem2 < 24) { cvt_moe_range(argp, lds, CV_GUS, CV_GU1, gw, NGW); __syncthreads(); } else TAILCVT(tbl[8] * 56, CV_GUS, CV_GU1); } } }
        }
        SEAM(pb + 8);
        if (IN(pb + 9)) for (int rep = 0; rep < (l == 1 ? REPS(pb + 9) : 1); ++rep) {
            if (l == 0) { GridSched S{G, bx, 72, 8, 88, (const char*)(ws + O_HID), (const char*)(ws + O_FD), (size_t)256 * DFF * 2, (size_t)256 * DFF * 2, FFN_DOWN_REV, WGM_FD};
                EpiResid<false> E{LAT, modl, 5, nullptr, nullptr}; gemm_phase<EpiResid<false>, GridSched>(lds, FFN_BLK ? 128 : DFF, DFF, S, E, FFN_BLK ? 65536 : 256, 256); TAILCVT(72 * 8, CV_FD0, CV_FD1); }
            else { LAS int* tbl = (LAS int*)(lds + MISC_OFF + 256); if (tid < 9) tbl[tid] = ((const int*)(ws + O_MISC + M_TOT))[16 + tid]; __syncthreads();
#if MOE_TAILSPLIT
                int sp = 1; { const int U = tbl[8] * 8, R = U % G; if (R > 0) { if (R * 14 <= G) sp = 14; else if (R * 8 <= G) sp = 8; else if (R * 7 <= G) sp = 7; else if (R * 4 <= G) sp = 4; else if (R * 2 <= G) sp = 2; } }
#if defined(FORCE_SP)
                { const int U = tbl[8] * 8, R = U % G; if (R > 0 && R * FORCE_SP <= G) sp = FORCE_SP; }
#endif
                MoeDownSched S{G, bx, sp, tbl, (const char*)(ws + O_HIDM), (const char*)(ws + O_MD), (size_t)256 * DE * 2, (size_t)256 * DE * 2, (size_t)2048 * DE * 2};
                EpiMoeDown E{(bf16*)(ws + O_OS), (float*)(ws + O_XG), (unsigned*)(ws + O_CTL) + CW_MOEC, sp}; gemm_phase<EpiMoeDown, MoeDownSched, G_ALIGN, G_SP2, MOE_WNT>(lds, MOE_BLK ? 128 : DE, MOE_BLK ? 128 : DE, S, E, MOE_BLK ? 65536 : 256, MOE_BLK ? 65536 : 256); }
#else
                MoeSched S{G, bx, 8, 112 / MOE_KSPLIT, tbl, (const char*)(ws + O_HIDM), (const char*)(ws + O_MD), (size_t)256 * DE * 2, (size_t)256 * DE * 2, (size_t)2048 * DE * 2, MOE_KSPLIT, (size_t)3584 * 2};
                EpiBf16Rows E{(bf16*)(ws + O_OS), 2048, false}; gemm_phase<EpiBf16Rows, MoeSched>(lds, DE, DE, S, E); }
#endif
        }
        SEAM(pb + 9);
        if (IN(pb + 10)) for (int rep = 0; rep < REPS(pb + 10); ++rep) {
            if (l == 0) { const int ln = opq(lane); f32x4 v[8]; int r = gw; if (r < R) norm_load(v, LAT + (size_t)r * D, ln);
                for (; r < R; r += NGW) { f32x4 vn[8]; const int rn = r + NGW; if (rn < R) norm_load(vn, LAT + (size_t)rn * D, ln);
                    norm_row<false>(v, args.in[6] + D, (const float*)(ws + O_MOD) + (size_t)9 * 12288, 0, 1, (bf16*)(ws + O_HN), r, ln, nullptr, nullptr, nullptr);
#pragma unroll
                    for (int j = 0; j < 8; ++j) v[j] = vn[j]; } }
            else { moe_combine_phase(argp, opq(gw), NGW, opq(lane)); }
        }
        if (l == 0) SEAM(pb + 11);
    #undef IN
#undef SEAM
#undef args
#undef argp
}
__global__ void __launch_bounds__(NTHREADS, 2) mega(Args args_unused) {
#define args (*kargs())
#define argp (kargs())
    extern __shared__ __attribute__((aligned(16))) unsigned char lds_raw[];
#if CODE_SHIFT >= 1
    asm volatile("s_nop 0");
#endif
#if CODE_SHIFT >= 2
    asm volatile("s_nop 0");
#endif
#if CODE_SHIFT >= 3
    asm volatile("s_nop 0");
#endif
#if CODE_SHIFT >= 4
    asm volatile("s_nop 0");
#endif
#if CODE_SHIFT >= 8
    asm volatile("s_nop 0\ns_nop 0\ns_nop 0\ns_nop 0");
#endif
    LAS unsigned char* lds = (LAS unsigned char*)lds_raw;
    volatile LAS unsigned* MISC = (volatile LAS unsigned*)(lds + MISC_OFF);
    int tid = threadIdx.x; asm volatile("" : "+v"(tid));
    const int lane = tid & 63, wave = __builtin_amdgcn_readfirstlane(tid >> 6);
    const int G = gridDim.x, bx = blockIdx.x; const int vcu = (G % 8 == 0) ? (bx % 8) * (G / 8) + bx / 8 : bx;
    const int gw = vcu * NWAVES + wave, NGW = G * NWAVES;
    unsigned char* ws = args.ws;
    for (int u = tid; u < 128; u += NTHREADS) MISC[u] = 0u;
    __syncthreads();
    const int lo = args.ph_lo, hi = args.ph_hi;
    XcdBarrier bar; bar.bar = (unsigned*)(ws + O_CTL) + CW_BAR; bar.x = 0; bar.st = nullptr;
    if (hi - lo > 1) bar = xcd_barrier_post((unsigned*)(ws + O_CTL) + CW_BAR + args.bar_region * XCD_BAR_WORDS, MISC + 8);
#define IN(k) (lo <= (k) && (k) < hi)
#define SEAM(k) do { if (IN(k) && IN((k) + 1)) { xcd_barrier(bar); if (PROBE_BAR) xcd_barrier(bar); } } while (0)
    const char* HNp = (const char*)(ws + O_HN);
    float* LAT = (float*)(ws + O_LAT);

    if (IN(0)) for (int rep = 0; rep < REPS(0); ++rep) { __syncthreads(); p0_ada(argp, lds, vcu, G); __syncthreads(); p0_convert(argp, lds, gw, NGW); __syncthreads();
        { LAS f32x2* tab = (LAS f32x2*)lds; for (int m = tid; m < 2048; m += NTHREADS) { float sn, cs; sincospif((float)m * (1.f / 1024.f), &sn, &cs); tab[m] = (f32x2){cs * 0.022097086912079608f, sn * 0.022097086912079608f}; } __syncthreads();
          p0_elementwise(argp, (size_t)vcu * NTHREADS + tid, (size_t)G * NTHREADS, tab); } }
    SEAM(0);
    if (IN(1)) {
        { const int ln = opq(lane); f32x4 v[8]; int r = gw; const float* x0 = args.in[0]; const float* c0 = args.in[2];
          if (r < R) norm_load(v, r < RL ? x0 + (size_t)r * D : c0 + (size_t)(r - RL) * D, ln);
          for (; r < R; r += NGW) { f32x4 vn[8]; const int rn = r + NGW; if (rn < R) norm_load(vn, rn < RL ? x0 + (size_t)rn * D : c0 + (size_t)(rn - RL) * D, ln);
              norm_row<false>(v, args.in[6], (const float*)(ws + O_MOD), 0, 1, (bf16*)(ws + O_HN), r, ln, nullptr, nullptr, nullptr);
#pragma unroll
              for (int j = 0; j < 8; ++j) v[j] = vn[j]; } }
        { FoldSched S{G, bx, (const char*)(ws + O_DG), (const char*)(ws + O_WUF)}; EpiFold E{(bf16*)(ws + O_WIN)}; gemm_phase<EpiFold, FoldSched>(lds, 256, 1024, S, E); }
    }
    SEAM(1);
    layer_phases<0>(lds, ws, lo, hi, bar, G, bx, vcu, gw, NGW, tid, lane, wave);
    layer_phases<1>(lds, ws, lo, hi, bar, G, bx, vcu, gw, NGW, tid, lane, wave);
#undef IN
#undef SEAM
#undef args
#undef argp
}
}
#ifndef MK_MODE
#define MK_MODE 0
#endif
extern "C" void kernel_launch(void* const* d_in, const int* in_sizes, int n_in, void* d_out, int out_size, void* d_ws, size_t ws_size, hipStream_t stream) {
    static int grid = 0;
    if (grid == 0) {
        if (n_in != 27 || out_size != fk::RL * fk::D || ws_size < fk::O_END) { fprintf(stderr, "kernel_launch: unexpected problem (n_in %d out %d ws %zu need %zu)\n", n_in, out_size, ws_size, (size_t)fk::O_END); grid = -1; return; }
        int dev = 0, cus = 0, per_cu = 0;
        if (hipGetDevice(&dev) != hipSuccess || hipDeviceGetAttribute(&cus, hipDeviceAttributeMultiprocessorCount, dev) != hipSuccess) { grid = -1; return; }
        if (hipFuncSetAttribute((const void*)fk::mega, hipFuncAttributeMaxDynamicSharedMemorySize, fk::LDS_BYTES) != hipSuccess) { fprintf(stderr, "kernel_launch: hipFuncSetAttribute failed\n"); grid = -1; return; }
        if (hipOccupancyMaxActiveBlocksPerMultiprocessor(&per_cu, (const void*)fk::mega, fk::NTHREADS, fk::LDS_BYTES) != hipSuccess || per_cu < 1) fprintf(stderr, "kernel_launch: occupancy query says %d\n", per_cu);
        (void)hipGetLastError();
        grid = cus;
    }
    if (grid < 0) return;
    (void)hipMemsetAsync((char*)d_ws + fk::O_CTL, 0, fk::CTL_ZERO_BYTES, stream);
    fk::Args a{};
    for (int i = 0; i < 27; ++i) a.in[i] = (const float*)d_in[i];
    a.out = (float*)d_out; a.ws = (unsigned char*)d_ws; a.pad = 0;
#if MK_MODE == 0
    a.ph_lo = 0; a.ph_hi = fk::NPHASE; a.bar_region = 0;
    hipLaunchKernelGGL(fk::mega, dim3(grid), dim3(fk::NTHREADS), fk::LDS_BYTES, stream, a);
#else
    for (int p = 0; p < fk::NPHASE; ++p) { a.ph_lo = p; a.ph_hi = p + 1; a.bar_region = p;
        hipLaunchKernelGGL(fk::mega, dim3(grid), dim3(fk::NTHREADS), fk::LDS_BYTES, stream, a); }
#endif
}
```

```cpp
#include <hip/hip_runtime.h>
#include <cstdio>
#include <cstdint>
namespace fk {
#define GAS __attribute__((address_space(1)))
#define LAS __attribute__((address_space(3)))
typedef unsigned short bf16;
typedef short bf16x8 __attribute__((ext_vector_type(8)));
typedef float f32x4 __attribute__((ext_vector_type(4)));
typedef float f32x2 __attribute__((ext_vector_type(2)));
typedef unsigned u32x4 __attribute__((ext_vector_type(4)));
typedef unsigned u32x2 __attribute__((ext_vector_type(2)));
#define LDS_WAIT() asm volatile("s_waitcnt lgkmcnt(0)" ::: "memory")
#define VM_WAIT() asm volatile("s_waitcnt vmcnt(0)" ::: "memory")

typedef int i32x8 __attribute__((ext_vector_type(8)));
typedef int i32x4 __attribute__((ext_vector_type(4)));
__device__ __forceinline__ unsigned cvt_fp8x4(float a, float b, float c, float d) {
    a = __builtin_amdgcn_fmed3f(a, -448.f, 448.f); b = __builtin_amdgcn_fmed3f(b, -448.f, 448.f); c = __builtin_amdgcn_fmed3f(c, -448.f, 448.f); d = __builtin_amdgcn_fmed3f(d, -448.f, 448.f);
    int r = __builtin_amdgcn_cvt_pk_fp8_f32(a, b, 0, false); r = __builtin_amdgcn_cvt_pk_fp8_f32(c, d, r, true); return (unsigned)r; }
__device__ __forceinline__ unsigned cvt_pk_bf16(float lo, float hi) { unsigned r; asm volatile("v_cvt_pk_bf16_f32 %0, %1, %2" : "=v"(r) : "v"(lo), "v"(hi)); return r; }
__device__ __forceinline__ float bf_lo(unsigned w) { return __uint_as_float(w << 16); }
__device__ __forceinline__ float bf_hi(unsigned w) { return __uint_as_float(w & 0xffff0000u); }
__device__ __forceinline__ float fexp(float x) { return __builtin_amdgcn_exp2f(x * 1.4426950408889634f); }
__device__ __forceinline__ float frcp(float x) { return __builtin_amdgcn_rcpf(x); }
__device__ __forceinline__ float fsigm(float x) { return frcp(1.f + fexp(-x)); }
__device__ __forceinline__ float fsilu(float x) { return x * frcp(1.f + fexp(-x)); }
__device__ __forceinline__ float fgelu(float x) { const float u = 1.5957691216057308f * (x + 0.044715f * x * x * x); return x * frcp(1.f + fexp(-u)); }
__device__ __forceinline__ int opq(int v) { asm volatile("" : "+v"(v)); return v; }
__device__ __forceinline__ float wave_sum(float v) {
#pragma unroll
    for (int o = 1; o < 64; o <<= 1) v += __shfl_xor(v, o);
    return v;
}

#ifndef G_WGM
#define G_WGM 4
#endif
constexpr int BM = 256, BK = 64, HALF = 128, HTB = HALF * BK * 2, STAGE_BYTES = 8 * HTB, NXCD = 8, WGM = G_WGM;
__device__ __forceinline__ int lds_byte(int r, int c) { const int st = (r >> 4) * 2 + (c >> 5), rr = r & 15, cc = c & 31, ob = rr * 64 + cc * 2; return st * 1024 + (ob ^ (((ob >> 9) & 1) << 5)); }
__device__ __forceinline__ void stage_rc(int b, int& R, int& C) { const int st = b / 1024, sb = b % 1024, swz = sb ^ (((sb >> 9) & 1) << 5); R = (st >> 1) * 16 + swz / 64; C = (st & 1) * 32 + (swz % 64) / 2; }
__device__ __forceinline__ int perm32(int rho) { const int n = rho >> 4, i = rho & 15; return 8 * (i >> 2) + 4 * n + (i & 3); }

struct Unit { const char* A; const char* B; int pm, pn, kind, nt, x; };

__device__ __forceinline__ void tile_of(int wgid, int nM, int nN, int& pm, int& pn, const int wgm = WGM) {
    const int nwg = nM * nN; { const int q = nwg / NXCD, r = nwg % NXCD, xcd = wgid % NXCD, off = wgid / NXCD; wgid = (xcd < r ? xcd * (q + 1) : r * (q + 1) + (xcd - r) * q) + off; }
    const int nig = wgm * nN, gid = wgid / nig, fm = gid * wgm, gsz = (nM - fm) < wgm ? (nM - fm) : wgm;
    pm = fm + ((wgid % nig) % gsz); pn = (wgid % nig) / gsz;
}

#ifndef G_ALIGN
#define G_ALIGN true
#endif
#ifndef G_SP2
#define G_SP2 true
#endif
template <int F8> struct pg8_frag { typedef bf16x8 T; static constexpr int NK = 2;
    static __device__ __forceinline__ T ld(const LAS unsigned char* p) { return *(const LAS bf16x8*)p; }
    static __device__ __forceinline__ T cat(i32x4 a, i32x4 b) { (void)b; return __builtin_bit_cast(bf16x8, a); }
    static __device__ __forceinline__ f32x4 mma(T b, T a, f32x4 c) { return __builtin_amdgcn_mfma_f32_16x16x32_bf16(b, a, c, 0, 0, 0); } };
template <> struct pg8_frag<1> { typedef i32x8 T; static constexpr int NK = 1;
    static __device__ __forceinline__ T ld(const LAS unsigned char* p) { return *(const LAS i32x8*)p; }
    static __device__ __forceinline__ T cat(i32x4 a, i32x4 b) { return __builtin_shufflevector(a, b, 0, 1, 2, 3, 4, 5, 6, 7); }
    static __device__ __forceinline__ f32x4 mma(T b, T a, f32x4 c) { asm volatile("v_mfma_f32_16x16x128_f8f6f4 %0, %1, %2, %0" : "+v"(c) : "v"(b), "v"(a)); return c; } };
template <class Epi, class Sched, bool ALIGN_EPI = G_ALIGN, bool SP2 = G_SP2, int BAUX = 0, int F8 = 0>
#define PG8_CAT(x, y) __builtin_shufflevector(__builtin_bit_cast(i32x4, x), __builtin_bit_cast(i32x4, y), 0, 1, 2, 3, 4, 5, 6, 7)
__device__ __forceinline__ void gemm_phase(LAS unsigned char* lds, const int lda, const int ldb, const Sched& S, const Epi& E, const size_t kpairA = 256, const size_t kpairB = 256) {
    int tid = threadIdx.x; asm volatile("" : "+v"(tid));
    const int wid = __builtin_amdgcn_readfirstlane(tid >> 6), lane = tid & 63, wr = wid >> 2, wc = wid & 3, fr = lane & 15, fq = lane >> 4;
    unsigned voffA[2], voffB[2];
#pragma unroll
    for (int i = 0; i < 2; ++i) { int R, C; stage_rc(tid * 16 + i * 8192, R, C); const int Rb = Epi::PERM ? ((R & ~31) + perm32(R & 31)) : R;
        voffA[i] = (unsigned)(R * lda + C) * 2u; voffB[i] = (unsigned)(Rb * ldb + C) * 2u; }
    const size_t kstep = (size_t)(BK * 2);
    const size_t hstepA = (size_t)HALF * lda * 2, hstepB = (size_t)HALF * ldb * 2;
    const unsigned ldsw = (unsigned)wid * 1024u;
    const int aoff = lds_byte(wr * 64 + fr, fq * 8), boff = lds_byte(wc * 32 + fr, fq * 8);
#define PG8_SA(b, h) (((b) * 2 + (h)) * HTB)
#define PG8_SB(b, h) ((4 + (b) * 2 + (h)) * HTB)
#define PG8_STAGE(bufoff, gbase, voff) do { const char* gb_ = (const char*)(gbase); asm volatile("" : "+s"(gb_)); _Pragma("unroll") for (int _i = 0; _i < 2; ++_i) { unsigned vo_ = (voff)[_i]; asm volatile("" : "+v"(vo_)); \
        __builtin_amdgcn_global_load_lds((const unsigned*)(gb_ + vo_), (LAS unsigned*)(lds + (bufoff) + ldsw + _i * 8192), 16, 0, 0); } } while (0)
#define PG8_STAGEB(bufoff, gbase, voff) do { const char* gb_ = (const char*)(gbase); asm volatile("" : "+s"(gb_)); _Pragma("unroll") for (int _i = 0; _i < 2; ++_i) { unsigned vo_ = (voff)[_i]; asm volatile("" : "+v"(vo_)); \
        __builtin_amdgcn_global_load_lds((const unsigned*)(gb_ + vo_), (LAS unsigned*)(lds + (bufoff) + ldsw + _i * 8192), 16, 0, BAUX); } } while (0)
#define PG8_LDA(dst, b, h) do { _Pragma("unroll") for (int m = 0; m < 4; ++m) { if constexpr (F8) dst[m][0] = pg8_frag<F8>::cat(*(const LAS i32x4*)(lds + PG8_SA(b, h) + aoff + m * 2048), *(const LAS i32x4*)(lds + PG8_SA(b, h) + aoff + m * 2048 + 1024)); \
        else { _Pragma("unroll") for (int k = 0; k < 2; ++k) dst[m][k] = pg8_frag<F8>::ld(lds + PG8_SA(b, h) + aoff + m * 2048 + k * 1024); } } } while (0)
#define PG8_LDB(dst, b, h) do { _Pragma("unroll") for (int n = 0; n < 2; ++n) { if constexpr (F8) dst[n][0] = pg8_frag<F8>::cat(*(const LAS i32x4*)(lds + PG8_SB(b, h) + boff + n * 2048), *(const LAS i32x4*)(lds + PG8_SB(b, h) + boff + n * 2048 + 1024)); \
        else { _Pragma("unroll") for (int k = 0; k < 2; ++k) dst[n][k] = pg8_frag<F8>::ld(lds + PG8_SB(b, h) + boff + n * 2048 + k * 1024); } } } while (0)
#ifndef G_PRIO
#define G_PRIO 1
#endif
#ifndef G_KOUT
#define G_KOUT 0
#endif
#if G_KOUT
#define PG8_MMA(ai, bj, At, Bt) do { if (G_PRIO) __builtin_amdgcn_s_setprio(G_PRIO); _Pragma("unroll") for (int k = 0; k < 2; ++k) _Pragma("unroll") for (int m = 0; m < 4; ++m) _Pragma("unroll") for (int n = 0; n < 2; ++n) \
        acc[ai][bj][m][n] = __builtin_amdgcn_mfma_f32_16x16x32_bf16(Bt[n][k], At[m][k], acc[ai][bj][m][n], 0, 0, 0); if (G_PRIO) __builtin_amdgcn_s_setprio(0); } while (0)
#else
#define PG8_MMA(ai, bj, At, Bt) do { if (G_PRIO) __builtin_amdgcn_s_setprio(G_PRIO); \
        if constexpr (F8) { _Pragma("unroll") for (int m = 0; m < 4; ++m) _Pragma("unroll") for (int n = 0; n < 2; ++n) \
            acc[ai][bj][m][n] = pg8_frag<F8>::mma(Bt[n][0], At[m][0], acc[ai][bj][m][n]); } \
        else { _Pragma("unroll") for (int m = 0; m < 4; ++m) _Pragma("unroll") for (int n = 0; n < 2; ++n) _Pragma("unroll") for (int k = 0; k < 2; ++k) \
            acc[ai][bj][m][n] = pg8_frag<F8>::mma(Bt[n][k], At[m][k], acc[ai][bj][m][n]); } if (G_PRIO) __builtin_amdgcn_s_setprio(0); } while (0)
#endif
#ifndef G_MMA2
#define G_MMA2 0
#endif
#if G_MMA2
#define PG8_MMA2(ai, At, Ba, Bb) do { __builtin_amdgcn_s_setprio(1); _Pragma("unroll") for (int m = 0; m < 4; ++m) _Pragma("unroll") for (int n = 0; n < 2; ++n) _Pragma("unroll") for (int k = 0; k < 2; ++k) \
        acc[ai][0][m][n] = __builtin_amdgcn_mfma_f32_16x16x32_bf16(Ba[n][k], At[m][k], acc[ai][0][m][n], 0, 0, 0); \
        _Pragma("unroll") for (int m = 0; m < 4; ++m) _Pragma("unroll") for (int n = 0; n < 2; ++n) _Pragma("unroll") for (int k = 0; k < 2; ++k) \
        acc[ai][1][m][n] = __builtin_amdgcn_mfma_f32_16x16x32_bf16(Bb[n][k], At[m][k], acc[ai][1][m][n], 0, 0, 0); __builtin_amdgcn_s_setprio(0); } while (0)
#else
#define PG8_MMA2(ai, At, Ba, Bb) do { PG8_MMA(ai, 0, At, Ba); PG8_MMA(ai, 1, At, Bb); } while (0)
#endif
#define PG8_WAIT_V(n) asm volatile("s_waitcnt vmcnt(" #n ")" ::: "memory")
#define PG8_WAIT_L(n) asm volatile("s_waitcnt lgkmcnt(" #n ")" ::: "memory")
#define PG8_BAR __builtin_amdgcn_s_barrier()
#define PG8_SCHED __builtin_amdgcn_sched_barrier(0)
    Unit cur, nxt; int ui = 0;
    if (!S.next(0, cur)) return;
    f32x4 acc[2][2][4][2];
#pragma unroll
    for (int a = 0; a < 2; ++a)
#pragma unroll
        for (int b = 0; b < 2; ++b)
#pragma unroll
            for (int m = 0; m < 4; ++m)
#pragma unroll
                for (int n = 0; n < 2; ++n) acc[a][b][m][n] = (f32x4){0.f, 0.f, 0.f, 0.f};
    typename pg8_frag<F8>::T At[4][pg8_frag<F8>::NK], B0[2][pg8_frag<F8>::NK], B1[2][pg8_frag<F8>::NK];
    const char* cA = cur.A; const char* cB = cur.B;
    if constexpr (SP2) {
        PG8_STAGEB(PG8_SB(0, 0), cB, voffB); PG8_STAGEB(PG8_SB(0, 1), cB + hstepB, voffB); PG8_STAGE(PG8_SA(0, 0), cA, voffA); PG8_STAGE(PG8_SA(0, 1), cA + hstepA, voffA);
        if (wr == 1) PG8_BAR;
        PG8_WAIT_V(2); PG8_BAR;
        PG8_STAGEB(PG8_SB(1, 0), cB + kstep, voffB); PG8_STAGE(PG8_SA(1, 0), cA + kstep, voffA); PG8_STAGEB(PG8_SB(1, 1), cB + hstepB + kstep, voffB);
        PG8_WAIT_V(6); PG8_BAR;
    } else {
        PG8_STAGEB(PG8_SB(0, 0), cB, voffB); PG8_STAGE(PG8_SA(0, 0), cA, voffA); PG8_STAGEB(PG8_SB(0, 1), cB + hstepB, voffB); PG8_STAGE(PG8_SA(0, 1), cA + hstepA, voffA);
        if (wr == 1) PG8_BAR;
        PG8_WAIT_V(4); PG8_BAR;
        PG8_STAGEB(PG8_SB(1, 0), cB + kstep, voffB); PG8_STAGE(PG8_SA(1, 0), cA + kstep, voffA); PG8_STAGEB(PG8_SB(1, 1), cB + hstepB + kstep, voffB);
        PG8_WAIT_V(6); PG8_BAR;
    }
    for (;;) {
        const bool has_next = S.next(ui + 1, nxt);
        const char* nA = has_next ? nxt.A : cA; const char* nB = has_next ? nxt.B : cB;
        const int nt = cur.nt;
        for (int t = 0; t < nt; t += 2) {
            const bool last = (t == nt - 2);
            const char* a1 = cA + (size_t)(t >> 1) * kpairA + kstep;
            const char* a2 = last ? nA : cA + (size_t)((t >> 1) + 1) * kpairA; const char* b2 = last ? nB : cB + (size_t)((t >> 1) + 1) * kpairB;
            const char* a3 = a2 + kstep; const char* b3 = b2 + kstep;
            if constexpr (SP2) {
            PG8_LDB(B0, 0, 0); PG8_LDB(B1, 0, 1); PG8_SCHED; PG8_LDA(At, 0, 0); PG8_STAGE(PG8_SA(1, 1), a1 + hstepA, voffA);
            PG8_WAIT_V(8); PG8_WAIT_L(0); PG8_BAR; PG8_MMA2(0, At, B0, B1); PG8_BAR; PG8_SCHED;
            PG8_LDA(At, 0, 1); PG8_STAGEB(PG8_SB(0, 0), b2, voffB); PG8_STAGEB(PG8_SB(0, 1), b2 + hstepB, voffB); PG8_STAGE(PG8_SA(0, 0), a2, voffA);
            PG8_WAIT_V(8); PG8_WAIT_L(0); PG8_BAR; PG8_MMA2(1, At, B0, B1); PG8_BAR; PG8_SCHED;
            PG8_LDB(B0, 1, 0); PG8_LDB(B1, 1, 1); PG8_SCHED; PG8_LDA(At, 1, 0); PG8_STAGE(PG8_SA(0, 1), a2 + hstepA, voffA);
            PG8_WAIT_V(8); PG8_WAIT_L(0); PG8_BAR; PG8_MMA2(0, At, B0, B1); PG8_BAR; PG8_SCHED;
            PG8_LDA(At, 1, 1); PG8_STAGEB(PG8_SB(1, 0), b3, voffB); PG8_STAGEB(PG8_SB(1, 1), b3 + hstepB, voffB); PG8_STAGE(PG8_SA(1, 0), a3, voffA);
            PG8_WAIT_V(8); PG8_WAIT_L(0); PG8_BAR; PG8_MMA2(1, At, B0, B1); PG8_BAR; PG8_SCHED;
            } else {
            PG8_LDB(B0, 0, 0); PG8_SCHED; PG8_LDA(At, 0, 0); PG8_STAGE(PG8_SA(1, 1), a1 + hstepA, voffA);
            PG8_WAIT_L(8); PG8_BAR; PG8_WAIT_L(0); PG8_MMA(0, 0, At, B0); PG8_BAR; PG8_SCHED;
            PG8_LDB(B1, 0, 1); PG8_STAGEB(PG8_SB(0, 0), b2, voffB);
            PG8_BAR; PG8_WAIT_L(0); PG8_MMA(0, 1, At, B1); PG8_BAR;
            PG8_LDA(At, 0, 1); PG8_STAGE(PG8_SA(0, 0), a2, voffA);
            PG8_BAR; PG8_WAIT_L(0); PG8_MMA(1, 0, At, B0); PG8_BAR; PG8_SCHED;
            PG8_STAGEB(PG8_SB(0, 1), b2 + hstepB, voffB);
            PG8_WAIT_V(6); PG8_BAR; PG8_MMA(1, 1, At, B1); PG8_BAR;
            PG8_LDB(B0, 1, 0); PG8_SCHED; PG8_LDA(At, 1, 0); PG8_STAGE(PG8_SA(0, 1), a2 + hstepA, voffA);
            PG8_WAIT_L(8); PG8_BAR; PG8_WAIT_L(0); PG8_MMA(0, 0, At, B0); PG8_BAR; PG8_SCHED;
            PG8_LDB(B1, 1, 1); PG8_STAGEB(PG8_SB(1, 0), b3, voffB);
            PG8_BAR; PG8_WAIT_L(0); PG8_MMA(0, 1, At, B1); PG8_BAR;
            PG8_LDA(At, 1, 1); PG8_STAGE(PG8_SA(1, 0), a3, voffA);
            PG8_BAR; PG8_WAIT_L(0); PG8_MMA(1, 0, At, B0); PG8_BAR; PG8_SCHED;
            PG8_STAGEB(PG8_SB(1, 1), b3 + hstepB, voffB);
            PG8_WAIT_V(6); PG8_BAR; PG8_MMA(1, 1, At, B1); PG8_BAR;
            }
        }
        if constexpr (ALIGN_EPI) { if (wr == 0) PG8_BAR; }
        if constexpr (F8) asm volatile("s_nop 15\n\ts_nop 7" ::: "memory");
        E(acc, cur, wr, wc, fr, fq);
        if (!has_next) break;
#pragma unroll
        for (int a = 0; a < 2; ++a)
#pragma unroll
            for (int b = 0; b < 2; ++b)
#pragma unroll
                for (int m = 0; m < 4; ++m)
#pragma unroll
                    for (int n = 0; n < 2; ++n) acc[a][b][m][n] = (f32x4){0.f, 0.f, 0.f, 0.f};
        cur = nxt; cA = nA; cB = nB; ++ui;
        if constexpr (ALIGN_EPI) { if (wr == 1) PG8_BAR; }
    }
    PG8_WAIT_V(0);
    if constexpr (!ALIGN_EPI) { if (wr == 0) PG8_BAR; }
    PG8_BAR;
#undef PG8_SA
#undef PG8_SB
#undef PG8_STAGE
#undef PG8_STAGEB
#undef PG8_LDA
#undef PG8_LDB
#undef PG8_MMA
#undef PG8_MMA2
#undef PG8_WAIT_V
#undef PG8_WAIT_L
#undef PG8_BAR
#undef PG8_SCHED
}

#define XB_TMO      128
#define XB_XCNT(j)  (256  + 64 * (j))
#define XB_XSUB(j)  (1280 + 64 * (j))
#define XB_XGEN(j)  (2304 + 64 * (j))
#define XB_TOP      3328
#define XB_TOPGEN   3392
#define XCD_BAR_WORDS 3456
#define XB_SPIN_CAP (1u << 18)
#ifndef XB_SLEEP
#define XB_SLEEP 1
#endif
__device__ __forceinline__ unsigned xb_ld(unsigned* p)              { return __hip_atomic_load(p, __ATOMIC_RELAXED, __HIP_MEMORY_SCOPE_AGENT); }
__device__ __forceinline__ unsigned xb_add(unsigned* p, unsigned v) { return __hip_atomic_fetch_add(p, v, __ATOMIC_RELAXED, __HIP_MEMORY_SCOPE_AGENT); }
__device__ __forceinline__ unsigned xb_xcc_id() { return (unsigned)__builtin_amdgcn_s_getreg((3 << 11) | 20) & 0xFu; }
#define XB_SPIN(cond, bar) do { unsigned _sp = 0; while (cond) { __builtin_amdgcn_s_sleep(XB_SLEEP); \
    if ((++_sp & 255u) == 0u) { if (xb_ld(&(bar)[XB_TMO])) break; if (_sp > XB_SPIN_CAP) { atomicAdd(&(bar)[XB_TMO], 1u); break; } } } } while (0)
struct XcdBarrier { unsigned* bar; unsigned x; volatile LAS unsigned* st; };
__device__ __forceinline__ XcdBarrier xcd_barrier_post(unsigned* bar, volatile LAS unsigned* st) {
    XcdBarrier b; b.bar = bar; b.x = xb_xcc_id(); b.st = st;
    if (threadIdx.x == 0) (void)xb_add(&bar[XB_XCNT(b.x)], 1u);
    return b;
}
__device__ __forceinline__ void xcd_barrier_complete(unsigned* bar, unsigned x, unsigned& nloc, unsigned& nx) {
    const unsigned G = gridDim.x * gridDim.y * gridDim.z;
    unsigned sum, cnt, mine, sp = 0u;
    for (;;) {
        sum = 0u; cnt = 0u; mine = 0u;
#pragma unroll
        for (unsigned j = 0; j < 16; ++j) { const unsigned c = xb_ld(&bar[XB_XCNT(j)]); sum += c; cnt += (c > 0u) ? 1u : 0u; mine = (j == x) ? c : mine; }
        if (sum == G) break;
        __builtin_amdgcn_s_sleep(1);
        if ((++sp & 255u) == 0u) { if (xb_ld(&bar[XB_TMO])) break; if (sp > XB_SPIN_CAP) { atomicAdd(&bar[XB_TMO], 1u); break; } }
    }
    nloc = mine > 0u ? mine : 1u; nx = cnt > 0u ? cnt : 1u;
}
__device__ __forceinline__ void xcd_barrier(const XcdBarrier& b) {
    asm volatile("s_waitcnt vmcnt(0)" ::: "memory");
    __syncthreads();
    if (threadIdx.x == 0) {
        unsigned* bar = b.bar;
        __builtin_amdgcn_s_waitcnt(0);
        unsigned nloc = b.st[0], nx = b.st[1];
        if (nloc == 0u) { xcd_barrier_complete(bar, b.x, nloc, nx); b.st[0] = nloc; b.st[1] = nx; }
        const unsigned old = xb_add(&bar[XB_XSUB(b.x)], 1u);
        const unsigned gen = old / nloc;
        if (old + 1u == (gen + 1u) * nloc) {
            __builtin_amdgcn_fence(__ATOMIC_RELEASE, "agent");
            asm volatile("s_waitcnt vmcnt(0)" ::: "memory");
            const unsigned og = xb_add(&bar[XB_TOP], 1u);
            const unsigned tg = og / nx;
            if (og + 1u == (tg + 1u) * nx) xb_add(&bar[XB_TOPGEN], 1u);
            else XB_SPIN(xb_ld(&bar[XB_TOPGEN]) == tg, bar);
            __builtin_amdgcn_fence(__ATOMIC_ACQUIRE, "agent");
            xb_add(&bar[XB_XGEN(b.x)], 1u);
            asm volatile("s_waitcnt vmcnt(0)" ::: "memory");
        } else {
            XB_SPIN(xb_ld(&bar[XB_XGEN(b.x)]) == gen, bar);
            __builtin_amdgcn_fence(__ATOMIC_ACQUIRE, "agent");
            asm volatile("s_waitcnt vmcnt(0)" ::: "memory");
        }
    }
    __syncthreads();
}
constexpr int D = 2048, NB = 8, L = 2048, LC = 256, RL = 16384, RC = 2048, R = 18432, NIN = 7168, GW = 64;
constexpr int DFF = 5632, NE = 8, DE = 7168, NH = 8, HD = 128, DL = 1024;
constexpr int WIN_ROWS = 7168;
constexpr int UT_LD = 36864;
constexpr int MAXSLOT = 34816;
constexpr int NCHUNK = 288;
constexpr int NWAVES = 8, NTHREADS = 512;
constexpr int LDS_BYTES = 147456;
constexpr int MISC_OFF = 140000;

constexpr size_t al256(size_t x) { return (x + 255) & ~(size_t)255; }
constexpr size_t O_CTL = 0, CTL_BYTES = 1u << 20, CTL_ZERO_BYTES = 65536;
constexpr size_t O_MOD = O_CTL + CTL_BYTES;
constexpr size_t O_MISC = O_MOD + al256((size_t)2 * 9 * 12288 * 4);
constexpr size_t O_LAT = O_MISC + (1u << 20);
constexpr size_t O_HN = O_LAT + (size_t)R * D * 4;
constexpr size_t O_WIN = O_HN + (size_t)R * D * 2;
constexpr size_t O_WFO = O_WIN + (size_t)2 * 8192 * 2048 * 2;
constexpr size_t O_WRO = O_WFO + (size_t)2 * 2048 * 1024 * 2;
constexpr size_t O_WO = O_WRO + (size_t)2 * 2048 * 1024 * 2;
constexpr size_t O_WAX = O_WO + (size_t)2 * 2048 * 2048 * 2;
constexpr size_t O_WUF = O_WAX + (size_t)2 * 2 * 2 * 8 * 128 * 128 * 2;
constexpr size_t O_DG = O_WUF + (size_t)2 * 2048 * 1024 * 2;
constexpr size_t O_FL = O_DG + (size_t)512 * 256 * 2;
constexpr size_t O_FLC = O_FL + (size_t)2048 * 4096 * 2;
constexpr size_t O_FGU = O_FLC + (size_t)256 * 4096 * 2;
constexpr size_t O_FD = O_FGU + (size_t)11264 * 2048 * 2;
constexpr size_t O_MGU = O_FD + (size_t)2048 * 5632 * 2;
constexpr size_t O_MD = O_MGU + (size_t)8 * 14336 * 2048 * 2;
constexpr size_t O_SCR = O_MD + (size_t)8 * 2048 * 7168 * 2;
constexpr size_t O_UT = O_SCR;
constexpr size_t O_UR = O_UT + (size_t)1024 * UT_LD * 2;
constexpr size_t O_GG = O_UR + (size_t)R * 1024 * 2;
constexpr size_t O_SGF = O_GG + (size_t)R * 1024 * 2;
constexpr size_t O_SGR = O_SGF + (size_t)R * 2048 * 2;
constexpr size_t O_Y = O_SGR + (size_t)R * 2048 * 2;
constexpr size_t O_T1 = O_Y + (size_t)R * 1024 * 2;
constexpr size_t O_HR = O_T1 + (size_t)R * 2048 * 2;
constexpr size_t O_MG = O_HR + (size_t)R * 1024 * 2;
constexpr size_t O_TOT = O_MG + (size_t)R * 2048 * 2;
constexpr size_t O_CAR = O_TOT + (size_t)NCHUNK * 2 * 1024 * 8;
constexpr size_t O_ZT = O_CAR + (size_t)NCHUNK * 2 * 1024 * 4;
constexpr size_t O_VV = O_ZT + (size_t)1024 * UT_LD * 2;
constexpr size_t O_MIXEND = O_VV + (size_t)R * 1024 * 2;
constexpr size_t O_HID = O_SCR;
constexpr size_t O_XG = O_SCR;
constexpr size_t O_HIDM = O_XG + (size_t)MAXSLOT * 2048 * 2;
constexpr size_t O_OS = O_HIDM + (size_t)MAXSLOT * 7168 * 2;
constexpr size_t O_END = O_OS + (size_t)2 * MAXSLOT * 2048 * 2;
static_assert(O_MIXEND <= O_END && O_HID + (size_t)R * DFF * 2 <= O_END, "scratch overlay");
static_assert(O_END <= (size_t)2085 * 1000 * 1000, "workspace budget");
constexpr size_t M_SEL = 0;
constexpr size_t M_GWT = 131072;
constexpr size_t M_SLOT = 262144;
constexpr size_t M_CNTB = 393216;
constexpr size_t M_TOT = 401408;
constexpr int CW_BAR = 4096, CW_MOEC = 8192;

struct Args { const float* in[27]; float* out; unsigned char* ws; int ph_lo, ph_hi, bar_region, pad; };
typedef const __attribute__((address_space(4))) Args* AP;
__device__ __forceinline__ AP kargs() { AP p = (AP)__builtin_amdgcn_kernarg_segment_ptr(); asm volatile("" : "+s"(p)); return p; }

__device__ __forceinline__ void p0_ada(AP a, LAS unsigned char* lds, int vcu, int G) {
    const int tid = threadIdx.x, lane = tid & 63, w = tid >> 6;
    LAS float* sc = (LAS float*)lds;
    LAS float* red = (LAS float*)(lds + 73728);
    const float* c = a->in[1]; const float* c_ctx = a->in[3];
    for (int i = tid; i < 9 * 2048; i += NTHREADS) { const int r = i >> 11, k = i & 2047; const float v = r < 8 ? c[r * 2048 + k] : c_ctx[k]; sc[i] = v / (1.f + expf(-v)); }
    __syncthreads();
    float* MOD = (float*)(a->ws + O_MOD);
    for (int item = vcu; item < 256; item += G) {
        const int l = item >> 7, cg = item & 127, col = cg * 96 + (lane < 48 ? lane : 0) * 2;
        const float* W = a->in[4] + (size_t)l * 2048 * 12288 + col;
        float acc[9][2];
#pragma unroll
        for (int r = 0; r < 9; ++r) { acc[r][0] = 0.f; acc[r][1] = 0.f; }
#pragma unroll 8
        for (int k = w * 256; k < w * 256 + 256; ++k) {
            const f32x2 wv = *(const f32x2*)(W + (size_t)k * 12288);
#pragma unroll
            for (int r = 0; r < 9; ++r) { const float s = sc[r * 2048 + k]; acc[r][0] = fmaf(s, wv.x, acc[r][0]); acc[r][1] = fmaf(s, wv.y, acc[r][1]); }
        }
#pragma unroll
        for (int r = 0; r < 9; ++r) if (lane < 48) { red[(w * 9 + r) * 128 + lane * 2] = acc[r][0]; red[(w * 9 + r) * 128 + lane * 2 + 1] = acc[r][1]; }
        __syncthreads();
        for (int i = tid; i < 9 * 128; i += NTHREADS) { const int r = i >> 7, cc = i & 127; if (cc >= 96) continue; float s = a->in[5][(size_t)l * 12288 + cg * 96 + cc];
#pragma unroll
            for (int ww = 0; ww < 8; ++ww) s += red[(ww * 9 + r) * 128 + cc];
            MOD[((size_t)l * 9 + r) * 12288 + cg * 96 + cc] = s; }
        __syncthreads();
    }
}

#ifndef SCAN_VV
#define SCAN_VV 1
#endif
#ifndef DFT2
#define DFT2 1
#endif
#ifndef MOE_BLK
#define MOE_BLK 1
#endif
#ifndef CVT_NT
#define CVT_NT 0
#endif
#ifndef MOE_F8
#define MOE_F8 1
#endif
#define W8_SC 256.f
#define X8_SC 16.f
#define H8_SC 4.f
#if CVT_NT
#define CVT_LOAD(p) __builtin_nontemporal_load(p)
#define CVT_STORE(v, p) __builtin_nontemporal_store(v, p)
#else
#define CVT_LOAD(p) (*(p))
#define CVT_STORE(v, p) (*(p) = (v))
#endif
template <int F8 = 0>
__device__ __forceinline__ void cvt_item(const float* src, int ldsrc, bf16* dst, int dpitch, int k0, int n0, int drow0, LAS float* scr, int lane, const int npairs = 0) {
    const float* s = src + (size_t)(k0 + (lane >> 4)) * ldsrc + n0 + (lane & 15) * 4;
    f32x4 v[16];
#pragma unroll
    for (int i = 0; i < 16; ++i) v[i] = CVT_LOAD((const f32x4*)(s + (size_t)(4 * i) * ldsrc));
#pragma unroll
    for (int i = 0; i < 16; ++i) { LAS float* q = scr + (4 * i + (lane >> 4)) * 65 + (lane & 15) * 4; q[0] = v[i].x; q[1] = v[i].y; q[2] = v[i].z; q[3] = v[i].w; }
    LDS_WAIT(); asm volatile("" ::: "memory");
    const int c = lane & 7;
#pragma unroll
    for (int jj = 0; jj < 8; ++jj) { const int n = (lane >> 3) + 8 * jj; const LAS float* q = scr + (8 * c) * 65 + n;
        if constexpr (F8) { u32x2 o8; o8.x = cvt_fp8x4(q[0 * 65] * W8_SC, q[1 * 65] * W8_SC, q[2 * 65] * W8_SC, q[3 * 65] * W8_SC); o8.y = cvt_fp8x4(q[4 * 65] * W8_SC, q[5 * 65] * W8_SC, q[6 * 65] * W8_SC, q[7 * 65] * W8_SC);
            const int dr8 = drow0 + n; unsigned char* dp8 = (unsigned char*)dst + ((size_t)(dr8 >> 8) * npairs + (k0 >> 8)) * 65536 + (size_t)(dr8 & 255) * 256 + (k0 & 255) + 8 * c;
            *(u32x2*)dp8 = o8; continue; }
        u32x4 o; o.x = cvt_pk_bf16(q[0 * 65], q[1 * 65]); o.y = cvt_pk_bf16(q[2 * 65], q[3 * 65]); o.z = cvt_pk_bf16(q[4 * 65], q[5 * 65]); o.w = cvt_pk_bf16(q[6 * 65], q[7 * 65]);
        const int dr = drow0 + n; bf16* dp = npairs ? dst + ((size_t)(dr >> 8) * npairs + (k0 >> 7)) * 32768 + (size_t)(dr & 255) * 128 + (k0 & 127) + 8 * c : dst + (size_t)dr * dpitch + k0 + 8 * c;
        CVT_STORE(o, (u32x4*)dp); }
    LDS_WAIT(); asm volatile("" ::: "memory");
}
constexpr int I_WIN = 32 * 96, I_FO = 16 * 32, I_O = 32 * 32, I_AX = 4, I_FG = 32 * 88, I_FD = 88 * 32, I_MG = 32 * 112, I_MD = 112 * 32;
constexpr int N_WIN = 2 * I_WIN, N_FO = 2 * I_FO, N_RO = N_FO, N_O = 2 * I_O, N_AX = 64 * I_AX, N_FG = I_FG, N_FU = I_FG, N_FD = I_FD, N_MG = 8 * I_MG, N_MU = N_MG, N_MD = 8 * I_MD;
constexpr int N_NONMOE = N_WIN + N_FO + N_RO + N_O + N_AX + N_FG + N_FU + N_FD, N_MOE = N_MG + N_MU + N_MD;
__device__ __forceinline__ void p0_convert(AP a, LAS unsigned char* lds, int gw, int NGW) {
    const int lane = threadIdx.x & 63, w = threadIdx.x >> 6;
    LAS float* scr = (LAS float*)(lds + w * 16640);
    unsigned char* ws = a->ws;
    for (int it = gw; it < N_NONMOE; it += NGW) {
        int r = it;
        if (r < N_WIN) { const int l = r / I_WIN, q = r % I_WIN, kb = q / 96, nb = q % 96;
            cvt_item(a->in[8] + (size_t)l * 2048 * NIN, NIN, (bf16*)(ws + O_WIN) + (size_t)l * WIN_ROWS * 2048, 2048, kb * 64, 1024 + nb * 64, 1024 + nb * 64, scr, lane); continue; } r -= N_WIN;
        if (r < N_FO) { const int l = r / I_FO, q = r % I_FO, kb = q / 32, nb = q % 32;
            cvt_item(a->in[16] + (size_t)l * 1024 * 2048, 2048, (bf16*)(ws + O_WFO) + (size_t)l * 2048 * 1024, 1024, kb * 64, nb * 64, nb * 64, scr, lane); continue; } r -= N_FO;
        if (r < N_RO) { const int l = r / I_FO, q = r % I_FO, kb = q / 32, nb = q % 32;
            cvt_item(a->in[17] + (size_t)l * 1024 * 2048, 2048, (bf16*)(ws + O_WRO) + (size_t)l * 2048 * 1024, 1024, kb * 64, nb * 64, nb * 64, scr, lane); continue; } r -= N_RO;
        if (r < N_O) { const int l = r / I_O, q = r % I_O, kb = q / 32, nb = q % 32;
            cvt_item(a->in[18] + (size_t)l * 2048 * 2048, 2048, (bf16*)(ws + O_WO) + (size_t)l * 2048 * 2048, 2048, kb * 64, nb * 64, nb * 64, scr, lane); continue; } r -= N_O;
        if (r < N_AX) { const int m = r / I_AX, q = r % I_AX, kb = q / 2, nb = q % 2;
            const int h = m & 7, gate = (m >> 3) & 1, ld = m >> 4;
            const float* src = (gate ? a->in[13] : a->in[11]) + ((size_t)ld * 8 + h) * 128 * 128;
            cvt_item(src, 128, (bf16*)(ws + O_WAX) + (size_t)m * 128 * 128, 128, kb * 64, nb * 64, nb * 64, scr, lane); continue; } r -= N_AX;
        if (r < N_FG) { const int kb = r / 88, nb = r % 88, n = nb * 64;
            cvt_item(a->in[19], DFF, (bf16*)(ws + O_FGU), 2048, kb * 64, n, (n >> 7) * 256 + (n & 127), scr, lane); continue; } r -= N_FG;
        if (r < N_FU) { const int kb = r / 88, nb = r % 88, n = nb * 64;
            cvt_item(a->in[20], DFF, (bf16*)(ws + O_FGU), 2048, kb * 64, n, (n >> 7) * 256 + 128 + (n & 127), scr, lane); continue; } r -= N_FU;
        { const int kb = r / 32, nb = r % 32;
            cvt_item(a->in[21], 2048, (bf16*)(ws + O_FD), DFF, kb * 64, nb * 64, nb * 64, scr, lane); }
    }
}
__device__ __forceinline__ void cvt_moe_range(AP a, LAS unsigned char* lds, int lo, int hi, int rank, int nrank) {
    const int lane = threadIdx.x & 63, w = threadIdx.x >> 6;
    LAS float* scr = (LAS float*)(lds + w * 16640);
    unsigned char* ws = a->ws;
    for (int it = lo + rank; it < hi; it += nrank) {
        int r = it;
        if (r < N_MG) { const int e = r / I_MG, q = r % I_MG, kb = q / 112, nb = q % 112, n = nb * 64;
            if (MOE_F8) cvt_item<1>(a->in[23] + (size_t)e * 2048 * DE, DE, (bf16*)(ws + O_MGU + (size_t)e * 14336 * 2048), 2048, kb * 64, n, (n >> 7) * 256 + (n & 127), scr, lane, 8); else
            cvt_item(a->in[23] + (size_t)e * 2048 * DE, DE, (bf16*)(ws + O_MGU) + (size_t)e * 14336 * 2048, 2048, kb * 64, n, (n >> 7) * 256 + (n & 127), scr, lane, MOE_BLK ? 16 : 0); continue; } r -= N_MG;
        if (r < N_MU) { const int e = r / I_MG, q = r % I_MG, kb = q / 112, nb = q % 112, n = nb * 64;
            if (MOE_F8) cvt_item<1>(a->in[24] + (size_t)e * 2048 * DE, DE, (bf16*)(ws + O_MGU + (size_t)e * 14336 * 2048), 2048, kb * 64, n, (n >> 7) * 256 + 128 + (n & 127), scr, lane, 8); else
            cvt_item(a->in[24] + (size_t)e * 2048 * DE, DE, (bf16*)(ws + O_MGU) + (size_t)e * 14336 * 2048, 2048, kb * 64, n, (n >> 7) * 256 + 128 + (n & 127), scr, lane, MOE_BLK ? 16 : 0); continue; } r -= N_MU;
        { const int e = r / I_MD, q = r % I_MD, kb = q / 32, nb = q % 32;
            if (MOE_F8) cvt_item<1>(a->in[25] + (size_t)e * DE * 2048, 2048, (bf16*)(ws + O_MD + (size_t)e * 2048 * DE), DE, kb * 64, nb * 64, nb * 64, scr, lane, 28); else
            cvt_item(a->in[25] + (size_t)e * DE * 2048, 2048, (bf16*)(ws + O_MD) + (size_t)e * 2048 * DE, DE, kb * 64, nb * 64, nb * 64, scr, lane, MOE_BLK ? 56 : 0); }
    }
}
__device__ __forceinline__ void p0_elementwise(AP a, size_t gt, size_t NGT, const LAS f32x2* tab) {
    unsigned char* ws = a->ws;
    for (size_t i = gt; i < (size_t)2 * 2048 * 128; i += NGT) { const int l = (int)(i / (2048 * 128)), d = (int)((i / 128) % 2048), j8 = (int)(i % 128) * 8;
        const float* s = a->in[8] + ((size_t)l * 2048 + d) * NIN + j8; const f32x4 v0 = *(const f32x4*)s, v1 = *(const f32x4*)(s + 4);
        u32x4 o; o.x = cvt_pk_bf16(v0.x, v0.y); o.y = cvt_pk_bf16(v0.z, v0.w); o.z = cvt_pk_bf16(v1.x, v1.y); o.w = cvt_pk_bf16(v1.z, v1.w);
        *(u32x4*)((bf16*)(ws + O_WUF) + ((size_t)l * 2048 + d) * 1024 + j8) = o; }
#if DFT2
    for (size_t i = gt; i < (size_t)256 * 64; i += NGT) { const int k = (int)(i / 64), j8 = (int)(i % 64) * 8; float v[8];
#pragma unroll
        for (int e = 0; e < 8; ++e) { const int j = j8 + e, t = j & 255; const int m = (k * t) & 255; float sn, cs; sincospif((float)m * (1.f / 128.f), &sn, &cs); v[e] = (j < 256 ? cs : sn) * 0.022097086912079608f; }
        u32x4 o; o.x = cvt_pk_bf16(v[0], v[1]); o.y = cvt_pk_bf16(v[2], v[3]); o.z = cvt_pk_bf16(v[4], v[5]); o.w = cvt_pk_bf16(v[6], v[7]);
        *(u32x4*)((bf16*)(ws + O_FL) + (size_t)k * 4096 + j8) = o; }
    (void)tab;
#else
    for (size_t i = gt; i < (size_t)2048 * 512; i += NGT) { const int k = (int)(i / 512), j8 = (int)(i % 512) * 8; float v[8];
#pragma unroll
        for (int e = 0; e < 8; ++e) { const int j = j8 + e, t = j & 2047; const int m = (k * t) & 2047; const f32x2 cs = tab[m]; v[e] = (j < 2048 ? cs.x : -cs.y); }
        u32x4 o; o.x = cvt_pk_bf16(v[0], v[1]); o.y = cvt_pk_bf16(v[2], v[3]); o.z = cvt_pk_bf16(v[4], v[5]); o.w = cvt_pk_bf16(v[6], v[7]);
        *(u32x4*)((bf16*)(ws + O_FL) + (size_t)k * 4096 + j8) = o; }
#endif
    for (size_t i = gt; i < (size_t)256 * 64; i += NGT) { const int k = (int)(i / 64), j8 = (int)(i % 64) * 8; float v[8];
#pragma unroll
        for (int e = 0; e < 8; ++e) { const int j = j8 + e, t = j & 255; const int m = (k * t) & 255; float s, c; sincospif((float)m * (1.f / 128.f), &s, &c); v[e] = (j < 256 ? c : -s) * 0.0625f; }
        u32x4 o; o.x = cvt_pk_bf16(v[0], v[1]); o.y = cvt_pk_bf16(v[2], v[3]); o.z = cvt_pk_bf16(v[4], v[5]); o.w = cvt_pk_bf16(v[6], v[7]);
        *(u32x4*)((bf16*)(ws + O_FLC) + (size_t)k * 4096 + j8) = o; }
    for (size_t i = gt; i < (size_t)256 * 32; i += NGT) { const int row = (int)(i / 32), j8 = (int)(i % 32) * 8, s_ = row > 128 ? 1 : 0, c_ = s_ ? row - 128 : row; float v[8];
#pragma unroll
        for (int e = 0; e < 8; ++e) { const int m = (c_ * (j8 + e)) & 255; float s, c; sincospif((float)m * (1.f / 128.f), &s, &c); v[e] = (s_ ? s : c) * 0.0625f; }
        u32x4 o; o.x = cvt_pk_bf16(v[0], v[1]); o.y = cvt_pk_bf16(v[2], v[3]); o.z = cvt_pk_bf16(v[4], v[5]); o.w = cvt_pk_bf16(v[6], v[7]);
        *(u32x4*)((bf16*)(ws + O_DG) + (size_t)row * 256 + j8) = o; }
}

__device__ __forceinline__ int mod_row(int r) { return r < RL ? (r >> 11) : 8; }
__device__ __forceinline__ void norm_load(f32x4 (&v)[8], const float* src, int lane) {
#pragma unroll
    for (int j = 0; j < 8; ++j) v[j] = ((const f32x4*)src)[lane + 64 * j];
}
template <bool ROUTER>
__device__ __forceinline__ int norm_row(const f32x4 (&v)[8], const float* g, const float* modl, int shift_chunk, int scale_chunk, bf16* dst, int row, int lane,
                                         const LAS float* rt, int* sel, float* gwt) {
    int picked = 0;
    float s = 0.f;
#pragma unroll
    for (int j = 0; j < 8; ++j) s += (v[j].x * v[j].x + v[j].y * v[j].y) + (v[j].z * v[j].z + v[j].w * v[j].w);
    const float rstd = rsqrtf(wave_sum(s) * (1.f / D) + 1e-6f);
    const float* mr = modl + (size_t)mod_row(row) * 12288;
    float lg[8];
    if (ROUTER) {
#pragma unroll
        for (int e = 0; e < 8; ++e) lg[e] = 0.f; }
#pragma unroll
    for (int j = 0; j < 8; ++j) {
        const int c = (lane + 64 * j) * 4;
        const f32x4 gg = *(const f32x4*)(g + c), sh = *(const f32x4*)(mr + shift_chunk * D + c), sc = *(const f32x4*)(mr + scale_chunk * D + c);
        f32x4 o = v[j] * rstd * gg; o = o * (sc + 1.f) + sh;
        u32x2 w; w.x = cvt_pk_bf16(o.x, o.y); w.y = cvt_pk_bf16(o.z, o.w);
        *(u32x2*)(dst + (size_t)row * D + c) = w;
        if (ROUTER) {
#pragma unroll
            for (int q = 0; q < 4; ++q) { const f32x4 r0 = *(const LAS f32x4*)(rt + (c + q) * 8), r1 = *(const LAS f32x4*)(rt + (c + q) * 8 + 4); const float x = o[q];
                lg[0] = fmaf(x, r0.x, lg[0]); lg[1] = fmaf(x, r0.y, lg[1]); lg[2] = fmaf(x, r0.z, lg[2]); lg[3] = fmaf(x, r0.w, lg[3]);
                lg[4] = fmaf(x, r1.x, lg[4]); lg[5] = fmaf(x, r1.y, lg[5]); lg[6] = fmaf(x, r1.z, lg[6]); lg[7] = fmaf(x, r1.w, lg[7]); } }
    }
    if (ROUTER) {
#pragma unroll
        for (int e = 0; e < 8; ++e) lg[e] = wave_sum(lg[e]);
        if (lane == 0) {
            int i1 = 0; float v1 = lg[0];
#pragma unroll
            for (int e = 1; e < 8; ++e) if (lg[e] > v1) { v1 = lg[e]; i1 = e; }
            int i2 = -1; float v2 = -3.0e38f;
#pragma unroll
            for (int e = 0; e < 8; ++e) if (e != i1 && lg[e] > v2) { v2 = lg[e]; i2 = e; }
            const float w1 = 1.f / (1.f + expf(v2 - v1));
            sel[row * 2] = i1; sel[row * 2 + 1] = i2; gwt[row * 2] = w1; gwt[row * 2 + 1] = 1.f - w1; picked = i1 | (i2 << 8);
        }
    }
    return picked;
}

__device__ __forceinline__ float one_minus_exp(float x, float a2) {
    const float t = -x; return t < 0.0625f ? t * (1.f - t * (0.5f - t * (0.16666667f - t * (0.041666668f - t * 0.0083333338f)))) : 1.f - a2; }
template <int PASS>
__device__ __forceinline__ void scan_unit(AP a, LAS unsigned char* lds, int l, int q, int h) {
    int tid = threadIdx.x; asm volatile("" : "+v"(tid));
    const int lane = tid & 63, w = __builtin_amdgcn_readfirstlane(tid >> 6), fr = lane & 15, fq = lane >> 4;
    LAS float* VS = (LAS float*)lds; LAS bf16* V16 = (LAS bf16*)(lds + 33792); LAS float* AS = (LAS float*)(lds + 51200); LAS float* BS = (LAS float*)(lds + 84992); LAS float* SEG = (LAS float*)(lds + 118784);
    unsigned char* ws = a->ws;
    const bool isctx = q >= 256;
    const int row0 = isctx ? RL + (q - 256) * 64 : q * 64;
    const int cpos0 = isctx ? ((q - 256) & 3) * 64 : 0;
    const int seglen = isctx ? LC : GW;
    const int t = tid >> 3, c16 = (tid & 7) * 16;
    {
        const bf16* UR = (const bf16*)(ws + O_UR);
        const float* cw = a->in[9] + (size_t)l * 4 * DL + h * HD + c16; const float* cb = a->in[10] + (size_t)l * DL + h * HD + c16;
        float v[16];
#pragma unroll
        for (int i = 0; i < 16; i += 4) { const f32x4 b4 = *(const f32x4*)(cb + i); v[i] = b4.x; v[i + 1] = b4.y; v[i + 2] = b4.z; v[i + 3] = b4.w; }
#pragma unroll
        for (int k = 0; k < 4; ++k) { const int p = cpos0 + t + k - 2;
            if (p >= 0 && p < seglen) { const bf16* src = UR + (size_t)(row0 + t + k - 2) * 1024 + h * HD + c16; const u32x4 u0 = *(const u32x4*)src, u1 = *(const u32x4*)(src + 8);
                const unsigned uu[8] = {u0.x, u0.y, u0.z, u0.w, u1.x, u1.y, u1.z, u1.w};
#pragma unroll
                for (int i = 0; i < 8; ++i) { const f32x2 wv = *(const f32x2*)(cw + (size_t)k * DL + 2 * i); v[2 * i] = fmaf(wv.x, bf_lo(uu[i]), v[2 * i]); v[2 * i + 1] = fmaf(wv.y, bf_hi(uu[i]), v[2 * i + 1]); } } }
#pragma unroll
        for (int i = 0; i < 16; i += 4) *(LAS f32x4*)(VS + t * 132 + c16 + i) = (f32x4){v[i], v[i + 1], v[i + 2], v[i + 3]};
        u32x4 o0, o1; o0.x = cvt_pk_bf16(v[0], v[1]); o0.y = cvt_pk_bf16(v[2], v[3]); o0.z = cvt_pk_bf16(v[4], v[5]); o0.w = cvt_pk_bf16(v[6], v[7]);
        o1.x = cvt_pk_bf16(v[8], v[9]); o1.y = cvt_pk_bf16(v[10], v[11]); o1.z = cvt_pk_bf16(v[12], v[13]); o1.w = cvt_pk_bf16(v[14], v[15]);
        *(LAS u32x4*)(V16 + t * 136 + c16) = o0; *(LAS u32x4*)(V16 + t * 136 + c16 + 8) = o1;
    }
    __syncthreads();
    float hsum[16];
#pragma unroll
    for (int i = 0; i < 16; ++i) hsum[i] = 0.f;
    const int ch = 16 * w + fr;
#pragma unroll 1
    for (int dir = 0; dir < 2; ++dir) {
        f32x4 acc[2][4];
#pragma unroll
        for (int g = 0; g < 2; ++g)
#pragma unroll
            for (int m = 0; m < 4; ++m) acc[g][m] = (f32x4){0.f, 0.f, 0.f, 0.f};
        const bf16* WT = (const bf16*)(ws + O_WAX) + ((size_t)((l * 2 + dir) * 2) * 8 + h) * 128 * 128;
#pragma unroll
        for (int ks = 0; ks < 4; ++ks) {
            const bf16x8 b0 = *(const bf16x8*)(WT + (size_t)ch * 128 + ks * 32 + fq * 8), b1 = *(const bf16x8*)(WT + (size_t)8 * 128 * 128 + (size_t)ch * 128 + ks * 32 + fq * 8);
#pragma unroll
            for (int m = 0; m < 4; ++m) { const bf16x8 af = *(const LAS bf16x8*)(V16 + (16 * m + fr) * 136 + ks * 32 + fq * 8);
                acc[0][m] = __builtin_amdgcn_mfma_f32_16x16x32_bf16(af, b0, acc[0][m], 0, 0, 0); acc[1][m] = __builtin_amdgcn_mfma_f32_16x16x32_bf16(af, b1, acc[1][m], 0, 0, 0); }
        }
        {
            const int gch = h * HD + ch;
            const float bia = a->in[12][(size_t)(l * 2 + dir) * DL + gch], bix = a->in[14][(size_t)(l * 2 + dir) * DL + gch], lm = a->in[15][(size_t)(l * 2 + dir) * DL + gch];
            const float sp8 = 8.f * log1pf(expf(-lm));
#pragma unroll
            for (int m = 0; m < 4; ++m)
#pragma unroll
                for (int j = 0; j < 4; ++j) { const int tok = 16 * m + 4 * fq + j;
                    const float rr = fsigm(acc[0][m][j] + bia), ii = fsigm(acc[1][m][j] + bix), vv = VS[tok * 132 + ch];
                    const float la = -sp8 * rr, av = fexp(la), a2 = av * av;
                    AS[tok * 132 + ch] = av; BS[tok * 132 + ch] = sqrtf(one_minus_exp(2.f * la, a2)) * (ii * vv); }
        }
        __syncthreads();
        {
            const int sg = tid >> 7, sc = tid & 127;
            float av[16], bv[16];
#pragma unroll
            for (int i = 0; i < 16; ++i) { const int tok = dir ? 63 - (16 * sg + i) : 16 * sg + i; av[i] = AS[tok * 132 + sc]; bv[i] = BS[tok * 132 + sc]; }
            float P = 1.f, hl = 0.f;
#pragma unroll
            for (int i = 0; i < 16; ++i) { hl = fmaf(av[i], hl, bv[i]); P *= av[i]; }
            SEG[(sg * 128 + sc) * 2] = P; SEG[(sg * 128 + sc) * 2 + 1] = hl;
            __syncthreads();
            if (PASS == 1) {
                if (sg == 0) { float A = 1.f, B = 0.f;
#pragma unroll
                    for (int s2 = 0; s2 < 4; ++s2) { const float p2 = SEG[(s2 * 128 + sc) * 2], h2 = SEG[(s2 * 128 + sc) * 2 + 1]; B = fmaf(p2, B, h2); A *= p2; }
                    *(f32x2*)((float*)(ws + O_TOT) + (((size_t)q * 2 + dir) * 1024 + h * HD + sc) * 2) = (f32x2){A, B}; }
            } else {
                float hc = ((const float*)(ws + O_CAR))[((size_t)q * 2 + dir) * 1024 + h * HD + sc];
#pragma unroll
                for (int s2 = 0; s2 < 3; ++s2) if (s2 < sg) { const float p2 = SEG[(s2 * 128 + sc) * 2], h2 = SEG[(s2 * 128 + sc) * 2 + 1]; hc = fmaf(p2, hc, h2); }
#pragma unroll
                for (int i = 0; i < 16; ++i) { const int tok = dir ? 63 - (16 * sg + i) : 16 * sg + i; hc = fmaf(av[i], hc, bv[i]); BS[tok * 132 + sc] = hc; }
            }
        }
        __syncthreads();
        if (PASS == 2) {
#pragma unroll
            for (int i = 0; i < 16; i += 4) { const f32x4 x = *(const LAS f32x4*)(BS + t * 132 + c16 + i); hsum[i] += x.x; hsum[i + 1] += x.y; hsum[i + 2] += x.z; hsum[i + 3] += x.w; }
            __syncthreads();
        }
    }
    if (PASS == 2) {
        const bf16* GGp = (const bf16*)(ws + O_GG) + (size_t)(row0 + t) * 1024 + h * HD + c16; const u32x4 g0 = *(const u32x4*)GGp, g1 = *(const u32x4*)(GGp + 8);
        const unsigned gu[8] = {g0.x, g0.y, g0.z, g0.w, g1.x, g1.y, g1.z, g1.w}; unsigned o[8];
#pragma unroll
        for (int i = 0; i < 8; ++i) o[i] = cvt_pk_bf16(hsum[2 * i] * bf_lo(gu[i]), hsum[2 * i + 1] * bf_hi(gu[i]));
        bf16* dst = (bf16*)(ws + O_HR) + (size_t)(row0 + t) * 1024 + h * HD + c16;
        *(u32x4*)dst = (u32x4){o[0], o[1], o[2], o[3]}; *(u32x4*)(dst + 8) = (u32x4){o[4], o[5], o[6], o[7]};
    }
}
template <int PASS>
__device__ __forceinline__ void scan_phase(AP a, LAS unsigned char* lds, const int l, const int nunits, const int vcu, const int G) {
    int tid0 = threadIdx.x; asm volatile("" : "+v"(tid0));
    const int w = __builtin_amdgcn_readfirstlane(tid0 >> 6);
    LAS float* VS = (LAS float*)lds; LAS bf16* V16 = (LAS bf16*)(lds + 33792); LAS float* AS = (LAS float*)(lds + 51200); LAS float* BS = (LAS float*)(lds + 84992); LAS float* SEG = (LAS float*)(lds + 118784);
    LAS float* CW = (LAS float*)(lds + 122880); LAS float* CB = (LAS float*)(lds + 124928);
    unsigned char* ws = a->ws;
    const bf16* UR = (const bf16*)(ws + O_UR);
#define SCAN_LANE_VARS(tid) const int lane = (tid) & 63, fr = lane & 15, fq = lane >> 4, t = (tid) >> 3, c16 = ((tid) & 7) * 16, ch = 16 * w + fr, sg = (tid) >> 7, sc = (tid) & 127; \
    (void)fq; (void)sg; (void)sc; (void)ch; (void)t; (void)c16
    int hcur = -1;
    bf16x8 wf[2][2][4]; float bia[2], bix[2], sp8[2];
    u32x4 ur[4][2];
#define SCAN_PREFETCH(uu) do { const int q_ = (uu) >> 3, h_ = (uu) & 7; const bool ic_ = q_ >= 256; const int r0_ = ic_ ? RL + (q_ - 256) * 64 : q_ * 64; \
        const int cp_ = ic_ ? ((q_ - 256) & 3) * 64 : 0, sl_ = ic_ ? LC : GW; \
        _Pragma("unroll") for (int k = 0; k < 4; ++k) { const int p_ = cp_ + t + k - 2; \
            if (p_ >= 0 && p_ < sl_) { const bf16* src_ = UR + (size_t)(r0_ + t + k - 2) * 1024 + h_ * HD + c16; ur[k][0] = *(const u32x4*)src_; ur[k][1] = *(const u32x4*)(src_ + 8); } \
            else { ur[k][0] = (u32x4){0u, 0u, 0u, 0u}; ur[k][1] = (u32x4){0u, 0u, 0u, 0u}; } } } while (0)
    if (vcu < nunits) { SCAN_LANE_VARS(tid0); SCAN_PREFETCH(vcu); }
    for (int u = vcu; u < nunits; u += G) {
        const int q = u >> 3, h = u & 7;
        const int tid = opq(tid0); SCAN_LANE_VARS(tid);
        const bool isctx = q >= 256; const int row0 = isctx ? RL + (q - 256) * 64 : q * 64;
        if (h != hcur) {
            hcur = h;
            __syncthreads();
            if (tid < 128) { CB[tid] = a->in[10][(size_t)l * DL + h * HD + tid];
#pragma unroll
                for (int k = 0; k < 4; ++k) CW[k * 128 + tid] = a->in[9][((size_t)l * 4 + k) * DL + h * HD + tid]; }
#pragma unroll
            for (int dir = 0; dir < 2; ++dir) {
                const bf16* WT = (const bf16*)(ws + O_WAX) + ((size_t)((l * 2 + dir) * 2) * 8 + h) * 128 * 128;
#pragma unroll
                for (int g = 0; g < 2; ++g)
#pragma unroll
                    for (int ks = 0; ks < 4; ++ks) wf[dir][g][ks] = *(const bf16x8*)(WT + (size_t)g * 8 * 128 * 128 + (size_t)ch * 128 + ks * 32 + fq * 8);
                const int gch = h * HD + ch;
                bia[dir] = a->in[12][(size_t)(l * 2 + dir) * DL + gch]; bix[dir] = a->in[14][(size_t)(l * 2 + dir) * DL + gch];
                sp8[dir] = 8.f * log1pf(expf(-a->in[15][(size_t)(l * 2 + dir) * DL + gch]));
            }
            __syncthreads();
        }
        float car[2]; u32x4 gg0, gg1;
        if (PASS == 2) {
            car[0] = ((const float*)(ws + O_CAR))[((size_t)q * 2 + 0) * 1024 + h * HD + sc]; car[1] = ((const float*)(ws + O_CAR))[((size_t)q * 2 + 1) * 1024 + h * HD + sc];
            const bf16* GGp = (const bf16*)(ws + O_GG) + (size_t)(row0 + t) * 1024 + h * HD + c16; gg0 = *(const u32x4*)GGp; gg1 = *(const u32x4*)(GGp + 8);
        }
        {
            float v[16];
#pragma unroll
            for (int i = 0; i < 16; i += 4) { const f32x4 b4 = *(const LAS f32x4*)(CB + c16 + i); v[i] = b4.x; v[i + 1] = b4.y; v[i + 2] = b4.z; v[i + 3] = b4.w; }
#pragma unroll
            for (int k = 0; k < 4; ++k) { const unsigned uu[8] = {ur[k][0].x, ur[k][0].y, ur[k][0].z, ur[k][0].w, ur[k][1].x, ur[k][1].y, ur[k][1].z, ur[k][1].w};
#pragma unroll
                for (int i = 0; i < 16; i += 4) { const f32x4 wv = *(const LAS f32x4*)(CW + k * 128 + c16 + i);
                    v[i] = fmaf(wv.x, bf_lo(uu[i / 2]), v[i]); v[i + 1] = fmaf(wv.y, bf_hi(uu[i / 2]), v[i + 1]); v[i + 2] = fmaf(wv.z, bf_lo(uu[i / 2 + 1]), v[i + 2]); v[i + 3] = fmaf(wv.w, bf_hi(uu[i / 2 + 1]), v[i + 3]); } }
#pragma unroll
            for (int i = 0; i < 16; i += 4) *(LAS f32x4*)(VS + t * 132 + c16 + i) = (f32x4){v[i], v[i + 1], v[i + 2], v[i + 3]};
            u32x4 o0, o1; o0.x = cvt_pk_bf16(v[0], v[1]); o0.y = cvt_pk_bf16(v[2], v[3]); o0.z = cvt_pk_bf16(v[4], v[5]); o0.w = cvt_pk_bf16(v[6], v[7]);
            o1.x = cvt_pk_bf16(v[8], v[9]); o1.y = cvt_pk_bf16(v[10], v[11]); o1.z = cvt_pk_bf16(v[12], v[13]); o1.w = cvt_pk_bf16(v[14], v[15]);
            *(LAS u32x4*)(V16 + t * 136 + c16) = o0; *(LAS u32x4*)(V16 + t * 136 + c16 + 8) = o1;
        }
        if (u + G < nunits) SCAN_PREFETCH(u + G);
        __syncthreads();
        float hsum[16];
#pragma unroll
        for (int i = 0; i < 16; ++i) hsum[i] = 0.f;
#pragma unroll
        for (int dir = 0; dir < 2; ++dir) {
            f32x4 acc[2][4];
#pragma unroll
            for (int g = 0; g < 2; ++g)
#pragma unroll
                for (int m = 0; m < 4; ++m) acc[g][m] = (f32x4){0.f, 0.f, 0.f, 0.f};
#pragma unroll
            for (int ks = 0; ks < 4; ++ks)
#pragma unroll
                for (int m = 0; m < 4; ++m) { const bf16x8 af = *(const LAS bf16x8*)(V16 + (16 * m + fr) * 136 + ks * 32 + fq * 8);
                    acc[0][m] = __builtin_amdgcn_mfma_f32_16x16x32_bf16(af, wf[dir][0][ks], acc[0][m], 0, 0, 0); acc[1][m] = __builtin_amdgcn_mfma_f32_16x16x32_bf16(af, wf[dir][1][ks], acc[1][m], 0, 0, 0); }
#pragma unroll
            for (int m = 0; m < 4; ++m)
#pragma unroll
                for (int j = 0; j < 4; ++j) { const int tok = 16 * m + 4 * fq + j;
                    const float rr = fsigm(acc[0][m][j] + bia[dir]), ii = fsigm(acc[1][m][j] + bix[dir]), vv = VS[tok * 132 + ch];
                    const float la = -sp8[dir] * rr, av = fexp(la), a2 = av * av;
                    AS[tok * 132 + ch] = av; BS[tok * 132 + ch] = sqrtf(one_minus_exp(2.f * la, a2)) * (ii * vv); }
            __syncthreads();
            {
                float av[16], bv[16];
#pragma unroll
                for (int i = 0; i < 16; ++i) { const int tok = dir ? 63 - (16 * sg + i) : 16 * sg + i; av[i] = AS[tok * 132 + sc]; bv[i] = BS[tok * 132 + sc]; }
                float P = 1.f, hl = 0.f;
#pragma unroll
                for (int i = 0; i < 16; ++i) { hl = fmaf(av[i], hl, bv[i]); P *= av[i]; }
                SEG[(sg * 128 + sc) * 2] = P; SEG[(sg * 128 + sc) * 2 + 1] = hl;
                __syncthreads();
                if (PASS == 1) {
                    if (sg == 0) { float A = 1.f, B = 0.f;
#pragma unroll
                        for (int s2 = 0; s2 < 4; ++s2) { const float p2 = SEG[(s2 * 128 + sc) * 2], h2 = SEG[(s2 * 128 + sc) * 2 + 1]; B = fmaf(p2, B, h2); A *= p2; }
                        *(f32x2*)((float*)(ws + O_TOT) + (((size_t)q * 2 + dir) * 1024 + h * HD + sc) * 2) = (f32x2){A, B}; }
                } else {
                    float hc = car[dir];
#pragma unroll
                    for (int s2 = 0; s2 < 3; ++s2) if (s2 < sg) { const float p2 = SEG[(s2 * 128 + sc) * 2], h2 = SEG[(s2 * 128 + sc) * 2 + 1]; hc = fmaf(p2, hc, h2); }
#pragma unroll
                    for (int i = 0; i < 16; ++i) { const int tok = dir ? 63 - (16 * sg + i) : 16 * sg + i; hc = fmaf(av[i], hc, bv[i]); BS[tok * 132 + sc] = hc; }
                }
            }
            __syncthreads();
            if (PASS == 2) {
#pragma unroll
                for (int i = 0; i < 16; i += 4) { const f32x4 x = *(const LAS f32x4*)(BS + t * 132 + c16 + i); hsum[i] += x.x; hsum[i + 1] += x.y; hsum[i + 2] += x.z; hsum[i + 3] += x.w; }
                __syncthreads();
            }
        }
        if (PASS == 2) {
            const unsigned gu[8] = {gg0.x, gg0.y, gg0.z, gg0.w, gg1.x, gg1.y, gg1.z, gg1.w}; unsigned o[8];
#pragma unroll
            for (int i = 0; i < 8; ++i) o[i] = cvt_pk_bf16(hsum[2 * i] * bf_lo(gu[i]), hsum[2 * i + 1] * bf_hi(gu[i]));
            bf16* dst = (bf16*)(ws + O_HR) + (size_t)(row0 + t) * 1024 + h * HD + c16;
            *(u32x4*)dst = (u32x4){o[0], o[1], o[2], o[3]}; *(u32x4*)(dst + 8) = (u32x4){o[4], o[5], o[6], o[7]};
        }
    }
#undef SCAN_PREFETCH
#undef SCAN_LANE_VARS
}
template <int PASS, int SKIP = 0>
__device__ __forceinline__ void scan_phase2(AP a, LAS unsigned char* lds, const int l, const int nunits, const int vcu, const int G) {
    int tid0 = threadIdx.x; asm volatile("" : "+v"(tid0));
    const int w = __builtin_amdgcn_readfirstlane(tid0 >> 6);
    LAS bf16* V16 = (LAS bf16*)lds; LAS float* HST = (LAS float*)(lds + 34816) + w * (64 * 17); LAS float* CW = (LAS float*)(lds + 69632); LAS float* CB = (LAS float*)(lds + 71680);
    unsigned char* ws = a->ws;
    const bf16* UR = (const bf16*)(ws + O_UR);
#define SCAN_LANE_VARS(tid) const int lane = (tid) & 63, fr = lane & 15, fq = lane >> 4, t = (tid) >> 3, c16 = ((tid) & 7) * 16, ch = 16 * w + fr; (void)fq; (void)ch; (void)t; (void)c16
    int hcur = -1;
    bf16x8 wf[2][2][4]; float nbia[2], nbix[2], nsp8[2];
    u32x4 ur[4][2];
#define SCAN_PREFETCH(uu) do { const int q_ = (uu) >> 3, h_ = (uu) & 7; const bool ic_ = q_ >= 256; const int r0_ = ic_ ? RL + (q_ - 256) * 64 : q_ * 64; \
        if (PASS == 2 && SCAN_VV) { const bf16* src_ = (const bf16*)(ws + O_VV) + (size_t)(r0_ + t) * 1024 + h_ * HD + c16; ur[0][0] = *(const u32x4*)src_; ur[0][1] = *(const u32x4*)(src_ + 8); break; }     \
        const int cp_ = ic_ ? ((q_ - 256) & 3) * 64 : 0, sl_ = ic_ ? LC : GW; \
        _Pragma("unroll") for (int k = 0; k < 4; ++k) { const int p_ = cp_ + t + k - 2; \
            if (p_ >= 0 && p_ < sl_) { const bf16* src_ = UR + (size_t)(r0_ + t + k - 2) * 1024 + h_ * HD + c16; ur[k][0] = *(const u32x4*)src_; ur[k][1] = *(const u32x4*)(src_ + 8); } \
            else { ur[k][0] = (u32x4){0u, 0u, 0u, 0u}; ur[k][1] = (u32x4){0u, 0u, 0u, 0u}; } } } while (0)
    if (vcu < nunits) { SCAN_LANE_VARS(tid0); SCAN_PREFETCH(vcu); }
    int par = 0;
    for (int u = vcu; u < nunits; u += G, par ^= 1) {
        const int q = u >> 3, h = u & 7;
        const int tid = opq(tid0); SCAN_LANE_VARS(tid);
        const bool isctx = q >= 256; const int row0 = isctx ? RL + (q - 256) * 64 : q * 64;
        LAS bf16* Vb = V16 + par * (64 * 136);
        if (h != hcur) {
            hcur = h;
            __syncthreads();
            if (tid < 128) { CB[tid] = a->in[10][(size_t)l * DL + h * HD + tid];
#pragma unroll
                for (int k = 0; k < 4; ++k) CW[k * 128 + tid] = a->in[9][((size_t)l * 4 + k) * DL + h * HD + tid]; }
#pragma unroll
            for (int dir = 0; dir < 2; ++dir) {
                const bf16* WT = (const bf16*)(ws + O_WAX) + ((size_t)((l * 2 + dir) * 2) * 8 + h) * 128 * 128;
#pragma unroll
                for (int g = 0; g < 2; ++g)
#pragma unroll
                    for (int ks = 0; ks < 4; ++ks) wf[dir][g][ks] = *(const bf16x8*)(WT + (size_t)g * 8 * 128 * 128 + (size_t)ch * 128 + ks * 32 + fq * 8);
                const int gch = h * HD + ch;
                nbia[dir] = -1.4426950408889634f * a->in[12][(size_t)(l * 2 + dir) * DL + gch]; nbix[dir] = -1.4426950408889634f * a->in[14][(size_t)(l * 2 + dir) * DL + gch];
                nsp8[dir] = -8.f * 1.4426950408889634f * log1pf(expf(-a->in[15][(size_t)(l * 2 + dir) * DL + gch]));
            }
            __syncthreads();
        }
        float car[2]; u32x4 gg0, gg1;
        if (PASS == 2) {
            car[0] = ((const float*)(ws + O_CAR))[((size_t)q * 2 + 0) * 1024 + h * HD + ch]; car[1] = ((const float*)(ws + O_CAR))[((size_t)q * 2 + 1) * 1024 + h * HD + ch];
            const bf16* GGp = (const bf16*)(ws + O_GG) + (size_t)(row0 + lane) * 1024 + h * HD + 16 * w; gg0 = *(const u32x4*)GGp; gg1 = *(const u32x4*)(GGp + 8);
        }
        if (PASS == 2 && SCAN_VV) { *(LAS u32x4*)(Vb + t * 136 + c16) = ur[0][0]; *(LAS u32x4*)(Vb + t * 136 + c16 + 8) = ur[0][1]; }
        else {
            float v[16];
#pragma unroll
            for (int i = 0; i < 16; i += 4) { const f32x4 b4 = *(const LAS f32x4*)(CB + c16 + i); v[i] = b4.x; v[i + 1] = b4.y; v[i + 2] = b4.z; v[i + 3] = b4.w; }
#pragma unroll
            for (int k = 0; k < 4; ++k) { const unsigned uu[8] = {ur[k][0].x, ur[k][0].y, ur[k][0].z, ur[k][0].w, ur[k][1].x, ur[k][1].y, ur[k][1].z, ur[k][1].w};
#pragma unroll
                for (int i = 0; i < 16; i += 4) { const f32x4 wv = *(const LAS f32x4*)(CW + k * 128 + c16 + i);
                    v[i] = fmaf(wv.x, bf_lo(uu[i / 2]), v[i]); v[i + 1] = fmaf(wv.y, bf_hi(uu[i / 2]), v[i + 1]); v[i + 2] = fmaf(wv.z, bf_lo(uu[i / 2 + 1]), v[i + 2]); v[i + 3] = fmaf(wv.w, bf_hi(uu[i / 2 + 1]), v[i + 3]); } }
            u32x4 o0, o1; o0.x = cvt_pk_bf16(v[0], v[1]); o0.y = cvt_pk_bf16(v[2], v[3]); o0.z = cvt_pk_bf16(v[4], v[5]); o0.w = cvt_pk_bf16(v[6], v[7]);
            o1.x = cvt_pk_bf16(v[8], v[9]); o1.y = cvt_pk_bf16(v[10], v[11]); o1.z = cvt_pk_bf16(v[12], v[13]); o1.w = cvt_pk_bf16(v[14], v[15]);
            *(LAS u32x4*)(Vb + t * 136 + c16) = o0; *(LAS u32x4*)(Vb + t * 136 + c16 + 8) = o1;
            if (PASS == 1 && SCAN_VV) { bf16* vd = (bf16*)(ws + O_VV) + (size_t)(row0 + t) * 1024 + h * HD + c16; *(u32x4*)vd = o0; *(u32x4*)(vd + 8) = o1; }
        }
        if (u + G < nunits) SCAN_PREFETCH(u + G);
        __syncthreads();
        if (SKIP == 1) continue;
        float vv[4][4];
#pragma unroll
        for (int m = 0; m < 4; ++m)
#pragma unroll
            for (int j = 0; j < 4; ++j) vv[m][j] = __uint_as_float(((unsigned)Vb[(16 * m + 4 * fq + j) * 136 + ch]) << 16);
        f32x4 acc2[2][2][4];
#pragma unroll
        for (int d2 = 0; d2 < 2; ++d2)
#pragma unroll
            for (int g = 0; g < 2; ++g)
#pragma unroll
                for (int m = 0; m < 4; ++m) acc2[d2][g][m] = (f32x4){0.f, 0.f, 0.f, 0.f};
#pragma unroll
        for (int ks = 0; ks < 4; ++ks)
#pragma unroll
            for (int m = 0; m < 4; ++m) { const bf16x8 af = *(const LAS bf16x8*)(Vb + (16 * m + fr) * 136 + ks * 32 + fq * 8);
#pragma unroll
                for (int d2 = 0; d2 < 2; ++d2) { acc2[d2][0][m] = __builtin_amdgcn_mfma_f32_16x16x32_bf16(af, wf[d2][0][ks], acc2[d2][0][m], 0, 0, 0); acc2[d2][1][m] = __builtin_amdgcn_mfma_f32_16x16x32_bf16(af, wf[d2][1][ks], acc2[d2][1][m], 0, 0, 0); } }
#pragma unroll
        for (int dir = 0; dir < 2; ++dir) {
            f32x4 (&acc)[2][4] = acc2[dir];
            float av[4][4], bv[4][4];
#pragma unroll
            for (int m = 0; m < 4; ++m)
#pragma unroll
                for (int j = 0; j < 4; ++j) {
                    if (SKIP == 3) { av[m][j] = acc[0][m][j]; bv[m][j] = acc[1][m][j] * vv[m][j]; continue; }
                    const float ex = __builtin_amdgcn_exp2f(fminf(fmaf(acc[0][m][j], -1.4426950408889634f, nbia[dir]), 60.f)), ey = __builtin_amdgcn_exp2f(fminf(fmaf(acc[1][m][j], -1.4426950408889634f, nbix[dir]), 60.f));
                    const float dx = 1.f + ex, dy = 1.f + ey, qq = frcp(dx * dy), rr = qq * dy, ii = qq * dx;
                    const float aa = __builtin_amdgcn_exp2f(nsp8[dir] * rr);
                    av[m][j] = aa; bv[m][j] = __builtin_amdgcn_sqrtf(fmaf(-aa, aa, 1.f)) * (ii * vv[m][j]); }
            float P[4], H[4];
#pragma unroll
            for (int m = 0; m < 4; ++m) { float p = 1.f, hh = 0.f;
#pragma unroll
                for (int i = 0; i < 4; ++i) { const int jj = dir ? 3 - i : i; hh = fmaf(av[m][jj], hh, bv[m][jj]); p *= av[m][jj]; }
                P[m] = p; H[m] = hh; }
            float Ae[4], He[4], TA[4], TB[4];
#pragma unroll
            for (int m = 0; m < 4; ++m) {
                float Pk[4], Hk[4];
#pragma unroll
                for (int k = 0; k < 4; ++k) { Pk[k] = __shfl(P[m], fr + 16 * k); Hk[k] = __shfl(H[m], fr + 16 * k); }
                float A = 1.f, B = 0.f, ae = 1.f, he = 0.f;
#pragma unroll
                for (int i = 0; i < 4; ++i) { const int k = dir ? 3 - i : i; if (k == fq) { ae = A; he = B; } B = fmaf(Pk[k], B, Hk[k]); A *= Pk[k]; }
                Ae[m] = ae; He[m] = he; TA[m] = A; TB[m] = B;
            }
            if (PASS == 1) {
                float A = 1.f, B = 0.f;
#pragma unroll
                for (int i = 0; i < 4; ++i) { const int m = dir ? 3 - i : i; B = fmaf(TA[m], B, TB[m]); A *= TA[m]; }
                if (fq == 0) *(f32x2*)((float*)(ws + (SKIP ? O_CAR : O_TOT)) + (((size_t)(SKIP ? 0 : q) * 2 + dir) * 1024 + h * HD + ch) * 2) = (f32x2){A, B};
            } else {
                float C = car[dir];
#pragma unroll
                for (int i = 0; i < 4; ++i) { const int m = dir ? 3 - i : i;
                    float hh = fmaf(Ae[m], C, He[m]);
#pragma unroll
                    for (int i2 = 0; i2 < 4; ++i2) { const int jj = dir ? 3 - i2 : i2; hh = fmaf(av[m][jj], hh, bv[m][jj]); LAS float* hp = HST + (16 * m + 4 * fq + jj) * 17 + fr; if (dir == 0) *hp = hh; else *hp += hh; }
                    C = fmaf(TA[m], C, TB[m]); }
            }
        }
        if (PASS == 2) {
            LDS_WAIT(); asm volatile("" ::: "memory");
            const unsigned gu[8] = {gg0.x, gg0.y, gg0.z, gg0.w, gg1.x, gg1.y, gg1.z, gg1.w}; unsigned o[8];
#pragma unroll
            for (int i = 0; i < 8; ++i) o[i] = cvt_pk_bf16(HST[lane * 17 + 2 * i] * bf_lo(gu[i]), HST[lane * 17 + 2 * i + 1] * bf_hi(gu[i]));
            bf16* dst = (bf16*)(ws + O_HR) + (size_t)(row0 + lane) * 1024 + h * HD + 16 * w;
            *(u32x4*)dst = (u32x4){o[0], o[1], o[2], o[3]}; *(u32x4*)(dst + 8) = (u32x4){o[4], o[5], o[6], o[7]};
            LDS_WAIT(); asm volatile("" ::: "memory");
        }
    }
#undef SCAN_PREFETCH
#undef SCAN_LANE_VARS
}
__device__ __forceinline__ void dft_stage1(AP a, const LAS f32x2* tab, size_t gt, size_t NGT) {
    unsigned char* ws = a->ws; const bf16* UT = (const bf16*)(ws + O_UT); bf16* ZT = (bf16*)(ws + O_ZT);
    for (size_t it = gt; it < (size_t)1024 * 8 * 64; it += NGT) {
        const int t2b = (int)(it & 63), b = (int)((it >> 6) & 7), c = (int)(it >> 9);
        const bf16* src = UT + (size_t)c * UT_LD + (size_t)b * 4096 + t2b * 4;
        u32x2 uc[8], us[8];
#pragma unroll
        for (int t1 = 0; t1 < 8; ++t1) { uc[t1] = *(const u32x2*)(src + 256 * t1); us[t1] = *(const u32x2*)(src + 2048 + 256 * t1); }
        unsigned zo[8][2][2];
#pragma unroll
        for (int e = 0; e < 4; e += 2) {
            float Zr[2][8], Zi[2][8];
#pragma unroll
            for (int h = 0; h < 2; ++h) {
                float xr[8], xi[8];
#pragma unroll
                for (int t1 = 0; t1 < 8; ++t1) { const unsigned wc_ = uc[t1][e >> 1], ws_ = us[t1][e >> 1]; xr[t1] = h ? bf_hi(wc_) : bf_lo(wc_); xi[t1] = -(h ? bf_hi(ws_) : bf_lo(ws_)); }
                float ar[8], ai[8];
#pragma unroll
                for (int i = 0; i < 4; ++i) { ar[i] = xr[i] + xr[i + 4]; ai[i] = xi[i] + xi[i + 4]; ar[i + 4] = xr[i] - xr[i + 4]; ai[i + 4] = xi[i] - xi[i + 4]; }
                { const float r = 0.70710678118654752f; const float t5r = (ar[5] + ai[5]) * r, t5i = (ai[5] - ar[5]) * r; ar[5] = t5r; ai[5] = t5i;
                  const float t6r = ai[6], t6i = -ar[6]; ar[6] = t6r; ai[6] = t6i;
                  const float t7r = (ai[7] - ar[7]) * r, t7i = (-ar[7] - ai[7]) * r; ar[7] = t7r; ai[7] = t7i; }
                float Xr[8], Xi[8];
#pragma unroll
                for (int o = 0; o < 2; ++o) {
                    const float b0r = ar[4 * o] + ar[4 * o + 2], b0i = ai[4 * o] + ai[4 * o + 2], b1r = ar[4 * o] - ar[4 * o + 2], b1i = ai[4 * o] - ai[4 * o + 2];
                    const float b2r = ar[4 * o + 1] + ar[4 * o + 3], b2i = ai[4 * o + 1] + ai[4 * o + 3];
                    const float dr = ar[4 * o + 1] - ar[4 * o + 3], di = ai[4 * o + 1] - ai[4 * o + 3], b3r = di, b3i = -dr;
                    Xr[o] = b0r + b2r; Xi[o] = b0i + b2i; Xr[2 + o] = b1r + b3r; Xi[2 + o] = b1i + b3i; Xr[4 + o] = b0r - b2r; Xi[4 + o] = b0i - b2i; Xr[6 + o] = b1r - b3r; Xi[6 + o] = b1i - b3i; }
                const int t2 = t2b * 4 + e + h;
                Zr[h][0] = Xr[0]; Zi[h][0] = Xi[0];
#pragma unroll
                for (int k1 = 1; k1 < 8; ++k1) { const f32x2 cs = tab[t2 * k1]; Zr[h][k1] = Xr[k1] * cs.x + Xi[k1] * cs.y; Zi[h][k1] = Xi[k1] * cs.x - Xr[k1] * cs.y; }
            }
#pragma unroll
            for (int k1 = 0; k1 < 8; ++k1) { zo[k1][0][e >> 1] = cvt_pk_bf16(Zr[0][k1], Zr[1][k1]); zo[k1][1][e >> 1] = cvt_pk_bf16(Zi[0][k1], Zi[1][k1]); }
        }
        bf16* dst = ZT + (size_t)c * UT_LD + (size_t)b * 4096 + t2b * 4;
#pragma unroll
        for (int k1 = 0; k1 < 8; ++k1) { *(u32x2*)(dst + k1 * 512) = (u32x2){zo[k1][0][0], zo[k1][0][1]}; *(u32x2*)(dst + k1 * 512 + 256) = (u32x2){zo[k1][1][0], zo[k1][1][1]}; }
    }
}
__device__ __forceinline__ void carry_phase(AP a, int gw, int NGW) {
    const int lane = opq(threadIdx.x) & 63; unsigned char* ws = a->ws;
    const f32x2* TOT = (const f32x2*)(ws + O_TOT); float* CAR = (float*)(ws + O_CAR);
    for (int item = gw; item < NB * 2 * 16; item += NGW) {
        const int cgp = item & 15, dir = (item >> 4) & 1, b = item >> 5, chn = cgp * 64 + lane;
        float hc = 0.f;
#pragma unroll 4
        for (int s = 0; s < 36; ++s) {
            int q; if (dir == 0) q = s < 4 ? 256 + b * 4 + s : b * 32 + (s - 4); else q = s < 4 ? 256 + b * 4 + (3 - s) : b * 32 + (31 - (s - 4));
            const size_t o = ((size_t)q * 2 + dir) * 1024 + chn;
            CAR[o] = hc; const f32x2 ab = TOT[o]; hc = fmaf(ab.x, hc, ab.y);
        }
    }
}
#ifndef FFN_BLK
#define FFN_BLK 1
#endif
#ifndef NORM_REV
#define NORM_REV 0
#endif
#ifndef CODE_SHIFT
#define CODE_SHIFT 0
#endif
#ifndef WGM_FD
#define WGM_FD 2
#endif
#ifndef WGM_MD
#define WGM_MD WGM
#endif
#ifndef WGM_K1
#define WGM_K1 WGM
#endif
#ifndef MOE_WNT
#define MOE_WNT 0
#endif
#ifndef FFN_DOWN_REV
#define FFN_DOWN_REV 1
#endif
#ifndef MOE_DOWN_REV
#define MOE_DOWN_REV 1
#endif
#ifndef MOE_DOWN_XCD
#define MOE_DOWN_XCD 0
#endif
#ifndef PROBE_BAR
#define PROBE_BAR 0
#endif
#ifndef MOE_NT
#define MOE_NT 0
#endif
#ifndef MOE_STAGGER
#define MOE_STAGGER 0
#endif
#ifndef MOE_WGM
#define MOE_WGM 0
#endif
#ifndef MOE_TAILSPLIT
#define MOE_TAILSPLIT 1
#endif
#ifndef SCANV
#define SCANV 2
#endif
#ifndef MOE_KSPLIT
#define MOE_KSPLIT 1
#endif
struct GridSched {
    int G, c, nM, nN, nt; const char* A; const char* B; size_t atile, btile; int rev = 0; int wgm = WGM;
    __device__ __forceinline__ bool next(int i, Unit& u) const {
        const int Lx = i * G + c; if (Lx >= nM * nN) return false;
        tile_of(rev ? nM * nN - 1 - Lx : Lx, nM, nN, u.pm, u.pn, wgm); u.A = A + (size_t)u.pm * atile; u.B = B + (size_t)u.pn * btile; u.nt = nt; u.kind = 0; u.x = 0; return true; }
};
struct FoldSched { int G, c; const char* DGp; const char* WUF;
    __device__ __forceinline__ bool next(int i, Unit& u) const {
        const int Lx = i * G + c; if (Lx >= 64) return false;
        const int pn = Lx & 7, g = (Lx >> 3) & 3, l = Lx >> 5;
        u.pm = 0; u.pn = pn; u.kind = g; u.x = l; { int n4 = 4; asm volatile("" : "+s"(n4)); u.nt = n4; }
        u.A = DGp; u.B = WUF + ((size_t)l * 2048 + pn * 256) * 1024 * 2 + (size_t)g * 256 * 2; return true; }
};
struct EpiFold { static constexpr bool PERM = true; bf16* WIN;
    __device__ __forceinline__ void operator()(const f32x4 (&acc)[2][2][4][2], const Unit& u, int wr, int wc, int fr, int fq) const { fr = opq(fr);
        bf16* base = WIN + (size_t)u.x * WIN_ROWS * 2048;
#pragma unroll
        for (int ai = 0; ai < 2; ++ai)
#pragma unroll
            for (int m = 0; m < 4; ++m) { const int row = u.kind * 256 + ai * HALF + wr * 64 + m * 16 + fr; bf16* rp = base + (size_t)row * 2048 + u.pn * 256 + wc * 32 + 8 * fq;
#pragma unroll
                for (int bj = 0; bj < 2; ++bj) { const f32x4 v0 = acc[ai][bj][m][0], v1 = acc[ai][bj][m][1];
                    u32x4 w; w.x = cvt_pk_bf16(v0[0], v0[1]); w.y = cvt_pk_bf16(v0[2], v0[3]); w.z = cvt_pk_bf16(v1[0], v1[1]); w.w = cvt_pk_bf16(v1[2], v1[3]); *(u32x4*)(rp + bj * HALF) = w; } __builtin_amdgcn_sched_barrier(0); }
    }
};
#ifndef LANE_LIN
#define LANE_LIN 1
#endif
__device__ __forceinline__ size_t lin_off(int pm, int pn8, int ai, int m, int bj, int tl);
struct WinSched { int G, c, l; const char* HNp; const char* WINl;
    __device__ __forceinline__ bool next(int i, Unit& u) const {
        int Lx = i * G + c; const int ntok = l == 0 ? 72 : 64; const int n0 = 4 * ntok, n1 = ntok * 24, n2 = l == 0 ? 0 : 32;
        if (Lx >= n0 + n1 + n2) return false;
        u.nt = 32; u.x = 0;
        if (Lx < n0) { tile_of(Lx, 4, ntok, u.pm, u.pn); u.kind = 0; u.A = WINl + (size_t)u.pm * 256 * 2048 * 2; u.B = HNp + (size_t)u.pn * 256 * 2048 * 2; return true; }
        Lx -= n0;
        if (Lx < n1) tile_of(Lx, ntok, 24, u.pm, u.pn); else { Lx -= n1; u.pm = 64 + (Lx & 7); u.pn = Lx >> 3; }
        u.kind = 1; u.A = HNp + (size_t)u.pm * 256 * 2048 * 2; u.B = WINl + (size_t)(1024 + u.pn * 256) * 2048 * 2; return true; }
};
struct EpiWin { static constexpr bool PERM = true; bf16 *UT, *UR, *GG, *SGF, *SGR;
    __device__ __forceinline__ void operator()(const f32x4 (&acc)[2][2][4][2], const Unit& u, int wr, int wc, int fr, int fq) const { fr = opq(fr);
        if (u.kind == 0) {
#pragma unroll
            for (int ai = 0; ai < 2; ++ai)
#pragma unroll
                for (int m = 0; m < 4; ++m) { const int rho = ai * HALF + wr * 64 + m * 16 + fr, sn = rho > 128 ? 1 : 0, c = sn ? rho - 128 : rho, cm = (256 - c) & 255;
                    const int ch = u.pm * 256 + c, chm = u.pm * 256 + cm;
#pragma unroll
                    for (int bj = 0; bj < 2; ++bj) { const int r = u.pn * 256 + bj * HALF + wc * 32 + 8 * fq;
                        const size_t tof = r < RL ? (size_t)(r >> 11) * 4096 + (r & 2047) : (size_t)32768 + ((r - RL) >> 8) * 512 + ((r - RL) & 255);
                        const size_t sof = r < RL ? 2048 : 256;
                        const f32x4 v0 = acc[ai][bj][m][0], v1 = acc[ai][bj][m][1];
                        u32x4 w; w.x = cvt_pk_bf16(v0[0], v0[1]); w.y = cvt_pk_bf16(v0[2], v0[3]); w.z = cvt_pk_bf16(v1[0], v1[1]); w.w = cvt_pk_bf16(v1[2], v1[3]);
                        if (sn == 0) { *(u32x4*)(UT + (size_t)ch * UT_LD + tof) = w;
                            if (cm != c) *(u32x4*)(UT + (size_t)chm * UT_LD + tof) = w;
                            else *(u32x4*)(UT + (size_t)ch * UT_LD + tof + sof) = (u32x4){0u, 0u, 0u, 0u}; }
                        else { *(u32x4*)(UT + (size_t)ch * UT_LD + tof + sof) = w;
                            const u32x4 wn = (u32x4){w.x ^ 0x80008000u, w.y ^ 0x80008000u, w.z ^ 0x80008000u, w.w ^ 0x80008000u}; *(u32x4*)(UT + (size_t)chm * UT_LD + tof + sof) = wn; } }
                    __builtin_amdgcn_sched_barrier(0); }
        } else {
            const int pn = u.pn; bf16* base; int ldc, ct, act;
            if (pn < 4) { base = UR; ldc = 1024; ct = pn; act = 0; } else if (pn < 8) { base = GG; ldc = 1024; ct = pn - 4; act = 1; }
            else if (pn < 16) { base = SGF; ldc = 2048; ct = pn - 8; act = 2; } else { base = SGR; ldc = 2048; ct = pn - 16; act = 2; }
#pragma unroll
            for (int ai = 0; ai < 2; ++ai)
#pragma unroll
                for (int m = 0; m < 4; ++m) { const int r = u.pm * 256 + ai * HALF + wr * 64 + m * 16 + fr; bf16* rp = base + (size_t)r * ldc + ct * 256 + wc * 32 + 8 * fq;
                    const int tl = (wr * 4 + wc) * 64 + fq * 16 + fr;
#pragma unroll
                    for (int bj = 0; bj < 2; ++bj) { f32x4 v0 = acc[ai][bj][m][0], v1 = acc[ai][bj][m][1];
                        if (act == 1) {
#pragma unroll
                            for (int j = 0; j < 4; ++j) { v0[j] = fgelu(v0[j]); v1[j] = fgelu(v1[j]); } }
                        else if (act == 2) {
#pragma unroll
                            for (int j = 0; j < 4; ++j) { v0[j] = fsigm(v0[j]); v1[j] = fsigm(v1[j]); } }
                        u32x4 w; w.x = cvt_pk_bf16(v0[0], v0[1]); w.y = cvt_pk_bf16(v0[2], v0[3]); w.z = cvt_pk_bf16(v1[0], v1[1]); w.w = cvt_pk_bf16(v1[2], v1[3]);
                        *(u32x4*)((LANE_LIN && act == 2) ? base + lin_off(u.pm, ct, ai, m, bj, tl) : rp + bj * HALF) = w; } __builtin_amdgcn_sched_barrier(0); }
        }
    }
};
struct DftSched { int G, c, l; const char* FLp; const char* FLCp; const char* UTp; const char* ZTp;
    __device__ __forceinline__ bool next(int i, Unit& u) const {
        int Lx = i * G + c; const int n0 = 256, n1 = l == 0 ? 32 : 0;
        if (Lx >= n0 + n1) return false;
#if DFT2
        if (Lx < n0) { const int b = Lx & 7, rest = Lx >> 3, pn = rest & 3, k1 = rest >> 2; u.pm = k1; u.pn = pn; u.kind = 0; u.x = b; u.nt = 8;
            u.A = FLp; u.B = ZTp + ((size_t)pn * 256 * UT_LD + (size_t)(b * 8 + k1) * 512) * 2; return true; }
#else
        if (Lx < n0) { const int b = Lx & 7, rest = Lx >> 3, pn = rest & 3, pm = rest >> 2; u.pm = pm; u.pn = pn; u.kind = 0; u.x = b; u.nt = 64;
            u.A = FLp + (size_t)pm * 256 * 4096 * 2; u.B = UTp + ((size_t)pn * 256 * UT_LD + (size_t)b * 4096) * 2; return true; }
#endif
        Lx -= n0; { const int b = Lx & 7, pn = Lx >> 3; u.pm = 0; u.pn = pn; u.kind = 1; u.x = b; u.nt = 8;
            u.A = FLCp; u.B = UTp + ((size_t)pn * 256 * UT_LD + 32768 + (size_t)b * 512) * 2; return true; }
    }
};
struct EpiBf16Rows { static constexpr bool PERM = true; bf16* O; int ldc;
    bool dft;
    __device__ __forceinline__ void operator()(const f32x4 (&acc)[2][2][4][2], const Unit& u, int wr, int wc, int fr, int fq) const { fr = opq(fr);
        const int rs = (DFT2 && dft && u.kind == 0) ? 8 : 1;
        const int row0 = dft ? (u.kind == 0 ? (DFT2 ? u.x * 2048 + u.pm : u.x * 2048 + u.pm * 256) : RL + u.x * 256) : u.pm * 256 + u.x * MAXSLOT;
#pragma unroll
        for (int ai = 0; ai < 2; ++ai)
#pragma unroll
            for (int m = 0; m < 4; ++m) { bf16* rp = O + (size_t)(row0 + rs * (ai * HALF + wr * 64 + m * 16 + fr)) * ldc + u.pn * 256 + wc * 32 + 8 * fq;
#pragma unroll
                for (int bj = 0; bj < 2; ++bj) { const f32x4 v0 = acc[ai][bj][m][0], v1 = acc[ai][bj][m][1];
                    u32x4 w; w.x = cvt_pk_bf16(v0[0], v0[1]); w.y = cvt_pk_bf16(v0[2], v0[3]); w.z = cvt_pk_bf16(v1[0], v1[1]); w.w = cvt_pk_bf16(v1[2], v1[3]); *(u32x4*)(rp + bj * HALF) = w; } __builtin_amdgcn_sched_barrier(0); }
    }
};
#ifndef LANE_LIN
#define LANE_LIN 1
#endif
__device__ __forceinline__ size_t lin_off(int pm, int pn8, int ai, int m, int bj, int tl) { return ((size_t)(pm * 8 + pn8) << 16) + (size_t)((((ai * 4 + m) * 2 + bj) * 512 + tl) * 8); }
template <bool ADD> struct EpiGate { static constexpr bool PERM = true; bf16* O; const bf16* gate; const bf16* addend;
    __device__ __forceinline__ void operator()(const f32x4 (&acc)[2][2][4][2], const Unit& u, int wr, int wc, int fr, int fq) const { fr = opq(fr);
        const int tl = (wr * 4 + wc) * 64 + fq * 16 + fr;
#pragma unroll
        for (int ai = 0; ai < 2; ++ai) {
            u32x4 g[4][2], t[4][2];
#pragma unroll
            for (int m = 0; m < 4; ++m) { const size_t off = (size_t)(u.pm * 256 + ai * HALF + wr * 64 + m * 16 + fr) * 2048 + u.pn * 256 + wc * 32 + 8 * fq;
#pragma unroll
                for (int bj = 0; bj < 2; ++bj) { const size_t lo = LANE_LIN ? lin_off(u.pm, u.pn, ai, m, bj, tl) : off + bj * HALF; g[m][bj] = *(const u32x4*)(gate + lo); if (ADD) t[m][bj] = *(const u32x4*)(addend + lo); } }
#pragma unroll
            for (int m = 0; m < 4; ++m) { const size_t off = (size_t)(u.pm * 256 + ai * HALF + wr * 64 + m * 16 + fr) * 2048 + u.pn * 256 + wc * 32 + 8 * fq;
#pragma unroll
                for (int bj = 0; bj < 2; ++bj) { const f32x4 v0 = acc[ai][bj][m][0], v1 = acc[ai][bj][m][1]; const u32x4 gg = g[m][bj];
                    float o[8] = {v0[0] * bf_lo(gg.x), v0[1] * bf_hi(gg.x), v0[2] * bf_lo(gg.y), v0[3] * bf_hi(gg.y), v1[0] * bf_lo(gg.z), v1[1] * bf_hi(gg.z), v1[2] * bf_lo(gg.w), v1[3] * bf_hi(gg.w)};
                    if (ADD) { const u32x4 tt = t[m][bj];
                        o[0] += bf_lo(tt.x); o[1] += bf_hi(tt.x); o[2] += bf_lo(tt.y); o[3] += bf_hi(tt.y); o[4] += bf_lo(tt.z); o[5] += bf_hi(tt.z); o[6] += bf_lo(tt.w); o[7] += bf_hi(tt.w); }
                    u32x4 w; w.x = cvt_pk_bf16(o[0], o[1]); w.y = cvt_pk_bf16(o[2], o[3]); w.z = cvt_pk_bf16(o[4], o[5]); w.w = cvt_pk_bf16(o[6], o[7]);
                    *(u32x4*)(O + ((LANE_LIN && !ADD) ? lin_off(u.pm, u.pn, ai, m, bj, tl) : off + bj * HALF)) = w; } }
            asm volatile("" ::: "memory"); __builtin_amdgcn_sched_barrier(0); }
    }
};
template <bool FIRST> struct EpiResid { static constexpr bool PERM = false; float* lat; const float* modl; int gate_chunk; const float* x0; const float* c0;
    __device__ __forceinline__ void operator()(const f32x4 (&acc)[2][2][4][2], const Unit& u, int wr, int wc, int fr, int fq) const { fr = opq(fr);
        const int bi = u.pm < 64 ? (u.pm >> 3) : 8; const int col0 = u.pn * 256 + wc * 32 + 4 * fq;
        const float* gp = modl + (size_t)bi * 12288 + gate_chunk * D + col0;
        f32x4 gv[2][2];
#pragma unroll
        for (int bj = 0; bj < 2; ++bj)
#pragma unroll
            for (int n = 0; n < 2; ++n) gv[bj][n] = *(const f32x4*)(gp + bj * HALF + n * 16);
#pragma unroll
        for (int ai = 0; ai < 2; ++ai) {
            f32x4 bsv[4][2][2];
#pragma unroll
            for (int m = 0; m < 4; ++m) { const int row = u.pm * 256 + ai * HALF + wr * 64 + m * 16 + fr; const float* rp = lat + (size_t)row * D + col0;
                const float* bp = FIRST ? (u.pm < 64 ? x0 + (size_t)row * D + col0 : c0 + (size_t)(row - RL) * D + col0) : rp;
#pragma unroll
                for (int bj = 0; bj < 2; ++bj)
#pragma unroll
                    for (int n = 0; n < 2; ++n) bsv[m][bj][n] = *(const f32x4*)(bp + bj * HALF + n * 16); }
#pragma unroll
            for (int m = 0; m < 4; ++m) { const int row = u.pm * 256 + ai * HALF + wr * 64 + m * 16 + fr; float* rp = lat + (size_t)row * D + col0;
#pragma unroll
                for (int bj = 0; bj < 2; ++bj)
#pragma unroll
                    for (int n = 0; n < 2; ++n) *(f32x4*)(rp + bj * HALF + n * 16) = bsv[m][bj][n] + gv[bj][n] * acc[ai][bj][m][n]; }
            asm volatile("" ::: "memory"); __builtin_amdgcn_sched_barrier(0); }
    }
};
struct EpiNull { static constexpr bool PERM = true; float* sink;
    __device__ __forceinline__ void operator()(const f32x4 (&acc)[2][2][4][2], const Unit& u, int wr, int wc, int fr, int fq) const {
        float s = 0.f;
#pragma unroll
        for (int ai = 0; ai < 2; ++ai)
#pragma unroll
            for (int bj = 0; bj < 2; ++bj)
#pragma unroll
                for (int m = 0; m < 4; ++m)
#pragma unroll
                    for (int n = 0; n < 2; ++n) s += acc[ai][bj][m][n][0] + acc[ai][bj][m][n][1] + acc[ai][bj][m][n][2] + acc[ai][bj][m][n][3];
        if (s == 1.2345e30f) sink[u.pm] = s;
    }
};
template <bool NT> struct EpiSwigluT { static constexpr bool PERM = true; bf16* O; int ldc; int blk = 0;
    __device__ __forceinline__ void operator()(const f32x4 (&acc)[2][2][4][2], const Unit& u, int wr, int wc, int fr, int fq) const { fr = opq(fr);
#pragma unroll
        for (int ai = 0; ai < 2; ++ai)
#pragma unroll
            for (int m = 0; m < 4; ++m) { bf16* rp = blk ? O + ((size_t)u.pm * blk + u.pn) * 32768 + (size_t)(ai * HALF + wr * 64 + m * 16 + fr) * 128 + wc * 32 + 8 * fq : O + (size_t)(u.pm * 256 + ai * HALF + wr * 64 + m * 16 + fr) * ldc + u.pn * 128 + wc * 32 + 8 * fq;
                const f32x4 g0 = acc[ai][0][m][0], g1 = acc[ai][0][m][1], u0 = acc[ai][1][m][0], u1 = acc[ai][1][m][1];
                u32x4 w; w.x = cvt_pk_bf16(fsilu(g0[0]) * u0[0], fsilu(g0[1]) * u0[1]); w.y = cvt_pk_bf16(fsilu(g0[2]) * u0[2], fsilu(g0[3]) * u0[3]);
                w.z = cvt_pk_bf16(fsilu(g1[0]) * u1[0], fsilu(g1[1]) * u1[1]); w.w = cvt_pk_bf16(fsilu(g1[2]) * u1[2], fsilu(g1[3]) * u1[3]); if (NT) __builtin_nontemporal_store(w, (u32x4*)rp); else *(u32x4*)rp = w; __builtin_amdgcn_sched_barrier(0); }
    }
};
typedef EpiSwigluT<false> EpiSwiglu;
struct EpiSwigluF8 { static constexpr bool PERM = true; unsigned char* O; float sc;
    __device__ __forceinline__ void operator()(const f32x4 (&acc)[2][2][4][2], const Unit& u, int wr, int wc, int fr, int fq) const { fr = opq(fr); fq = opq(fq);
        const float su = sc * H8_SC;
#pragma unroll
        for (int ai = 0; ai < 2; ++ai)
#pragma unroll
            for (int m = 0; m < 4; ++m) { unsigned char* rp = O + ((size_t)u.pm * 28 + (u.pn >> 1)) * 65536 + (size_t)(ai * HALF + wr * 64 + m * 16 + fr) * 256 + (u.pn & 1) * 128 + wc * 32 + 8 * fq;
                const f32x4 g0 = acc[ai][0][m][0] * sc, g1 = acc[ai][0][m][1] * sc, u0 = acc[ai][1][m][0] * su, u1 = acc[ai][1][m][1] * su;
                u32x2 w; w.x = cvt_fp8x4(fsilu(g0[0]) * u0[0], fsilu(g0[1]) * u0[1], fsilu(g0[2]) * u0[2], fsilu(g0[3]) * u0[3]);
                w.y = cvt_fp8x4(fsilu(g1[0]) * u1[0], fsilu(g1[1]) * u1[1], fsilu(g1[2]) * u1[2], fsilu(g1[3]) * u1[3]); *(u32x2*)rp = w; __builtin_amdgcn_sched_barrier(0); }
    }
};
struct EpiSwigluWrap { static constexpr bool PERM = true; bf16* O; int ldc;
    __device__ __forceinline__ void operator()(const f32x4 (&acc)[2][2][4][2], const Unit& u, int wr, int wc, int fr, int fq) const { fr = opq(fr);
#pragma unroll
        for (int ai = 0; ai < 2; ++ai)
#pragma unroll
            for (int m = 0; m < 4; ++m) { bf16* rp = O + (size_t)((u.pm & 7) * 256 + ai * HALF + wr * 64 + m * 16 + fr) * ldc + u.pn * 128 + wc * 32 + 8 * fq;
                const f32x4 g0 = acc[ai][0][m][0], g1 = acc[ai][0][m][1], u0 = acc[ai][1][m][0], u1 = acc[ai][1][m][1];
                u32x4 w; w.x = cvt_pk_bf16(fsilu(g0[0]) * u0[0], fsilu(g0[1]) * u0[1]); w.y = cvt_pk_bf16(fsilu(g0[2]) * u0[2], fsilu(g0[3]) * u0[3]);
                w.z = cvt_pk_bf16(fsilu(g1[0]) * u1[0], fsilu(g1[1]) * u1[1]); w.w = cvt_pk_bf16(fsilu(g1[2]) * u1[2], fsilu(g1[3]) * u1[3]); *(u32x4*)rp = w; __builtin_amdgcn_sched_barrier(0); }
    }
};
__device__ __forceinline__ const char* uni_ptr(const char* p) { const unsigned long long v = (unsigned long long)p;
    const unsigned lo = (unsigned)__builtin_amdgcn_readfirstlane((int)(unsigned)v), hi = (unsigned)__builtin_amdgcn_readfirstlane((int)(unsigned)(v >> 32)); return (const char*)(((unsigned long long)hi << 32) | lo); }
__device__ __forceinline__ void uni_unit(Unit& u) { u.A = uni_ptr(u.A); u.B = uni_ptr(u.B); u.pm = __builtin_amdgcn_readfirstlane(u.pm); u.pn = __builtin_amdgcn_readfirstlane(u.pn);
    u.kind = __builtin_amdgcn_readfirstlane(u.kind); u.x = __builtin_amdgcn_readfirstlane(u.x); u.nt = __builtin_amdgcn_readfirstlane(u.nt); }
struct MoeSched { int G, c, nN, nt; const LAS int* tbl; const char* A; const char* B; size_t atile, btile, bexp; int ksplit; size_t khalf;
    __device__ __forceinline__ bool next(int i, Unit& u) const {
        int Lx = i * G + c; const int total = tbl[8] * nN; if (Lx >= total * ksplit) return false;
        int kh = 0; if (ksplit == 2) { kh = Lx >= total ? 1 : 0; Lx -= kh * total; }
        int e = 0;
#pragma unroll
        for (int k = 1; k < 8; ++k) e += (Lx >= tbl[k] * nN) ? 1 : 0;
        const int t0 = tbl[e], te = tbl[e + 1] - t0, lx = Lx - t0 * nN;
        { int pml, pnl; tile_of(lx, te, nN, pml, pnl, MOE_WGM ? (MOE_WGM < te ? MOE_WGM : te) : WGM); u.pm = t0 + pml; u.pn = pnl; }
        u.kind = e; u.x = kh; u.nt = nt;
        u.A = A + (size_t)u.pm * atile + (size_t)kh * khalf; u.B = B + (size_t)e * bexp + (size_t)u.pn * btile + (size_t)kh * khalf; uni_unit(u); return true; }
};


struct MoeDownSched { int G, c, sp; const LAS int* tbl; const char* A; const char* B; size_t atile, btile, bexp;
    __device__ __forceinline__ bool next(int i, Unit& u) const {
        const int U = tbl[8] * 8, full = U / G, R = U - full * G;
        int Lx = i * G + c, k = 0, rr = -1;
        if (i > full) return false;
        if (i == full) { if (sp > 1) { if (c >= R * sp) return false; rr = c / sp; k = c - rr * sp; Lx = full * G + rr; } else if (c >= R) return false; }
        else if (MOE_DOWN_REV) Lx = full * G - 1 - Lx;
        int e = 0;
#pragma unroll
        for (int kk = 1; kk < 8; ++kk) e += (Lx >= tbl[kk] * 8) ? 1 : 0;
        const int t0 = tbl[e], te = tbl[e + 1] - t0, lx = Lx - t0 * 8;
#if MOE_DOWN_XCD
        { const int id = (lx & 7) * te + (lx >> 3); u.pm = t0 + (id >> 3); u.pn = id & 7; }
#else
        { int pml, pnl; tile_of(lx, te, 8, pml, pnl, WGM_MD); u.pm = t0 + pml; u.pn = pnl; }
#endif
        u.kind = e; const int nts = rr < 0 ? (MOE_F8 ? 56 : 112) : (MOE_F8 ? 56 : 112) / sp; u.nt = nts; u.x = rr < 0 ? 0 : 1 + rr * 16 + k;
        const size_t ko = MOE_BLK ? (size_t)k * (nts >> 1) * 65536 : (size_t)k * nts * 128;
        u.A = A + (size_t)u.pm * atile + ko; u.B = B + (size_t)e * bexp + (size_t)u.pn * btile + ko; uni_unit(u); return true; }
};
struct EpiMoeDown { static constexpr bool PERM = true; bf16* O; float* part; unsigned* cnt; int sp; float osc = 1.f;
    __device__ __forceinline__ void store_rows(const f32x4 (&v)[2][2][4][2], const Unit& u, int wr, int wc, int fr, int fq) const {
#pragma unroll
        for (int ai = 0; ai < 2; ++ai)
#pragma unroll
            for (int m = 0; m < 4; ++m) { bf16* rp = O + (size_t)(u.pm * 256 + ai * HALF + wr * 64 + m * 16 + fr) * 2048 + u.pn * 256 + wc * 32 + 8 * fq;
#pragma unroll
                for (int bj = 0; bj < 2; ++bj) { const f32x4 v0 = v[ai][bj][m][0] * osc, v1 = v[ai][bj][m][1] * osc;
                    u32x4 w; w.x = cvt_pk_bf16(v0[0], v0[1]); w.y = cvt_pk_bf16(v0[2], v0[3]); w.z = cvt_pk_bf16(v1[0], v1[1]); w.w = cvt_pk_bf16(v1[2], v1[3]); *(u32x4*)(rp + bj * HALF) = w; } __builtin_amdgcn_sched_barrier(0); }
    }
    template <int SP> __device__ __forceinline__ void reduce_store(const float* P0, const Unit& u, int wr, int wc, int fr, int fq) const {
        constexpr int NPB = SP <= 4 ? 4 : (SP <= 8 ? 2 : 1);
#pragma unroll
        for (int ai = 0; ai < 2; ++ai)
#pragma unroll
            for (int m = 0; m < 4; ++m) { bf16* rp = O + (size_t)(u.pm * 256 + ai * HALF + wr * 64 + m * 16 + fr) * 2048 + u.pn * 256 + wc * 32 + 8 * fq;
                f32x4 v[4];
#pragma unroll
                for (int p0 = 0; p0 < 4; p0 += NPB) { f32x4 t[NPB][SP];
#pragma unroll
                    for (int pp = 0; pp < NPB; ++pp) { const int idx = (ai * 4 + m) * 4 + p0 + pp;
#pragma unroll
                        for (int kk = 0; kk < SP; ++kk) t[pp][kk] = *(const f32x4*)(P0 + ((size_t)kk << 16) + idx * 2048); }
#pragma unroll
                    for (int pp = 0; pp < NPB; ++pp) { f32x4 a4 = t[pp][0];
#pragma unroll
                        for (int kk = 1; kk < SP; ++kk) a4 += t[pp][kk];
                        v[p0 + pp] = a4 * osc; }
                    asm volatile("" ::: "memory"); }
#pragma unroll
                for (int bj = 0; bj < 2; ++bj) { u32x4 w; w.x = cvt_pk_bf16(v[2 * bj][0], v[2 * bj][1]); w.y = cvt_pk_bf16(v[2 * bj][2], v[2 * bj][3]); w.z = cvt_pk_bf16(v[2 * bj + 1][0], v[2 * bj + 1][1]); w.w = cvt_pk_bf16(v[2 * bj + 1][2], v[2 * bj + 1][3]);
                    *(u32x4*)(rp + bj * HALF) = w; }
                __builtin_amdgcn_sched_barrier(0); }
    }
    __device__ __forceinline__ void operator()(const f32x4 (&acc)[2][2][4][2], const Unit& u, int wr, int wc, int fr, int fq) const { fr = opq(fr); fq = opq(fq);
        if (u.x == 0) { store_rows(acc, u, wr, wc, fr, fq); return; }
        const int rr = (u.x - 1) >> 4, k = (u.x - 1) & 15, wid = wr * 4 + wc, tl = wid * 64 + fq * 16 + fr;
        float* P = part + ((size_t)(rr * sp + k) << 16) + (size_t)tl * 4;
#pragma unroll
        for (int ai = 0; ai < 2; ++ai)
#pragma unroll
            for (int m = 0; m < 4; ++m)
#pragma unroll
                for (int bj = 0; bj < 2; ++bj)
#pragma unroll
                    for (int n = 0; n < 2; ++n) { const int idx = ((ai * 4 + m) * 2 + bj) * 2 + n; float* q = P + idx * 2048; const f32x4 vv = acc[ai][bj][m][n];
                        asm volatile("global_store_dwordx4 %0, %1, off sc1" :: "v"(q), "v"(vv) : "memory"); }
        asm volatile("s_waitcnt vmcnt(0)" ::: "memory");
        unsigned tk = 0u; if (fq * 16 + fr == 0) tk = __hip_atomic_fetch_add(cnt + rr * 8 + wid, 1u, __ATOMIC_RELAXED, __HIP_MEMORY_SCOPE_AGENT);
        tk = (unsigned)__builtin_amdgcn_readfirstlane((int)tk);
        if (tk + 1u == (unsigned)sp) {
            __builtin_amdgcn_fence(__ATOMIC_ACQUIRE, "agent"); asm volatile("s_waitcnt vmcnt(0)" ::: "memory");
            const float* P0 = part + ((size_t)(rr * sp) << 16) + (size_t)tl * 4;
            switch (sp) { case 2: reduce_store<2>(P0, u, wr, wc, fr, fq); break; case 4: reduce_store<4>(P0, u, wr, wc, fr, fq); break; case 7: reduce_store<7>(P0, u, wr, wc, fr, fq); break;
                          case 8: reduce_store<8>(P0, u, wr, wc, fr, fq); break; default: reduce_store<14>(P0, u, wr, wc, fr, fq); break; }
        }
    }
};

__device__ __forceinline__ void moe_gather(AP a, LAS unsigned char* lds, int vcu, int G) {
    const int tid = opq(threadIdx.x), lane = tid & 63, w = tid >> 6; unsigned char* ws = a->ws;
    LAS int* cl = (LAS int*)lds;
    LAS int* pre = cl + 2048;
    LAS int* off = pre + 8;
    LAS int* tot = off + 24;
    LAS int* sl = tot + 8;
    const int* cntb = (const int*)(ws + O_MISC + M_CNTB); const int* sel = (const int*)(ws + O_MISC + M_SEL);
    int* slot_of = (int*)(ws + O_MISC + M_SLOT);
    const bf16* HN = (const bf16*)(ws + O_HN); bf16* XG = (bf16*)(ws + O_XG);
    for (int i = tid; i < 2048; i += NTHREADS) cl[i] = cntb[i];
    __syncthreads();
    for (int g = vcu; g < 256; g += G) {
        if (tid < 8) { int s = 0, p = 0;
#pragma unroll 8
            for (int j = 0; j < 256; ++j) { const int v = cl[j * 8 + tid]; p += (j < g) ? v : 0; s += v; }
            pre[tid] = p; tot[tid] = s; }
        __syncthreads();
        if (tid == 0) { int o = 0; for (int e = 0; e < 8; ++e) { off[e] = o * 256; off[8 + e] = o; o += (tot[e] + 255) >> 8; } off[16] = o;
            if (g == 0) { int* T = (int*)(ws + O_MISC + M_TOT); for (int e = 0; e < 8; ++e) T[e] = tot[e]; for (int e = 0; e < 9; ++e) T[16 + e] = off[8 + e]; } }
        __syncthreads();
        if (w == 0) { const int tkn = g * 64 + lane; const int s0 = sel[tkn * 2], s1 = sel[tkn * 2 + 1]; int slot0 = 0, slot1 = 0;
            const unsigned long long lt = (1ull << lane) - 1ull;
#pragma unroll
            for (int e = 0; e < 8; ++e) { const unsigned long long mk = __ballot(s0 == e || s1 == e); const int rk = __popcll(mk & lt);
                if (s0 == e) slot0 = off[e] + pre[e] + rk; if (s1 == e) slot1 = off[e] + pre[e] + rk; }
            slot_of[tkn * 2] = slot0; slot_of[tkn * 2 + 1] = slot1; sl[lane * 2] = slot0; sl[lane * 2 + 1] = slot1; }
        __syncthreads();
        for (int p0 = w * 16; p0 < w * 16 + 16; p0 += 4) { u32x4 v[4][4];
#pragma unroll
            for (int r = 0; r < 4; ++r) { const int tkn = g * 64 + ((p0 + r) >> 1); const u32x4* sp_ = (const u32x4*)(HN + (size_t)tkn * D) + lane;
#pragma unroll
                for (int j = 0; j < 4; ++j) v[r][j] = sp_[64 * j]; }
#pragma unroll
            for (int r = 0; r < 4; ++r) { const int slot = sl[p0 + r];
                if (MOE_F8) { u32x2* d8 = (u32x2*)((unsigned char*)XG + (size_t)slot * D) + lane;
#pragma unroll
                    for (int j = 0; j < 4; ++j) { const u32x4 q = v[r][j]; u32x2 o8;
                        o8.x = cvt_fp8x4(bf_lo(q.x) * X8_SC, bf_hi(q.x) * X8_SC, bf_lo(q.y) * X8_SC, bf_hi(q.y) * X8_SC); o8.y = cvt_fp8x4(bf_lo(q.z) * X8_SC, bf_hi(q.z) * X8_SC, bf_lo(q.w) * X8_SC, bf_hi(q.w) * X8_SC);
                        d8[64 * j] = o8; } continue; }
                u32x4* d = (u32x4*)(XG + (size_t)slot * D) + lane;
#pragma unroll
                for (int j = 0; j < 4; ++j) d[64 * j] = v[r][j]; } }
        if (g < 8) { const int r0 = off[g] + tot[g], r1 = off[g] + (((tot[g] + 255) >> 8) << 8);
            for (int r = r0 + w; r < r1; r += NWAVES) {
                if (MOE_F8) { u32x2* d8 = (u32x2*)((unsigned char*)XG + (size_t)r * D) + lane;
#pragma unroll
                    for (int j = 0; j < 4; ++j) d8[64 * j] = (u32x2){0u, 0u}; continue; }
                u32x4* d = (u32x4*)(XG + (size_t)r * D) + lane;
#pragma unroll
                for (int j = 0; j < 4; ++j) d[64 * j] = (u32x4){0u, 0u, 0u, 0u}; } }
        __syncthreads();
    }
}
struct CombIdx { int s0, s1; float w0, w1; };
__device__ __forceinline__ CombIdx comb_idx(const unsigned char* ws, int row) { const int* slot_of = (const int*)(ws + O_MISC + M_SLOT); const float* gwt = (const float*)(ws + O_MISC + M_GWT);
    CombIdx c; c.s0 = slot_of[row * 2]; c.s1 = slot_of[row * 2 + 1]; c.w0 = gwt[row * 2]; c.w1 = gwt[row * 2 + 1]; return c; }
__device__ __forceinline__ void comb_load(const unsigned char* ws, int row, const CombIdx& c, int lane, f32x4 (&xv)[8], u32x2 (&p0)[8], u32x2 (&p1)[8]) {
    const f32x4* xr = (const f32x4*)((const float*)(ws + O_LAT) + (size_t)row * D);
    const u32x2* o0 = (const u32x2*)((const bf16*)(ws + O_OS) + (size_t)c.s0 * D); const u32x2* o1 = (const u32x2*)((const bf16*)(ws + O_OS) + (size_t)c.s1 * D);
#pragma unroll
    for (int j = 0; j < 8; ++j) { const int i4 = lane + 64 * j; xv[j] = xr[i4]; p0[j] = o0[i4]; p1[j] = o1[i4]; }
}
__device__ __forceinline__ void comb_row(AP a, int row, const CombIdx& c, int lane, const f32x4 (&xv)[8], const u32x2 (&p0)[8], const u32x2 (&p1)[8]) {
    const unsigned char* ws = a->ws; const float w0 = c.w0, w1 = c.w1;
    const float* g2 = (const float*)(ws + O_MOD) + ((size_t)9 + (row >> 11)) * 12288 + 5 * D;
    f32x4 v[8]; float s = 0.f;
#pragma unroll
    for (int j = 0; j < 8; ++j) { const int i4 = lane + 64 * j; const f32x4 gg = *(const f32x4*)(g2 + i4 * 4);
        f32x4 m; m.x = w0 * bf_lo(p0[j].x) + w1 * bf_lo(p1[j].x); m.y = w0 * bf_hi(p0[j].x) + w1 * bf_hi(p1[j].x); m.z = w0 * bf_lo(p0[j].y) + w1 * bf_lo(p1[j].y); m.w = w0 * bf_hi(p0[j].y) + w1 * bf_hi(p1[j].y);
        v[j] = xv[j] + gg * m; s += (v[j].x * v[j].x + v[j].y * v[j].y) + (v[j].z * v[j].z + v[j].w * v[j].w); }
    const float rstd = rsqrtf(wave_sum(s) * (1.f / D) + 1e-6f);
    f32x4* out = (f32x4*)(a->out + (size_t)row * D);
#pragma unroll
    for (int j = 0; j < 8; ++j) { const int i4 = lane + 64 * j; out[i4] = v[j] * rstd * *(const f32x4*)(a->in[26] + i4 * 4); }
}
__device__ __forceinline__ void moe_combine_phase(AP a, int gw, int NGW, int lane) {
    const unsigned char* ws = a->ws; int r = gw; if (r >= RL) return;
    CombIdx ci = comb_idx(ws, r), cn = ci; if (r + NGW < RL) cn = comb_idx(ws, r + NGW);
    f32x4 xv[8]; u32x2 p0[8], p1[8]; comb_load(ws, r, ci, lane, xv, p0, p1);
    for (; r < RL; r += NGW) {
        const int rn = r + NGW, rnn = rn + NGW; f32x4 xn[8]; u32x2 q0[8], q1[8]; CombIdx cnn = cn;
        if (rn < RL) comb_load(ws, rn, cn, lane, xn, q0, q1);
        if (rnn < RL) cnn = comb_idx(ws, rnn);
        comb_row(a, r, ci, lane, xv, p0, p1);
#pragma unroll
        for (int j = 0; j < 8; ++j) { xv[j] = xn[j]; p0[j] = q0[j]; p1[j] = q1[j]; }
        ci = cn; cn = cnn;
    }
}

constexpr int NPHASE = 26;
constexpr int l_min(int a, int b) { return a < b ? a : b; }
#ifndef PROBE_PHASE
#define PROBE_PHASE (-1)
#endif
#define REPS(k) (((k) == PROBE_PHASE) ? 2 : 1)
#ifndef CVB
#define CVB 125
#endif
constexpr int cvb(int n) { return (int)((long long)n * CVB / 100); }
#ifndef CVQ
#define CVQ 0, 5000, 5000, 11000, 9000, 30000, 10000, 0
#endif
constexpr int cvq[8] = {CVQ};
constexpr int CV_W00 = 0, CV_W01 = CV_W00 + cvb(cvq[0]), CV_T10 = CV_W01, CV_T11 = CV_T10 + cvb(cvq[1]), CV_MG0 = CV_T11, CV_MG1 = CV_MG0 + cvb(cvq[2]), CV_OUT0 = CV_MG1, CV_OUT1 = CV_OUT0 + cvb(cvq[3]),
              CV_FG0 = CV_OUT1, CV_FG1 = CV_FG0 + cvb(cvq[4]), CV_FD0 = CV_FG1, CV_FD1 = CV_FD0 + cvb(cvq[5]),
              CV_GU0 = N_MOE - cvb(cvq[7]), CV_GU1 = N_MOE,
              CV_WI0 = l_min(CV_FD1, CV_GU0), CV_WI1 = l_min(CV_WI0 + cvb(cvq[6]), CV_GU0), CV_FLUSH = CV_WI1;
static_assert(CV_GU0 >= N_MG + N_MU && CV_FD1 <= N_MOE, "conversion slices");
constexpr int CV_GUS = CV_GU0;
#define TAILCVT(total, c0, c1) do { const int rem_ = (total) % G; if (l == 0 || (c0) == CV_WI0 || (c0) == CV_GUS) { if (rem_ != 0 && bx >= rem_ && (c0) < N_MOE) cvt_moe_range(argp, lds, (c0), l_min((c1), N_MOE), (bx - rem_) * NWAVES + wave, (G - rem_) * NWAVES); __syncthreads(); } } while (0)
template <int l>
__device__ __forceinline__ void layer_phases(LAS unsigned char* lds, unsigned char* ws, const int lo, const int hi, const XcdBarrier& bar, const int G, const int bx, const int vcu, const int gw, const int NGW, const int tid, const int lane, const int wave) {
#define args (*kargs())
#define argp (kargs())
#define IN(k) (lo <= (k) && (k) < hi)
#define SEAM(k) do { if (IN(k) && IN((k) + 1)) { xcd_barrier(bar); if (PROBE_BAR) xcd_barrier(bar); } } while (0)
    const char* HNp = (const char*)(ws + O_HN);
    float* LAT = (float*)(ws + O_LAT);
        const int pb = 2 + 12 * l;
        const float* modl = (const float*)(ws + O_MOD) + (size_t)l * 9 * 12288;
        const int ntok = l == 0 ? 72 : 64;
        if (IN(pb + 0)) for (int rep = 0; rep < REPS(pb + 0); ++rep) { WinSched S{G, bx, l, HNp, (const char*)(ws + O_WIN) + (size_t)l * WIN_ROWS * 2048 * 2};
            EpiWin E{(bf16*)(ws + O_UT), (bf16*)(ws + O_UR), (bf16*)(ws + O_GG), (bf16*)(ws + O_SGF), (bf16*)(ws + O_SGR)}; gemm_phase<EpiWin, WinSched>(lds, 2048, 2048, S, E); if (l == 1) TAILCVT(1824, CV_WI0, CV_WI1); else TAILCVT(2016, CV_W00, CV_W01); }
        SEAM(pb + 0);
        if (IN(pb + 1)) for (int rep = 0; rep < REPS(pb + 1); ++rep) {
#if defined(PROBE_SKIP)
            if (rep == 1) scan_phase2<1, PROBE_SKIP>(argp, lds, l, NCHUNK * 8, vcu, G); else
#endif
            if (SCANV == 2) scan_phase2<1>(argp, lds, l, NCHUNK * 8, vcu, G); else scan_phase<1>(argp, lds, l, NCHUNK * 8, vcu, G);
#if DFT2
            { __syncthreads(); LAS f32x2* tab = (LAS f32x2*)lds;
              for (int m = opq(tid); m < 2048; m += NTHREADS) { float sn, cs; sincospif((float)m * (1.f / 1024.f), &sn, &cs); tab[m] = (f32x2){cs, sn}; }
              __syncthreads(); dft_stage1(argp, tab, (size_t)vcu * NTHREADS + opq(tid), (size_t)G * NTHREADS); __syncthreads(); }
#endif
            }
        SEAM(pb + 1);
        if (IN(pb + 2)) for (int rep = 0; rep < REPS(pb + 2); ++rep) { DftSched S{G, bx, l, (const char*)(ws + O_FL), (const char*)(ws + O_FLC), (const char*)(ws + O_UT), (const char*)(ws + O_ZT)}; EpiBf16Rows E{(bf16*)(ws + O_Y), 1024, true};
            gemm_phase<EpiBf16Rows, DftSched>(lds, 4096, UT_LD, S, E); carry_phase(argp, opq(gw), NGW); }
        SEAM(pb + 2);
        if (IN(pb + 3)) for (int rep = 0; rep < REPS(pb + 3); ++rep) { GridSched S{G, bx, ntok, 8, 16, (const char*)(ws + O_Y), (const char*)(ws + O_WFO) + (size_t)l * 2048 * 1024 * 2, (size_t)256 * 1024 * 2, (size_t)256 * 1024 * 2, 0, WGM_K1};
            EpiGate<false> E{(bf16*)(ws + O_T1), (const bf16*)(ws + O_SGF), nullptr}; gemm_phase<EpiGate<false>, GridSched>(lds, 1024, 1024, S, E); TAILCVT(ntok * 8, CV_T10, CV_T11);
            if (SCANV == 2) scan_phase2<2>(argp, lds, l, (l == 0 ? NCHUNK : 256) * 8, vcu, G); else scan_phase<2>(argp, lds, l, (l == 0 ? NCHUNK : 256) * 8, vcu, G); }
        SEAM(pb + 3);
        if (IN(pb + 4)) for (int rep = 0; rep < REPS(pb + 4); ++rep) { GridSched S{G, bx, ntok, 8, 16, (const char*)(ws + O_HR), (const char*)(ws + O_WRO) + (size_t)l * 2048 * 1024 * 2, (size_t)256 * 1024 * 2, (size_t)256 * 1024 * 2, 0, WGM_K1};
            EpiGate<true> E{(bf16*)(ws + O_MG), (const bf16*)(ws + O_SGR), (const bf16*)(ws + O_T1)}; gemm_phase<EpiGate<true>, GridSched>(lds, 1024, 1024, S, E); TAILCVT(ntok * 8, CV_MG0, CV_MG1); }
        SEAM(pb + 4);
        if (IN(pb + 5)) { GridSched S{G, bx, ntok, 8, 32, (const char*)(ws + O_MG), (const char*)(ws + O_WO) + (size_t)l * 2048 * 2048 * 2, (size_t)256 * 2048 * 2, (size_t)256 * 2048 * 2};
            EpiResid<l == 0> E{LAT, modl, 2, args.in[0], args.in[2]}; gemm_phase<EpiResid<l == 0>, GridSched>(lds, 2048, 2048, S, E); TAILCVT(ntok * 8, CV_OUT0, CV_OUT1); }
        SEAM(pb + 5);
        if (IN(pb + 6)) for (int rep = 0; rep < REPS(pb + 6); ++rep) {
            if (l == 0) { const int ln = opq(lane); f32x4 v[8]; int r = NORM_REV ? R - 1 - gw : gw; const int st = NORM_REV ? -NGW : NGW;
                if (r >= 0 && r < R) norm_load(v, LAT + (size_t)r * D, ln);
                for (; r >= 0 && r < R; r += st) { f32x4 vn[8]; const int rn = r + st; if (rn >= 0 && rn < R) norm_load(vn, LAT + (size_t)rn * D, ln);
                    norm_row<false>(v, args.in[7], modl, 3, 4, (bf16*)(ws + O_HN), r, ln, nullptr, nullptr, nullptr);
#pragma unroll
                    for (int j = 0; j < 8; ++j) v[j] = vn[j]; } }
            else {
                LAS float* rt = (LAS float*)lds; for (int i = tid; i < 2048 * 8; i += NTHREADS) rt[i] = args.in[22][i];
                LAS int* gs = (LAS int*)(lds + 65536);
                __syncthreads();
                int* sel = (int*)(ws + O_MISC + M_SEL); float* gwt = (float*)(ws + O_MISC + M_GWT); int* cntb = (int*)(ws + O_MISC + M_CNTB);
                for (int g = vcu; g < 256; g += G) {
                    { const int ln = opq(lane); f32x4 v[8]; norm_load(v, LAT + (size_t)(g * 64 + wave * 8) * D, ln);
                      for (int k = 0; k < 8; ++k) { const int r = g * 64 + wave * 8 + k; f32x4 vn[8]; if (k < 7) norm_load(vn, LAT + (size_t)(r + 1) * D, ln);
                        const int pk = norm_row<true>(v, args.in[7] + D, modl, 3, 4, (bf16*)(ws + O_HN), r, ln, rt, sel, gwt);
                        if (lane == 0) { gs[(wave * 8 + k) * 2] = pk & 255; gs[(wave * 8 + k) * 2 + 1] = pk >> 8; }
#pragma unroll
                        for (int j = 0; j < 8; ++j) v[j] = vn[j]; } }
                    __syncthreads();
                    if (wave == 0) { const int s0 = gs[lane * 2], s1 = gs[lane * 2 + 1];
#pragma unroll
                        for (int e = 0; e < 8; ++e) { const unsigned long long mk = __ballot(s0 == e || s1 == e); if (lane == e) cntb[g * 8 + e] = __popcll(mk); } }
                    __syncthreads();
                }
            }
        }
        SEAM(pb + 6);
        if (l == 1) { if (IN(pb + 7)) { moe_gather(argp, lds, vcu, G); __syncthreads(); cvt_moe_range(argp, lds, CV_FLUSH, CV_GUS, gw, NGW); } SEAM(pb + 7); }
        if (IN(pb + 8)) for (int rep = 0; rep < REPS(pb + 8); ++rep) {
            if (l == 0) { GridSched S{G, bx, 72, 44, 32, HNp, (const char*)(ws + O_FGU), (size_t)256 * 2048 * 2, (size_t)256 * 2048 * 2};
#if defined(PROBE_ALT)
#if PROBE_ALT == 2
                if (rep == 1) { EpiSwiglu E{(bf16*)(ws + O_HIDM + (size_t)80 * 1024 * 1024), DFF}; gemm_phase<EpiSwiglu, GridSched>(lds, 2048, 2048, S, E); } else
#else
                if (rep == 1) { EpiNull E{(float*)(ws + O_HIDM)}; gemm_phase<EpiNull, GridSched>(lds, 2048, 2048, S, E); } else
#endif
#endif
                { EpiSwiglu E{(bf16*)(ws + O_HID), DFF, FFN_BLK ? 44 : 0}; gemm_phase<EpiSwiglu, GridSched>(lds, 2048, 2048, S, E); TAILCVT(72 * 44, CV_FG0, CV_FG1); } }
            else { LAS int* tbl = (LAS int*)(lds + MISC_OFF + 256); if (tid < 9) tbl[tid] = ((const int*)(ws + O_MISC + M_TOT))[16 + tid]; __syncthreads();
                MoeSched S{G, bx, 56, MOE_F8 ? 16 : 32, tbl, (const char*)(ws + O_XG), (const char*)(ws + O_MGU), (size_t)256 * 2048 * (MOE_F8 ? 1 : 2), (size_t)256 * 2048 * (MOE_F8 ? 1 : 2), (size_t)14336 * 2048 * (MOE_F8 ? 1 : 2), 1, 0};
                if (MOE_STAGGER) {
                    const unsigned long long t0 = __builtin_amdgcn_s_memrealtime(), dl = (unsigned long long)(((bx >> 3) & 3) * MOE_STAGGER);
                    while (__builtin_amdgcn_s_memrealtime() - t0 < dl) __builtin_amdgcn_s_sleep(8); }
#if defined(PROBE_MOE)
                if (rep == 1 && PROBE_MOE == 3) { EpiSwigluWrap E3{(bf16*)(ws + O_OS), DE}; gemm_phase<EpiSwigluWrap, MoeSched>(lds, 2048, 2048, S, E3); } else
                if (rep == 1) { MoeSched S2 = S; if (PROBE_MOE == 2) S2.bexp = 0; EpiNull E2{(float*)(ws + O_OS)}; gemm_phase<EpiNull, MoeSched>(lds, 2048, MOE_BLK ? 128 : 2048, S2, E2, 256, MOE_BLK ? 65536 : 256); } else
#endif
                {
#if MOE_F8
                  { EpiSwigluF8 E{ws + O_HIDM, 1.f / (X8_SC * W8_SC)}; gemm_phase<EpiSwigluF8, MoeSched, G_ALIGN, G_SP2, MOE_WNT, 1>(lds, 1024, 128, S, E, 256, 65536); }
#else
                  { EpiSwigluT<MOE_NT != 0> E{(bf16*)(ws + O_HIDM), DE, MOE_BLK ? 56 : 0}; gemm_phase<EpiSwigluT<MOE_NT != 0>, MoeSched, G_ALIGN, G_SP2, MOE_WNT>(lds, 2048, MOE_BLK ? 128 : 2048, S, E, 256, MOE_BLK ? 65536 : 256); }
#endif
                  { const int rem2 = (tbl[8] * 56) % G;
                    if (rem2 == 0 || G - rem2 < 24) { cvt_moe_range(argp, lds, CV_GUS, CV_GU1, gw, NGW); __syncthreads(); } else TAILCVT(tbl[8] * 56, CV_GUS, CV_GU1); } } }
        }
        SEAM(pb + 8);
        if (IN(pb + 9)) for (int rep = 0; rep < (l == 1 ? REPS(pb + 9) : 1); ++rep) {
            if (l == 0) { GridSched S{G, bx, 72, 8, 88, (const char*)(ws + O_HID), (const char*)(ws + O_FD), (size_t)256 * DFF * 2, (size_t)256 * DFF * 2, FFN_DOWN_REV, WGM_FD};
                EpiResid<false> E{LAT, modl, 5, nullptr, nullptr}; gemm_phase<EpiResid<false>, GridSched>(lds, FFN_BLK ? 128 : DFF, DFF, S, E, FFN_BLK ? 65536 : 256, 256); TAILCVT(72 * 8, CV_FD0, CV_FD1); }
            else { LAS int* tbl = (LAS int*)(lds + MISC_OFF + 256); if (tid < 9) tbl[tid] = ((const int*)(ws + O_MISC + M_TOT))[16 + tid]; __syncthreads();
#if MOE_TAILSPLIT
                int sp = 1; { const int U = tbl[8] * 8, R = U % G; if (R > 0) { if (R * 14 <= G) sp = 14; else if (!MOE_F8 && R * 8 <= G) sp = 8; else if (R * 7 <= G) sp = 7; else if (R * 4 <= G) sp = 4; else if (R * 2 <= G) sp = 2; } }
#if defined(FORCE_SP)
                { const int U = tbl[8] * 8, R = U % G; if (R > 0 && R * FORCE_SP <= G) sp = FORCE_SP; }
#endif
                MoeDownSched S{G, bx, sp, tbl, (const char*)(ws + O_HIDM), (const char*)(ws + O_MD), (size_t)256 * DE * (MOE_F8 ? 1 : 2), (size_t)256 * DE * (MOE_F8 ? 1 : 2), (size_t)2048 * DE * (MOE_F8 ? 1 : 2)};
                EpiMoeDown E{(bf16*)(ws + O_OS), (float*)(ws + O_XG), (unsigned*)(ws + O_CTL) + CW_MOEC, sp, MOE_F8 ? 1.f / (H8_SC * W8_SC) : 1.f};
                gemm_phase<EpiMoeDown, MoeDownSched, G_ALIGN, G_SP2, MOE_WNT, MOE_F8>(lds, MOE_BLK ? 128 : DE, MOE_BLK ? 128 : DE, S, E, MOE_BLK ? 65536 : 256, MOE_BLK ? 65536 : 256); }
#else
                MoeSched S{G, bx, 8, 112 / MOE_KSPLIT, tbl, (const char*)(ws + O_HIDM), (const char*)(ws + O_MD), (size_t)256 * DE * 2, (size_t)256 * DE * 2, (size_t)2048 * DE * 2, MOE_KSPLIT, (size_t)3584 * 2};
                EpiBf16Rows E{(bf16*)(ws + O_OS), 2048, false}; gemm_phase<EpiBf16Rows, MoeSched>(lds, DE, DE, S, E); }
#endif
        }
        SEAM(pb + 9);
        if (IN(pb + 10)) for (int rep = 0; rep < REPS(pb + 10); ++rep) {
            if (l == 0) { const int ln = opq(lane); f32x4 v[8]; int r = gw; if (r < R) norm_load(v, LAT + (size_t)r * D, ln);
                for (; r < R; r += NGW) { f32x4 vn[8]; const int rn = r + NGW; if (rn < R) norm_load(vn, LAT + (size_t)rn * D, ln);
                    norm_row<false>(v, args.in[6] + D, (const float*)(ws + O_MOD) + (size_t)9 * 12288, 0, 1, (bf16*)(ws + O_HN), r, ln, nullptr, nullptr, nullptr);
#pragma unroll
                    for (int j = 0; j < 8; ++j) v[j] = vn[j]; } }
            else { moe_combine_phase(argp, opq(gw), NGW, opq(lane)); }
        }
        if (l == 0) SEAM(pb + 11);
    #undef IN
#undef SEAM
#undef args
#undef argp
}
__global__ void __launch_bounds__(NTHREADS, 2) mega(Args args_unused) {
#define args (*kargs())
#define argp (kargs())
    extern __shared__ __attribute__((aligned(16))) unsigned char lds_raw[];
#if CODE_SHIFT >= 1
    asm volatile("s_nop 0");
#endif
#if CODE_SHIFT >= 2
    asm volatile("s_nop 0");
#endif
#if CODE_SHIFT >= 3
    asm volatile("s_nop 0");
#endif
#if CODE_SHIFT >= 4
    asm volatile("s_nop 0");
#endif
#if CODE_SHIFT >= 8
    asm volatile("s_nop 0\ns_nop 0\ns_nop 0\ns_nop 0");
#endif
    LAS unsigned char* lds = (LAS unsigned char*)lds_raw;
    volatile LAS unsigned* MISC = (volatile LAS unsigned*)(lds + MISC_OFF);
    int tid = threadIdx.x; asm volatile("" : "+v"(tid));
    const int lane = tid & 63, wave = __builtin_amdgcn_readfirstlane(tid >> 6);
    const int G = gridDim.x, bx = blockIdx.x; const int vcu = (G % 8 == 0) ? (bx % 8) * (G / 8) + bx / 8 : bx;
    const int gw = vcu * NWAVES + wave, NGW = G * NWAVES;
    unsigned char* ws = args.ws;
    for (int u = tid; u < 128; u += NTHREADS) MISC[u] = 0u;
    __syncthreads();
    const int lo = args.ph_lo, hi = args.ph_hi;
    XcdBarrier bar; bar.bar = (unsigned*)(ws + O_CTL) + CW_BAR; bar.x = 0; bar.st = nullptr;
    if (hi - lo > 1) bar = xcd_barrier_post((unsigned*)(ws + O_CTL) + CW_BAR + args.bar_region * XCD_BAR_WORDS, MISC + 8);
#define IN(k) (lo <= (k) && (k) < hi)
#define SEAM(k) do { if (IN(k) && IN((k) + 1)) { xcd_barrier(bar); if (PROBE_BAR) xcd_barrier(bar); } } while (0)
    const char* HNp = (const char*)(ws + O_HN);
    float* LAT = (float*)(ws + O_LAT);

    if (IN(0)) for (int rep = 0; rep < REPS(0); ++rep) { __syncthreads(); p0_ada(argp, lds, vcu, G); __syncthreads(); p0_convert(argp, lds, gw, NGW); __syncthreads();
        { LAS f32x2* tab = (LAS f32x2*)lds; for (int m = tid; m < 2048; m += NTHREADS) { float sn, cs; sincospif((float)m * (1.f / 1024.f), &sn, &cs); tab[m] = (f32x2){cs * 0.022097086912079608f, sn * 0.022097086912079608f}; } __syncthreads();
          p0_elementwise(argp, (size_t)vcu * NTHREADS + tid, (size_t)G * NTHREADS, tab); } }
    SEAM(0);
    if (IN(1)) {
        { const int ln = opq(lane); f32x4 v[8]; int r = gw; const float* x0 = args.in[0]; const float* c0 = args.in[2];
          if (r < R) norm_load(v, r < RL ? x0 + (size_t)r * D : c0 + (size_t)(r - RL) * D, ln);
          for (; r < R; r += NGW) { f32x4 vn[8]; const int rn = r + NGW; if (rn < R) norm_load(vn, rn < RL ? x0 + (size_t)rn * D : c0 + (size_t)(rn - RL) * D, ln);
              norm_row<false>(v, args.in[6], (const float*)(ws + O_MOD), 0, 1, (bf16*)(ws + O_HN), r, ln, nullptr, nullptr, nullptr);
#pragma unroll
              for (int j = 0; j < 8; ++j) v[j] = vn[j]; } }
        { FoldSched S{G, bx, (const char*)(ws + O_DG), (const char*)(ws + O_WUF)}; EpiFold E{(bf16*)(ws + O_WIN)}; gemm_phase<EpiFold, FoldSched>(lds, 256, 1024, S, E); }
    }
    SEAM(1);
    layer_phases<0>(lds, ws, lo, hi, bar, G, bx, vcu, gw, NGW, tid, lane, wave);
    layer_phases<1>(lds, ws, lo, hi, bar, G, bx, vcu, gw, NGW, tid, lane, wave);
#undef IN
#undef SEAM
#undef args
#undef argp
}
}
#ifndef MK_MODE
#define MK_MODE 0
#endif
extern "C" void kernel_launch(void* const* d_in, const int* in_sizes, int n_in, void* d_out, int out_size, void* d_ws, size_t ws_size, hipStream_t stream) {
    static int grid = 0;
    if (grid == 0) {
        if (n_in != 27 || out_size != fk::RL * fk::D || ws_size < fk::O_END) { fprintf(stderr, "kernel_launch: unexpected problem (n_in %d out %d ws %zu need %zu)\n", n_in, out_size, ws_size, (size_t)fk::O_END); grid = -1; return; }
        int dev = 0, cus = 0, per_cu = 0;
        if (hipGetDevice(&dev) != hipSuccess || hipDeviceGetAttribute(&cus, hipDeviceAttributeMultiprocessorCount, dev) != hipSuccess) { grid = -1; return; }
        if (hipFuncSetAttribute((const void*)fk::mega, hipFuncAttributeMaxDynamicSharedMemorySize, fk::LDS_BYTES) != hipSuccess) { fprintf(stderr, "kernel_launch: hipFuncSetAttribute failed\n"); grid = -1; return; }
        if (hipOccupancyMaxActiveBlocksPerMultiprocessor(&per_cu, (const void*)fk::mega, fk::NTHREADS, fk::LDS_BYTES) != hipSuccess || per_cu < 1) fprintf(stderr, "kernel_launch: occupancy query says %d\n", per_cu);
        (void)hipGetLastError();
        grid = cus;
    }
    if (grid < 0) return;
    (void)hipMemsetAsync((char*)d_ws + fk::O_CTL, 0, fk::CTL_ZERO_BYTES, stream);
    fk::Args a{};
    for (int i = 0; i < 27; ++i) a.in[i] = (const float*)d_in[i];
    a.out = (float*)d_out; a.ws = (unsigned char*)d_ws; a.pad = 0;
#if MK_MODE == 0
    a.ph_lo = 0; a.ph_hi = fk::NPHASE; a.bar_region = 0;
    hipLaunchKernelGGL(fk::mega, dim3(grid), dim3(fk::NTHREADS), fk::LDS_BYTES, stream, a);
#else
    for (int p = 0; p < fk::NPHASE; ++p) { a.ph_lo = p; a.ph_hi = p + 1; a.bar_region = p;
        hipLaunchKernelGGL(fk::mega, dim3(grid), dim3(fk::NTHREADS), fk::LDS_BYTES, stream, a); }
#endif
}
```

```cpp
#include <hip/hip_runtime.h>
#include <cstdio>
#include <cstdint>
namespace fk {
#define GAS __attribute__((address_space(1)))
#define LAS __attribute__((address_space(3)))
typedef unsigned short bf16;
typedef short bf16x8 __attribute__((ext_vector_type(8)));
typedef float f32x4 __attribute__((ext_vector_type(4)));
typedef float f32x2 __attribute__((ext_vector_type(2)));
typedef unsigned u32x4 __attribute__((ext_vector_type(4)));
typedef unsigned u32x2 __attribute__((ext_vector_type(2)));
#define LDS_WAIT() asm volatile("s_waitcnt lgkmcnt(0)" ::: "memory")
#define VM_WAIT() asm volatile("s_waitcnt vmcnt(0)" ::: "memory")

typedef int i32x8 __attribute__((ext_vector_type(8)));
typedef int i32x4 __attribute__((ext_vector_type(4)));
__device__ __forceinline__ unsigned cvt_fp8x4(float a, float b, float c, float d) {
    a = __builtin_amdgcn_fmed3f(a, -448.f, 448.f); b = __builtin_amdgcn_fmed3f(b, -448.f, 448.f); c = __builtin_amdgcn_fmed3f(c, -448.f, 448.f); d = __builtin_amdgcn_fmed3f(d, -448.f, 448.f);
    int r = __builtin_amdgcn_cvt_pk_fp8_f32(a, b, 0, false); r = __builtin_amdgcn_cvt_pk_fp8_f32(c, d, r, true); return (unsigned)r; }
__device__ __forceinline__ unsigned cvt_pk_bf16(float lo, float hi) { unsigned r; asm volatile("v_cvt_pk_bf16_f32 %0, %1, %2" : "=v"(r) : "v"(lo), "v"(hi)); return r; }
__device__ __forceinline__ float bf_lo(unsigned w) { return __uint_as_float(w << 16); }
__device__ __forceinline__ float bf_hi(unsigned w) { return __uint_as_float(w & 0xffff0000u); }
__device__ __forceinline__ float fexp(float x) { return __builtin_amdgcn_exp2f(x * 1.4426950408889634f); }
__device__ __forceinline__ float frcp(float x) { return __builtin_amdgcn_rcpf(x); }
__device__ __forceinline__ float fsigm(float x) { return frcp(1.f + fexp(-x)); }
__device__ __forceinline__ float fsilu(float x) { return x * frcp(1.f + fexp(-x)); }
__device__ __forceinline__ float fgelu(float x) { const float u = 1.5957691216057308f * (x + 0.044715f * x * x * x); return x * frcp(1.f + fexp(-u)); }
__device__ __forceinline__ int opq(int v) { asm volatile("" : "+v"(v)); return v; }
__device__ __forceinline__ float wave_sum(float v) {
#pragma unroll
    for (int o = 1; o < 64; o <<= 1) v += __shfl_xor(v, o);
    return v;
}

#ifndef G_WGM
#define G_WGM 4
#endif
constexpr int BM = 256, BK = 64, HALF = 128, HTB = HALF * BK * 2, STAGE_BYTES = 8 * HTB, NXCD = 8, WGM = G_WGM;
__device__ __forceinline__ int lds_byte(int r, int c) { const int st = (r >> 4) * 2 + (c >> 5), rr = r & 15, cc = c & 31, ob = rr * 64 + cc * 2; return st * 1024 + (ob ^ (((ob >> 9) & 1) << 5)); }
__device__ __forceinline__ void stage_rc(int b, int& R, int& C) { const int st = b / 1024, sb = b % 1024, swz = sb ^ (((sb >> 9) & 1) << 5); R = (st >> 1) * 16 + swz / 64; C = (st & 1) * 32 + (swz % 64) / 2; }
__device__ __forceinline__ int perm32(int rho) { const int n = rho >> 4, i = rho & 15; return 8 * (i >> 2) + 4 * n + (i & 3); }

struct Unit { const char* A; const char* B; int pm, pn, kind, nt, x; };

__device__ __forceinline__ void tile_of(int wgid, int nM, int nN, int& pm, int& pn, const int wgm = WGM) {
    const int nwg = nM * nN; { const int q = nwg / NXCD, r = nwg % NXCD, xcd = wgid % NXCD, off = wgid / NXCD; wgid = (xcd < r ? xcd * (q + 1) : r * (q + 1) + (xcd - r) * q) + off; }
    const int nig = wgm * nN, gid = wgid / nig, fm = gid * wgm, gsz = (nM - fm) < wgm ? (nM - fm) : wgm;
    pm = fm + ((wgid % nig) % gsz); pn = (wgid % nig) / gsz;
}

#ifndef G_ALIGN
#define G_ALIGN true
#endif
#ifndef G_SP2
#define G_SP2 true
#endif
template <int F8> struct pg8_frag { typedef bf16x8 T; static constexpr int NK = 2;
    static __device__ __forceinline__ T ld(const LAS unsigned char* p) { return *(const LAS bf16x8*)p; }
    static __device__ __forceinline__ T cat(i32x4 a, i32x4 b) { (void)b; return __builtin_bit_cast(bf16x8, a); }
    static __device__ __forceinline__ f32x4 mma(T b, T a, f32x4 c) { return __builtin_amdgcn_mfma_f32_16x16x32_bf16(b, a, c, 0, 0, 0); } };
template <> struct pg8_frag<1> { typedef i32x8 T; static constexpr int NK = 1;
    static __device__ __forceinline__ T ld(const LAS unsigned char* p) { return *(const LAS i32x8*)p; }
    static __device__ __forceinline__ T cat(i32x4 a, i32x4 b) { return __builtin_shufflevector(a, b, 0, 1, 2, 3, 4, 5, 6, 7); }
    static __device__ __forceinline__ f32x4 mma(T b, T a, f32x4 c) { asm volatile("v_mfma_f32_16x16x128_f8f6f4 %0, %1, %2, %0" : "+v"(c) : "v"(b), "v"(a)); return c; } };
template <class Epi, class Sched, bool ALIGN_EPI = G_ALIGN, bool SP2 = G_SP2, int BAUX = 0, int F8 = 0>
#define PG8_CAT(x, y) __builtin_shufflevector(__builtin_bit_cast(i32x4, x), __builtin_bit_cast(i32x4, y), 0, 1, 2, 3, 4, 5, 6, 7)
__device__ __forceinline__ void gemm_phase(LAS unsigned char* lds, const int lda, const int ldb, const Sched& S, const Epi& E, const size_t kpairA = 256, const size_t kpairB = 256) {
    int tid = threadIdx.x; asm volatile("" : "+v"(tid));
    const int wid = __builtin_amdgcn_readfirstlane(tid >> 6), lane = tid & 63, wr = wid >> 2, wc = wid & 3, fr = lane & 15, fq = lane >> 4;
    unsigned voffA[2], voffB[2];
#pragma unroll
    for (int i = 0; i < 2; ++i) { int R, C; stage_rc(tid * 16 + i * 8192, R, C); const int Rb = Epi::PERM ? ((R & ~31) + perm32(R & 31)) : R;
        voffA[i] = (unsigned)(R * lda + C) * 2u; voffB[i] = (unsigned)(Rb * ldb + C) * 2u; }
    const size_t kstep = (size_t)(BK * 2);
    const size_t hstepA = (size_t)HALF * lda * 2, hstepB = (size_t)HALF * ldb * 2;
    const unsigned ldsw = (unsigned)wid * 1024u;
    const int aoff = lds_byte(wr * 64 + fr, fq * 8), boff = lds_byte(wc * 32 + fr, fq * 8);
#define PG8_SA(b, h) (((b) * 2 + (h)) * HTB)
#define PG8_SB(b, h) ((4 + (b) * 2 + (h)) * HTB)
#define PG8_STAGE(bufoff, gbase, voff) do { const char* gb_ = (const char*)(gbase); asm volatile("" : "+s"(gb_)); _Pragma("unroll") for (int _i = 0; _i < 2; ++_i) { unsigned vo_ = (voff)[_i]; asm volatile("" : "+v"(vo_)); \
        __builtin_amdgcn_global_load_lds((const unsigned*)(gb_ + vo_), (LAS unsigned*)(lds + (bufoff) + ldsw + _i * 8192), 16, 0, 0); } } while (0)
#define PG8_STAGEB(bufoff, gbase, voff) do { const char* gb_ = (const char*)(gbase); asm volatile("" : "+s"(gb_)); _Pragma("unroll") for (int _i = 0; _i < 2; ++_i) { unsigned vo_ = (voff)[_i]; asm volatile("" : "+v"(vo_)); \
        __builtin_amdgcn_global_load_lds((const unsigned*)(gb_ + vo_), (LAS unsigned*)(lds + (bufoff) + ldsw + _i * 8192), 16, 0, BAUX); } } while (0)
#define PG8_LDA(dst, b, h) do { _Pragma("unroll") for (int m = 0; m < 4; ++m) { if constexpr (F8) dst[m][0] = pg8_frag<F8>::cat(*(const LAS i32x4*)(lds + PG8_SA(b, h) + aoff + m * 2048), *(const LAS i32x4*)(lds + PG8_SA(b, h) + aoff + m * 2048 + 1024)); \
        else { _Pragma("unroll") for (int k = 0; k < 2; ++k) dst[m][k] = pg8_frag<F8>::ld(lds + PG8_SA(b, h) + aoff + m * 2048 + k * 1024); } } } while (0)
#define PG8_LDB(dst, b, h) do { _Pragma("unroll") for (int n = 0; n < 2; ++n) { if constexpr (F8) dst[n][0] = pg8_frag<F8>::cat(*(const LAS i32x4*)(lds + PG8_SB(b, h) + boff + n * 2048), *(const LAS i32x4*)(lds + PG8_SB(b, h) + boff + n * 2048 + 1024)); \
        else { _Pragma("unroll") for (int k = 0; k < 2; ++k) dst[n][k] = pg8_frag<F8>::ld(lds + PG8_SB(b, h) + boff + n * 2048 + k * 1024); } } } while (0)
#ifndef G_PRIO
#define G_PRIO 1
#endif
#ifndef G_KOUT
#define G_KOUT 0
#endif
#if G_KOUT
#define PG8_MMA(ai, bj, At, Bt) do { if (G_PRIO) __builtin_amdgcn_s_setprio(G_PRIO); _Pragma("unroll") for (int k = 0; k < 2; ++k) _Pragma("unroll") for (int m = 0; m < 4; ++m) _Pragma("unroll") for (int n = 0; n < 2; ++n) \
        acc[ai][bj][m][n] = __builtin_amdgcn_mfma_f32_16x16x32_bf16(Bt[n][k], At[m][k], acc[ai][bj][m][n], 0, 0, 0); if (G_PRIO) __builtin_amdgcn_s_setprio(0); } while (0)
#else
#define PG8_MMA(ai, bj, At, Bt) do { if (G_PRIO) __builtin_amdgcn_s_setprio(G_PRIO); \
        if constexpr (F8) { _Pragma("unroll") for (int m = 0; m < 4; ++m) _Pragma("unroll") for (int n = 0; n < 2; ++n) \
            acc[ai][bj][m][n] = pg8_frag<F8>::mma(Bt[n][0], At[m][0], acc[ai][bj][m][n]); } \
        else { _Pragma("unroll") for (int m = 0; m < 4; ++m) _Pragma("unroll") for (int n = 0; n < 2; ++n) _Pragma("unroll") for (int k = 0; k < 2; ++k) \
            acc[ai][bj][m][n] = pg8_frag<F8>::mma(Bt[n][k], At[m][k], acc[ai][bj][m][n]); } if (G_PRIO) __builtin_amdgcn_s_setprio(0); } while (0)
#endif
#ifndef G_MMA2
#define G_MMA2 0
#endif
#if G_MMA2
#define PG8_MMA2(ai, At, Ba, Bb) do { __builtin_amdgcn_s_setprio(1); _Pragma("unroll") for (int m = 0; m < 4; ++m) _Pragma("unroll") for (int n = 0; n < 2; ++n) _Pragma("unroll") for (int k = 0; k < 2; ++k) \
        acc[ai][0][m][n] = __builtin_amdgcn_mfma_f32_16x16x32_bf16(Ba[n][k], At[m][k], acc[ai][0][m][n], 0, 0, 0); \
        _Pragma("unroll") for (int m = 0; m < 4; ++m) _Pragma("unroll") for (int n = 0; n < 2; ++n) _Pragma("unroll") for (int k = 0; k < 2; ++k) \
        acc[ai][1][m][n] = __builtin_amdgcn_mfma_f32_16x16x32_bf16(Bb[n][k], At[m][k], acc[ai][1][m][n], 0, 0, 0); __builtin_amdgcn_s_setprio(0); } while (0)
#else
#define PG8_MMA2(ai, At, Ba, Bb) do { PG8_MMA(ai, 0, At, Ba); PG8_MMA(ai, 1, At, Bb); } while (0)
#endif
#define PG8_WAIT_V(n) asm volatile("s_waitcnt vmcnt(" #n ")" ::: "memory")
#define PG8_WAIT_L(n) asm volatile("s_waitcnt lgkmcnt(" #n ")" ::: "memory")
#define PG8_BAR __builtin_amdgcn_s_barrier()
#define PG8_SCHED __builtin_amdgcn_sched_barrier(0)
    Unit cur, nxt; int ui = 0;
    if (!S.next(0, cur)) return;
    f32x4 acc[2][2][4][2];
#pragma unroll
    for (int a = 0; a < 2; ++a)
#pragma unroll
        for (int b = 0; b < 2; ++b)
#pragma unroll
            for (int m = 0; m < 4; ++m)
#pragma unroll
                for (int n = 0; n < 2; ++n) acc[a][b][m][n] = (f32x4){0.f, 0.f, 0.f, 0.f};
    typename pg8_frag<F8>::T At[4][pg8_frag<F8>::NK], B0[2][pg8_frag<F8>::NK], B1[2][pg8_frag<F8>::NK];
    const char* cA = cur.A; const char* cB = cur.B;
    if constexpr (SP2) {
        PG8_STAGEB(PG8_SB(0, 0), cB, voffB); PG8_STAGEB(PG8_SB(0, 1), cB + hstepB, voffB); PG8_STAGE(PG8_SA(0, 0), cA, voffA); PG8_STAGE(PG8_SA(0, 1), cA + hstepA, voffA);
        if (wr == 1) PG8_BAR;
        PG8_WAIT_V(2); PG8_BAR;
        PG8_STAGEB(PG8_SB(1, 0), cB + kstep, voffB); PG8_STAGE(PG8_SA(1, 0), cA + kstep, voffA); PG8_STAGEB(PG8_SB(1, 1), cB + hstepB + kstep, voffB);
        PG8_WAIT_V(6); PG8_BAR;
    } else {
        PG8_STAGEB(PG8_SB(0, 0), cB, voffB); PG8_STAGE(PG8_SA(0, 0), cA, voffA); PG8_STAGEB(PG8_SB(0, 1), cB + hstepB, voffB); PG8_STAGE(PG8_SA(0, 1), cA + hstepA, voffA);
        if (wr == 1) PG8_BAR;
        PG8_WAIT_V(4); PG8_BAR;
        PG8_STAGEB(PG8_SB(1, 0), cB + kstep, voffB); PG8_STAGE(PG8_SA(1, 0), cA + kstep, voffA); PG8_STAGEB(PG8_SB(1, 1), cB + hstepB + kstep, voffB);
        PG8_WAIT_V(6); PG8_BAR;
    }
    for (;;) {
        const bool has_next = S.next(ui + 1, nxt);
        const char* nA = has_next ? nxt.A : cA; const char* nB = has_next ? nxt.B : cB;
        const int nt = cur.nt;
        for (int t = 0; t < nt; t += 2) {
            const bool last = (t == nt - 2);
            const char* a1 = cA + (size_t)(t >> 1) * kpairA + kstep;
            const char* a2 = last ? nA : cA + (size_t)((t >> 1) + 1) * kpairA; const char* b2 = last ? nB : cB + (size_t)((t >> 1) + 1) * kpairB;
            const char* a3 = a2 + kstep; const char* b3 = b2 + kstep;
            if constexpr (SP2) {
            PG8_LDB(B0, 0, 0); PG8_LDB(B1, 0, 1); PG8_SCHED; PG8_LDA(At, 0, 0); PG8_STAGE(PG8_SA(1, 1), a1 + hstepA, voffA);
            PG8_WAIT_V(8); PG8_WAIT_L(0); PG8_BAR; PG8_MMA2(0, At, B0, B1); PG8_BAR; PG8_SCHED;
            PG8_LDA(At, 0, 1); PG8_STAGEB(PG8_SB(0, 0), b2, voffB); PG8_STAGEB(PG8_SB(0, 1), b2 + hstepB, voffB); PG8_STAGE(PG8_SA(0, 0), a2, voffA);
            PG8_WAIT_V(8); PG8_WAIT_L(0); PG8_BAR; PG8_MMA2(1, At, B0, B1); PG8_BAR; PG8_SCHED;
            PG8_LDB(B0, 1, 0); PG8_LDB(B1, 1, 1); PG8_SCHED; PG8_LDA(At, 1, 0); PG8_STAGE(PG8_SA(0, 1), a2 + hstepA, voffA);
            PG8_WAIT_V(8); PG8_WAIT_L(0); PG8_BAR; PG8_MMA2(0, At, B0, B1); PG8_BAR; PG8_SCHED;
            PG8_LDA(At, 1, 1); PG8_STAGEB(PG8_SB(1, 0), b3, voffB); PG8_STAGEB(PG8_SB(1, 1), b3 + hstepB, voffB); PG8_STAGE(PG8_SA(1, 0), a3, voffA);
            PG8_WAIT_V(8); PG8_WAIT_L(0); PG8_BAR; PG8_MMA2(1, At, B0, B1); PG8_BAR; PG8_SCHED;
            } else {
            PG8_LDB(B0, 0, 0); PG8_SCHED; PG8_LDA(At, 0, 0); PG8_STAGE(PG8_SA(1, 1), a1 + hstepA, voffA);
            PG8_WAIT_L(8); PG8_BAR; PG8_WAIT_L(0); PG8_MMA(0, 0, At, B0); PG8_BAR; PG8_SCHED;
            PG8_LDB(B1, 0, 1); PG8_STAGEB(PG8_SB(0, 0), b2, voffB);
            PG8_BAR; PG8_WAIT_L(0); PG8_MMA(0, 1, At, B1); PG8_BAR;
            PG8_LDA(At, 0, 1); PG8_STAGE(PG8_SA(0, 0), a2, voffA);
            PG8_BAR; PG8_WAIT_L(0); PG8_MMA(1, 0, At, B0); PG8_BAR; PG8_SCHED;
            PG8_STAGEB(PG8_SB(0, 1), b2 + hstepB, voffB);
            PG8_WAIT_V(6); PG8_BAR; PG8_MMA(1, 1, At, B1); PG8_BAR;
            PG8_LDB(B0, 1, 0); PG8_SCHED; PG8_LDA(At, 1, 0); PG8_STAGE(PG8_SA(0, 1), a2 + hstepA, voffA);
            PG8_WAIT_L(8); PG8_BAR; PG8_WAIT_L(0); PG8_MMA(0, 0, At, B0); PG8_BAR; PG8_SCHED;
            PG8_LDB(B1, 1, 1); PG8_STAGEB(PG8_SB(1, 0), b3, voffB);
            PG8_BAR; PG8_WAIT_L(0); PG8_MMA(0, 1, At, B1); PG8_BAR;
            PG8_LDA(At, 1, 1); PG8_STAGE(PG8_SA(1, 0), a3, voffA);
            PG8_BAR; PG8_WAIT_L(0); PG8_MMA(1, 0, At, B0); PG8_BAR; PG8_SCHED;
            PG8_STAGEB(PG8_SB(1, 1), b3 + hstepB, voffB);
            PG8_WAIT_V(6); PG8_BAR; PG8_MMA(1, 1, At, B1); PG8_BAR;
            }
        }
        if constexpr (ALIGN_EPI) { if (wr == 0) PG8_BAR; }
        if constexpr (F8) asm volatile("s_nop 15\n\ts_nop 7" ::: "memory");
        E(acc, cur, wr, wc, fr, fq);
        if (!has_next) break;
#pragma unroll
        for (int a = 0; a < 2; ++a)
#pragma unroll
            for (int b = 0; b < 2; ++b)
#pragma unroll
                for (int m = 0; m < 4; ++m)
#pragma unroll
                    for (int n = 0; n < 2; ++n) acc[a][b][m][n] = (f32x4){0.f, 0.f, 0.f, 0.f};
        cur = nxt; cA = nA; cB = nB; ++ui;
        if constexpr (ALIGN_EPI) { if (wr == 1) PG8_BAR; }
    }
    PG8_WAIT_V(0);
    if constexpr (!ALIGN_EPI) { if (wr == 0) PG8_BAR; }
    PG8_BAR;
#undef PG8_SA
#undef PG8_SB
#undef PG8_STAGE
#undef PG8_STAGEB
#undef PG8_LDA
#undef PG8_LDB
#undef PG8_MMA
#undef PG8_MMA2
#undef PG8_WAIT_V
#undef PG8_WAIT_L
#undef PG8_BAR
#undef PG8_SCHED
}

#define XB_TMO      128
#define XB_XCNT(j)  (256  + 64 * (j))
#define XB_XSUB(j)  (1280 + 64 * (j))
#define XB_XGEN(j)  (2304 + 64 * (j))
#define XB_TOP      3328
#define XB_TOPGEN   3392
#define XCD_BAR_WORDS 3456
#define XB_SPIN_CAP (1u << 18)
#ifndef XB_SLEEP
#define XB_SLEEP 1
#endif
__device__ __forceinline__ unsigned xb_ld(unsigned* p)              { return __hip_atomic_load(p, __ATOMIC_RELAXED, __HIP_MEMORY_SCOPE_AGENT); }
__device__ __forceinline__ unsigned xb_add(unsigned* p, unsigned v) { return __hip_atomic_fetch_add(p, v, __ATOMIC_RELAXED, __HIP_MEMORY_SCOPE_AGENT); }
__device__ __forceinline__ unsigned xb_xcc_id() { return (unsigned)__builtin_amdgcn_s_getreg((3 << 11) | 20) & 0xFu; }
#define XB_SPIN(cond, bar) do { unsigned _sp = 0; while (cond) { __builtin_amdgcn_s_sleep(XB_SLEEP); \
    if ((++_sp & 255u) == 0u) { if (xb_ld(&(bar)[XB_TMO])) break; if (_sp > XB_SPIN_CAP) { atomicAdd(&(bar)[XB_TMO], 1u); break; } } } } while (0)
struct XcdBarrier { unsigned* bar; unsigned x; volatile LAS unsigned* st; };
__device__ __forceinline__ XcdBarrier xcd_barrier_post(unsigned* bar, volatile LAS unsigned* st) {
    XcdBarrier b; b.bar = bar; b.x = xb_xcc_id(); b.st = st;
    if (threadIdx.x == 0) (void)xb_add(&bar[XB_XCNT(b.x)], 1u);
    return b;
}
__device__ __forceinline__ void xcd_barrier_complete(unsigned* bar, unsigned x, unsigned& nloc, unsigned& nx) {
    const unsigned G = gridDim.x * gridDim.y * gridDim.z;
    unsigned sum, cnt, mine, sp = 0u;
    for (;;) {
        sum = 0u; cnt = 0u; mine = 0u;
#pragma unroll
        for (unsigned j = 0; j < 16; ++j) { const unsigned c = xb_ld(&bar[XB_XCNT(j)]); sum += c; cnt += (c > 0u) ? 1u : 0u; mine = (j == x) ? c : mine; }
        if (sum == G) break;
        __builtin_amdgcn_s_sleep(1);
        if ((++sp & 255u) == 0u) { if (xb_ld(&bar[XB_TMO])) break; if (sp > XB_SPIN_CAP) { atomicAdd(&bar[XB_TMO], 1u); break; } }
    }
    nloc = mine > 0u ? mine : 1u; nx = cnt > 0u ? cnt : 1u;
}
__device__ __forceinline__ void xcd_barrier(const XcdBarrier& b) {
    asm volatile("s_waitcnt vmcnt(0)" ::: "memory");
    __syncthreads();
    if (threadIdx.x == 0) {
        unsigned* bar = b.bar;
        __builtin_amdgcn_s_waitcnt(0);
        unsigned nloc = b.st[0], nx = b.st[1];
        if (nloc == 0u) { xcd_barrier_complete(bar, b.x, nloc, nx); b.st[0] = nloc; b.st[1] = nx; }
        const unsigned old = xb_add(&bar[XB_XSUB(b.x)], 1u);
        const unsigned gen = old / nloc;
        if (old + 1u == (gen + 1u) * nloc) {
            __builtin_amdgcn_fence(__ATOMIC_RELEASE, "agent");
            asm volatile("s_waitcnt vmcnt(0)" ::: "memory");
            const unsigned og = xb_add(&bar[XB_TOP], 1u);
            const unsigned tg = og / nx;
            if (og + 1u == (tg + 1u) * nx) xb_add(&bar[XB_TOPGEN], 1u);
            else XB_SPIN(xb_ld(&bar[XB_TOPGEN]) == tg, bar);
            __builtin_amdgcn_fence(__ATOMIC_ACQUIRE, "agent");
            xb_add(&bar[XB_XGEN(b.x)], 1u);
            asm volatile("s_waitcnt vmcnt(0)" ::: "memory");
        } else {
            XB_SPIN(xb_ld(&bar[XB_XGEN(b.x)]) == gen, bar);
            __builtin_amdgcn_fence(__ATOMIC_ACQUIRE, "agent");
            asm volatile("s_waitcnt vmcnt(0)" ::: "memory");
        }
    }
    __syncthreads();
}
constexpr int D = 2048, NB = 8, L = 2048, LC = 256, RL = 16384, RC = 2048, R = 18432, NIN = 7168, GW = 64;
constexpr int DFF = 5632, NE = 8, DE = 7168, NH = 8, HD = 128, DL = 1024;
constexpr int WIN_ROWS = 7168;
constexpr int UT_LD = 36864;
constexpr int MAXSLOT = 34816;
constexpr int NCHUNK = 288;
constexpr int NWAVES = 8, NTHREADS = 512;
constexpr int LDS_BYTES = 147456;
constexpr int MISC_OFF = 140000;

constexpr size_t al256(size_t x) { return (x + 255) & ~(size_t)255; }
constexpr size_t O_CTL = 0, CTL_BYTES = 1u << 20, CTL_ZERO_BYTES = 65536;
constexpr size_t O_MOD = O_CTL + CTL_BYTES;
constexpr size_t O_MISC = O_MOD + al256((size_t)2 * 9 * 12288 * 4);
constexpr size_t O_LAT = O_MISC + (1u << 20);
constexpr size_t O_HN = O_LAT + (size_t)R * D * 4;
constexpr size_t O_WIN = O_HN + (size_t)R * D * 2;
constexpr size_t O_WFO = O_WIN + (size_t)2 * 8192 * 2048 * 2;
constexpr size_t O_WRO = O_WFO + (size_t)2 * 2048 * 1024 * 2;
constexpr size_t O_WO = O_WRO + (size_t)2 * 2048 * 1024 * 2;
constexpr size_t O_WAX = O_WO + (size_t)2 * 2048 * 2048 * 2;
constexpr size_t O_WUF = O_WAX + (size_t)2 * 2 * 2 * 8 * 128 * 128 * 2;
constexpr size_t O_DG = O_WUF + (size_t)2 * 2048 * 1024 * 2;
constexpr size_t O_FL = O_DG + (size_t)512 * 256 * 2;
constexpr size_t O_FLC = O_FL + (size_t)2048 * 4096 * 2;
constexpr size_t O_FGU = O_FLC + (size_t)256 * 4096 * 2;
constexpr size_t O_FD = O_FGU + (size_t)11264 * 2048 * 2;
constexpr size_t O_MGU = O_FD + (size_t)2048 * 5632 * 2;
constexpr size_t O_MD = O_MGU + (size_t)8 * 14336 * 2048 * 2;
constexpr size_t O_SCR = O_MD + (size_t)8 * 2048 * 7168 * 2;
constexpr size_t O_UT = O_SCR;
constexpr size_t O_UR = O_UT + (size_t)1024 * UT_LD * 2;
constexpr size_t O_GG = O_UR + (size_t)R * 1024 * 2;
constexpr size_t O_SGF = O_GG + (size_t)R * 1024 * 2;
constexpr size_t O_SGR = O_SGF + (size_t)R * 2048 * 2;
constexpr size_t O_Y = O_SGR + (size_t)R * 2048 * 2;
constexpr size_t O_T1 = O_Y + (size_t)R * 1024 * 2;
constexpr size_t O_HR = O_T1 + (size_t)R * 2048 * 2;
constexpr size_t O_MG = O_HR + (size_t)R * 1024 * 2;
constexpr size_t O_TOT = O_MG + (size_t)R * 2048 * 2;
constexpr size_t O_CAR = O_TOT + (size_t)NCHUNK * 2 * 1024 * 8;
constexpr size_t O_ZT = O_CAR + (size_t)NCHUNK * 2 * 1024 * 4;
constexpr size_t O_VV = O_ZT + (size_t)1024 * UT_LD * 2;
constexpr size_t O_MIXEND = O_VV + (size_t)R * 1024 * 2;
constexpr size_t O_HID = O_SCR;
constexpr size_t O_XG = O_SCR;
constexpr size_t O_HIDM = O_XG + (size_t)MAXSLOT * 2048 * 2;
constexpr size_t O_OS = O_HIDM + (size_t)MAXSLOT * 7168 * 2;
constexpr size_t O_END = O_OS + (size_t)2 * MAXSLOT * 2048 * 2;
static_assert(O_MIXEND <= O_END && O_HID + (size_t)R * DFF * 2 <= O_END, "scratch overlay");
static_assert(O_END <= (size_t)2085 * 1000 * 1000, "workspace budget");
constexpr size_t M_SEL = 0;
constexpr size_t M_GWT = 131072;
constexpr size_t M_SLOT = 262144;
constexpr size_t M_CNTB = 393216;
constexpr size_t M_TOT = 401408;
constexpr int CW_BAR = 4096, CW_MOEC = 8192;

struct Args { const float* in[27]; float* out; unsigned char* ws; int ph_lo, ph_hi, bar_region, pad; };
typedef const __attribute__((address_space(4))) Args* AP;
__device__ __forceinline__ AP kargs() { AP p = (AP)__builtin_amdgcn_kernarg_segment_ptr(); asm volatile("" : "+s"(p)); return p; }

__device__ __forceinline__ void p0_ada(AP a, LAS unsigned char* lds, int vcu, int G) {
    const int tid = threadIdx.x, lane = tid & 63, w = tid >> 6;
    LAS float* sc = (LAS float*)lds;
    LAS float* red = (LAS float*)(lds + 73728);
    const float* c = a->in[1]; const float* c_ctx = a->in[3];
    for (int i = tid; i < 9 * 2048; i += NTHREADS) { const int r = i >> 11, k = i & 2047; const float v = r < 8 ? c[r * 2048 + k] : c_ctx[k]; sc[i] = v / (1.f + expf(-v)); }
    __syncthreads();
    float* MOD = (float*)(a->ws + O_MOD);
    for (int item = vcu; item < 256; item += G) {
        const int l = item >> 7, cg = item & 127, col = cg * 96 + (lane < 48 ? lane : 0) * 2;
        const float* W = a->in[4] + (size_t)l * 2048 * 12288 + col;
        float acc[9][2];
#pragma unroll
        for (int r = 0; r < 9; ++r) { acc[r][0] = 0.f; acc[r][1] = 0.f; }
#pragma unroll 8
        for (int k = w * 256; k < w * 256 + 256; ++k) {
            const f32x2 wv = *(const f32x2*)(W + (size_t)k * 12288);
#pragma unroll
            for (int r = 0; r < 9; ++r) { const float s = sc[r * 2048 + k]; acc[r][0] = fmaf(s, wv.x, acc[r][0]); acc[r][1] = fmaf(s, wv.y, acc[r][1]); }
        }
#pragma unroll
        for (int r = 0; r < 9; ++r) if (lane < 48) { red[(w * 9 + r) * 128 + lane * 2] = acc[r][0]; red[(w * 9 + r) * 128 + lane * 2 + 1] = acc[r][1]; }
        __syncthreads();
        for (int i = tid; i < 9 * 128; i += NTHREADS) { const int r = i >> 7, cc = i & 127; if (cc >= 96) continue; float s = a->in[5][(size_t)l * 12288 + cg * 96 + cc];
#pragma unroll
            for (int ww = 0; ww < 8; ++ww) s += red[(ww * 9 + r) * 128 + cc];
            MOD[((size_t)l * 9 + r) * 12288 + cg * 96 + cc] = s; }
        __syncthreads();
    }
}

#ifndef SCAN_VV
#define SCAN_VV 1
#endif
#ifndef DFT2
#define DFT2 1
#endif
#ifndef MOE_BLK
#define MOE_BLK 1
#endif
#ifndef CVT_NT
#define CVT_NT 0
#endif
#ifndef FFN_F8
#define FFN_F8 1
#endif
#ifndef MOE_F8
#define MOE_F8 1
#endif
#define W8_SC 256.f
#define X8_SC 16.f
#define H8_SC 4.f
#if CVT_NT
#define CVT_LOAD(p) __builtin_nontemporal_load(p)
#define CVT_STORE(v, p) __builtin_nontemporal_store(v, p)
#else
#define CVT_LOAD(p) (*(p))
#define CVT_STORE(v, p) (*(p) = (v))
#endif
template <int F8 = 0>
__device__ __forceinline__ void cvt_item(const float* src, int ldsrc, bf16* dst, int dpitch, int k0, int n0, int drow0, LAS float* scr, int lane, const int npairs = 0) {
    const float* s = src + (size_t)(k0 + (lane >> 4)) * ldsrc + n0 + (lane & 15) * 4;
    f32x4 v[16];
#pragma unroll
    for (int i = 0; i < 16; ++i) v[i] = CVT_LOAD((const f32x4*)(s + (size_t)(4 * i) * ldsrc));
#pragma unroll
    for (int i = 0; i < 16; ++i) { LAS float* q = scr + (4 * i + (lane >> 4)) * 65 + (lane & 15) * 4; q[0] = v[i].x; q[1] = v[i].y; q[2] = v[i].z; q[3] = v[i].w; }
    LDS_WAIT(); asm volatile("" ::: "memory");
    const int c = lane & 7;
#pragma unroll
    for (int jj = 0; jj < 8; ++jj) { const int n = (lane >> 3) + 8 * jj; const LAS float* q = scr + (8 * c) * 65 + n;
        if constexpr (F8) { u32x2 o8; o8.x = cvt_fp8x4(q[0 * 65] * W8_SC, q[1 * 65] * W8_SC, q[2 * 65] * W8_SC, q[3 * 65] * W8_SC); o8.y = cvt_fp8x4(q[4 * 65] * W8_SC, q[5 * 65] * W8_SC, q[6 * 65] * W8_SC, q[7 * 65] * W8_SC);
            const int dr8 = drow0 + n; unsigned char* dp8 = npairs ? (unsigned char*)dst + ((size_t)(dr8 >> 8) * npairs + (k0 >> 8)) * 65536 + (size_t)(dr8 & 255) * 256 + (k0 & 255) + 8 * c
                                                                     : (unsigned char*)dst + (size_t)dr8 * dpitch + k0 + 8 * c;
            *(u32x2*)dp8 = o8; continue; }
        u32x4 o; o.x = cvt_pk_bf16(q[0 * 65], q[1 * 65]); o.y = cvt_pk_bf16(q[2 * 65], q[3 * 65]); o.z = cvt_pk_bf16(q[4 * 65], q[5 * 65]); o.w = cvt_pk_bf16(q[6 * 65], q[7 * 65]);
        const int dr = drow0 + n; bf16* dp = npairs ? dst + ((size_t)(dr >> 8) * npairs + (k0 >> 7)) * 32768 + (size_t)(dr & 255) * 128 + (k0 & 127) + 8 * c : dst + (size_t)dr * dpitch + k0 + 8 * c;
        CVT_STORE(o, (u32x4*)dp); }
    LDS_WAIT(); asm volatile("" ::: "memory");
}
constexpr int I_WIN = 32 * 96, I_FO = 16 * 32, I_O = 32 * 32, I_AX = 4, I_FG = 32 * 88, I_FD = 88 * 32, I_MG = 32 * 112, I_MD = 112 * 32;
constexpr int N_WIN = 2 * I_WIN, N_FO = 2 * I_FO, N_RO = N_FO, N_O = 2 * I_O, N_AX = 64 * I_AX, N_FG = I_FG, N_FU = I_FG, N_FD = I_FD, N_MG = 8 * I_MG, N_MU = N_MG, N_MD = 8 * I_MD;
constexpr int N_NONMOE = N_WIN + N_FO + N_RO + N_O + N_AX + N_FG + N_FU + N_FD, N_MOE = N_MG + N_MU + N_MD;
__device__ __forceinline__ void p0_convert(AP a, LAS unsigned char* lds, int gw, int NGW) {
    const int lane = threadIdx.x & 63, w = threadIdx.x >> 6;
    LAS float* scr = (LAS float*)(lds + w * 16640);
    unsigned char* ws = a->ws;
    for (int it = gw; it < N_NONMOE; it += NGW) {
        int r = it;
        if (r < N_WIN) { const int l = r / I_WIN, q = r % I_WIN, kb = q / 96, nb = q % 96;
            cvt_item(a->in[8] + (size_t)l * 2048 * NIN, NIN, (bf16*)(ws + O_WIN) + (size_t)l * WIN_ROWS * 2048, 2048, kb * 64, 1024 + nb * 64, 1024 + nb * 64, scr, lane); continue; } r -= N_WIN;
        if (r < N_FO) { const int l = r / I_FO, q = r % I_FO, kb = q / 32, nb = q % 32;
            cvt_item(a->in[16] + (size_t)l * 1024 * 2048, 2048, (bf16*)(ws + O_WFO) + (size_t)l * 2048 * 1024, 1024, kb * 64, nb * 64, nb * 64, scr, lane); continue; } r -= N_FO;
        if (r < N_RO) { const int l = r / I_FO, q = r % I_FO, kb = q / 32, nb = q % 32;
            cvt_item(a->in[17] + (size_t)l * 1024 * 2048, 2048, (bf16*)(ws + O_WRO) + (size_t)l * 2048 * 1024, 1024, kb * 64, nb * 64, nb * 64, scr, lane); continue; } r -= N_RO;
        if (r < N_O) { const int l = r / I_O, q = r % I_O, kb = q / 32, nb = q % 32;
            cvt_item(a->in[18] + (size_t)l * 2048 * 2048, 2048, (bf16*)(ws + O_WO) + (size_t)l * 2048 * 2048, 2048, kb * 64, nb * 64, nb * 64, scr, lane); continue; } r -= N_O;
        if (r < N_AX) { const int m = r / I_AX, q = r % I_AX, kb = q / 2, nb = q % 2;
            const int h = m & 7, gate = (m >> 3) & 1, ld = m >> 4;
            const float* src = (gate ? a->in[13] : a->in[11]) + ((size_t)ld * 8 + h) * 128 * 128;
            cvt_item(src, 128, (bf16*)(ws + O_WAX) + (size_t)m * 128 * 128, 128, kb * 64, nb * 64, nb * 64, scr, lane); continue; } r -= N_AX;
        if (r < N_FG) { const int kb = r / 88, nb = r % 88, n = nb * 64;
            if (FFN_F8) cvt_item<1>(a->in[19], DFF, (bf16*)(ws + O_FGU), 2048, kb * 64, n, (n >> 7) * 256 + (n & 127), scr, lane); else
            cvt_item(a->in[19], DFF, (bf16*)(ws + O_FGU), 2048, kb * 64, n, (n >> 7) * 256 + (n & 127), scr, lane); continue; } r -= N_FG;
        if (r < N_FU) { const int kb = r / 88, nb = r % 88, n = nb * 64;
            if (FFN_F8) cvt_item<1>(a->in[20], DFF, (bf16*)(ws + O_FGU), 2048, kb * 64, n, (n >> 7) * 256 + 128 + (n & 127), scr, lane); else
            cvt_item(a->in[20], DFF, (bf16*)(ws + O_FGU), 2048, kb * 64, n, (n >> 7) * 256 + 128 + (n & 127), scr, lane); continue; } r -= N_FU;
        { const int kb = r / 32, nb = r % 32;
            if (FFN_F8) cvt_item<1>(a->in[21], 2048, (bf16*)(ws + O_FD), DFF, kb * 64, nb * 64, nb * 64, scr, lane); else
            cvt_item(a->in[21], 2048, (bf16*)(ws + O_FD), DFF, kb * 64, nb * 64, nb * 64, scr, lane); }
    }
}
__device__ __forceinline__ void cvt_moe_range(AP a, LAS unsigned char* lds, int lo, int hi, int rank, int nrank) {
    const int lane = threadIdx.x & 63, w = threadIdx.x >> 6;
    LAS float* scr = (LAS float*)(lds + w * 16640);
    unsigned char* ws = a->ws;
    for (int it = lo + rank; it < hi; it += nrank) {
        int r = it;
        if (r < N_MG) { const int e = r / I_MG, q = r % I_MG, kb = q / 112, nb = q % 112, n = nb * 64;
            if (MOE_F8) cvt_item<1>(a->in[23] + (size_t)e * 2048 * DE, DE, (bf16*)(ws + O_MGU + (size_t)e * 14336 * 2048), 2048, kb * 64, n, (n >> 7) * 256 + (n & 127), scr, lane, 8); else
            cvt_item(a->in[23] + (size_t)e * 2048 * DE, DE, (bf16*)(ws + O_MGU) + (size_t)e * 14336 * 2048, 2048, kb * 64, n, (n >> 7) * 256 + (n & 127), scr, lane, MOE_BLK ? 16 : 0); continue; } r -= N_MG;
        if (r < N_MU) { const int e = r / I_MG, q = r % I_MG, kb = q / 112, nb = q % 112, n = nb * 64;
            if (MOE_F8) cvt_item<1>(a->in[24] + (size_t)e * 2048 * DE, DE, (bf16*)(ws + O_MGU + (size_t)e * 14336 * 2048), 2048, kb * 64, n, (n >> 7) * 256 + 128 + (n & 127), scr, lane, 8); else
            cvt_item(a->in[24] + (size_t)e * 2048 * DE, DE, (bf16*)(ws + O_MGU) + (size_t)e * 14336 * 2048, 2048, kb * 64, n, (n >> 7) * 256 + 128 + (n & 127), scr, lane, MOE_BLK ? 16 : 0); continue; } r -= N_MU;
        { const int e = r / I_MD, q = r % I_MD, kb = q / 32, nb = q % 32;
            if (MOE_F8) cvt_item<1>(a->in[25] + (size_t)e * DE * 2048, 2048, (bf16*)(ws + O_MD + (size_t)e * 2048 * DE), DE, kb * 64, nb * 64, nb * 64, scr, lane, 28); else
            cvt_item(a->in[25] + (size_t)e * DE * 2048, 2048, (bf16*)(ws + O_MD) + (size_t)e * 2048 * DE, DE, kb * 64, nb * 64, nb * 64, scr, lane, MOE_BLK ? 56 : 0); }
    }
}
__device__ __forceinline__ void p0_elementwise(AP a, size_t gt, size_t NGT, const LAS f32x2* tab) {
    unsigned char* ws = a->ws;
    for (size_t i = gt; i < (size_t)2 * 2048 * 128; i += NGT) { const int l = (int)(i / (2048 * 128)), d = (int)((i / 128) % 2048), j8 = (int)(i % 128) * 8;
        const float* s = a->in[8] + ((size_t)l * 2048 + d) * NIN + j8; const f32x4 v0 = *(const f32x4*)s, v1 = *(const f32x4*)(s + 4);
        u32x4 o; o.x = cvt_pk_bf16(v0.x, v0.y); o.y = cvt_pk_bf16(v0.z, v0.w); o.z = cvt_pk_bf16(v1.x, v1.y); o.w = cvt_pk_bf16(v1.z, v1.w);
        *(u32x4*)((bf16*)(ws + O_WUF) + ((size_t)l * 2048 + d) * 1024 + j8) = o; }
#if DFT2
    for (size_t i = gt; i < (size_t)256 * 64; i += NGT) { const int k = (int)(i / 64), j8 = (int)(i % 64) * 8; float v[8];
#pragma unroll
        for (int e = 0; e < 8; ++e) { const int j = j8 + e, t = j & 255; const int m = (k * t) & 255; float sn, cs; sincospif((float)m * (1.f / 128.f), &sn, &cs); v[e] = (j < 256 ? cs : sn) * 0.022097086912079608f; }
        u32x4 o; o.x = cvt_pk_bf16(v[0], v[1]); o.y = cvt_pk_bf16(v[2], v[3]); o.z = cvt_pk_bf16(v[4], v[5]); o.w = cvt_pk_bf16(v[6], v[7]);
        *(u32x4*)((bf16*)(ws + O_FL) + (size_t)k * 4096 + j8) = o; }
    (void)tab;
#else
    for (size_t i = gt; i < (size_t)2048 * 512; i += NGT) { const int k = (int)(i / 512), j8 = (int)(i % 512) * 8; float v[8];
#pragma unroll
        for (int e = 0; e < 8; ++e) { const int j = j8 + e, t = j & 2047; const int m = (k * t) & 2047; const f32x2 cs = tab[m]; v[e] = (j < 2048 ? cs.x : -cs.y); }
        u32x4 o; o.x = cvt_pk_bf16(v[0], v[1]); o.y = cvt_pk_bf16(v[2], v[3]); o.z = cvt_pk_bf16(v[4], v[5]); o.w = cvt_pk_bf16(v[6], v[7]);
        *(u32x4*)((bf16*)(ws + O_FL) + (size_t)k * 4096 + j8) = o; }
#endif
    for (size_t i = gt; i < (size_t)256 * 64; i += NGT) { const int k = (int)(i / 64), j8 = (int)(i % 64) * 8; float v[8];
#pragma unroll
        for (int e = 0; e < 8; ++e) { const int j = j8 + e, t = j & 255; const int m = (k * t) & 255; float s, c; sincospif((float)m * (1.f / 128.f), &s, &c); v[e] = (j < 256 ? c : -s) * 0.0625f; }
        u32x4 o; o.x = cvt_pk_bf16(v[0], v[1]); o.y = cvt_pk_bf16(v[2], v[3]); o.z = cvt_pk_bf16(v[4], v[5]); o.w = cvt_pk_bf16(v[6], v[7]);
        *(u32x4*)((bf16*)(ws + O_FLC) + (size_t)k * 4096 + j8) = o; }
    for (size_t i = gt; i < (size_t)256 * 32; i += NGT) { const int row = (int)(i / 32), j8 = (int)(i % 32) * 8, s_ = row > 128 ? 1 : 0, c_ = s_ ? row - 128 : row; float v[8];
#pragma unroll
        for (int e = 0; e < 8; ++e) { const int m = (c_ * (j8 + e)) & 255; float s, c; sincospif((float)m * (1.f / 128.f), &s, &c); v[e] = (s_ ? s : c) * 0.0625f; }
        u32x4 o; o.x = cvt_pk_bf16(v[0], v[1]); o.y = cvt_pk_bf16(v[2], v[3]); o.z = cvt_pk_bf16(v[4], v[5]); o.w = cvt_pk_bf16(v[6], v[7]);
        *(u32x4*)((bf16*)(ws + O_DG) + (size_t)row * 256 + j8) = o; }
}

__device__ __forceinline__ int mod_row(int r) { return r < RL ? (r >> 11) : 8; }
__device__ __forceinline__ void norm_load(f32x4 (&v)[8], const float* src, int lane) {
#pragma unroll
    for (int j = 0; j < 8; ++j) v[j] = ((const f32x4*)src)[lane + 64 * j];
}
template <bool ROUTER, int F8OUT = 0>
__device__ __forceinline__ int norm_row(const f32x4 (&v)[8], const float* g, const float* modl, int shift_chunk, int scale_chunk, bf16* dst, int row, int lane,
                                         const LAS float* rt, int* sel, float* gwt) {
    int picked = 0;
    float s = 0.f;
#pragma unroll
    for (int j = 0; j < 8; ++j) s += (v[j].x * v[j].x + v[j].y * v[j].y) + (v[j].z * v[j].z + v[j].w * v[j].w);
    const float rstd = rsqrtf(wave_sum(s) * (1.f / D) + 1e-6f);
    const float* mr = modl + (size_t)mod_row(row) * 12288;
    float lg[8];
    if (ROUTER) {
#pragma unroll
        for (int e = 0; e < 8; ++e) lg[e] = 0.f; }
#pragma unroll
    for (int j = 0; j < 8; ++j) {
        const int c = (lane + 64 * j) * 4;
        const f32x4 gg = *(const f32x4*)(g + c), sh = *(const f32x4*)(mr + shift_chunk * D + c), sc = *(const f32x4*)(mr + scale_chunk * D + c);
        f32x4 o = v[j] * rstd * gg; o = o * (sc + 1.f) + sh;
        if constexpr (F8OUT) *(unsigned*)((unsigned char*)dst + (size_t)row * D + c) = cvt_fp8x4(o.x * X8_SC, o.y * X8_SC, o.z * X8_SC, o.w * X8_SC);
        else { u32x2 w; w.x = cvt_pk_bf16(o.x, o.y); w.y = cvt_pk_bf16(o.z, o.w);
        *(u32x2*)(dst + (size_t)row * D + c) = w; }
        if (ROUTER) {
#pragma unroll
            for (int q = 0; q < 4; ++q) { const f32x4 r0 = *(const LAS f32x4*)(rt + (c + q) * 8), r1 = *(const LAS f32x4*)(rt + (c + q) * 8 + 4); const float x = o[q];
                lg[0] = fmaf(x, r0.x, lg[0]); lg[1] = fmaf(x, r0.y, lg[1]); lg[2] = fmaf(x, r0.z, lg[2]); lg[3] = fmaf(x, r0.w, lg[3]);
                lg[4] = fmaf(x, r1.x, lg[4]); lg[5] = fmaf(x, r1.y, lg[5]); lg[6] = fmaf(x, r1.z, lg[6]); lg[7] = fmaf(x, r1.w, lg[7]); } }
    }
    if (ROUTER) {
#pragma unroll
        for (int e = 0; e < 8; ++e) lg[e] = wave_sum(lg[e]);
        if (lane == 0) {
            int i1 = 0; float v1 = lg[0];
#pragma unroll
            for (int e = 1; e < 8; ++e) if (lg[e] > v1) { v1 = lg[e]; i1 = e; }
            int i2 = -1; float v2 = -3.0e38f;
#pragma unroll
            for (int e = 0; e < 8; ++e) if (e != i1 && lg[e] > v2) { v2 = lg[e]; i2 = e; }
            const float w1 = 1.f / (1.f + expf(v2 - v1));
            sel[row * 2] = i1; sel[row * 2 + 1] = i2; gwt[row * 2] = w1; gwt[row * 2 + 1] = 1.f - w1; picked = i1 | (i2 << 8);
        }
    }
    return picked;
}

__device__ __forceinline__ float one_minus_exp(float x, float a2) {
    const float t = -x; return t < 0.0625f ? t * (1.f - t * (0.5f - t * (0.16666667f - t * (0.041666668f - t * 0.0083333338f)))) : 1.f - a2; }
template <int PASS>
__device__ __forceinline__ void scan_unit(AP a, LAS unsigned char* lds, int l, int q, int h) {
    int tid = threadIdx.x; asm volatile("" : "+v"(tid));
    const int lane = tid & 63, w = __builtin_amdgcn_readfirstlane(tid >> 6), fr = lane & 15, fq = lane >> 4;
    LAS float* VS = (LAS float*)lds; LAS bf16* V16 = (LAS bf16*)(lds + 33792); LAS float* AS = (LAS float*)(lds + 51200); LAS float* BS = (LAS float*)(lds + 84992); LAS float* SEG = (LAS float*)(lds + 118784);
    unsigned char* ws = a->ws;
    const bool isctx = q >= 256;
    const int row0 = isctx ? RL + (q - 256) * 64 : q * 64;
    const int cpos0 = isctx ? ((q - 256) & 3) * 64 : 0;
    const int seglen = isctx ? LC : GW;
    const int t = tid >> 3, c16 = (tid & 7) * 16;
    {
        const bf16* UR = (const bf16*)(ws + O_UR);
        const float* cw = a->in[9] + (size_t)l * 4 * DL + h * HD + c16; const float* cb = a->in[10] + (size_t)l * DL + h * HD + c16;
        float v[16];
#pragma unroll
        for (int i = 0; i < 16; i += 4) { const f32x4 b4 = *(const f32x4*)(cb + i); v[i] = b4.x; v[i + 1] = b4.y; v[i + 2] = b4.z; v[i + 3] = b4.w; }
#pragma unroll
        for (int k = 0; k < 4; ++k) { const int p = cpos0 + t + k - 2;
            if (p >= 0 && p < seglen) { const bf16* src = UR + (size_t)(row0 + t + k - 2) * 1024 + h * HD + c16; const u32x4 u0 = *(const u32x4*)src, u1 = *(const u32x4*)(src + 8);
                const unsigned uu[8] = {u0.x, u0.y, u0.z, u0.w, u1.x, u1.y, u1.z, u1.w};
#pragma unroll
                for (int i = 0; i < 8; ++i) { const f32x2 wv = *(const f32x2*)(cw + (size_t)k * DL + 2 * i); v[2 * i] = fmaf(wv.x, bf_lo(uu[i]), v[2 * i]); v[2 * i + 1] = fmaf(wv.y, bf_hi(uu[i]), v[2 * i + 1]); } } }
#pragma unroll
        for (int i = 0; i < 16; i += 4) *(LAS f32x4*)(VS + t * 132 + c16 + i) = (f32x4){v[i], v[i + 1], v[i + 2], v[i + 3]};
        u32x4 o0, o1; o0.x = cvt_pk_bf16(v[0], v[1]); o0.y = cvt_pk_bf16(v[2], v[3]); o0.z = cvt_pk_bf16(v[4], v[5]); o0.w = cvt_pk_bf16(v[6], v[7]);
        o1.x = cvt_pk_bf16(v[8], v[9]); o1.y = cvt_pk_bf16(v[10], v[11]); o1.z = cvt_pk_bf16(v[12], v[13]); o1.w = cvt_pk_bf16(v[14], v[15]);
        *(LAS u32x4*)(V16 + t * 136 + c16) = o0; *(LAS u32x4*)(V16 + t * 136 + c16 + 8) = o1;
    }
    __syncthreads();
    float hsum[16];
#pragma unroll
    for (int i = 0; i < 16; ++i) hsum[i] = 0.f;
    const int ch = 16 * w + fr;
#pragma unroll 1
    for (int dir = 0; dir < 2; ++dir) {
        f32x4 acc[2][4];
#pragma unroll
        for (int g = 0; g < 2; ++g)
#pragma unroll
            for (int m = 0; m < 4; ++m) acc[g][m] = (f32x4){0.f, 0.f, 0.f, 0.f};
        const bf16* WT = (const bf16*)(ws + O_WAX) + ((size_t)((l * 2 + dir) * 2) * 8 + h) * 128 * 128;
#pragma unroll
        for (int ks = 0; ks < 4; ++ks) {
            const bf16x8 b0 = *(const bf16x8*)(WT + (size_t)ch * 128 + ks * 32 + fq * 8), b1 = *(const bf16x8*)(WT + (size_t)8 * 128 * 128 + (size_t)ch * 128 + ks * 32 + fq * 8);
#pragma unroll
            for (int m = 0; m < 4; ++m) { const bf16x8 af = *(const LAS bf16x8*)(V16 + (16 * m + fr) * 136 + ks * 32 + fq * 8);
                acc[0][m] = __builtin_amdgcn_mfma_f32_16x16x32_bf16(af, b0, acc[0][m], 0, 0, 0); acc[1][m] = __builtin_amdgcn_mfma_f32_16x16x32_bf16(af, b1, acc[1][m], 0, 0, 0); }
        }
        {
            const int gch = h * HD + ch;
            const float bia = a->in[12][(size_t)(l * 2 + dir) * DL + gch], bix = a->in[14][(size_t)(l * 2 + dir) * DL + gch], lm = a->in[15][(size_t)(l * 2 + dir) * DL + gch];
            const float sp8 = 8.f * log1pf(expf(-lm));
#pragma unroll
            for (int m = 0; m < 4; ++m)
#pragma unroll
                for (int j = 0; j < 4; ++j) { const int tok = 16 * m + 4 * fq + j;
                    const float rr = fsigm(acc[0][m][j] + bia), ii = fsigm(acc[1][m][j] + bix), vv = VS[tok * 132 + ch];
                    const float la = -sp8 * rr, av = fexp(la), a2 = av * av;
                    AS[tok * 132 + ch] = av; BS[tok * 132 + ch] = sqrtf(one_minus_exp(2.f * la, a2)) * (ii * vv); }
        }
        __syncthreads();
        {
            const int sg = tid >> 7, sc = tid & 127;
            float av[16], bv[16];
#pragma unroll
            for (int i = 0; i < 16; ++i) { const int tok = dir ? 63 - (16 * sg + i) : 16 * sg + i; av[i] = AS[tok * 132 + sc]; bv[i] = BS[tok * 132 + sc]; }
            float P = 1.f, hl = 0.f;
#pragma unroll
            for (int i = 0; i < 16; ++i) { hl = fmaf(av[i], hl, bv[i]); P *= av[i]; }
            SEG[(sg * 128 + sc) * 2] = P; SEG[(sg * 128 + sc) * 2 + 1] = hl;
            __syncthreads();
            if (PASS == 1) {
                if (sg == 0) { float A = 1.f, B = 0.f;
#pragma unroll
                    for (int s2 = 0; s2 < 4; ++s2) { const float p2 = SEG[(s2 * 128 + sc) * 2], h2 = SEG[(s2 * 128 + sc) * 2 + 1]; B = fmaf(p2, B, h2); A *= p2; }
                    *(f32x2*)((float*)(ws + O_TOT) + (((size_t)q * 2 + dir) * 1024 + h * HD + sc) * 2) = (f32x2){A, B}; }
            } else {
                float hc = ((const float*)(ws + O_CAR))[((size_t)q * 2 + dir) * 1024 + h * HD + sc];
#pragma unroll
                for (int s2 = 0; s2 < 3; ++s2) if (s2 < sg) { const float p2 = SEG[(s2 * 128 + sc) * 2], h2 = SEG[(s2 * 128 + sc) * 2 + 1]; hc = fmaf(p2, hc, h2); }
#pragma unroll
                for (int i = 0; i < 16; ++i) { const int tok = dir ? 63 - (16 * sg + i) : 16 * sg + i; hc = fmaf(av[i], hc, bv[i]); BS[tok * 132 + sc] = hc; }
            }
        }
        __syncthreads();
        if (PASS == 2) {
#pragma unroll
            for (int i = 0; i < 16; i += 4) { const f32x4 x = *(const LAS f32x4*)(BS + t * 132 + c16 + i); hsum[i] += x.x; hsum[i + 1] += x.y; hsum[i + 2] += x.z; hsum[i + 3] += x.w; }
            __syncthreads();
        }
    }
    if (PASS == 2) {
        const bf16* GGp = (const bf16*)(ws + O_GG) + (size_t)(row0 + t) * 1024 + h * HD + c16; const u32x4 g0 = *(const u32x4*)GGp, g1 = *(const u32x4*)(GGp + 8);
        const unsigned gu[8] = {g0.x, g0.y, g0.z, g0.w, g1.x, g1.y, g1.z, g1.w}; unsigned o[8];
#pragma unroll
        for (int i = 0; i < 8; ++i) o[i] = cvt_pk_bf16(hsum[2 * i] * bf_lo(gu[i]), hsum[2 * i + 1] * bf_hi(gu[i]));
        bf16* dst = (bf16*)(ws + O_HR) + (size_t)(row0 + t) * 1024 + h * HD + c16;
        *(u32x4*)dst = (u32x4){o[0], o[1], o[2], o[3]}; *(u32x4*)(dst + 8) = (u32x4){o[4], o[5], o[6], o[7]};
    }
}
template <int PASS>
__device__ __forceinline__ void scan_phase(AP a, LAS unsigned char* lds, const int l, const int nunits, const int vcu, const int G) {
    int tid0 = threadIdx.x; asm volatile("" : "+v"(tid0));
    const int w = __builtin_amdgcn_readfirstlane(tid0 >> 6);
    LAS float* VS = (LAS float*)lds; LAS bf16* V16 = (LAS bf16*)(lds + 33792); LAS float* AS = (LAS float*)(lds + 51200); LAS float* BS = (LAS float*)(lds + 84992); LAS float* SEG = (LAS float*)(lds + 118784);
    LAS float* CW = (LAS float*)(lds + 122880); LAS float* CB = (LAS float*)(lds + 124928);
    unsigned char* ws = a->ws;
    const bf16* UR = (const bf16*)(ws + O_UR);
#define SCAN_LANE_VARS(tid) const int lane = (tid) & 63, fr = lane & 15, fq = lane >> 4, t = (tid) >> 3, c16 = ((tid) & 7) * 16, ch = 16 * w + fr, sg = (tid) >> 7, sc = (tid) & 127; \
    (void)fq; (void)sg; (void)sc; (void)ch; (void)t; (void)c16
    int hcur = -1;
    bf16x8 wf[2][2][4]; float bia[2], bix[2], sp8[2];
    u32x4 ur[4][2];
#define SCAN_PREFETCH(uu) do { const int q_ = (uu) >> 3, h_ = (uu) & 7; const bool ic_ = q_ >= 256; const int r0_ = ic_ ? RL + (q_ - 256) * 64 : q_ * 64; \
        const int cp_ = ic_ ? ((q_ - 256) & 3) * 64 : 0, sl_ = ic_ ? LC : GW; \
        _Pragma("unroll") for (int k = 0; k < 4; ++k) { const int p_ = cp_ + t + k - 2; \
            if (p_ >= 0 && p_ < sl_) { const bf16* src_ = UR + (size_t)(r0_ + t + k - 2) * 1024 + h_ * HD + c16; ur[k][0] = *(const u32x4*)src_; ur[k][1] = *(const u32x4*)(src_ + 8); } \
            else { ur[k][0] = (u32x4){0u, 0u, 0u, 0u}; ur[k][1] = (u32x4){0u, 0u, 0u, 0u}; } } } while (0)
    if (vcu < nunits) { SCAN_LANE_VARS(tid0); SCAN_PREFETCH(vcu); }
    for (int u = vcu; u < nunits; u += G) {
        const int q = u >> 3, h = u & 7;
        const int tid = opq(tid0); SCAN_LANE_VARS(tid);
        const bool isctx = q >= 256; const int row0 = isctx ? RL + (q - 256) * 64 : q * 64;
        if (h != hcur) {
            hcur = h;
            __syncthreads();
            if (tid < 128) { CB[tid] = a->in[10][(size_t)l * DL + h * HD + tid];
#pragma unroll
                for (int k = 0; k < 4; ++k) CW[k * 128 + tid] = a->in[9][((size_t)l * 4 + k) * DL + h * HD + tid]; }
#pragma unroll
            for (int dir = 0; dir < 2; ++dir) {
                const bf16* WT = (const bf16*)(ws + O_WAX) + ((size_t)((l * 2 + dir) * 2) * 8 + h) * 128 * 128;
#pragma unroll
                for (int g = 0; g < 2; ++g)
#pragma unroll
                    for (int ks = 0; ks < 4; ++ks) wf[dir][g][ks] = *(const bf16x8*)(WT + (size_t)g * 8 * 128 * 128 + (size_t)ch * 128 + ks * 32 + fq * 8);
                const int gch = h * HD + ch;
                bia[dir] = a->in[12][(size_t)(l * 2 + dir) * DL + gch]; bix[dir] = a->in[14][(size_t)(l * 2 + dir) * DL + gch];
                sp8[dir] = 8.f * log1pf(expf(-a->in[15][(size_t)(l * 2 + dir) * DL + gch]));
            }
            __syncthreads();
        }
        float car[2]; u32x4 gg0, gg1;
        if (PASS == 2) {
            car[0] = ((const float*)(ws + O_CAR))[((size_t)q * 2 + 0) * 1024 + h * HD + sc]; car[1] = ((const float*)(ws + O_CAR))[((size_t)q * 2 + 1) * 1024 + h * HD + sc];
            const bf16* GGp = (const bf16*)(ws + O_GG) + (size_t)(row0 + t) * 1024 + h * HD + c16; gg0 = *(const u32x4*)GGp; gg1 = *(const u32x4*)(GGp + 8);
        }
        {
            float v[16];
#pragma unroll
            for (int i = 0; i < 16; i += 4) { const f32x4 b4 = *(const LAS f32x4*)(CB + c16 + i); v[i] = b4.x; v[i + 1] = b4.y; v[i + 2] = b4.z; v[i + 3] = b4.w; }
#pragma unroll
            for (int k = 0; k < 4; ++k) { const unsigned uu[8] = {ur[k][0].x, ur[k][0].y, ur[k][0].z, ur[k][0].w, ur[k][1].x, ur[k][1].y, ur[k][1].z, ur[k][1].w};
#pragma unroll
                for (int i = 0; i < 16; i += 4) { const f32x4 wv = *(const LAS f32x4*)(CW + k * 128 + c16 + i);
                    v[i] = fmaf(wv.x, bf_lo(uu[i / 2]), v[i]); v[i + 1] = fmaf(wv.y, bf_hi(uu[i / 2]), v[i + 1]); v[i + 2] = fmaf(wv.z, bf_lo(uu[i / 2 + 1]), v[i + 2]); v[i + 3] = fmaf(wv.w, bf_hi(uu[i / 2 + 1]), v[i + 3]); } }
#pragma unroll
            for (int i = 0; i < 16; i += 4) *(LAS f32x4*)(VS + t * 132 + c16 + i) = (f32x4){v[i], v[i + 1], v[i + 2], v[i + 3]};
            u32x4 o0, o1; o0.x = cvt_pk_bf16(v[0], v[1]); o0.y = cvt_pk_bf16(v[2], v[3]); o0.z = cvt_pk_bf16(v[4], v[5]); o0.w = cvt_pk_bf16(v[6], v[7]);
            o1.x = cvt_pk_bf16(v[8], v[9]); o1.y = cvt_pk_bf16(v[10], v[11]); o1.z = cvt_pk_bf16(v[12], v[13]); o1.w = cvt_pk_bf16(v[14], v[15]);
            *(LAS u32x4*)(V16 + t * 136 + c16) = o0; *(LAS u32x4*)(V16 + t * 136 + c16 + 8) = o1;
        }
        if (u + G < nunits) SCAN_PREFETCH(u + G);
        __syncthreads();
        float hsum[16];
#pragma unroll
        for (int i = 0; i < 16; ++i) hsum[i] = 0.f;
#pragma unroll
        for (int dir = 0; dir < 2; ++dir) {
            f32x4 acc[2][4];
#pragma unroll
            for (int g = 0; g < 2; ++g)
#pragma unroll
                for (int m = 0; m < 4; ++m) acc[g][m] = (f32x4){0.f, 0.f, 0.f, 0.f};
#pragma unroll
            for (int ks = 0; ks < 4; ++ks)
#pragma unroll
                for (int m = 0; m < 4; ++m) { const bf16x8 af = *(const LAS bf16x8*)(V16 + (16 * m + fr) * 136 + ks * 32 + fq * 8);
                    acc[0][m] = __builtin_amdgcn_mfma_f32_16x16x32_bf16(af, wf[dir][0][ks], acc[0][m], 0, 0, 0); acc[1][m] = __builtin_amdgcn_mfma_f32_16x16x32_bf16(af, wf[dir][1][ks], acc[1][m], 0, 0, 0); }
#pragma unroll
            for (int m = 0; m < 4; ++m)
#pragma unroll
                for (int j = 0; j < 4; ++j) { const int tok = 16 * m + 4 * fq + j;
                    const float rr = fsigm(acc[0][m][j] + bia[dir]), ii = fsigm(acc[1][m][j] + bix[dir]), vv = VS[tok * 132 + ch];
                    const float la = -sp8[dir] * rr, av = fexp(la), a2 = av * av;
                    AS[tok * 132 + ch] = av; BS[tok * 132 + ch] = sqrtf(one_minus_exp(2.f * la, a2)) * (ii * vv); }
            __syncthreads();
            {
                float av[16], bv[16];
#pragma unroll
                for (int i = 0; i < 16; ++i) { const int tok = dir ? 63 - (16 * sg + i) : 16 * sg + i; av[i] = AS[tok * 132 + sc]; bv[i] = BS[tok * 132 + sc]; }
                float P = 1.f, hl = 0.f;
#pragma unroll
                for (int i = 0; i < 16; ++i) { hl = fmaf(av[i], hl, bv[i]); P *= av[i]; }
                SEG[(sg * 128 + sc) * 2] = P; SEG[(sg * 128 + sc) * 2 + 1] = hl;
                __syncthreads();
                if (PASS == 1) {
                    if (sg == 0) { float A = 1.f, B = 0.f;
#pragma unroll
                        for (int s2 = 0; s2 < 4; ++s2) { const float p2 = SEG[(s2 * 128 + sc) * 2], h2 = SEG[(s2 * 128 + sc) * 2 + 1]; B = fmaf(p2, B, h2); A *= p2; }
                        *(f32x2*)((float*)(ws + O_TOT) + (((size_t)q * 2 + dir) * 1024 + h * HD + sc) * 2) = (f32x2){A, B}; }
                } else {
                    float hc = car[dir];
#pragma unroll
                    for (int s2 = 0; s2 < 3; ++s2) if (s2 < sg) { const float p2 = SEG[(s2 * 128 + sc) * 2], h2 = SEG[(s2 * 128 + sc) * 2 + 1]; hc = fmaf(p2, hc, h2); }
#pragma unroll
                    for (int i = 0; i < 16; ++i) { const int tok = dir ? 63 - (16 * sg + i) : 16 * sg + i; hc = fmaf(av[i], hc, bv[i]); BS[tok * 132 + sc] = hc; }
                }
            }
            __syncthreads();
            if (PASS == 2) {
#pragma unroll
                for (int i = 0; i < 16; i += 4) { const f32x4 x = *(const LAS f32x4*)(BS + t * 132 + c16 + i); hsum[i] += x.x; hsum[i + 1] += x.y; hsum[i + 2] += x.z; hsum[i + 3] += x.w; }
                __syncthreads();
            }
        }
        if (PASS == 2) {
            const unsigned gu[8] = {gg0.x, gg0.y, gg0.z, gg0.w, gg1.x, gg1.y, gg1.z, gg1.w}; unsigned o[8];
#pragma unroll
            for (int i = 0; i < 8; ++i) o[i] = cvt_pk_bf16(hsum[2 * i] * bf_lo(gu[i]), hsum[2 * i + 1] * bf_hi(gu[i]));
            bf16* dst = (bf16*)(ws + O_HR) + (size_t)(row0 + t) * 1024 + h * HD + c16;
            *(u32x4*)dst = (u32x4){o[0], o[1], o[2], o[3]}; *(u32x4*)(dst + 8) = (u32x4){o[4], o[5], o[6], o[7]};
        }
    }
#undef SCAN_PREFETCH
#undef SCAN_LANE_VARS
}
template <int PASS, int SKIP = 0>
__device__ __forceinline__ void scan_phase2(AP a, LAS unsigned char* lds, const int l, const int nunits, const int vcu, const int G) {
    int tid0 = threadIdx.x; asm volatile("" : "+v"(tid0));
    const int w = __builtin_amdgcn_readfirstlane(tid0 >> 6);
    LAS bf16* V16 = (LAS bf16*)lds; LAS float* HST = (LAS float*)(lds + 34816) + w * (64 * 17); LAS float* CW = (LAS float*)(lds + 69632); LAS float* CB = (LAS float*)(lds + 71680);
    unsigned char* ws = a->ws;
    const bf16* UR = (const bf16*)(ws + O_UR);
#define SCAN_LANE_VARS(tid) const int lane = (tid) & 63, fr = lane & 15, fq = lane >> 4, t = (tid) >> 3, c16 = ((tid) & 7) * 16, ch = 16 * w + fr; (void)fq; (void)ch; (void)t; (void)c16
    int hcur = -1;
    bf16x8 wf[2][2][4]; float nbia[2], nbix[2], nsp8[2];
    u32x4 ur[4][2];
#define SCAN_PREFETCH(uu) do { const int q_ = (uu) >> 3, h_ = (uu) & 7; const bool ic_ = q_ >= 256; const int r0_ = ic_ ? RL + (q_ - 256) * 64 : q_ * 64; \
        if (PASS == 2 && SCAN_VV) { const bf16* src_ = (const bf16*)(ws + O_VV) + (size_t)(r0_ + t) * 1024 + h_ * HD + c16; ur[0][0] = *(const u32x4*)src_; ur[0][1] = *(const u32x4*)(src_ + 8); break; }     \
        const int cp_ = ic_ ? ((q_ - 256) & 3) * 64 : 0, sl_ = ic_ ? LC : GW; \
        _Pragma("unroll") for (int k = 0; k < 4; ++k) { const int p_ = cp_ + t + k - 2; \
            if (p_ >= 0 && p_ < sl_) { const bf16* src_ = UR + (size_t)(r0_ + t + k - 2) * 1024 + h_ * HD + c16; ur[k][0] = *(const u32x4*)src_; ur[k][1] = *(const u32x4*)(src_ + 8); } \
            else { ur[k][0] = (u32x4){0u, 0u, 0u, 0u}; ur[k][1] = (u32x4){0u, 0u, 0u, 0u}; } } } while (0)
    if (vcu < nunits) { SCAN_LANE_VARS(tid0); SCAN_PREFETCH(vcu); }
    int par = 0;
    for (int u = vcu; u < nunits; u += G, par ^= 1) {
        const int q = u >> 3, h = u & 7;
        const int tid = opq(tid0); SCAN_LANE_VARS(tid);
        const bool isctx = q >= 256; const int row0 = isctx ? RL + (q - 256) * 64 : q * 64;
        LAS bf16* Vb = V16 + par * (64 * 136);
        if (h != hcur) {
            hcur = h;
            __syncthreads();
            if (tid < 128) { CB[tid] = a->in[10][(size_t)l * DL + h * HD + tid];
#pragma unroll
                for (int k = 0; k < 4; ++k) CW[k * 128 + tid] = a->in[9][((size_t)l * 4 + k) * DL + h * HD + tid]; }
#pragma unroll
            for (int dir = 0; dir < 2; ++dir) {
                const bf16* WT = (const bf16*)(ws + O_WAX) + ((size_t)((l * 2 + dir) * 2) * 8 + h) * 128 * 128;
#pragma unroll
                for (int g = 0; g < 2; ++g)
#pragma unroll
                    for (int ks = 0; ks < 4; ++ks) wf[dir][g][ks] = *(const bf16x8*)(WT + (size_t)g * 8 * 128 * 128 + (size_t)ch * 128 + ks * 32 + fq * 8);
                const int gch = h * HD + ch;
                nbia[dir] = -1.4426950408889634f * a->in[12][(size_t)(l * 2 + dir) * DL + gch]; nbix[dir] = -1.4426950408889634f * a->in[14][(size_t)(l * 2 + dir) * DL + gch];
                nsp8[dir] = -8.f * 1.4426950408889634f * log1pf(expf(-a->in[15][(size_t)(l * 2 + dir) * DL + gch]));
            }
            __syncthreads();
        }
        float car[2]; u32x4 gg0, gg1;
        if (PASS == 2) {
            car[0] = ((const float*)(ws + O_CAR))[((size_t)q * 2 + 0) * 1024 + h * HD + ch]; car[1] = ((const float*)(ws + O_CAR))[((size_t)q * 2 + 1) * 1024 + h * HD + ch];
            const bf16* GGp = (const bf16*)(ws + O_GG) + (size_t)(row0 + lane) * 1024 + h * HD + 16 * w; gg0 = *(const u32x4*)GGp; gg1 = *(const u32x4*)(GGp + 8);
        }
        if (PASS == 2 && SCAN_VV) { *(LAS u32x4*)(Vb + t * 136 + c16) = ur[0][0]; *(LAS u32x4*)(Vb + t * 136 + c16 + 8) = ur[0][1]; }
        else {
            float v[16];
#pragma unroll
            for (int i = 0; i < 16; i += 4) { const f32x4 b4 = *(const LAS f32x4*)(CB + c16 + i); v[i] = b4.x; v[i + 1] = b4.y; v[i + 2] = b4.z; v[i + 3] = b4.w; }
#pragma unroll
            for (int k = 0; k < 4; ++k) { const unsigned uu[8] = {ur[k][0].x, ur[k][0].y, ur[k][0].z, ur[k][0].w, ur[k][1].x, ur[k][1].y, ur[k][1].z, ur[k][1].w};
#pragma unroll
                for (int i = 0; i < 16; i += 4) { const f32x4 wv = *(const LAS f32x4*)(CW + k * 128 + c16 + i);
                    v[i] = fmaf(wv.x, bf_lo(uu[i / 2]), v[i]); v[i + 1] = fmaf(wv.y, bf_hi(uu[i / 2]), v[i + 1]); v[i + 2] = fmaf(wv.z, bf_lo(uu[i / 2 + 1]), v[i + 2]); v[i + 3] = fmaf(wv.w, bf_hi(uu[i / 2 + 1]), v[i + 3]); } }
            u32x4 o0, o1; o0.x = cvt_pk_bf16(v[0], v[1]); o0.y = cvt_pk_bf16(v[2], v[3]); o0.z = cvt_pk_bf16(v[4], v[5]); o0.w = cvt_pk_bf16(v[6], v[7]);
            o1.x = cvt_pk_bf16(v[8], v[9]); o1.y = cvt_pk_bf16(v[10], v[11]); o1.z = cvt_pk_bf16(v[12], v[13]); o1.w = cvt_pk_bf16(v[14], v[15]);
            *(LAS u32x4*)(Vb + t * 136 + c16) = o0; *(LAS u32x4*)(Vb + t * 136 + c16 + 8) = o1;
            if (PASS == 1 && SCAN_VV) { bf16* vd = (bf16*)(ws + O_VV) + (size_t)(row0 + t) * 1024 + h * HD + c16; *(u32x4*)vd = o0; *(u32x4*)(vd + 8) = o1; }
        }
        if (u + G < nunits) SCAN_PREFETCH(u + G);
        __syncthreads();
        if (SKIP == 1) continue;
        float vv[4][4];
#pragma unroll
        for (int m = 0; m < 4; ++m)
#pragma unroll
            for (int j = 0; j < 4; ++j) vv[m][j] = __uint_as_float(((unsigned)Vb[(16 * m + 4 * fq + j) * 136 + ch]) << 16);
        f32x4 acc2[2][2][4];
#pragma unroll
        for (int d2 = 0; d2 < 2; ++d2)
#pragma unroll
            for (int g = 0; g < 2; ++g)
#pragma unroll
                for (int m = 0; m < 4; ++m) acc2[d2][g][m] = (f32x4){0.f, 0.f, 0.f, 0.f};
#pragma unroll
        for (int ks = 0; ks < 4; ++ks)
#pragma unroll
            for (int m = 0; m < 4; ++m) { const bf16x8 af = *(const LAS bf16x8*)(Vb + (16 * m + fr) * 136 + ks * 32 + fq * 8);
#pragma unroll
                for (int d2 = 0; d2 < 2; ++d2) { acc2[d2][0][m] = __builtin_amdgcn_mfma_f32_16x16x32_bf16(af, wf[d2][0][ks], acc2[d2][0][m], 0, 0, 0); acc2[d2][1][m] = __builtin_amdgcn_mfma_f32_16x16x32_bf16(af, wf[d2][1][ks], acc2[d2][1][m], 0, 0, 0); } }
#pragma unroll
        for (int dir = 0; dir < 2; ++dir) {
            f32x4 (&acc)[2][4] = acc2[dir];
            float av[4][4], bv[4][4];
#pragma unroll
            for (int m = 0; m < 4; ++m)
#pragma unroll
                for (int j = 0; j < 4; ++j) {
                    if (SKIP == 3) { av[m][j] = acc[0][m][j]; bv[m][j] = acc[1][m][j] * vv[m][j]; continue; }
                    const float ex = __builtin_amdgcn_exp2f(fminf(fmaf(acc[0][m][j], -1.4426950408889634f, nbia[dir]), 60.f)), ey = __builtin_amdgcn_exp2f(fminf(fmaf(acc[1][m][j], -1.4426950408889634f, nbix[dir]), 60.f));
                    const float dx = 1.f + ex, dy = 1.f + ey, qq = frcp(dx * dy), rr = qq * dy, ii = qq * dx;
                    const float aa = __builtin_amdgcn_exp2f(nsp8[dir] * rr);
                    av[m][j] = aa; bv[m][j] = __builtin_amdgcn_sqrtf(fmaf(-aa, aa, 1.f)) * (ii * vv[m][j]); }
            float P[4], H[4];
#pragma unroll
            for (int m = 0; m < 4; ++m) { float p = 1.f, hh = 0.f;
#pragma unroll
                for (int i = 0; i < 4; ++i) { const int jj = dir ? 3 - i : i; hh = fmaf(av[m][jj], hh, bv[m][jj]); p *= av[m][jj]; }
                P[m] = p; H[m] = hh; }
            float Ae[4], He[4], TA[4], TB[4];
#pragma unroll
            for (int m = 0; m < 4; ++m) {
                float Pk[4], Hk[4];
#pragma unroll
                for (int k = 0; k < 4; ++k) { Pk[k] = __shfl(P[m], fr + 16 * k); Hk[k] = __shfl(H[m], fr + 16 * k); }
                float A = 1.f, B = 0.f, ae = 1.f, he = 0.f;
#pragma unroll
                for (int i = 0; i < 4; ++i) { const int k = dir ? 3 - i : i; if (k == fq) { ae = A; he = B; } B = fmaf(Pk[k], B, Hk[k]); A *= Pk[k]; }
                Ae[m] = ae; He[m] = he; TA[m] = A; TB[m] = B;
            }
            if (PASS == 1) {
                float A = 1.f, B = 0.f;
#pragma unroll
                for (int i = 0; i < 4; ++i) { const int m = dir ? 3 - i : i; B = fmaf(TA[m], B, TB[m]); A *= TA[m]; }
                if (fq == 0) *(f32x2*)((float*)(ws + (SKIP ? O_CAR : O_TOT)) + (((size_t)(SKIP ? 0 : q) * 2 + dir) * 1024 + h * HD + ch) * 2) = (f32x2){A, B};
            } else {
                float C = car[dir];
#pragma unroll
                for (int i = 0; i < 4; ++i) { const int m = dir ? 3 - i : i;
                    float hh = fmaf(Ae[m], C, He[m]);
#pragma unroll
                    for (int i2 = 0; i2 < 4; ++i2) { const int jj = dir ? 3 - i2 : i2; hh = fmaf(av[m][jj], hh, bv[m][jj]); LAS float* hp = HST + (16 * m + 4 * fq + jj) * 17 + fr; if (dir == 0) *hp = hh; else *hp += hh; }
                    C = fmaf(TA[m], C, TB[m]); }
            }
        }
        if (PASS == 2) {
            LDS_WAIT(); asm volatile("" ::: "memory");
            const unsigned gu[8] = {gg0.x, gg0.y, gg0.z, gg0.w, gg1.x, gg1.y, gg1.z, gg1.w}; unsigned o[8];
#pragma unroll
            for (int i = 0; i < 8; ++i) o[i] = cvt_pk_bf16(HST[lane * 17 + 2 * i] * bf_lo(gu[i]), HST[lane * 17 + 2 * i + 1] * bf_hi(gu[i]));
            bf16* dst = (bf16*)(ws + O_HR) + (size_t)(row0 + lane) * 1024 + h * HD + 16 * w;
            *(u32x4*)dst = (u32x4){o[0], o[1], o[2], o[3]}; *(u32x4*)(dst + 8) = (u32x4){o[4], o[5], o[6], o[7]};
            LDS_WAIT(); asm volatile("" ::: "memory");
        }
    }
#undef SCAN_PREFETCH
#undef SCAN_LANE_VARS
}
__device__ __forceinline__ void dft_stage1(AP a, const LAS f32x2* tab, size_t gt, size_t NGT) {
    unsigned char* ws = a->ws; const bf16* UT = (const bf16*)(ws + O_UT); bf16* ZT = (bf16*)(ws + O_ZT);
    for (size_t it = gt; it < (size_t)1024 * 8 * 64; it += NGT) {
        const int t2b = (int)(it & 63), b = (int)((it >> 6) & 7), c = (int)(it >> 9);
        const bf16* src = UT + (size_t)c * UT_LD + (size_t)b * 4096 + t2b * 4;
        u32x2 uc[8], us[8];
#pragma unroll
        for (int t1 = 0; t1 < 8; ++t1) { uc[t1] = *(const u32x2*)(src + 256 * t1); us[t1] = *(const u32x2*)(src + 2048 + 256 * t1); }
        unsigned zo[8][2][2];
#pragma unroll
        for (int e = 0; e < 4; e += 2) {
            float Zr[2][8], Zi[2][8];
#pragma unroll
            for (int h = 0; h < 2; ++h) {
                float xr[8], xi[8];
#pragma unroll
                for (int t1 = 0; t1 < 8; ++t1) { const unsigned wc_ = uc[t1][e >> 1], ws_ = us[t1][e >> 1]; xr[t1] = h ? bf_hi(wc_) : bf_lo(wc_); xi[t1] = -(h ? bf_hi(ws_) : bf_lo(ws_)); }
                float ar[8], ai[8];
#pragma unroll
                for (int i = 0; i < 4; ++i) { ar[i] = xr[i] + xr[i + 4]; ai[i] = xi[i] + xi[i + 4]; ar[i + 4] = xr[i] - xr[i + 4]; ai[i + 4] = xi[i] - xi[i + 4]; }
                { const float r = 0.70710678118654752f; const float t5r = (ar[5] + ai[5]) * r, t5i = (ai[5] - ar[5]) * r; ar[5] = t5r; ai[5] = t5i;
                  const float t6r = ai[6], t6i = -ar[6]; ar[6] = t6r; ai[6] = t6i;
                  const float t7r = (ai[7] - ar[7]) * r, t7i = (-ar[7] - ai[7]) * r; ar[7] = t7r; ai[7] = t7i; }
                float Xr[8], Xi[8];
#pragma unroll
                for (int o = 0; o < 2; ++o) {
                    const float b0r = ar[4 * o] + ar[4 * o + 2], b0i = ai[4 * o] + ai[4 * o + 2], b1r = ar[4 * o] - ar[4 * o + 2], b1i = ai[4 * o] - ai[4 * o + 2];
                    const float b2r = ar[4 * o + 1] + ar[4 * o + 3], b2i = ai[4 * o + 1] + ai[4 * o + 3];
                    const float dr = ar[4 * o + 1] - ar[4 * o + 3], di = ai[4 * o + 1] - ai[4 * o + 3], b3r = di, b3i = -dr;
                    Xr[o] = b0r + b2r; Xi[o] = b0i + b2i; Xr[2 + o] = b1r + b3r; Xi[2 + o] = b1i + b3i; Xr[4 + o] = b0r - b2r; Xi[4 + o] = b0i - b2i; Xr[6 + o] = b1r - b3r; Xi[6 + o] = b1i - b3i; }
                const int t2 = t2b * 4 + e + h;
                Zr[h][0] = Xr[0]; Zi[h][0] = Xi[0];
#pragma unroll
                for (int k1 = 1; k1 < 8; ++k1) { const f32x2 cs = tab[t2 * k1]; Zr[h][k1] = Xr[k1] * cs.x + Xi[k1] * cs.y; Zi[h][k1] = Xi[k1] * cs.x - Xr[k1] * cs.y; }
            }
#pragma unroll
            for (int k1 = 0; k1 < 8; ++k1) { zo[k1][0][e >> 1] = cvt_pk_bf16(Zr[0][k1], Zr[1][k1]); zo[k1][1][e >> 1] = cvt_pk_bf16(Zi[0][k1], Zi[1][k1]); }
        }
        bf16* dst = ZT + (size_t)c * UT_LD + (size_t)b * 4096 + t2b * 4;
#pragma unroll
        for (int k1 = 0; k1 < 8; ++k1) { *(u32x2*)(dst + k1 * 512) = (u32x2){zo[k1][0][0], zo[k1][0][1]}; *(u32x2*)(dst + k1 * 512 + 256) = (u32x2){zo[k1][1][0], zo[k1][1][1]}; }
    }
}
__device__ __forceinline__ void carry_phase(AP a, int gw, int NGW) {
    const int lane = opq(threadIdx.x) & 63; unsigned char* ws = a->ws;
    const f32x2* TOT = (const f32x2*)(ws + O_TOT); float* CAR = (float*)(ws + O_CAR);
    for (int item = gw; item < NB * 2 * 16; item += NGW) {
        const int cgp = item & 15, dir = (item >> 4) & 1, b = item >> 5, chn = cgp * 64 + lane;
        float hc = 0.f;
#pragma unroll 4
        for (int s = 0; s < 36; ++s) {
            int q; if (dir == 0) q = s < 4 ? 256 + b * 4 + s : b * 32 + (s - 4); else q = s < 4 ? 256 + b * 4 + (3 - s) : b * 32 + (31 - (s - 4));
            const size_t o = ((size_t)q * 2 + dir) * 1024 + chn;
            CAR[o] = hc; const f32x2 ab = TOT[o]; hc = fmaf(ab.x, hc, ab.y);
        }
    }
}
#ifndef FFN_BLK
#define FFN_BLK 1
#endif
#ifndef NORM_REV
#define NORM_REV 0
#endif
#ifndef CODE_SHIFT
#define CODE_SHIFT 0
#endif
#ifndef WGM_FD
#define WGM_FD 2
#endif
#ifndef WGM_MD
#define WGM_MD WGM
#endif
#ifndef WGM_K1
#define WGM_K1 WGM
#endif
#ifndef MOE_WNT
#define MOE_WNT 0
#endif
#ifndef FFN_DOWN_REV
#define FFN_DOWN_REV 1
#endif
#ifndef MOE_DOWN_REV
#define MOE_DOWN_REV 1
#endif
#ifndef MOE_DOWN_XCD
#define MOE_DOWN_XCD 0
#endif
#ifndef PROBE_BAR
#define PROBE_BAR 0
#endif
#ifndef MOE_NT
#define MOE_NT 0
#endif
#ifndef MOE_STAGGER
#define MOE_STAGGER 0
#endif
#ifndef MOE_WGM
#define MOE_WGM 0
#endif
#ifndef MOE_TAILSPLIT
#define MOE_TAILSPLIT 1
#endif
#ifndef SCANV
#define SCANV 2
#endif
#ifndef MOE_KSPLIT
#define MOE_KSPLIT 1
#endif
struct GridSched {
    int G, c, nM, nN, nt; const char* A; const char* B; size_t atile, btile; int rev = 0; int wgm = WGM;
    __device__ __forceinline__ bool next(int i, Unit& u) const {
        const int Lx = i * G + c; if (Lx >= nM * nN) return false;
        tile_of(rev ? nM * nN - 1 - Lx : Lx, nM, nN, u.pm, u.pn, wgm); u.A = A + (size_t)u.pm * atile; u.B = B + (size_t)u.pn * btile; u.nt = nt; u.kind = 0; u.x = 0; return true; }
};
struct FoldSched { int G, c; const char* DGp; const char* WUF;
    __device__ __forceinline__ bool next(int i, Unit& u) const {
        const int Lx = i * G + c; if (Lx >= 64) return false;
        const int pn = Lx & 7, g = (Lx >> 3) & 3, l = Lx >> 5;
        u.pm = 0; u.pn = pn; u.kind = g; u.x = l; { int n4 = 4; asm volatile("" : "+s"(n4)); u.nt = n4; }
        u.A = DGp; u.B = WUF + ((size_t)l * 2048 + pn * 256) * 1024 * 2 + (size_t)g * 256 * 2; return true; }
};
struct EpiFold { static constexpr bool PERM = true; bf16* WIN;
    __device__ __forceinline__ void operator()(const f32x4 (&acc)[2][2][4][2], const Unit& u, int wr, int wc, int fr, int fq) const { fr = opq(fr);
        bf16* base = WIN + (size_t)u.x * WIN_ROWS * 2048;
#pragma unroll
        for (int ai = 0; ai < 2; ++ai)
#pragma unroll
            for (int m = 0; m < 4; ++m) { const int row = u.kind * 256 + ai * HALF + wr * 64 + m * 16 + fr; bf16* rp = base + (size_t)row * 2048 + u.pn * 256 + wc * 32 + 8 * fq;
#pragma unroll
                for (int bj = 0; bj < 2; ++bj) { const f32x4 v0 = acc[ai][bj][m][0], v1 = acc[ai][bj][m][1];
                    u32x4 w; w.x = cvt_pk_bf16(v0[0], v0[1]); w.y = cvt_pk_bf16(v0[2], v0[3]); w.z = cvt_pk_bf16(v1[0], v1[1]); w.w = cvt_pk_bf16(v1[2], v1[3]); *(u32x4*)(rp + bj * HALF) = w; } __builtin_amdgcn_sched_barrier(0); }
    }
};
#ifndef LANE_LIN
#define LANE_LIN 1
#endif
__device__ __forceinline__ size_t lin_off(int pm, int pn8, int ai, int m, int bj, int tl);
struct WinSched { int G, c, l; const char* HNp; const char* WINl;
    __device__ __forceinline__ bool next(int i, Unit& u) const {
        int Lx = i * G + c; const int ntok = l == 0 ? 72 : 64; const int n0 = 4 * ntok, n1 = ntok * 24, n2 = l == 0 ? 0 : 32;
        if (Lx >= n0 + n1 + n2) return false;
        u.nt = 32; u.x = 0;
        if (Lx < n0) { tile_of(Lx, 4, ntok, u.pm, u.pn); u.kind = 0; u.A = WINl + (size_t)u.pm * 256 * 2048 * 2; u.B = HNp + (size_t)u.pn * 256 * 2048 * 2; return true; }
        Lx -= n0;
        if (Lx < n1) tile_of(Lx, ntok, 24, u.pm, u.pn); else { Lx -= n1; u.pm = 64 + (Lx & 7); u.pn = Lx >> 3; }
        u.kind = 1; u.A = HNp + (size_t)u.pm * 256 * 2048 * 2; u.B = WINl + (size_t)(1024 + u.pn * 256) * 2048 * 2; return true; }
};
struct EpiWin { static constexpr bool PERM = true; bf16 *UT, *UR, *GG, *SGF, *SGR;
    __device__ __forceinline__ void operator()(const f32x4 (&acc)[2][2][4][2], const Unit& u, int wr, int wc, int fr, int fq) const { fr = opq(fr);
        if (u.kind == 0) {
#pragma unroll
            for (int ai = 0; ai < 2; ++ai)
#pragma unroll
                for (int m = 0; m < 4; ++m) { const int rho = ai * HALF + wr * 64 + m * 16 + fr, sn = rho > 128 ? 1 : 0, c = sn ? rho - 128 : rho, cm = (256 - c) & 255;
                    const int ch = u.pm * 256 + c, chm = u.pm * 256 + cm;
#pragma unroll
                    for (int bj = 0; bj < 2; ++bj) { const int r = u.pn * 256 + bj * HALF + wc * 32 + 8 * fq;
                        const size_t tof = r < RL ? (size_t)(r >> 11) * 4096 + (r & 2047) : (size_t)32768 + ((r - RL) >> 8) * 512 + ((r - RL) & 255);
                        const size_t sof = r < RL ? 2048 : 256;
                        const f32x4 v0 = acc[ai][bj][m][0], v1 = acc[ai][bj][m][1];
                        u32x4 w; w.x = cvt_pk_bf16(v0[0], v0[1]); w.y = cvt_pk_bf16(v0[2], v0[3]); w.z = cvt_pk_bf16(v1[0], v1[1]); w.w = cvt_pk_bf16(v1[2], v1[3]);
                        if (sn == 0) { *(u32x4*)(UT + (size_t)ch * UT_LD + tof) = w;
                            if (cm != c) *(u32x4*)(UT + (size_t)chm * UT_LD + tof) = w;
                            else *(u32x4*)(UT + (size_t)ch * UT_LD + tof + sof) = (u32x4){0u, 0u, 0u, 0u}; }
                        else { *(u32x4*)(UT + (size_t)ch * UT_LD + tof + sof) = w;
                            const u32x4 wn = (u32x4){w.x ^ 0x80008000u, w.y ^ 0x80008000u, w.z ^ 0x80008000u, w.w ^ 0x80008000u}; *(u32x4*)(UT + (size_t)chm * UT_LD + tof + sof) = wn; } }
                    __builtin_amdgcn_sched_barrier(0); }
        } else {
            const int pn = u.pn; bf16* base; int ldc, ct, act;
            if (pn < 4) { base = UR; ldc = 1024; ct = pn; act = 0; } else if (pn < 8) { base = GG; ldc = 1024; ct = pn - 4; act = 1; }
            else if (pn < 16) { base = SGF; ldc = 2048; ct = pn - 8; act = 2; } else { base = SGR; ldc = 2048; ct = pn - 16; act = 2; }
#pragma unroll
            for (int ai = 0; ai < 2; ++ai)
#pragma unroll
                for (int m = 0; m < 4; ++m) { const int r = u.pm * 256 + ai * HALF + wr * 64 + m * 16 + fr; bf16* rp = base + (size_t)r * ldc + ct * 256 + wc * 32 + 8 * fq;
                    const int tl = (wr * 4 + wc) * 64 + fq * 16 + fr;
#pragma unroll
                    for (int bj = 0; bj < 2; ++bj) { f32x4 v0 = acc[ai][bj][m][0], v1 = acc[ai][bj][m][1];
                        if (act == 1) {
#pragma unroll
                            for (int j = 0; j < 4; ++j) { v0[j] = fgelu(v0[j]); v1[j] = fgelu(v1[j]); } }
                        else if (act == 2) {
#pragma unroll
                            for (int j = 0; j < 4; ++j) { v0[j] = fsigm(v0[j]); v1[j] = fsigm(v1[j]); } }
                        u32x4 w; w.x = cvt_pk_bf16(v0[0], v0[1]); w.y = cvt_pk_bf16(v0[2], v0[3]); w.z = cvt_pk_bf16(v1[0], v1[1]); w.w = cvt_pk_bf16(v1[2], v1[3]);
                        *(u32x4*)((LANE_LIN && act == 2) ? base + lin_off(u.pm, ct, ai, m, bj, tl) : rp + bj * HALF) = w; } __builtin_amdgcn_sched_barrier(0); }
        }
    }
};
struct DftSched { int G, c, l; const char* FLp; const char* FLCp; const char* UTp; const char* ZTp;
    __device__ __forceinline__ bool next(int i, Unit& u) const {
        int Lx = i * G + c; const int n0 = 256, n1 = l == 0 ? 32 : 0;
        if (Lx >= n0 + n1) return false;
#if DFT2
        if (Lx < n0) { const int b = Lx & 7, rest = Lx >> 3, pn = rest & 3, k1 = rest >> 2; u.pm = k1; u.pn = pn; u.kind = 0; u.x = b; u.nt = 8;
            u.A = FLp; u.B = ZTp + ((size_t)pn * 256 * UT_LD + (size_t)(b * 8 + k1) * 512) * 2; return true; }
#else
        if (Lx < n0) { const int b = Lx & 7, rest = Lx >> 3, pn = rest & 3, pm = rest >> 2; u.pm = pm; u.pn = pn; u.kind = 0; u.x = b; u.nt = 64;
            u.A = FLp + (size_t)pm * 256 * 4096 * 2; u.B = UTp + ((size_t)pn * 256 * UT_LD + (size_t)b * 4096) * 2; return true; }
#endif
        Lx -= n0; { const int b = Lx & 7, pn = Lx >> 3; u.pm = 0; u.pn = pn; u.kind = 1; u.x = b; u.nt = 8;
            u.A = FLCp; u.B = UTp + ((size_t)pn * 256 * UT_LD + 32768 + (size_t)b * 512) * 2; return true; }
    }
};
struct EpiBf16Rows { static constexpr bool PERM = true; bf16* O; int ldc;
    bool dft;
    __device__ __forceinline__ void operator()(const f32x4 (&acc)[2][2][4][2], const Unit& u, int wr, int wc, int fr, int fq) const { fr = opq(fr);
        const int rs = (DFT2 && dft && u.kind == 0) ? 8 : 1;
        const int row0 = dft ? (u.kind == 0 ? (DFT2 ? u.x * 2048 + u.pm : u.x * 2048 + u.pm * 256) : RL + u.x * 256) : u.pm * 256 + u.x * MAXSLOT;
#pragma unroll
        for (int ai = 0; ai < 2; ++ai)
#pragma unroll
            for (int m = 0; m < 4; ++m) { bf16* rp = O + (size_t)(row0 + rs * (ai * HALF + wr * 64 + m * 16 + fr)) * ldc + u.pn * 256 + wc * 32 + 8 * fq;
#pragma unroll
                for (int bj = 0; bj < 2; ++bj) { const f32x4 v0 = acc[ai][bj][m][0], v1 = acc[ai][bj][m][1];
                    u32x4 w; w.x = cvt_pk_bf16(v0[0], v0[1]); w.y = cvt_pk_bf16(v0[2], v0[3]); w.z = cvt_pk_bf16(v1[0], v1[1]); w.w = cvt_pk_bf16(v1[2], v1[3]); *(u32x4*)(rp + bj * HALF) = w; } __builtin_amdgcn_sched_barrier(0); }
    }
};
#ifndef LANE_LIN
#define LANE_LIN 1
#endif
__device__ __forceinline__ size_t lin_off(int pm, int pn8, int ai, int m, int bj, int tl) { return ((size_t)(pm * 8 + pn8) << 16) + (size_t)((((ai * 4 + m) * 2 + bj) * 512 + tl) * 8); }
template <bool ADD> struct EpiGate { static constexpr bool PERM = true; bf16* O; const bf16* gate; const bf16* addend;
    __device__ __forceinline__ void operator()(const f32x4 (&acc)[2][2][4][2], const Unit& u, int wr, int wc, int fr, int fq) const { fr = opq(fr);
        const int tl = (wr * 4 + wc) * 64 + fq * 16 + fr;
#pragma unroll
        for (int ai = 0; ai < 2; ++ai) {
            u32x4 g[4][2], t[4][2];
#pragma unroll
            for (int m = 0; m < 4; ++m) { const size_t off = (size_t)(u.pm * 256 + ai * HALF + wr * 64 + m * 16 + fr) * 2048 + u.pn * 256 + wc * 32 + 8 * fq;
#pragma unroll
                for (int bj = 0; bj < 2; ++bj) { const size_t lo = LANE_LIN ? lin_off(u.pm, u.pn, ai, m, bj, tl) : off + bj * HALF; g[m][bj] = *(const u32x4*)(gate + lo); if (ADD) t[m][bj] = *(const u32x4*)(addend + lo); } }
#pragma unroll
            for (int m = 0; m < 4; ++m) { const size_t off = (size_t)(u.pm * 256 + ai * HALF + wr * 64 + m * 16 + fr) * 2048 + u.pn * 256 + wc * 32 + 8 * fq;
#pragma unroll
                for (int bj = 0; bj < 2; ++bj) { const f32x4 v0 = acc[ai][bj][m][0], v1 = acc[ai][bj][m][1]; const u32x4 gg = g[m][bj];
                    float o[8] = {v0[0] * bf_lo(gg.x), v0[1] * bf_hi(gg.x), v0[2] * bf_lo(gg.y), v0[3] * bf_hi(gg.y), v1[0] * bf_lo(gg.z), v1[1] * bf_hi(gg.z), v1[2] * bf_lo(gg.w), v1[3] * bf_hi(gg.w)};
                    if (ADD) { const u32x4 tt = t[m][bj];
                        o[0] += bf_lo(tt.x); o[1] += bf_hi(tt.x); o[2] += bf_lo(tt.y); o[3] += bf_hi(tt.y); o[4] += bf_lo(tt.z); o[5] += bf_hi(tt.z); o[6] += bf_lo(tt.w); o[7] += bf_hi(tt.w); }
                    u32x4 w; w.x = cvt_pk_bf16(o[0], o[1]); w.y = cvt_pk_bf16(o[2], o[3]); w.z = cvt_pk_bf16(o[4], o[5]); w.w = cvt_pk_bf16(o[6], o[7]);
                    *(u32x4*)(O + ((LANE_LIN && !ADD) ? lin_off(u.pm, u.pn, ai, m, bj, tl) : off + bj * HALF)) = w; } }
            asm volatile("" ::: "memory"); __builtin_amdgcn_sched_barrier(0); }
    }
};
template <bool FIRST> struct EpiResid { static constexpr bool PERM = false; float* lat; const float* modl; int gate_chunk; const float* x0; const float* c0; float osc = 1.f;
    __device__ __forceinline__ void operator()(const f32x4 (&acc)[2][2][4][2], const Unit& u, int wr, int wc, int fr, int fq) const { fr = opq(fr);
        const int bi = u.pm < 64 ? (u.pm >> 3) : 8; const int col0 = u.pn * 256 + wc * 32 + 4 * fq;
        const float* gp = modl + (size_t)bi * 12288 + gate_chunk * D + col0;
        f32x4 gv[2][2];
#pragma unroll
        for (int bj = 0; bj < 2; ++bj)
#pragma unroll
            for (int n = 0; n < 2; ++n) gv[bj][n] = *(const f32x4*)(gp + bj * HALF + n * 16) * osc;
#pragma unroll
        for (int ai = 0; ai < 2; ++ai) {
            f32x4 bsv[4][2][2];
#pragma unroll
            for (int m = 0; m < 4; ++m) { const int row = u.pm * 256 + ai * HALF + wr * 64 + m * 16 + fr; const float* rp = lat + (size_t)row * D + col0;
                const float* bp = FIRST ? (u.pm < 64 ? x0 + (size_t)row * D + col0 : c0 + (size_t)(row - RL) * D + col0) : rp;
#pragma unroll
                for (int bj = 0; bj < 2; ++bj)
#pragma unroll
                    for (int n = 0; n < 2; ++n) bsv[m][bj][n] = *(const f32x4*)(bp + bj * HALF + n * 16); }
#pragma unroll
            for (int m = 0; m < 4; ++m) { const int row = u.pm * 256 + ai * HALF + wr * 64 + m * 16 + fr; float* rp = lat + (size_t)row * D + col0;
#pragma unroll
                for (int bj = 0; bj < 2; ++bj)
#pragma unroll
                    for (int n = 0; n < 2; ++n) *(f32x4*)(rp + bj * HALF + n * 16) = bsv[m][bj][n] + gv[bj][n] * acc[ai][bj][m][n]; }
            asm volatile("" ::: "memory"); __builtin_amdgcn_sched_barrier(0); }
    }
};
struct EpiNull { static constexpr bool PERM = true; float* sink;
    __device__ __forceinline__ void operator()(const f32x4 (&acc)[2][2][4][2], const Unit& u, int wr, int wc, int fr, int fq) const {
        float s = 0.f;
#pragma unroll
        for (int ai = 0; ai < 2; ++ai)
#pragma unroll
            for (int bj = 0; bj < 2; ++bj)
#pragma unroll
                for (int m = 0; m < 4; ++m)
#pragma unroll
                    for (int n = 0; n < 2; ++n) s += acc[ai][bj][m][n][0] + acc[ai][bj][m][n][1] + acc[ai][bj][m][n][2] + acc[ai][bj][m][n][3];
        if (s == 1.2345e30f) sink[u.pm] = s;
    }
};
template <bool NT> struct EpiSwigluT { static constexpr bool PERM = true; bf16* O; int ldc; int blk = 0;
    __device__ __forceinline__ void operator()(const f32x4 (&acc)[2][2][4][2], const Unit& u, int wr, int wc, int fr, int fq) const { fr = opq(fr);
#pragma unroll
        for (int ai = 0; ai < 2; ++ai)
#pragma unroll
            for (int m = 0; m < 4; ++m) { bf16* rp = blk ? O + ((size_t)u.pm * blk + u.pn) * 32768 + (size_t)(ai * HALF + wr * 64 + m * 16 + fr) * 128 + wc * 32 + 8 * fq : O + (size_t)(u.pm * 256 + ai * HALF + wr * 64 + m * 16 + fr) * ldc + u.pn * 128 + wc * 32 + 8 * fq;
                const f32x4 g0 = acc[ai][0][m][0], g1 = acc[ai][0][m][1], u0 = acc[ai][1][m][0], u1 = acc[ai][1][m][1];
                u32x4 w; w.x = cvt_pk_bf16(fsilu(g0[0]) * u0[0], fsilu(g0[1]) * u0[1]); w.y = cvt_pk_bf16(fsilu(g0[2]) * u0[2], fsilu(g0[3]) * u0[3]);
                w.z = cvt_pk_bf16(fsilu(g1[0]) * u1[0], fsilu(g1[1]) * u1[1]); w.w = cvt_pk_bf16(fsilu(g1[2]) * u1[2], fsilu(g1[3]) * u1[3]); if (NT) __builtin_nontemporal_store(w, (u32x4*)rp); else *(u32x4*)rp = w; __builtin_amdgcn_sched_barrier(0); }
    }
};
typedef EpiSwigluT<false> EpiSwiglu;
struct EpiSwigluF8 { static constexpr bool PERM = true; unsigned char* O; float sc; int nblk = 28;
    __device__ __forceinline__ void operator()(const f32x4 (&acc)[2][2][4][2], const Unit& u, int wr, int wc, int fr, int fq) const { fr = opq(fr); fq = opq(fq);
        const float su = sc * H8_SC;
#pragma unroll
        for (int ai = 0; ai < 2; ++ai)
#pragma unroll
            for (int m = 0; m < 4; ++m) { unsigned char* rp = O + ((size_t)u.pm * nblk + (u.pn >> 1)) * 65536 + (size_t)(ai * HALF + wr * 64 + m * 16 + fr) * 256 + (u.pn & 1) * 128 + wc * 32 + 8 * fq;
                const f32x4 g0 = acc[ai][0][m][0] * sc, g1 = acc[ai][0][m][1] * sc, u0 = acc[ai][1][m][0] * su, u1 = acc[ai][1][m][1] * su;
                u32x2 w; w.x = cvt_fp8x4(fsilu(g0[0]) * u0[0], fsilu(g0[1]) * u0[1], fsilu(g0[2]) * u0[2], fsilu(g0[3]) * u0[3]);
                w.y = cvt_fp8x4(fsilu(g1[0]) * u1[0], fsilu(g1[1]) * u1[1], fsilu(g1[2]) * u1[2], fsilu(g1[3]) * u1[3]); *(u32x2*)rp = w; __builtin_amdgcn_sched_barrier(0); }
    }
};
struct EpiSwigluWrap { static constexpr bool PERM = true; bf16* O; int ldc;
    __device__ __forceinline__ void operator()(const f32x4 (&acc)[2][2][4][2], const Unit& u, int wr, int wc, int fr, int fq) const { fr = opq(fr);
#pragma unroll
        for (int ai = 0; ai < 2; ++ai)
#pragma unroll
            for (int m = 0; m < 4; ++m) { bf16* rp = O + (size_t)((u.pm & 7) * 256 + ai * HALF + wr * 64 + m * 16 + fr) * ldc + u.pn * 128 + wc * 32 + 8 * fq;
                const f32x4 g0 = acc[ai][0][m][0], g1 = acc[ai][0][m][1], u0 = acc[ai][1][m][0], u1 = acc[ai][1][m][1];
                u32x4 w; w.x = cvt_pk_bf16(fsilu(g0[0]) * u0[0], fsilu(g0[1]) * u0[1]); w.y = cvt_pk_bf16(fsilu(g0[2]) * u0[2], fsilu(g0[3]) * u0[3]);
                w.z = cvt_pk_bf16(fsilu(g1[0]) * u1[0], fsilu(g1[1]) * u1[1]); w.w = cvt_pk_bf16(fsilu(g1[2]) * u1[2], fsilu(g1[3]) * u1[3]); *(u32x4*)rp = w; __builtin_amdgcn_sched_barrier(0); }
    }
};
__device__ __forceinline__ const char* uni_ptr(const char* p) { const unsigned long long v = (unsigned long long)p;
    const unsigned lo = (unsigned)__builtin_amdgcn_readfirstlane((int)(unsigned)v), hi = (unsigned)__builtin_amdgcn_readfirstlane((int)(unsigned)(v >> 32)); return (const char*)(((unsigned long long)hi << 32) | lo); }
__device__ __forceinline__ void uni_unit(Unit& u) { u.A = uni_ptr(u.A); u.B = uni_ptr(u.B); u.pm = __builtin_amdgcn_readfirstlane(u.pm); u.pn = __builtin_amdgcn_readfirstlane(u.pn);
    u.kind = __builtin_amdgcn_readfirstlane(u.kind); u.x = __builtin_amdgcn_readfirstlane(u.x); u.nt = __builtin_amdgcn_readfirstlane(u.nt); }
struct MoeSched { int G, c, nN, nt; const LAS int* tbl; const char* A; const char* B; size_t atile, btile, bexp; int ksplit; size_t khalf;
    __device__ __forceinline__ bool next(int i, Unit& u) const {
        int Lx = i * G + c; const int total = tbl[8] * nN; if (Lx >= total * ksplit) return false;
        int kh = 0; if (ksplit == 2) { kh = Lx >= total ? 1 : 0; Lx -= kh * total; }
        int e = 0;
#pragma unroll
        for (int k = 1; k < 8; ++k) e += (Lx >= tbl[k] * nN) ? 1 : 0;
        const int t0 = tbl[e], te = tbl[e + 1] - t0, lx = Lx - t0 * nN;
        { int pml, pnl; tile_of(lx, te, nN, pml, pnl, MOE_WGM ? (MOE_WGM < te ? MOE_WGM : te) : WGM); u.pm = t0 + pml; u.pn = pnl; }
        u.kind = e; u.x = kh; u.nt = nt;
        u.A = A + (size_t)u.pm * atile + (size_t)kh * khalf; u.B = B + (size_t)e * bexp + (size_t)u.pn * btile + (size_t)kh * khalf; uni_unit(u); return true; }
};


struct MoeDownSched { int G, c, sp; const LAS int* tbl; const char* A; const char* B; size_t atile, btile, bexp;
    __device__ __forceinline__ bool next(int i, Unit& u) const {
        const int U = tbl[8] * 8, full = U / G, R = U - full * G;
        int Lx = i * G + c, k = 0, rr = -1;
        if (i > full) return false;
        if (i == full) { if (sp > 1) { if (c >= R * sp) return false; rr = c / sp; k = c - rr * sp; Lx = full * G + rr; } else if (c >= R) return false; }
        else if (MOE_DOWN_REV) Lx = full * G - 1 - Lx;
        int e = 0;
#pragma unroll
        for (int kk = 1; kk < 8; ++kk) e += (Lx >= tbl[kk] * 8) ? 1 : 0;
        const int t0 = tbl[e], te = tbl[e + 1] - t0, lx = Lx - t0 * 8;
#if MOE_DOWN_XCD
        { const int id = (lx & 7) * te + (lx >> 3); u.pm = t0 + (id >> 3); u.pn = id & 7; }
#else
        { int pml, pnl; tile_of(lx, te, 8, pml, pnl, WGM_MD); u.pm = t0 + pml; u.pn = pnl; }
#endif
        u.kind = e; const int nts = rr < 0 ? (MOE_F8 ? 56 : 112) : (MOE_F8 ? 56 : 112) / sp; u.nt = nts; u.x = rr < 0 ? 0 : 1 + rr * 16 + k;
        const size_t ko = MOE_BLK ? (size_t)k * (nts >> 1) * 65536 : (size_t)k * nts * 128;
        u.A = A + (size_t)u.pm * atile + ko; u.B = B + (size_t)e * bexp + (size_t)u.pn * btile + ko; uni_unit(u); return true; }
};
struct EpiMoeDown { static constexpr bool PERM = true; bf16* O; float* part; unsigned* cnt; int sp; float osc = 1.f;
    __device__ __forceinline__ void store_rows(const f32x4 (&v)[2][2][4][2], const Unit& u, int wr, int wc, int fr, int fq) const {
#pragma unroll
        for (int ai = 0; ai < 2; ++ai)
#pragma unroll
            for (int m = 0; m < 4; ++m) { bf16* rp = O + (size_t)(u.pm * 256 + ai * HALF + wr * 64 + m * 16 + fr) * 2048 + u.pn * 256 + wc * 32 + 8 * fq;
#pragma unroll
                for (int bj = 0; bj < 2; ++bj) { const f32x4 v0 = v[ai][bj][m][0] * osc, v1 = v[ai][bj][m][1] * osc;
                    u32x4 w; w.x = cvt_pk_bf16(v0[0], v0[1]); w.y = cvt_pk_bf16(v0[2], v0[3]); w.z = cvt_pk_bf16(v1[0], v1[1]); w.w = cvt_pk_bf16(v1[2], v1[3]); *(u32x4*)(rp + bj * HALF) = w; } __builtin_amdgcn_sched_barrier(0); }
    }
    template <int SP> __device__ __forceinline__ void reduce_store(const float* P0, const Unit& u, int wr, int wc, int fr, int fq) const {
        constexpr int NPB = SP <= 4 ? 4 : (SP <= 8 ? 2 : 1);
#pragma unroll
        for (int ai = 0; ai < 2; ++ai)
#pragma unroll
            for (int m = 0; m < 4; ++m) { bf16* rp = O + (size_t)(u.pm * 256 + ai * HALF + wr * 64 + m * 16 + fr) * 2048 + u.pn * 256 + wc * 32 + 8 * fq;
                f32x4 v[4];
#pragma unroll
                for (int p0 = 0; p0 < 4; p0 += NPB) { f32x4 t[NPB][SP];
#pragma unroll
                    for (int pp = 0; pp < NPB; ++pp) { const int idx = (ai * 4 + m) * 4 + p0 + pp;
#pragma unroll
                        for (int kk = 0; kk < SP; ++kk) t[pp][kk] = *(const f32x4*)(P0 + ((size_t)kk << 16) + idx * 2048); }
#pragma unroll
                    for (int pp = 0; pp < NPB; ++pp) { f32x4 a4 = t[pp][0];
#pragma unroll
                        for (int kk = 1; kk < SP; ++kk) a4 += t[pp][kk];
                        v[p0 + pp] = a4 * osc; }
                    asm volatile("" ::: "memory"); }
#pragma unroll
                for (int bj = 0; bj < 2; ++bj) { u32x4 w; w.x = cvt_pk_bf16(v[2 * bj][0], v[2 * bj][1]); w.y = cvt_pk_bf16(v[2 * bj][2], v[2 * bj][3]); w.z = cvt_pk_bf16(v[2 * bj + 1][0], v[2 * bj + 1][1]); w.w = cvt_pk_bf16(v[2 * bj + 1][2], v[2 * bj + 1][3]);
                    *(u32x4*)(rp + bj * HALF) = w; }
                __builtin_amdgcn_sched_barrier(0); }
    }
    __device__ __forceinline__ void operator()(const f32x4 (&acc)[2][2][4][2], const Unit& u, int wr, int wc, int fr, int fq) const { fr = opq(fr); fq = opq(fq);
        if (u.x == 0) { store_rows(acc, u, wr, wc, fr, fq); return; }
        const int rr = (u.x - 1) >> 4, k = (u.x - 1) & 15, wid = wr * 4 + wc, tl = wid * 64 + fq * 16 + fr;
        float* P = part + ((size_t)(rr * sp + k) << 16) + (size_t)tl * 4;
#pragma unroll
        for (int ai = 0; ai < 2; ++ai)
#pragma unroll
            for (int m = 0; m < 4; ++m)
#pragma unroll
                for (int bj = 0; bj < 2; ++bj)
#pragma unroll
                    for (int n = 0; n < 2; ++n) { const int idx = ((ai * 4 + m) * 2 + bj) * 2 + n; float* q = P + idx * 2048; const f32x4 vv = acc[ai][bj][m][n];
                        asm volatile("global_store_dwordx4 %0, %1, off sc1" :: "v"(q), "v"(vv) : "memory"); }
        asm volatile("s_waitcnt vmcnt(0)" ::: "memory");
        unsigned tk = 0u; if (fq * 16 + fr == 0) tk = __hip_atomic_fetch_add(cnt + rr * 8 + wid, 1u, __ATOMIC_RELAXED, __HIP_MEMORY_SCOPE_AGENT);
        tk = (unsigned)__builtin_amdgcn_readfirstlane((int)tk);
        if (tk + 1u == (unsigned)sp) {
            __builtin_amdgcn_fence(__ATOMIC_ACQUIRE, "agent"); asm volatile("s_waitcnt vmcnt(0)" ::: "memory");
            const float* P0 = part + ((size_t)(rr * sp) << 16) + (size_t)tl * 4;
            switch (sp) { case 2: reduce_store<2>(P0, u, wr, wc, fr, fq); break; case 4: reduce_store<4>(P0, u, wr, wc, fr, fq); break; case 7: reduce_store<7>(P0, u, wr, wc, fr, fq); break;
                          case 8: reduce_store<8>(P0, u, wr, wc, fr, fq); break; default: reduce_store<14>(P0, u, wr, wc, fr, fq); break; }
        }
    }
};

__device__ __forceinline__ void moe_gather(AP a, LAS unsigned char* lds, int vcu, int G) {
    const int tid = opq(threadIdx.x), lane = tid & 63, w = tid >> 6; unsigned char* ws = a->ws;
    LAS int* cl = (LAS int*)lds;
    LAS int* pre = cl + 2048;
    LAS int* off = pre + 8;
    LAS int* tot = off + 24;
    LAS int* sl = tot + 8;
    const int* cntb = (const int*)(ws + O_MISC + M_CNTB); const int* sel = (const int*)(ws + O_MISC + M_SEL);
    int* slot_of = (int*)(ws + O_MISC + M_SLOT);
    const bf16* HN = (const bf16*)(ws + O_HN); bf16* XG = (bf16*)(ws + O_XG);
    for (int i = tid; i < 2048; i += NTHREADS) cl[i] = cntb[i];
    __syncthreads();
    for (int g = vcu; g < 256; g += G) {
        if (tid < 8) { int s = 0, p = 0;
#pragma unroll 8
            for (int j = 0; j < 256; ++j) { const int v = cl[j * 8 + tid]; p += (j < g) ? v : 0; s += v; }
            pre[tid] = p; tot[tid] = s; }
        __syncthreads();
        if (tid == 0) { int o = 0; for (int e = 0; e < 8; ++e) { off[e] = o * 256; off[8 + e] = o; o += (tot[e] + 255) >> 8; } off[16] = o;
            if (g == 0) { int* T = (int*)(ws + O_MISC + M_TOT); for (int e = 0; e < 8; ++e) T[e] = tot[e]; for (int e = 0; e < 9; ++e) T[16 + e] = off[8 + e]; } }
        __syncthreads();
        if (w == 0) { const int tkn = g * 64 + lane; const int s0 = sel[tkn * 2], s1 = sel[tkn * 2 + 1]; int slot0 = 0, slot1 = 0;
            const unsigned long long lt = (1ull << lane) - 1ull;
#pragma unroll
            for (int e = 0; e < 8; ++e) { const unsigned long long mk = __ballot(s0 == e || s1 == e); const int rk = __popcll(mk & lt);
                if (s0 == e) slot0 = off[e] + pre[e] + rk; if (s1 == e) slot1 = off[e] + pre[e] + rk; }
            slot_of[tkn * 2] = slot0; slot_of[tkn * 2 + 1] = slot1; sl[lane * 2] = slot0; sl[lane * 2 + 1] = slot1; }
        __syncthreads();
        for (int p0 = w * 16; p0 < w * 16 + 16; p0 += 4) { u32x4 v[4][4];
#pragma unroll
            for (int r = 0; r < 4; ++r) { const int tkn = g * 64 + ((p0 + r) >> 1); const u32x4* sp_ = (const u32x4*)(HN + (size_t)tkn * D) + lane;
#pragma unroll
                for (int j = 0; j < 4; ++j) v[r][j] = sp_[64 * j]; }
#pragma unroll
            for (int r = 0; r < 4; ++r) { const int slot = sl[p0 + r];
                if (MOE_F8) { u32x2* d8 = (u32x2*)((unsigned char*)XG + (size_t)slot * D) + lane;
#pragma unroll
                    for (int j = 0; j < 4; ++j) { const u32x4 q = v[r][j]; u32x2 o8;
                        o8.x = cvt_fp8x4(bf_lo(q.x) * X8_SC, bf_hi(q.x) * X8_SC, bf_lo(q.y) * X8_SC, bf_hi(q.y) * X8_SC); o8.y = cvt_fp8x4(bf_lo(q.z) * X8_SC, bf_hi(q.z) * X8_SC, bf_lo(q.w) * X8_SC, bf_hi(q.w) * X8_SC);
                        d8[64 * j] = o8; } continue; }
                u32x4* d = (u32x4*)(XG + (size_t)slot * D) + lane;
#pragma unroll
                for (int j = 0; j < 4; ++j) d[64 * j] = v[r][j]; } }
        if (g < 8) { const int r0 = off[g] + tot[g], r1 = off[g] + (((tot[g] + 255) >> 8) << 8);
            for (int r = r0 + w; r < r1; r += NWAVES) {
                if (MOE_F8) { u32x2* d8 = (u32x2*)((unsigned char*)XG + (size_t)r * D) + lane;
#pragma unroll
                    for (int j = 0; j < 4; ++j) d8[64 * j] = (u32x2){0u, 0u}; continue; }
                u32x4* d = (u32x4*)(XG + (size_t)r * D) + lane;
#pragma unroll
                for (int j = 0; j < 4; ++j) d[64 * j] = (u32x4){0u, 0u, 0u, 0u}; } }
        __syncthreads();
    }
}
struct CombIdx { int s0, s1; float w0, w1; };
__device__ __forceinline__ CombIdx comb_idx(const unsigned char* ws, int row) { const int* slot_of = (const int*)(ws + O_MISC + M_SLOT); const float* gwt = (const float*)(ws + O_MISC + M_GWT);
    CombIdx c; c.s0 = slot_of[row * 2]; c.s1 = slot_of[row * 2 + 1]; c.w0 = gwt[row * 2]; c.w1 = gwt[row * 2 + 1]; return c; }
__device__ __forceinline__ void comb_load(const unsigned char* ws, int row, const CombIdx& c, int lane, f32x4 (&xv)[8], u32x2 (&p0)[8], u32x2 (&p1)[8]) {
    const f32x4* xr = (const f32x4*)((const float*)(ws + O_LAT) + (size_t)row * D);
    const u32x2* o0 = (const u32x2*)((const bf16*)(ws + O_OS) + (size_t)c.s0 * D); const u32x2* o1 = (const u32x2*)((const bf16*)(ws + O_OS) + (size_t)c.s1 * D);
#pragma unroll
    for (int j = 0; j < 8; ++j) { const int i4 = lane + 64 * j; xv[j] = xr[i4]; p0[j] = o0[i4]; p1[j] = o1[i4]; }
}
__device__ __forceinline__ void comb_row(AP a, int row, const CombIdx& c, int lane, const f32x4 (&xv)[8], const u32x2 (&p0)[8], const u32x2 (&p1)[8]) {
    const unsigned char* ws = a->ws; const float w0 = c.w0, w1 = c.w1;
    const float* g2 = (const float*)(ws + O_MOD) + ((size_t)9 + (row >> 11)) * 12288 + 5 * D;
    f32x4 v[8]; float s = 0.f;
#pragma unroll
    for (int j = 0; j < 8; ++j) { const int i4 = lane + 64 * j; const f32x4 gg = *(const f32x4*)(g2 + i4 * 4);
        f32x4 m; m.x = w0 * bf_lo(p0[j].x) + w1 * bf_lo(p1[j].x); m.y = w0 * bf_hi(p0[j].x) + w1 * bf_hi(p1[j].x); m.z = w0 * bf_lo(p0[j].y) + w1 * bf_lo(p1[j].y); m.w = w0 * bf_hi(p0[j].y) + w1 * bf_hi(p1[j].y);
        v[j] = xv[j] + gg * m; s += (v[j].x * v[j].x + v[j].y * v[j].y) + (v[j].z * v[j].z + v[j].w * v[j].w); }
    const float rstd = rsqrtf(wave_sum(s) * (1.f / D) + 1e-6f);
    f32x4* out = (f32x4*)(a->out + (size_t)row * D);
#pragma unroll
    for (int j = 0; j < 8; ++j) { const int i4 = lane + 64 * j; out[i4] = v[j] * rstd * *(const f32x4*)(a->in[26] + i4 * 4); }
}
__device__ __forceinline__ void moe_combine_phase(AP a, int gw, int NGW, int lane) {
    const unsigned char* ws = a->ws; int r = gw; if (r >= RL) return;
    CombIdx ci = comb_idx(ws, r), cn = ci; if (r + NGW < RL) cn = comb_idx(ws, r + NGW);
    f32x4 xv[8]; u32x2 p0[8], p1[8]; comb_load(ws, r, ci, lane, xv, p0, p1);
    for (; r < RL; r += NGW) {
        const int rn = r + NGW, rnn = rn + NGW; f32x4 xn[8]; u32x2 q0[8], q1[8]; CombIdx cnn = cn;
        if (rn < RL) comb_load(ws, rn, cn, lane, xn, q0, q1);
        if (rnn < RL) cnn = comb_idx(ws, rnn);
        comb_row(a, r, ci, lane, xv, p0, p1);
#pragma unroll
        for (int j = 0; j < 8; ++j) { xv[j] = xn[j]; p0[j] = q0[j]; p1[j] = q1[j]; }
        ci = cn; cn = cnn;
    }
}

constexpr int NPHASE = 26;
constexpr int l_min(int a, int b) { return a < b ? a : b; }
#ifndef PROBE_PHASE
#define PROBE_PHASE (-1)
#endif
#define REPS(k) (((k) == PROBE_PHASE) ? 2 : 1)
#ifndef CVB
#define CVB 125
#endif
constexpr int cvb(int n) { return (int)((long long)n * CVB / 100); }
#ifndef CVQ
#define CVQ 0, 5000, 5000, 11000, 9000, 30000, 10000, 0
#endif
constexpr int cvq[8] = {CVQ};
constexpr int CV_W00 = 0, CV_W01 = CV_W00 + cvb(cvq[0]), CV_T10 = CV_W01, CV_T11 = CV_T10 + cvb(cvq[1]), CV_MG0 = CV_T11, CV_MG1 = CV_MG0 + cvb(cvq[2]), CV_OUT0 = CV_MG1, CV_OUT1 = CV_OUT0 + cvb(cvq[3]),
              CV_FG0 = CV_OUT1, CV_FG1 = CV_FG0 + cvb(cvq[4]), CV_FD0 = CV_FG1, CV_FD1 = CV_FD0 + cvb(cvq[5]),
              CV_GU0 = N_MOE - cvb(cvq[7]), CV_GU1 = N_MOE,
              CV_WI0 = l_min(CV_FD1, CV_GU0), CV_WI1 = l_min(CV_WI0 + cvb(cvq[6]), CV_GU0), CV_FLUSH = CV_WI1;
static_assert(CV_GU0 >= N_MG + N_MU && CV_FD1 <= N_MOE, "conversion slices");
constexpr int CV_GUS = CV_GU0;
#define TAILCVT(total, c0, c1) do { const int rem_ = (total) % G; if (l == 0 || (c0) == CV_WI0 || (c0) == CV_GUS) { if (rem_ != 0 && bx >= rem_ && (c0) < N_MOE) cvt_moe_range(argp, lds, (c0), l_min((c1), N_MOE), (bx - rem_) * NWAVES + wave, (G - rem_) * NWAVES); __syncthreads(); } } while (0)
template <int l>
__device__ __forceinline__ void layer_phases(LAS unsigned char* lds, unsigned char* ws, const int lo, const int hi, const XcdBarrier& bar, const int G, const int bx, const int vcu, const int gw, const int NGW, const int tid, const int lane, const int wave) {
#define args (*kargs())
#define argp (kargs())
#define IN(k) (lo <= (k) && (k) < hi)
#define SEAM(k) do { if (IN(k) && IN((k) + 1)) { xcd_barrier(bar); if (PROBE_BAR) xcd_barrier(bar); } } while (0)
    const char* HNp = (const char*)(ws + O_HN);
    float* LAT = (float*)(ws + O_LAT);
        const int pb = 2 + 12 * l;
        const float* modl = (const float*)(ws + O_MOD) + (size_t)l * 9 * 12288;
        const int ntok = l == 0 ? 72 : 64;
        if (IN(pb + 0)) for (int rep = 0; rep < REPS(pb + 0); ++rep) { WinSched S{G, bx, l, HNp, (const char*)(ws + O_WIN) + (size_t)l * WIN_ROWS * 2048 * 2};
            EpiWin E{(bf16*)(ws + O_UT), (bf16*)(ws + O_UR), (bf16*)(ws + O_GG), (bf16*)(ws + O_SGF), (bf16*)(ws + O_SGR)}; gemm_phase<EpiWin, WinSched>(lds, 2048, 2048, S, E); if (l == 1) TAILCVT(1824, CV_WI0, CV_WI1); else TAILCVT(2016, CV_W00, CV_W01); }
        SEAM(pb + 0);
        if (IN(pb + 1)) for (int rep = 0; rep < REPS(pb + 1); ++rep) {
#if defined(PROBE_SKIP)
            if (rep == 1) scan_phase2<1, PROBE_SKIP>(argp, lds, l, NCHUNK * 8, vcu, G); else
#endif
            if (SCANV == 2) scan_phase2<1>(argp, lds, l, NCHUNK * 8, vcu, G); else scan_phase<1>(argp, lds, l, NCHUNK * 8, vcu, G);
#if DFT2
            { __syncthreads(); LAS f32x2* tab = (LAS f32x2*)lds;
              for (int m = opq(tid); m < 2048; m += NTHREADS) { float sn, cs; sincospif((float)m * (1.f / 1024.f), &sn, &cs); tab[m] = (f32x2){cs, sn}; }
              __syncthreads(); dft_stage1(argp, tab, (size_t)vcu * NTHREADS + opq(tid), (size_t)G * NTHREADS); __syncthreads(); }
#endif
            }
        SEAM(pb + 1);
        if (IN(pb + 2)) for (int rep = 0; rep < REPS(pb + 2); ++rep) { DftSched S{G, bx, l, (const char*)(ws + O_FL), (const char*)(ws + O_FLC), (const char*)(ws + O_UT), (const char*)(ws + O_ZT)}; EpiBf16Rows E{(bf16*)(ws + O_Y), 1024, true};
            gemm_phase<EpiBf16Rows, DftSched>(lds, 4096, UT_LD, S, E); carry_phase(argp, opq(gw), NGW); }
        SEAM(pb + 2);
        if (IN(pb + 3)) for (int rep = 0; rep < REPS(pb + 3); ++rep) { GridSched S{G, bx, ntok, 8, 16, (const char*)(ws + O_Y), (const char*)(ws + O_WFO) + (size_t)l * 2048 * 1024 * 2, (size_t)256 * 1024 * 2, (size_t)256 * 1024 * 2, 0, WGM_K1};
            EpiGate<false> E{(bf16*)(ws + O_T1), (const bf16*)(ws + O_SGF), nullptr}; gemm_phase<EpiGate<false>, GridSched>(lds, 1024, 1024, S, E); TAILCVT(ntok * 8, CV_T10, CV_T11);
            if (SCANV == 2) scan_phase2<2>(argp, lds, l, (l == 0 ? NCHUNK : 256) * 8, vcu, G); else scan_phase<2>(argp, lds, l, (l == 0 ? NCHUNK : 256) * 8, vcu, G); }
        SEAM(pb + 3);
        if (IN(pb + 4)) for (int rep = 0; rep < REPS(pb + 4); ++rep) { GridSched S{G, bx, ntok, 8, 16, (const char*)(ws + O_HR), (const char*)(ws + O_WRO) + (size_t)l * 2048 * 1024 * 2, (size_t)256 * 1024 * 2, (size_t)256 * 1024 * 2, 0, WGM_K1};
            EpiGate<true> E{(bf16*)(ws + O_MG), (const bf16*)(ws + O_SGR), (const bf16*)(ws + O_T1)}; gemm_phase<EpiGate<true>, GridSched>(lds, 1024, 1024, S, E); TAILCVT(ntok * 8, CV_MG0, CV_MG1); }
        SEAM(pb + 4);
        if (IN(pb + 5)) { GridSched S{G, bx, ntok, 8, 32, (const char*)(ws + O_MG), (const char*)(ws + O_WO) + (size_t)l * 2048 * 2048 * 2, (size_t)256 * 2048 * 2, (size_t)256 * 2048 * 2};
            EpiResid<l == 0> E{LAT, modl, 2, args.in[0], args.in[2]}; gemm_phase<EpiResid<l == 0>, GridSched>(lds, 2048, 2048, S, E); TAILCVT(ntok * 8, CV_OUT0, CV_OUT1); }
        SEAM(pb + 5);
        if (IN(pb + 6)) for (int rep = 0; rep < REPS(pb + 6); ++rep) {
            if (l == 0) { const int ln = opq(lane); f32x4 v[8]; int r = NORM_REV ? R - 1 - gw : gw; const int st = NORM_REV ? -NGW : NGW;
                if (r >= 0 && r < R) norm_load(v, LAT + (size_t)r * D, ln);
                for (; r >= 0 && r < R; r += st) { f32x4 vn[8]; const int rn = r + st; if (rn >= 0 && rn < R) norm_load(vn, LAT + (size_t)rn * D, ln);
                    norm_row<false, FFN_F8>(v, args.in[7], modl, 3, 4, (bf16*)(ws + O_HN), r, ln, nullptr, nullptr, nullptr);
#pragma unroll
                    for (int j = 0; j < 8; ++j) v[j] = vn[j]; } }
            else {
                LAS float* rt = (LAS float*)lds; for (int i = tid; i < 2048 * 8; i += NTHREADS) rt[i] = args.in[22][i];
                LAS int* gs = (LAS int*)(lds + 65536);
                __syncthreads();
                int* sel = (int*)(ws + O_MISC + M_SEL); float* gwt = (float*)(ws + O_MISC + M_GWT); int* cntb = (int*)(ws + O_MISC + M_CNTB);
                for (int g = vcu; g < 256; g += G) {
                    { const int ln = opq(lane); f32x4 v[8]; norm_load(v, LAT + (size_t)(g * 64 + wave * 8) * D, ln);
                      for (int k = 0; k < 8; ++k) { const int r = g * 64 + wave * 8 + k; f32x4 vn[8]; if (k < 7) norm_load(vn, LAT + (size_t)(r + 1) * D, ln);
                        const int pk = norm_row<true>(v, args.in[7] + D, modl, 3, 4, (bf16*)(ws + O_HN), r, ln, rt, sel, gwt);
                        if (lane == 0) { gs[(wave * 8 + k) * 2] = pk & 255; gs[(wave * 8 + k) * 2 + 1] = pk >> 8; }
#pragma unroll
                        for (int j = 0; j < 8; ++j) v[j] = vn[j]; } }
                    __syncthreads();
                    if (wave == 0) { const int s0 = gs[lane * 2], s1 = gs[lane * 2 + 1];
#pragma unroll
                        for (int e = 0; e < 8; ++e) { const unsigned long long mk = __ballot(s0 == e || s1 == e); if (lane == e) cntb[g * 8 + e] = __popcll(mk); } }
                    __syncthreads();
                }
            }
        }
        SEAM(pb + 6);
        if (l == 1) { if (IN(pb + 7)) { moe_gather(argp, lds, vcu, G); __syncthreads(); cvt_moe_range(argp, lds, CV_FLUSH, CV_GUS, gw, NGW); } SEAM(pb + 7); }
        if (IN(pb + 8)) for (int rep = 0; rep < REPS(pb + 8); ++rep) {
            if (l == 0) { GridSched S{G, bx, 72, 44, FFN_F8 ? 16 : 32, HNp, (const char*)(ws + O_FGU), (size_t)256 * 2048 * (FFN_F8 ? 1 : 2), (size_t)256 * 2048 * (FFN_F8 ? 1 : 2)};
#if defined(PROBE_ALT)
#if PROBE_ALT == 2
                if (rep == 1) { EpiSwiglu E{(bf16*)(ws + O_HIDM + (size_t)80 * 1024 * 1024), DFF}; gemm_phase<EpiSwiglu, GridSched>(lds, 2048, 2048, S, E); } else
#else
                if (rep == 1) { EpiNull E{(float*)(ws + O_HIDM)}; gemm_phase<EpiNull, GridSched>(lds, 2048, 2048, S, E); } else
#endif
#endif
                {
#if FFN_F8
                  { EpiSwigluF8 E{ws + O_HID, 1.f / (X8_SC * W8_SC), 22}; gemm_phase<EpiSwigluF8, GridSched, G_ALIGN, G_SP2, 0, 1>(lds, 1024, 1024, S, E); }
#else
                  { EpiSwiglu E{(bf16*)(ws + O_HID), DFF, FFN_BLK ? 44 : 0}; gemm_phase<EpiSwiglu, GridSched>(lds, 2048, 2048, S, E); }
#endif
                  TAILCVT(72 * 44, CV_FG0, CV_FG1); } }
            else { LAS int* tbl = (LAS int*)(lds + MISC_OFF + 256); if (tid < 9) tbl[tid] = ((const int*)(ws + O_MISC + M_TOT))[16 + tid]; __syncthreads();
                MoeSched S{G, bx, 56, MOE_F8 ? 16 : 32, tbl, (const char*)(ws + O_XG), (const char*)(ws + O_MGU), (size_t)256 * 2048 * (MOE_F8 ? 1 : 2), (size_t)256 * 2048 * (MOE_F8 ? 1 : 2), (size_t)14336 * 2048 * (MOE_F8 ? 1 : 2), 1, 0};
                if (MOE_STAGGER) {
                    const unsigned long long t0 = __builtin_amdgcn_s_memrealtime(), dl = (unsigned long long)(((bx >> 3) & 3) * MOE_STAGGER);
                    while (__builtin_amdgcn_s_memrealtime() - t0 < dl) __builtin_amdgcn_s_sleep(8); }
#if defined(PROBE_MOE)
                if (rep == 1 && PROBE_MOE == 3) { EpiSwigluWrap E3{(bf16*)(ws + O_OS), DE}; gemm_phase<EpiSwigluWrap, MoeSched>(lds, 2048, 2048, S, E3); } else
                if (rep == 1) { MoeSched S2 = S; if (PROBE_MOE == 2) S2.bexp = 0; EpiNull E2{(float*)(ws + O_OS)}; gemm_phase<EpiNull, MoeSched>(lds, 2048, MOE_BLK ? 128 : 2048, S2, E2, 256, MOE_BLK ? 65536 : 256); } else
#endif
                {
#if MOE_F8
                  { EpiSwigluF8 E{ws + O_HIDM, 1.f / (X8_SC * W8_SC)}; gemm_phase<EpiSwigluF8, MoeSched, G_ALIGN, G_SP2, MOE_WNT, 1>(lds, 1024, 128, S, E, 256, 65536); }
#else
                  { EpiSwigluT<MOE_NT != 0> E{(bf16*)(ws + O_HIDM), DE, MOE_BLK ? 56 : 0}; gemm_phase<EpiSwigluT<MOE_NT != 0>, MoeSched, G_ALIGN, G_SP2, MOE_WNT>(lds, 2048, MOE_BLK ? 128 : 2048, S, E, 256, MOE_BLK ? 65536 : 256); }
#endif
                  { const int rem2 = (tbl[8] * 56) % G;
                    if (rem2 == 0 || G - rem2 < 24) { cvt_moe_range(argp, lds, CV_GUS, CV_GU1, gw, NGW); __syncthreads(); } else TAILCVT(tbl[8] * 56, CV_GUS, CV_GU1); } } }
        }
        SEAM(pb + 8);
        if (IN(pb + 9)) for (int rep = 0; rep < (l == 1 ? REPS(pb + 9) : 1); ++rep) {
            if (l == 0) { GridSched S{G, bx, 72, 8, FFN_F8 ? 44 : 88, (const char*)(ws + O_HID), (const char*)(ws + O_FD), (size_t)256 * DFF * (FFN_F8 ? 1 : 2), (size_t)256 * DFF * (FFN_F8 ? 1 : 2), FFN_DOWN_REV, WGM_FD};
#if FFN_F8
                { EpiResid<false> E{LAT, modl, 5, nullptr, nullptr, 1.f / (H8_SC * W8_SC)}; gemm_phase<EpiResid<false>, GridSched, G_ALIGN, G_SP2, 0, 1>(lds, 128, DFF / 2, S, E, 65536, 256); }
#else
                { EpiResid<false> E{LAT, modl, 5, nullptr, nullptr}; gemm_phase<EpiResid<false>, GridSched>(lds, FFN_BLK ? 128 : DFF, DFF, S, E, FFN_BLK ? 65536 : 256, 256); }
#endif
                TAILCVT(72 * 8, CV_FD0, CV_FD1); }
            else { LAS int* tbl = (LAS int*)(lds + MISC_OFF + 256); if (tid < 9) tbl[tid] = ((const int*)(ws + O_MISC + M_TOT))[16 + tid]; __syncthreads();
#if MOE_TAILSPLIT
                int sp = 1; { const int U = tbl[8] * 8, R = U % G; if (R > 0) { if (R * 14 <= G) sp = 14; else if (!MOE_F8 && R * 8 <= G) sp = 8; else if (R * 7 <= G) sp = 7; else if (R * 4 <= G) sp = 4; else if (R * 2 <= G) sp = 2; } }
#if defined(FORCE_SP)
                { const int U = tbl[8] * 8, R = U % G; if (R > 0 && R * FORCE_SP <= G) sp = FORCE_SP; }
#endif
                MoeDownSched S{G, bx, sp, tbl, (const char*)(ws + O_HIDM), (const char*)(ws + O_MD), (size_t)256 * DE * (MOE_F8 ? 1 : 2), (size_t)256 * DE * (MOE_F8 ? 1 : 2), (size_t)2048 * DE * (MOE_F8 ? 1 : 2)};
                EpiMoeDown E{(bf16*)(ws + O_OS), (float*)(ws + O_XG), (unsigned*)(ws + O_CTL) + CW_MOEC, sp, MOE_F8 ? 1.f / (H8_SC * W8_SC) : 1.f};
                gemm_phase<EpiMoeDown, MoeDownSched, G_ALIGN, G_SP2, MOE_WNT, MOE_F8>(lds, MOE_BLK ? 128 : DE, MOE_BLK ? 128 : DE, S, E, MOE_BLK ? 65536 : 256, MOE_BLK ? 65536 : 256); }
#else
                MoeSched S{G, bx, 8, 112 / MOE_KSPLIT, tbl, (const char*)(ws + O_HIDM), (const char*)(ws + O_MD), (size_t)256 * DE * 2, (size_t)256 * DE * 2, (size_t)2048 * DE * 2, MOE_KSPLIT, (size_t)3584 * 2};
                EpiBf16Rows E{(bf16*)(ws + O_OS), 2048, false}; gemm_phase<EpiBf16Rows, MoeSched>(lds, DE, DE, S, E); }
#endif
        }
        SEAM(pb + 9);
        if (IN(pb + 10)) for (int rep = 0; rep < REPS(pb + 10); ++rep) {
            if (l == 0) { const int ln = opq(lane); f32x4 v[8]; int r = gw; if (r < R) norm_load(v, LAT + (size_t)r * D, ln);
                for (; r < R; r += NGW) { f32x4 vn[8]; const int rn = r + NGW; if (rn < R) norm_load(vn, LAT + (size_t)rn * D, ln);
                    norm_row<false>(v, args.in[6] + D, (const float*)(ws + O_MOD) + (size_t)9 * 12288, 0, 1, (bf16*)(ws + O_HN), r, ln, nullptr, nullptr, nullptr);
#pragma unroll
                    for (int j = 0; j < 8; ++j) v[j] = vn[j]; } }
            else { moe_combine_phase(argp, opq(gw), NGW, opq(lane)); }
        }
        if (l == 0) SEAM(pb + 11);
    #undef IN
#undef SEAM
#undef args
#undef argp
}
__global__ void __launch_bounds__(NTHREADS, 2) mega(Args args_unused) {
#define args (*kargs())
#define argp (kargs())
    extern __shared__ __attribute__((aligned(16))) unsigned char lds_raw[];
#if CODE_SHIFT >= 1
    asm volatile("s_nop 0");
#endif
#if CODE_SHIFT >= 2
    asm volatile("s_nop 0");
#endif
#if CODE_SHIFT >= 3
    asm volatile("s_nop 0");
#endif
#if CODE_SHIFT >= 4
    asm volatile("s_nop 0");
#endif
#if CODE_SHIFT >= 8
    asm volatile("s_nop 0\ns_nop 0\ns_nop 0\ns_nop 0");
#endif
    LAS unsigned char* lds = (LAS unsigned char*)lds_raw;
    volatile LAS unsigned* MISC = (volatile LAS unsigned*)(lds + MISC_OFF);
    int tid = threadIdx.x; asm volatile("" : "+v"(tid));
    const int lane = tid & 63, wave = __builtin_amdgcn_readfirstlane(tid >> 6);
    const int G = gridDim.x, bx = blockIdx.x; const int vcu = (G % 8 == 0) ? (bx % 8) * (G / 8) + bx / 8 : bx;
    const int gw = vcu * NWAVES + wave, NGW = G * NWAVES;
    unsigned char* ws = args.ws;
    for (int u = tid; u < 128; u += NTHREADS) MISC[u] = 0u;
    __syncthreads();
    const int lo = args.ph_lo, hi = args.ph_hi;
    XcdBarrier bar; bar.bar = (unsigned*)(ws + O_CTL) + CW_BAR; bar.x = 0; bar.st = nullptr;
    if (hi - lo > 1) bar = xcd_barrier_post((unsigned*)(ws + O_CTL) + CW_BAR + args.bar_region * XCD_BAR_WORDS, MISC + 8);
#define IN(k) (lo <= (k) && (k) < hi)
#define SEAM(k) do { if (IN(k) && IN((k) + 1)) { xcd_barrier(bar); if (PROBE_BAR) xcd_barrier(bar); } } while (0)
    const char* HNp = (const char*)(ws + O_HN);
    float* LAT = (float*)(ws + O_LAT);

    if (IN(0)) for (int rep = 0; rep < REPS(0); ++rep) { __syncthreads(); p0_ada(argp, lds, vcu, G); __syncthreads(); p0_convert(argp, lds, gw, NGW); __syncthreads();
        { LAS f32x2* tab = (LAS f32x2*)lds; for (int m = tid; m < 2048; m += NTHREADS) { float sn, cs; sincospif((float)m * (1.f / 1024.f), &sn, &cs); tab[m] = (f32x2){cs * 0.022097086912079608f, sn * 0.022097086912079608f}; } __syncthreads();
          p0_elementwise(argp, (size_t)vcu * NTHREADS + tid, (size_t)G * NTHREADS, tab); } }
    SEAM(0);
    if (IN(1)) {
        { const int ln = opq(lane); f32x4 v[8]; int r = gw; const float* x0 = args.in[0]; const float* c0 = args.in[2];
          if (r < R) norm_load(v, r < RL ? x0 + (size_t)r * D : c0 + (size_t)(r - RL) * D, ln);
          for (; r < R; r += NGW) { f32x4 vn[8]; const int rn = r + NGW; if (rn < R) norm_load(vn, rn < RL ? x0 + (size_t)rn * D : c0 + (size_t)(rn - RL) * D, ln);
              norm_row<false>(v, args.in[6], (const float*)(ws + O_MOD), 0, 1, (bf16*)(ws + O_HN), r, ln, nullptr, nullptr, nullptr);
#pragma unroll
              for (int j = 0; j < 8; ++j) v[j] = vn[j]; } }
        { FoldSched S{G, bx, (const char*)(ws + O_DG), (const char*)(ws + O_WUF)}; EpiFold E{(bf16*)(ws + O_WIN)}; gemm_phase<EpiFold, FoldSched>(lds, 256, 1024, S, E); }
    }
    SEAM(1);
    layer_phases<0>(lds, ws, lo, hi, bar, G, bx, vcu, gw, NGW, tid, lane, wave);
    layer_phases<1>(lds, ws, lo, hi, bar, G, bx, vcu, gw, NGW, tid, lane, wave);
#undef IN
#undef SEAM
#undef args
#undef argp
}
}
#ifndef MK_MODE
#define MK_MODE 0
#endif
extern "C" void kernel_launch(void* const* d_in, const int* in_sizes, int n_in, void* d_out, int out_size, void* d_ws, size_t ws_size, hipStream_t stream) {
    static int grid = 0;
    if (grid == 0) {
        if (n_in != 27 || out_size != fk::RL * fk::D || ws_size < fk::O_END) { fprintf(stderr, "kernel_launch: unexpected problem (n_in %d out %d ws %zu need %zu)\n", n_in, out_size, ws_size, (size_t)fk::O_END); grid = -1; return; }
        int dev = 0, cus = 0, per_cu = 0;
        if (hipGetDevice(&dev) != hipSuccess || hipDeviceGetAttribute(&cus, hipDeviceAttributeMultiprocessorCount, dev) != hipSuccess) { grid = -1; return; }
        if (hipFuncSetAttribute((const void*)fk::mega, hipFuncAttributeMaxDynamicSharedMemorySize, fk::LDS_BYTES) != hipSuccess) { fprintf(stderr, "kernel_launch: hipFuncSetAttribute failed\n"); grid = -1; return; }
        if (hipOccupancyMaxActiveBlocksPerMultiprocessor(&per_cu, (const void*)fk::mega, fk::NTHREADS, fk::LDS_BYTES) != hipSuccess || per_cu < 1) fprintf(stderr, "kernel_launch: occupancy query says %d\n", per_cu);
        (void)hipGetLastError();
        grid = cus;
    }
    if (grid < 0) return;
    (void)hipMemsetAsync((char*)d_ws + fk::O_CTL, 0, fk::CTL_ZERO_BYTES, stream);
    fk::Args a{};
    for (int i = 0; i < 27; ++i) a.in[i] = (const float*)d_in[i];
    a.out = (float*)d_out; a.ws = (unsigned char*)d_ws; a.pad = 0;
#if MK_MODE == 0
    a.ph_lo = 0; a.ph_hi = fk::NPHASE; a.bar_region = 0;
    hipLaunchKernelGGL(fk::mega, dim3(grid), dim3(fk::NTHREADS), fk::LDS_BYTES, stream, a);
#else
    for (int p = 0; p < fk::NPHASE; ++p) { a.ph_lo = p; a.ph_hi = p + 1; a.bar_region = p;
        hipLaunchKernelGGL(fk::mega, dim3(grid), dim3(fk::NTHREADS), fk::LDS_BYTES, stream, a); }
#endif
}
```

```cpp
#include <hip/hip_runtime.h>
#include <cstdio>
#include <cstdint>
namespace fk {
#define GAS __attribute__((address_space(1)))
#define LAS __attribute__((address_space(3)))
typedef unsigned short bf16;
typedef short bf16x8 __attribute__((ext_vector_type(8)));
typedef float f32x4 __attribute__((ext_vector_type(4)));
typedef float f32x2 __attribute__((ext_vector_type(2)));
typedef unsigned u32x4 __attribute__((ext_vector_type(4)));
typedef unsigned u32x2 __attribute__((ext_vector_type(2)));
#define LDS_WAIT() asm volatile("s_waitcnt lgkmcnt(0)" ::: "memory")
#define VM_WAIT() asm volatile("s_waitcnt vmcnt(0)" ::: "memory")

typedef int i32x8 __attribute__((ext_vector_type(8)));
typedef int i32x4 __attribute__((ext_vector_type(4)));
__device__ __forceinline__ unsigned cvt_fp8x4(float a, float b, float c, float d) {
    a = __builtin_amdgcn_fmed3f(a, -448.f, 448.f); b = __builtin_amdgcn_fmed3f(b, -448.f, 448.f); c = __builtin_amdgcn_fmed3f(c, -448.f, 448.f); d = __builtin_amdgcn_fmed3f(d, -448.f, 448.f);
    int r = __builtin_amdgcn_cvt_pk_fp8_f32(a, b, 0, false); r = __builtin_amdgcn_cvt_pk_fp8_f32(c, d, r, true); return (unsigned)r; }
__device__ __forceinline__ unsigned cvt_pk_bf16(float lo, float hi) { unsigned r; asm volatile("v_cvt_pk_bf16_f32 %0, %1, %2" : "=v"(r) : "v"(lo), "v"(hi)); return r; }
__device__ __forceinline__ float bf_lo(unsigned w) { return __uint_as_float(w << 16); }
__device__ __forceinline__ float bf_hi(unsigned w) { return __uint_as_float(w & 0xffff0000u); }
__device__ __forceinline__ float fexp(float x) { return __builtin_amdgcn_exp2f(x * 1.4426950408889634f); }
__device__ __forceinline__ float frcp(float x) { return __builtin_amdgcn_rcpf(x); }
__device__ __forceinline__ float fsigm(float x) { return frcp(1.f + fexp(-x)); }
__device__ __forceinline__ float fsilu(float x) { return x * frcp(1.f + fexp(-x)); }
__device__ __forceinline__ float fgelu(float x) { const float u = 1.5957691216057308f * (x + 0.044715f * x * x * x); return x * frcp(1.f + fexp(-u)); }
__device__ __forceinline__ int opq(int v) { asm volatile("" : "+v"(v)); return v; }
__device__ __forceinline__ float wave_sum(float v) {
#pragma unroll
    for (int o = 1; o < 64; o <<= 1) v += __shfl_xor(v, o);
    return v;
}

#ifndef G_WGM
#define G_WGM 4
#endif
constexpr int BM = 256, BK = 64, HALF = 128, HTB = HALF * BK * 2, STAGE_BYTES = 8 * HTB, NXCD = 8, WGM = G_WGM;
__device__ __forceinline__ int lds_byte(int r, int c) { const int st = (r >> 4) * 2 + (c >> 5), rr = r & 15, cc = c & 31, ob = rr * 64 + cc * 2; return st * 1024 + (ob ^ (((ob >> 9) & 1) << 5)); }
__device__ __forceinline__ void stage_rc(int b, int& R, int& C) { const int st = b / 1024, sb = b % 1024, swz = sb ^ (((sb >> 9) & 1) << 5); R = (st >> 1) * 16 + swz / 64; C = (st & 1) * 32 + (swz % 64) / 2; }
__device__ __forceinline__ int perm32(int rho) { const int n = rho >> 4, i = rho & 15; return 8 * (i >> 2) + 4 * n + (i & 3); }

struct Unit { const char* A; const char* B; int pm, pn, kind, nt, x; };

__device__ __forceinline__ void tile_of(int wgid, int nM, int nN, int& pm, int& pn, const int wgm = WGM) {
    const int nwg = nM * nN; { const int q = nwg / NXCD, r = nwg % NXCD, xcd = wgid % NXCD, off = wgid / NXCD; wgid = (xcd < r ? xcd * (q + 1) : r * (q + 1) + (xcd - r) * q) + off; }
    const int nig = wgm * nN, gid = wgid / nig, fm = gid * wgm, gsz = (nM - fm) < wgm ? (nM - fm) : wgm;
    pm = fm + ((wgid % nig) % gsz); pn = (wgid % nig) / gsz;
}

#ifndef G_ALIGN
#define G_ALIGN true
#endif
#ifndef G_SP2
#define G_SP2 true
#endif
template <int F8> struct pg8_frag { typedef bf16x8 T; static constexpr int NK = 2;
    static __device__ __forceinline__ T ld(const LAS unsigned char* p) { return *(const LAS bf16x8*)p; }
    static __device__ __forceinline__ T cat(i32x4 a, i32x4 b) { (void)b; return __builtin_bit_cast(bf16x8, a); }
    static __device__ __forceinline__ f32x4 mma(T b, T a, f32x4 c) { return __builtin_amdgcn_mfma_f32_16x16x32_bf16(b, a, c, 0, 0, 0); } };
template <> struct pg8_frag<1> { typedef i32x8 T; static constexpr int NK = 1;
    static __device__ __forceinline__ T ld(const LAS unsigned char* p) { return *(const LAS i32x8*)p; }
    static __device__ __forceinline__ T cat(i32x4 a, i32x4 b) { return __builtin_shufflevector(a, b, 0, 1, 2, 3, 4, 5, 6, 7); }
    static __device__ __forceinline__ f32x4 mma(T b, T a, f32x4 c) { asm volatile("v_mfma_f32_16x16x128_f8f6f4 %0, %1, %2, %0" : "+v"(c) : "v"(b), "v"(a)); return c; } };
template <class Epi, class Sched, bool ALIGN_EPI = G_ALIGN, bool SP2 = G_SP2, int BAUX = 0, int F8 = 0>
#define PG8_CAT(x, y) __builtin_shufflevector(__builtin_bit_cast(i32x4, x), __builtin_bit_cast(i32x4, y), 0, 1, 2, 3, 4, 5, 6, 7)
__device__ __forceinline__ void gemm_phase(LAS unsigned char* lds, const int lda, const int ldb, const Sched& S, const Epi& E, const size_t kpairA = 256, const size_t kpairB = 256) {
    int tid = threadIdx.x; asm volatile("" : "+v"(tid));
    const int wid = __builtin_amdgcn_readfirstlane(tid >> 6), lane = tid & 63, wr = wid >> 2, wc = wid & 3, fr = lane & 15, fq = lane >> 4;
    unsigned voffA[2], voffB[2];
#pragma unroll
    for (int i = 0; i < 2; ++i) { int R, C; stage_rc(tid * 16 + i * 8192, R, C); const int Rb = Epi::PERM ? ((R & ~31) + perm32(R & 31)) : R;
        voffA[i] = (unsigned)(R * lda + C) * 2u; voffB[i] = (unsigned)(Rb * ldb + C) * 2u; }
    const size_t kstep = (size_t)(BK * 2);
    const size_t hstepA = (size_t)HALF * lda * 2, hstepB = (size_t)HALF * ldb * 2;
    const unsigned ldsw = (unsigned)wid * 1024u;
    const int aoff = lds_byte(wr * 64 + fr, fq * 8), boff = lds_byte(wc * 32 + fr, fq * 8);
#define PG8_SA(b, h) (((b) * 2 + (h)) * HTB)
#define PG8_SB(b, h) ((4 + (b) * 2 + (h)) * HTB)
#define PG8_STAGE(bufoff, gbase, voff) do { const char* gb_ = (const char*)(gbase); asm volatile("" : "+s"(gb_)); _Pragma("unroll") for (int _i = 0; _i < 2; ++_i) { unsigned vo_ = (voff)[_i]; asm volatile("" : "+v"(vo_)); \
        __builtin_amdgcn_global_load_lds((const unsigned*)(gb_ + vo_), (LAS unsigned*)(lds + (bufoff) + ldsw + _i * 8192), 16, 0, 0); } } while (0)
#define PG8_STAGEB(bufoff, gbase, voff) do { const char* gb_ = (const char*)(gbase); asm volatile("" : "+s"(gb_)); _Pragma("unroll") for (int _i = 0; _i < 2; ++_i) { unsigned vo_ = (voff)[_i]; asm volatile("" : "+v"(vo_)); \
        __builtin_amdgcn_global_load_lds((const unsigned*)(gb_ + vo_), (LAS unsigned*)(lds + (bufoff) + ldsw + _i * 8192), 16, 0, BAUX); } } while (0)
#define PG8_LDA(dst, b, h) do { _Pragma("unroll") for (int m = 0; m < 4; ++m) { if constexpr (F8) dst[m][0] = pg8_frag<F8>::cat(*(const LAS i32x4*)(lds + PG8_SA(b, h) + aoff + m * 2048), *(const LAS i32x4*)(lds + PG8_SA(b, h) + aoff + m * 2048 + 1024)); \
        else { _Pragma("unroll") for (int k = 0; k < 2; ++k) dst[m][k] = pg8_frag<F8>::ld(lds + PG8_SA(b, h) + aoff + m * 2048 + k * 1024); } } } while (0)
#define PG8_LDB(dst, b, h) do { _Pragma("unroll") for (int n = 0; n < 2; ++n) { if constexpr (F8) dst[n][0] = pg8_frag<F8>::cat(*(const LAS i32x4*)(lds + PG8_SB(b, h) + boff + n * 2048), *(const LAS i32x4*)(lds + PG8_SB(b, h) + boff + n * 2048 + 1024)); \
        else { _Pragma("unroll") for (int k = 0; k < 2; ++k) dst[n][k] = pg8_frag<F8>::ld(lds + PG8_SB(b, h) + boff + n * 2048 + k * 1024); } } } while (0)
#ifndef G_PRIO
#define G_PRIO 1
#endif
#ifndef G_KOUT
#define G_KOUT 0
#endif
#if G_KOUT
#define PG8_MMA(ai, bj, At, Bt) do { if (G_PRIO) __builtin_amdgcn_s_setprio(G_PRIO); _Pragma("unroll") for (int k = 0; k < 2; ++k) _Pragma("unroll") for (int m = 0; m < 4; ++m) _Pragma("unroll") for (int n = 0; n < 2; ++n) \
        acc[ai][bj][m][n] = __builtin_amdgcn_mfma_f32_16x16x32_bf16(Bt[n][k], At[m][k], acc[ai][bj][m][n], 0, 0, 0); if (G_PRIO) __builtin_amdgcn_s_setprio(0); } while (0)
#else
#define PG8_MMA(ai, bj, At, Bt) do { if (G_PRIO) __builtin_amdgcn_s_setprio(G_PRIO); \
        if constexpr (F8) { _Pragma("unroll") for (int m = 0; m < 4; ++m) _Pragma("unroll") for (int n = 0; n < 2; ++n) \
            acc[ai][bj][m][n] = pg8_frag<F8>::mma(Bt[n][0], At[m][0], acc[ai][bj][m][n]); } \
        else { _Pragma("unroll") for (int m = 0; m < 4; ++m) _Pragma("unroll") for (int n = 0; n < 2; ++n) _Pragma("unroll") for (int k = 0; k < 2; ++k) \
            acc[ai][bj][m][n] = pg8_frag<F8>::mma(Bt[n][k], At[m][k], acc[ai][bj][m][n]); } if (G_PRIO) __builtin_amdgcn_s_setprio(0); } while (0)
#endif
#ifndef G_MMA2
#define G_MMA2 0
#endif
#if G_MMA2
#define PG8_MMA2(ai, At, Ba, Bb) do { __builtin_amdgcn_s_setprio(1); _Pragma("unroll") for (int m = 0; m < 4; ++m) _Pragma("unroll") for (int n = 0; n < 2; ++n) _Pragma("unroll") for (int k = 0; k < 2; ++k) \
        acc[ai][0][m][n] = __builtin_amdgcn_mfma_f32_16x16x32_bf16(Ba[n][k], At[m][k], acc[ai][0][m][n], 0, 0, 0); \
        _Pragma("unroll") for (int m = 0; m < 4; ++m) _Pragma("unroll") for (int n = 0; n < 2; ++n) _Pragma("unroll") for (int k = 0; k < 2; ++k) \
        acc[ai][1][m][n] = __builtin_amdgcn_mfma_f32_16x16x32_bf16(Bb[n][k], At[m][k], acc[ai][1][m][n], 0, 0, 0); __builtin_amdgcn_s_setprio(0); } while (0)
#else
#define PG8_MMA2(ai, At, Ba, Bb) do { PG8_MMA(ai, 0, At, Ba); PG8_MMA(ai, 1, At, Bb); } while (0)
#endif
#define PG8_WAIT_V(n) asm volatile("s_waitcnt vmcnt(" #n ")" ::: "memory")
#define PG8_WAIT_L(n) asm volatile("s_waitcnt lgkmcnt(" #n ")" ::: "memory")
#define PG8_BAR __builtin_amdgcn_s_barrier()
#define PG8_SCHED __builtin_amdgcn_sched_barrier(0)
    Unit cur, nxt; int ui = 0;
    if (!S.next(0, cur)) return;
    f32x4 acc[2][2][4][2];
#pragma unroll
    for (int a = 0; a < 2; ++a)
#pragma unroll
        for (int b = 0; b < 2; ++b)
#pragma unroll
            for (int m = 0; m < 4; ++m)
#pragma unroll
                for (int n = 0; n < 2; ++n) acc[a][b][m][n] = (f32x4){0.f, 0.f, 0.f, 0.f};
    typename pg8_frag<F8>::T At[4][pg8_frag<F8>::NK], B0[2][pg8_frag<F8>::NK], B1[2][pg8_frag<F8>::NK];
    const char* cA = cur.A; const char* cB = cur.B;
    if constexpr (SP2) {
        PG8_STAGEB(PG8_SB(0, 0), cB, voffB); PG8_STAGEB(PG8_SB(0, 1), cB + hstepB, voffB); PG8_STAGE(PG8_SA(0, 0), cA, voffA); PG8_STAGE(PG8_SA(0, 1), cA + hstepA, voffA);
        if (wr == 1) PG8_BAR;
        PG8_WAIT_V(2); PG8_BAR;
        PG8_STAGEB(PG8_SB(1, 0), cB + kstep, voffB); PG8_STAGE(PG8_SA(1, 0), cA + kstep, voffA); PG8_STAGEB(PG8_SB(1, 1), cB + hstepB + kstep, voffB);
        PG8_WAIT_V(6); PG8_BAR;
    } else {
        PG8_STAGEB(PG8_SB(0, 0), cB, voffB); PG8_STAGE(PG8_SA(0, 0), cA, voffA); PG8_STAGEB(PG8_SB(0, 1), cB + hstepB, voffB); PG8_STAGE(PG8_SA(0, 1), cA + hstepA, voffA);
        if (wr == 1) PG8_BAR;
        PG8_WAIT_V(4); PG8_BAR;
        PG8_STAGEB(PG8_SB(1, 0), cB + kstep, voffB); PG8_STAGE(PG8_SA(1, 0), cA + kstep, voffA); PG8_STAGEB(PG8_SB(1, 1), cB + hstepB + kstep, voffB);
        PG8_WAIT_V(6); PG8_BAR;
    }
    for (;;) {
        const bool has_next = S.next(ui + 1, nxt);
        const char* nA = has_next ? nxt.A : cA; const char* nB = has_next ? nxt.B : cB;
        const int nt = cur.nt;
        for (int t = 0; t < nt; t += 2) {
            const bool last = (t == nt - 2);
            const char* a1 = cA + (size_t)(t >> 1) * kpairA + kstep;
            const char* a2 = last ? nA : cA + (size_t)((t >> 1) + 1) * kpairA; const char* b2 = last ? nB : cB + (size_t)((t >> 1) + 1) * kpairB;
            const char* a3 = a2 + kstep; const char* b3 = b2 + kstep;
            if constexpr (SP2) {
            PG8_LDB(B0, 0, 0); PG8_LDB(B1, 0, 1); PG8_SCHED; PG8_LDA(At, 0, 0); PG8_STAGE(PG8_SA(1, 1), a1 + hstepA, voffA);
            PG8_WAIT_V(8); PG8_WAIT_L(0); PG8_BAR; PG8_MMA2(0, At, B0, B1); PG8_BAR; PG8_SCHED;
            PG8_LDA(At, 0, 1); PG8_STAGEB(PG8_SB(0, 0), b2, voffB); PG8_STAGEB(PG8_SB(0, 1), b2 + hstepB, voffB); PG8_STAGE(PG8_SA(0, 0), a2, voffA);
            PG8_WAIT_V(8); PG8_WAIT_L(0); PG8_BAR; PG8_MMA2(1, At, B0, B1); PG8_BAR; PG8_SCHED;
            PG8_LDB(B0, 1, 0); PG8_LDB(B1, 1, 1); PG8_SCHED; PG8_LDA(At, 1, 0); PG8_STAGE(PG8_SA(0, 1), a2 + hstepA, voffA);
            PG8_WAIT_V(8); PG8_WAIT_L(0); PG8_BAR; PG8_MMA2(0, At, B0, B1); PG8_BAR; PG8_SCHED;
            PG8_LDA(At, 1, 1); PG8_STAGEB(PG8_SB(1, 0), b3, voffB); PG8_STAGEB(PG8_SB(1, 1), b3 + hstepB, voffB); PG8_STAGE(PG8_SA(1, 0), a3, voffA);
            PG8_WAIT_V(8); PG8_WAIT_L(0); PG8_BAR; PG8_MMA2(1, At, B0, B1); PG8_BAR; PG8_SCHED;
            } else {
            PG8_LDB(B0, 0, 0); PG8_SCHED; PG8_LDA(At, 0, 0); PG8_STAGE(PG8_SA(1, 1), a1 + hstepA, voffA);
            PG8_WAIT_L(8); PG8_BAR; PG8_WAIT_L(0); PG8_MMA(0, 0, At, B0); PG8_BAR; PG8_SCHED;
            PG8_LDB(B1, 0, 1); PG8_STAGEB(PG8_SB(0, 0), b2, voffB);
            PG8_BAR; PG8_WAIT_L(0); PG8_MMA(0, 1, At, B1); PG8_BAR;
            PG8_LDA(At, 0, 1); PG8_STAGE(PG8_SA(0, 0), a2, voffA);
            PG8_BAR; PG8_WAIT_L(0); PG8_MMA(1, 0, At, B0); PG8_BAR; PG8_SCHED;
            PG8_STAGEB(PG8_SB(0, 1), b2 + hstepB, voffB);
            PG8_WAIT_V(6); PG8_BAR; PG8_MMA(1, 1, At, B1); PG8_BAR;
            PG8_LDB(B0, 1, 0); PG8_SCHED; PG8_LDA(At, 1, 0); PG8_STAGE(PG8_SA(0, 1), a2 + hstepA, voffA);
            PG8_WAIT_L(8); PG8_BAR; PG8_WAIT_L(0); PG8_MMA(0, 0, At, B0); PG8_BAR; PG8_SCHED;
            PG8_LDB(B1, 1, 1); PG8_STAGEB(PG8_SB(1, 0), b3, voffB);
            PG8_BAR; PG8_WAIT_L(0); PG8_MMA(0, 1, At, B1); PG8_BAR;
            PG8_LDA(At, 1, 1); PG8_STAGE(PG8_SA(1, 0), a3, voffA);
            PG8_BAR; PG8_WAIT_L(0); PG8_MMA(1, 0, At, B0); PG8_BAR; PG8_SCHED;
            PG8_STAGEB(PG8_SB(1, 1), b3 + hstepB, voffB);
            PG8_WAIT_V(6); PG8_BAR; PG8_MMA(1, 1, At, B1); PG8_BAR;
            }
        }
        if constexpr (ALIGN_EPI) { if (wr == 0) PG8_BAR; }
        if constexpr (F8) asm volatile("s_nop 15\n\ts_nop 7" ::: "memory");
        E(acc, cur, wr, wc, fr, fq);
        if (!has_next) break;
#pragma unroll
        for (int a = 0; a < 2; ++a)
#pragma unroll
            for (int b = 0; b < 2; ++b)
#pragma unroll
                for (int m = 0; m < 4; ++m)
#pragma unroll
                    for (int n = 0; n < 2; ++n) acc[a][b][m][n] = (f32x4){0.f, 0.f, 0.f, 0.f};
        cur = nxt; cA = nA; cB = nB; ++ui;
        if constexpr (ALIGN_EPI) { if (wr == 1) PG8_BAR; }
    }
    PG8_WAIT_V(0);
    if constexpr (!ALIGN_EPI) { if (wr == 0) PG8_BAR; }
    PG8_BAR;
#undef PG8_SA
#undef PG8_SB
#undef PG8_STAGE
#undef PG8_STAGEB
#undef PG8_LDA
#undef PG8_LDB
#undef PG8_MMA
#undef PG8_MMA2
#undef PG8_WAIT_V
#undef PG8_WAIT_L
#undef PG8_BAR
#undef PG8_SCHED
}

#define XB_TMO      128
#define XB_XCNT(j)  (256  + 64 * (j))
#define XB_XSUB(j)  (1280 + 64 * (j))
#define XB_XGEN(j)  (2304 + 64 * (j))
#define XB_TOP      3328
#define XB_TOPGEN   3392
#define XCD_BAR_WORDS 3456
#define XB_SPIN_CAP (1u << 18)
#ifndef XB_SLEEP
#define XB_SLEEP 1
#endif
__device__ __forceinline__ unsigned xb_ld(unsigned* p)              { return __hip_atomic_load(p, __ATOMIC_RELAXED, __HIP_MEMORY_SCOPE_AGENT); }
__device__ __forceinline__ unsigned xb_add(unsigned* p, unsigned v) { return __hip_atomic_fetch_add(p, v, __ATOMIC_RELAXED, __HIP_MEMORY_SCOPE_AGENT); }
__device__ __forceinline__ unsigned xb_xcc_id() { return (unsigned)__builtin_amdgcn_s_getreg((3 << 11) | 20) & 0xFu; }
#define XB_SPIN(cond, bar) do { unsigned _sp = 0; while (cond) { __builtin_amdgcn_s_sleep(XB_SLEEP); \
    if ((++_sp & 255u) == 0u) { if (xb_ld(&(bar)[XB_TMO])) break; if (_sp > XB_SPIN_CAP) { atomicAdd(&(bar)[XB_TMO], 1u); break; } } } } while (0)
struct XcdBarrier { unsigned* bar; unsigned x; volatile LAS unsigned* st; };
__device__ __forceinline__ XcdBarrier xcd_barrier_post(unsigned* bar, volatile LAS unsigned* st) {
    XcdBarrier b; b.bar = bar; b.x = xb_xcc_id(); b.st = st;
    if (threadIdx.x == 0) (void)xb_add(&bar[XB_XCNT(b.x)], 1u);
    return b;
}
__device__ __forceinline__ void xcd_barrier_complete(unsigned* bar, unsigned x, unsigned& nloc, unsigned& nx) {
    const unsigned G = gridDim.x * gridDim.y * gridDim.z;
    unsigned sum, cnt, mine, sp = 0u;
    for (;;) {
        sum = 0u; cnt = 0u; mine = 0u;
#pragma unroll
        for (unsigned j = 0; j < 16; ++j) { const unsigned c = xb_ld(&bar[XB_XCNT(j)]); sum += c; cnt += (c > 0u) ? 1u : 0u; mine = (j == x) ? c : mine; }
        if (sum == G) break;
        __builtin_amdgcn_s_sleep(1);
        if ((++sp & 255u) == 0u) { if (xb_ld(&bar[XB_TMO])) break; if (sp > XB_SPIN_CAP) { atomicAdd(&bar[XB_TMO], 1u); break; } }
    }
    nloc = mine > 0u ? mine : 1u; nx = cnt > 0u ? cnt : 1u;
}
__device__ __forceinline__ void xcd_barrier(const XcdBarrier& b) {
    asm volatile("s_waitcnt vmcnt(0)" ::: "memory");
    __syncthreads();
    if (threadIdx.x == 0) {
        unsigned* bar = b.bar;
        __builtin_amdgcn_s_waitcnt(0);
        unsigned nloc = b.st[0], nx = b.st[1];
        if (nloc == 0u) { xcd_barrier_complete(bar, b.x, nloc, nx); b.st[0] = nloc; b.st[1] = nx; }
        const unsigned old = xb_add(&bar[XB_XSUB(b.x)], 1u);
        const unsigned gen = old / nloc;
        if (old + 1u == (gen + 1u) * nloc) {
            __builtin_amdgcn_fence(__ATOMIC_RELEASE, "agent");
            asm volatile("s_waitcnt vmcnt(0)" ::: "memory");
            const unsigned og = xb_add(&bar[XB_TOP], 1u);
            const unsigned tg = og / nx;
            if (og + 1u == (tg + 1u) * nx) xb_add(&bar[XB_TOPGEN], 1u);
            else XB_SPIN(xb_ld(&bar[XB_TOPGEN]) == tg, bar);
            __builtin_amdgcn_fence(__ATOMIC_ACQUIRE, "agent");
            xb_add(&bar[XB_XGEN(b.x)], 1u);
            asm volatile("s_waitcnt vmcnt(0)" ::: "memory");
        } else {
            XB_SPIN(xb_ld(&bar[XB_XGEN(b.x)]) == gen, bar);
            __builtin_amdgcn_fence(__ATOMIC_ACQUIRE, "agent");
            asm volatile("s_waitcnt vmcnt(0)" ::: "memory");
        }
    }
    __syncthreads();
}
constexpr int D = 2048, NB = 8, L = 2048, LC = 256, RL = 16384, RC = 2048, R = 18432, NIN = 7168, GW = 64;
constexpr int DFF = 5632, NE = 8, DE = 7168, NH = 8, HD = 128, DL = 1024;
constexpr int WIN_ROWS = 7168;
constexpr int UT_LD = 36864;
constexpr int MAXSLOT = 34816;
constexpr int NCHUNK = 288;
constexpr int NWAVES = 8, NTHREADS = 512;
constexpr int LDS_BYTES = 147456;
constexpr int MISC_OFF = 140000;

constexpr size_t al256(size_t x) { return (x + 255) & ~(size_t)255; }
constexpr size_t O_CTL = 0, CTL_BYTES = 1u << 20, CTL_ZERO_BYTES = 65536;
constexpr size_t O_MOD = O_CTL + CTL_BYTES;
constexpr size_t O_MISC = O_MOD + al256((size_t)2 * 9 * 12288 * 4);
constexpr size_t O_LAT = O_MISC + (1u << 20);
constexpr size_t O_HN = O_LAT + (size_t)R * D * 4;
constexpr size_t O_WIN = O_HN + (size_t)R * D * 2;
constexpr size_t O_WFO = O_WIN + (size_t)2 * 8192 * 2048 * 2;
constexpr size_t O_WRO = O_WFO + (size_t)2 * 2048 * 1024 * 2;
constexpr size_t O_WO = O_WRO + (size_t)2 * 2048 * 1024 * 2;
constexpr size_t O_WAX = O_WO + (size_t)2 * 2048 * 2048 * 2;
constexpr size_t O_WUF = O_WAX + (size_t)2 * 2 * 2 * 8 * 128 * 128 * 2;
constexpr size_t O_DG = O_WUF + (size_t)2 * 2048 * 1024 * 2;
constexpr size_t O_FL = O_DG + (size_t)512 * 256 * 2;
constexpr size_t O_FLC = O_FL + (size_t)2048 * 4096 * 2;
constexpr size_t O_FGU = O_FLC + (size_t)256 * 4096 * 2;
constexpr size_t O_FD = O_FGU + (size_t)11264 * 2048 * 2;
constexpr size_t O_MGU = O_FD + (size_t)2048 * 5632 * 2;
constexpr size_t O_MD = O_MGU + (size_t)8 * 14336 * 2048 * 2;
constexpr size_t O_HN8 = O_MGU + (size_t)8 * 14336 * 2048;
constexpr size_t O_WIN8 = O_HN8 + (size_t)18432 * 2048;
constexpr size_t O_SCR = O_MD + (size_t)8 * 2048 * 7168 * 2;
constexpr size_t O_UT = O_SCR;
constexpr size_t O_UR = O_UT + (size_t)1024 * UT_LD * 2;
constexpr size_t O_GG = O_UR + (size_t)R * 1024 * 2;
constexpr size_t O_SGF = O_GG + (size_t)R * 1024 * 2;
constexpr size_t O_SGR = O_SGF + (size_t)R * 2048 * 2;
constexpr size_t O_Y = O_SGR + (size_t)R * 2048 * 2;
constexpr size_t O_T1 = O_Y + (size_t)R * 1024 * 2;
constexpr size_t O_HR = O_T1 + (size_t)R * 2048 * 2;
constexpr size_t O_MG = O_HR + (size_t)R * 1024 * 2;
constexpr size_t O_TOT = O_MG + (size_t)R * 2048 * 2;
constexpr size_t O_CAR = O_TOT + (size_t)NCHUNK * 2 * 1024 * 8;
constexpr size_t O_ZT = O_CAR + (size_t)NCHUNK * 2 * 1024 * 4;
constexpr size_t O_VV = O_ZT + (size_t)1024 * UT_LD * 2;
constexpr size_t O_MIXEND = O_VV + (size_t)R * 1024 * 2;
constexpr size_t O_HID = O_SCR;
constexpr size_t O_XG = O_SCR;
constexpr size_t O_HIDM = O_XG + (size_t)MAXSLOT * 2048 * 2;
constexpr size_t O_OS = O_HIDM + (size_t)MAXSLOT * 7168 * 2;
constexpr size_t O_END = O_OS + (size_t)2 * MAXSLOT * 2048 * 2;
static_assert(O_MIXEND <= O_END && O_HID + (size_t)R * DFF * 2 <= O_END, "scratch overlay");
static_assert(O_END <= (size_t)2085 * 1000 * 1000, "workspace budget");
constexpr size_t M_SEL = 0;
constexpr size_t M_GWT = 131072;
constexpr size_t M_SLOT = 262144;
constexpr size_t M_CNTB = 393216;
constexpr size_t M_TOT = 401408;
constexpr int CW_BAR = 4096, CW_MOEC = 8192;

struct Args { const float* in[27]; float* out; unsigned char* ws; int ph_lo, ph_hi, bar_region, pad; };
typedef const __attribute__((address_space(4))) Args* AP;
__device__ __forceinline__ AP kargs() { AP p = (AP)__builtin_amdgcn_kernarg_segment_ptr(); asm volatile("" : "+s"(p)); return p; }

__device__ __forceinline__ void p0_ada(AP a, LAS unsigned char* lds, int vcu, int G) {
    const int tid = threadIdx.x, lane = tid & 63, w = tid >> 6;
    LAS float* sc = (LAS float*)lds;
    LAS float* red = (LAS float*)(lds + 73728);
    const float* c = a->in[1]; const float* c_ctx = a->in[3];
    for (int i = tid; i < 9 * 2048; i += NTHREADS) { const int r = i >> 11, k = i & 2047; const float v = r < 8 ? c[r * 2048 + k] : c_ctx[k]; sc[i] = v / (1.f + expf(-v)); }
    __syncthreads();
    float* MOD = (float*)(a->ws + O_MOD);
    for (int item = vcu; item < 256; item += G) {
        const int l = item >> 7, cg = item & 127, col = cg * 96 + (lane < 48 ? lane : 0) * 2;
        const float* W = a->in[4] + (size_t)l * 2048 * 12288 + col;
        float acc[9][2];
#pragma unroll
        for (int r = 0; r < 9; ++r) { acc[r][0] = 0.f; acc[r][1] = 0.f; }
#pragma unroll 8
        for (int k = w * 256; k < w * 256 + 256; ++k) {
            const f32x2 wv = *(const f32x2*)(W + (size_t)k * 12288);
#pragma unroll
            for (int r = 0; r < 9; ++r) { const float s = sc[r * 2048 + k]; acc[r][0] = fmaf(s, wv.x, acc[r][0]); acc[r][1] = fmaf(s, wv.y, acc[r][1]); }
        }
#pragma unroll
        for (int r = 0; r < 9; ++r) if (lane < 48) { red[(w * 9 + r) * 128 + lane * 2] = acc[r][0]; red[(w * 9 + r) * 128 + lane * 2 + 1] = acc[r][1]; }
        __syncthreads();
        for (int i = tid; i < 9 * 128; i += NTHREADS) { const int r = i >> 7, cc = i & 127; if (cc >= 96) continue; float s = a->in[5][(size_t)l * 12288 + cg * 96 + cc];
#pragma unroll
            for (int ww = 0; ww < 8; ++ww) s += red[(ww * 9 + r) * 128 + cc];
            MOD[((size_t)l * 9 + r) * 12288 + cg * 96 + cc] = s; }
        __syncthreads();
    }
}

#ifndef SCAN_VV
#define SCAN_VV 1
#endif
#ifndef DFT2
#define DFT2 1
#endif
#ifndef MOE_BLK
#define MOE_BLK 1
#endif
#ifndef CVT_NT
#define CVT_NT 0
#endif
#ifndef WIN_F8
#define WIN_F8 1
#endif
#ifndef FFN_F8
#define FFN_F8 1
#endif
#ifndef MOE_F8
#define MOE_F8 1
#endif
#define W8_SC 256.f
#define X8_SC 16.f
#define H8_SC 4.f
#if CVT_NT
#define CVT_LOAD(p) __builtin_nontemporal_load(p)
#define CVT_STORE(v, p) __builtin_nontemporal_store(v, p)
#else
#define CVT_LOAD(p) (*(p))
#define CVT_STORE(v, p) (*(p) = (v))
#endif
template <int F8 = 0>
__device__ __forceinline__ void cvt_item(const float* src, int ldsrc, bf16* dst, int dpitch, int k0, int n0, int drow0, LAS float* scr, int lane, const int npairs = 0) {
    const float* s = src + (size_t)(k0 + (lane >> 4)) * ldsrc + n0 + (lane & 15) * 4;
    f32x4 v[16];
#pragma unroll
    for (int i = 0; i < 16; ++i) v[i] = CVT_LOAD((const f32x4*)(s + (size_t)(4 * i) * ldsrc));
#pragma unroll
    for (int i = 0; i < 16; ++i) { LAS float* q = scr + (4 * i + (lane >> 4)) * 65 + (lane & 15) * 4; q[0] = v[i].x; q[1] = v[i].y; q[2] = v[i].z; q[3] = v[i].w; }
    LDS_WAIT(); asm volatile("" ::: "memory");
    const int c = lane & 7;
#pragma unroll
    for (int jj = 0; jj < 8; ++jj) { const int n = (lane >> 3) + 8 * jj; const LAS float* q = scr + (8 * c) * 65 + n;
        if constexpr (F8) { u32x2 o8; o8.x = cvt_fp8x4(q[0 * 65] * W8_SC, q[1 * 65] * W8_SC, q[2 * 65] * W8_SC, q[3 * 65] * W8_SC); o8.y = cvt_fp8x4(q[4 * 65] * W8_SC, q[5 * 65] * W8_SC, q[6 * 65] * W8_SC, q[7 * 65] * W8_SC);
            const int dr8 = drow0 + n; unsigned char* dp8 = npairs ? (unsigned char*)dst + ((size_t)(dr8 >> 8) * npairs + (k0 >> 8)) * 65536 + (size_t)(dr8 & 255) * 256 + (k0 & 255) + 8 * c
                                                                     : (unsigned char*)dst + (size_t)dr8 * dpitch + k0 + 8 * c;
            *(u32x2*)dp8 = o8; continue; }
        u32x4 o; o.x = cvt_pk_bf16(q[0 * 65], q[1 * 65]); o.y = cvt_pk_bf16(q[2 * 65], q[3 * 65]); o.z = cvt_pk_bf16(q[4 * 65], q[5 * 65]); o.w = cvt_pk_bf16(q[6 * 65], q[7 * 65]);
        const int dr = drow0 + n; bf16* dp = npairs ? dst + ((size_t)(dr >> 8) * npairs + (k0 >> 7)) * 32768 + (size_t)(dr & 255) * 128 + (k0 & 127) + 8 * c : dst + (size_t)dr * dpitch + k0 + 8 * c;
        CVT_STORE(o, (u32x4*)dp); }
    LDS_WAIT(); asm volatile("" ::: "memory");
}
constexpr int I_WIN = 32 * 96, I_FO = 16 * 32, I_O = 32 * 32, I_AX = 4, I_FG = 32 * 88, I_FD = 88 * 32, I_MG = 32 * 112, I_MD = 112 * 32;
constexpr int N_WIN = 2 * I_WIN, N_FO = 2 * I_FO, N_RO = N_FO, N_O = 2 * I_O, N_AX = 64 * I_AX, N_FG = I_FG, N_FU = I_FG, N_FD = I_FD, N_MG = 8 * I_MG, N_MU = N_MG, N_MD = 8 * I_MD;
constexpr int N_NONMOE = N_WIN + N_FO + N_RO + N_O + N_AX + N_FG + N_FU + N_FD, N_MOE = N_MG + N_MU + N_MD;
__device__ __forceinline__ void p0_convert(AP a, LAS unsigned char* lds, int gw, int NGW) {
    const int lane = threadIdx.x & 63, w = threadIdx.x >> 6;
    LAS float* scr = (LAS float*)(lds + w * 16640);
    unsigned char* ws = a->ws;
    for (int it = gw; it < N_NONMOE; it += NGW) {
        int r = it;
        if (r < N_WIN) { const int l = r / I_WIN, q = r % I_WIN, kb = q / 96, nb = q % 96;
            if (WIN_F8 && nb >= 32) cvt_item<1>(a->in[8] + (size_t)l * 2048 * NIN, NIN, (bf16*)(ws + O_WIN8 + (size_t)l * 4096 * 2048), 2048, kb * 64, 1024 + nb * 64, (nb - 32) * 64, scr, lane); else
            cvt_item(a->in[8] + (size_t)l * 2048 * NIN, NIN, (bf16*)(ws + O_WIN) + (size_t)l * WIN_ROWS * 2048, 2048, kb * 64, 1024 + nb * 64, 1024 + nb * 64, scr, lane); continue; } r -= N_WIN;
        if (r < N_FO) { const int l = r / I_FO, q = r % I_FO, kb = q / 32, nb = q % 32;
            cvt_item(a->in[16] + (size_t)l * 1024 * 2048, 2048, (bf16*)(ws + O_WFO) + (size_t)l * 2048 * 1024, 1024, kb * 64, nb * 64, nb * 64, scr, lane); continue; } r -= N_FO;
        if (r < N_RO) { const int l = r / I_FO, q = r % I_FO, kb = q / 32, nb = q % 32;
            cvt_item(a->in[17] + (size_t)l * 1024 * 2048, 2048, (bf16*)(ws + O_WRO) + (size_t)l * 2048 * 1024, 1024, kb * 64, nb * 64, nb * 64, scr, lane); continue; } r -= N_RO;
        if (r < N_O) { const int l = r / I_O, q = r % I_O, kb = q / 32, nb = q % 32;
            cvt_item(a->in[18] + (size_t)l * 2048 * 2048, 2048, (bf16*)(ws + O_WO) + (size_t)l * 2048 * 2048, 2048, kb * 64, nb * 64, nb * 64, scr, lane); continue; } r -= N_O;
        if (r < N_AX) { const int m = r / I_AX, q = r % I_AX, kb = q / 2, nb = q % 2;
            const int h = m & 7, gate = (m >> 3) & 1, ld = m >> 4;
            const float* src = (gate ? a->in[13] : a->in[11]) + ((size_t)ld * 8 + h) * 128 * 128;
            cvt_item(src, 128, (bf16*)(ws + O_WAX) + (size_t)m * 128 * 128, 128, kb * 64, nb * 64, nb * 64, scr, lane); continue; } r -= N_AX;
        if (r < N_FG) { const int kb = r / 88, nb = r % 88, n = nb * 64;
            if (FFN_F8) cvt_item<1>(a->in[19], DFF, (bf16*)(ws + O_FGU), 2048, kb * 64, n, (n >> 7) * 256 + (n & 127), scr, lane); else
            cvt_item(a->in[19], DFF, (bf16*)(ws + O_FGU), 2048, kb * 64, n, (n >> 7) * 256 + (n & 127), scr, lane); continue; } r -= N_FG;
        if (r < N_FU) { const int kb = r / 88, nb = r % 88, n = nb * 64;
            if (FFN_F8) cvt_item<1>(a->in[20], DFF, (bf16*)(ws + O_FGU), 2048, kb * 64, n, (n >> 7) * 256 + 128 + (n & 127), scr, lane); else
            cvt_item(a->in[20], DFF, (bf16*)(ws + O_FGU), 2048, kb * 64, n, (n >> 7) * 256 + 128 + (n & 127), scr, lane); continue; } r -= N_FU;
        { const int kb = r / 32, nb = r % 32;
            if (FFN_F8) cvt_item<1>(a->in[21], 2048, (bf16*)(ws + O_FD), DFF, kb * 64, nb * 64, nb * 64, scr, lane); else
            cvt_item(a->in[21], 2048, (bf16*)(ws + O_FD), DFF, kb * 64, nb * 64, nb * 64, scr, lane); }
    }
}
__device__ __forceinline__ void cvt_moe_range(AP a, LAS unsigned char* lds, int lo, int hi, int rank, int nrank) {
    const int lane = threadIdx.x & 63, w = threadIdx.x >> 6;
    LAS float* scr = (LAS float*)(lds + w * 16640);
    unsigned char* ws = a->ws;
    for (int it = lo + rank; it < hi; it += nrank) {
        int r = it;
        if (r < N_MG) { const int e = r / I_MG, q = r % I_MG, kb = q / 112, nb = q % 112, n = nb * 64;
            if (MOE_F8) cvt_item<1>(a->in[23] + (size_t)e * 2048 * DE, DE, (bf16*)(ws + O_MGU + (size_t)e * 14336 * 2048), 2048, kb * 64, n, (n >> 7) * 256 + (n & 127), scr, lane, 8); else
            cvt_item(a->in[23] + (size_t)e * 2048 * DE, DE, (bf16*)(ws + O_MGU) + (size_t)e * 14336 * 2048, 2048, kb * 64, n, (n >> 7) * 256 + (n & 127), scr, lane, MOE_BLK ? 16 : 0); continue; } r -= N_MG;
        if (r < N_MU) { const int e = r / I_MG, q = r % I_MG, kb = q / 112, nb = q % 112, n = nb * 64;
            if (MOE_F8) cvt_item<1>(a->in[24] + (size_t)e * 2048 * DE, DE, (bf16*)(ws + O_MGU + (size_t)e * 14336 * 2048), 2048, kb * 64, n, (n >> 7) * 256 + 128 + (n & 127), scr, lane, 8); else
            cvt_item(a->in[24] + (size_t)e * 2048 * DE, DE, (bf16*)(ws + O_MGU) + (size_t)e * 14336 * 2048, 2048, kb * 64, n, (n >> 7) * 256 + 128 + (n & 127), scr, lane, MOE_BLK ? 16 : 0); continue; } r -= N_MU;
        { const int e = r / I_MD, q = r % I_MD, kb = q / 32, nb = q % 32;
            if (MOE_F8) cvt_item<1>(a->in[25] + (size_t)e * DE * 2048, 2048, (bf16*)(ws + O_MD + (size_t)e * 2048 * DE), DE, kb * 64, nb * 64, nb * 64, scr, lane, 28); else
            cvt_item(a->in[25] + (size_t)e * DE * 2048, 2048, (bf16*)(ws + O_MD) + (size_t)e * 2048 * DE, DE, kb * 64, nb * 64, nb * 64, scr, lane, MOE_BLK ? 56 : 0); }
    }
}
__device__ __forceinline__ void p0_elementwise(AP a, size_t gt, size_t NGT, const LAS f32x2* tab) {
    unsigned char* ws = a->ws;
    for (size_t i = gt; i < (size_t)2 * 2048 * 128; i += NGT) { const int l = (int)(i / (2048 * 128)), d = (int)((i / 128) % 2048), j8 = (int)(i % 128) * 8;
        const float* s = a->in[8] + ((size_t)l * 2048 + d) * NIN + j8; const f32x4 v0 = *(const f32x4*)s, v1 = *(const f32x4*)(s + 4);
        u32x4 o; o.x = cvt_pk_bf16(v0.x, v0.y); o.y = cvt_pk_bf16(v0.z, v0.w); o.z = cvt_pk_bf16(v1.x, v1.y); o.w = cvt_pk_bf16(v1.z, v1.w);
        *(u32x4*)((bf16*)(ws + O_WUF) + ((size_t)l * 2048 + d) * 1024 + j8) = o; }
#if DFT2
    for (size_t i = gt; i < (size_t)256 * 64; i += NGT) { const int k = (int)(i / 64), j8 = (int)(i % 64) * 8; float v[8];
#pragma unroll
        for (int e = 0; e < 8; ++e) { const int j = j8 + e, t = j & 255; const int m = (k * t) & 255; float sn, cs; sincospif((float)m * (1.f / 128.f), &sn, &cs); v[e] = (j < 256 ? cs : sn) * 0.022097086912079608f; }
        u32x4 o; o.x = cvt_pk_bf16(v[0], v[1]); o.y = cvt_pk_bf16(v[2], v[3]); o.z = cvt_pk_bf16(v[4], v[5]); o.w = cvt_pk_bf16(v[6], v[7]);
        *(u32x4*)((bf16*)(ws + O_FL) + (size_t)k * 4096 + j8) = o; }
    (void)tab;
#else
    for (size_t i = gt; i < (size_t)2048 * 512; i += NGT) { const int k = (int)(i / 512), j8 = (int)(i % 512) * 8; float v[8];
#pragma unroll
        for (int e = 0; e < 8; ++e) { const int j = j8 + e, t = j & 2047; const int m = (k * t) & 2047; const f32x2 cs = tab[m]; v[e] = (j < 2048 ? cs.x : -cs.y); }
        u32x4 o; o.x = cvt_pk_bf16(v[0], v[1]); o.y = cvt_pk_bf16(v[2], v[3]); o.z = cvt_pk_bf16(v[4], v[5]); o.w = cvt_pk_bf16(v[6], v[7]);
        *(u32x4*)((bf16*)(ws + O_FL) + (size_t)k * 4096 + j8) = o; }
#endif
    for (size_t i = gt; i < (size_t)256 * 64; i += NGT) { const int k = (int)(i / 64), j8 = (int)(i % 64) * 8; float v[8];
#pragma unroll
        for (int e = 0; e < 8; ++e) { const int j = j8 + e, t = j & 255; const int m = (k * t) & 255; float s, c; sincospif((float)m * (1.f / 128.f), &s, &c); v[e] = (j < 256 ? c : -s) * 0.0625f; }
        u32x4 o; o.x = cvt_pk_bf16(v[0], v[1]); o.y = cvt_pk_bf16(v[2], v[3]); o.z = cvt_pk_bf16(v[4], v[5]); o.w = cvt_pk_bf16(v[6], v[7]);
        *(u32x4*)((bf16*)(ws + O_FLC) + (size_t)k * 4096 + j8) = o; }
    for (size_t i = gt; i < (size_t)256 * 32; i += NGT) { const int row = (int)(i / 32), j8 = (int)(i % 32) * 8, s_ = row > 128 ? 1 : 0, c_ = s_ ? row - 128 : row; float v[8];
#pragma unroll
        for (int e = 0; e < 8; ++e) { const int m = (c_ * (j8 + e)) & 255; float s, c; sincospif((float)m * (1.f / 128.f), &s, &c); v[e] = (s_ ? s : c) * 0.0625f; }
        u32x4 o; o.x = cvt_pk_bf16(v[0], v[1]); o.y = cvt_pk_bf16(v[2], v[3]); o.z = cvt_pk_bf16(v[4], v[5]); o.w = cvt_pk_bf16(v[6], v[7]);
        *(u32x4*)((bf16*)(ws + O_DG) + (size_t)row * 256 + j8) = o; }
}

__device__ __forceinline__ int mod_row(int r) { return r < RL ? (r >> 11) : 8; }
__device__ __forceinline__ void norm_load(f32x4 (&v)[8], const float* src, int lane) {
#pragma unroll
    for (int j = 0; j < 8; ++j) v[j] = ((const f32x4*)src)[lane + 64 * j];
}
template <bool ROUTER, int F8OUT = 0>
__device__ __forceinline__ int norm_row(const f32x4 (&v)[8], const float* g, const float* modl, int shift_chunk, int scale_chunk, bf16* dst, int row, int lane,
                                         const LAS float* rt, int* sel, float* gwt, unsigned char* dst8 = nullptr) {
    int picked = 0;
    float s = 0.f;
#pragma unroll
    for (int j = 0; j < 8; ++j) s += (v[j].x * v[j].x + v[j].y * v[j].y) + (v[j].z * v[j].z + v[j].w * v[j].w);
    const float rstd = rsqrtf(wave_sum(s) * (1.f / D) + 1e-6f);
    const float* mr = modl + (size_t)mod_row(row) * 12288;
    float lg[8];
    if (ROUTER) {
#pragma unroll
        for (int e = 0; e < 8; ++e) lg[e] = 0.f; }
#pragma unroll
    for (int j = 0; j < 8; ++j) {
        const int c = (lane + 64 * j) * 4;
        const f32x4 gg = *(const f32x4*)(g + c), sh = *(const f32x4*)(mr + shift_chunk * D + c), sc = *(const f32x4*)(mr + scale_chunk * D + c);
        f32x4 o = v[j] * rstd * gg; o = o * (sc + 1.f) + sh;
        if constexpr (F8OUT == 1) *(unsigned*)((unsigned char*)dst + (size_t)row * D + c) = cvt_fp8x4(o.x * X8_SC, o.y * X8_SC, o.z * X8_SC, o.w * X8_SC);
        else { if constexpr (F8OUT == 2) *(unsigned*)(dst8 + (size_t)row * D + c) = cvt_fp8x4(o.x * X8_SC, o.y * X8_SC, o.z * X8_SC, o.w * X8_SC); u32x2 w; w.x = cvt_pk_bf16(o.x, o.y); w.y = cvt_pk_bf16(o.z, o.w);
        *(u32x2*)(dst + (size_t)row * D + c) = w; }
        if (ROUTER) {
#pragma unroll
            for (int q = 0; q < 4; ++q) { const f32x4 r0 = *(const LAS f32x4*)(rt + (c + q) * 8), r1 = *(const LAS f32x4*)(rt + (c + q) * 8 + 4); const float x = o[q];
                lg[0] = fmaf(x, r0.x, lg[0]); lg[1] = fmaf(x, r0.y, lg[1]); lg[2] = fmaf(x, r0.z, lg[2]); lg[3] = fmaf(x, r0.w, lg[3]);
                lg[4] = fmaf(x, r1.x, lg[4]); lg[5] = fmaf(x, r1.y, lg[5]); lg[6] = fmaf(x, r1.z, lg[6]); lg[7] = fmaf(x, r1.w, lg[7]); } }
    }
    if (ROUTER) {
#pragma unroll
        for (int e = 0; e < 8; ++e) lg[e] = wave_sum(lg[e]);
        if (lane == 0) {
            int i1 = 0; float v1 = lg[0];
#pragma unroll
            for (int e = 1; e < 8; ++e) if (lg[e] > v1) { v1 = lg[e]; i1 = e; }
            int i2 = -1; float v2 = -3.0e38f;
#pragma unroll
            for (int e = 0; e < 8; ++e) if (e != i1 && lg[e] > v2) { v2 = lg[e]; i2 = e; }
            const float w1 = 1.f / (1.f + expf(v2 - v1));
            sel[row * 2] = i1; sel[row * 2 + 1] = i2; gwt[row * 2] = w1; gwt[row * 2 + 1] = 1.f - w1; picked = i1 | (i2 << 8);
        }
    }
    return picked;
}

__device__ __forceinline__ float one_minus_exp(float x, float a2) {
    const float t = -x; return t < 0.0625f ? t * (1.f - t * (0.5f - t * (0.16666667f - t * (0.041666668f - t * 0.0083333338f)))) : 1.f - a2; }
template <int PASS>
__device__ __forceinline__ void scan_unit(AP a, LAS unsigned char* lds, int l, int q, int h) {
    int tid = threadIdx.x; asm volatile("" : "+v"(tid));
    const int lane = tid & 63, w = __builtin_amdgcn_readfirstlane(tid >> 6), fr = lane & 15, fq = lane >> 4;
    LAS float* VS = (LAS float*)lds; LAS bf16* V16 = (LAS bf16*)(lds + 33792); LAS float* AS = (LAS float*)(lds + 51200); LAS float* BS = (LAS float*)(lds + 84992); LAS float* SEG = (LAS float*)(lds + 118784);
    unsigned char* ws = a->ws;
    const bool isctx = q >= 256;
    const int row0 = isctx ? RL + (q - 256) * 64 : q * 64;
    const int cpos0 = isctx ? ((q - 256) & 3) * 64 : 0;
    const int seglen = isctx ? LC : GW;
    const int t = tid >> 3, c16 = (tid & 7) * 16;
    {
        const bf16* UR = (const bf16*)(ws + O_UR);
        const float* cw = a->in[9] + (size_t)l * 4 * DL + h * HD + c16; const float* cb = a->in[10] + (size_t)l * DL + h * HD + c16;
        float v[16];
#pragma unroll
        for (int i = 0; i < 16; i += 4) { const f32x4 b4 = *(const f32x4*)(cb + i); v[i] = b4.x; v[i + 1] = b4.y; v[i + 2] = b4.z; v[i + 3] = b4.w; }
#pragma unroll
        for (int k = 0; k < 4; ++k) { const int p = cpos0 + t + k - 2;
            if (p >= 0 && p < seglen) { const bf16* src = UR + (size_t)(row0 + t + k - 2) * 1024 + h * HD + c16; const u32x4 u0 = *(const u32x4*)src, u1 = *(const u32x4*)(src + 8);
                const unsigned uu[8] = {u0.x, u0.y, u0.z, u0.w, u1.x, u1.y, u1.z, u1.w};
#pragma unroll
                for (int i = 0; i < 8; ++i) { const f32x2 wv = *(const f32x2*)(cw + (size_t)k * DL + 2 * i); v[2 * i] = fmaf(wv.x, bf_lo(uu[i]), v[2 * i]); v[2 * i + 1] = fmaf(wv.y, bf_hi(uu[i]), v[2 * i + 1]); } } }
#pragma unroll
        for (int i = 0; i < 16; i += 4) *(LAS f32x4*)(VS + t * 132 + c16 + i) = (f32x4){v[i], v[i + 1], v[i + 2], v[i + 3]};
        u32x4 o0, o1; o0.x = cvt_pk_bf16(v[0], v[1]); o0.y = cvt_pk_bf16(v[2], v[3]); o0.z = cvt_pk_bf16(v[4], v[5]); o0.w = cvt_pk_bf16(v[6], v[7]);
        o1.x = cvt_pk_bf16(v[8], v[9]); o1.y = cvt_pk_bf16(v[10], v[11]); o1.z = cvt_pk_bf16(v[12], v[13]); o1.w = cvt_pk_bf16(v[14], v[15]);
        *(LAS u32x4*)(V16 + t * 136 + c16) = o0; *(LAS u32x4*)(V16 + t * 136 + c16 + 8) = o1;
    }
    __syncthreads();
    float hsum[16];
#pragma unroll
    for (int i = 0; i < 16; ++i) hsum[i] = 0.f;
    const int ch = 16 * w + fr;
#pragma unroll 1
    for (int dir = 0; dir < 2; ++dir) {
        f32x4 acc[2][4];
#pragma unroll
        for (int g = 0; g < 2; ++g)
#pragma unroll
            for (int m = 0; m < 4; ++m) acc[g][m] = (f32x4){0.f, 0.f, 0.f, 0.f};
        const bf16* WT = (const bf16*)(ws + O_WAX) + ((size_t)((l * 2 + dir) * 2) * 8 + h) * 128 * 128;
#pragma unroll
        for (int ks = 0; ks < 4; ++ks) {
            const bf16x8 b0 = *(const bf16x8*)(WT + (size_t)ch * 128 + ks * 32 + fq * 8), b1 = *(const bf16x8*)(WT + (size_t)8 * 128 * 128 + (size_t)ch * 128 + ks * 32 + fq * 8);
#pragma unroll
            for (int m = 0; m < 4; ++m) { const bf16x8 af = *(const LAS bf16x8*)(V16 + (16 * m + fr) * 136 + ks * 32 + fq * 8);
                acc[0][m] = __builtin_amdgcn_mfma_f32_16x16x32_bf16(af, b0, acc[0][m], 0, 0, 0); acc[1][m] = __builtin_amdgcn_mfma_f32_16x16x32_bf16(af, b1, acc[1][m], 0, 0, 0); }
        }
        {
            const int gch = h * HD + ch;
            const float bia = a->in[12][(size_t)(l * 2 + dir) * DL + gch], bix = a->in[14][(size_t)(l * 2 + dir) * DL + gch], lm = a->in[15][(size_t)(l * 2 + dir) * DL + gch];
            const float sp8 = 8.f * log1pf(expf(-lm));
#pragma unroll
            for (int m = 0; m < 4; ++m)
#pragma unroll
                for (int j = 0; j < 4; ++j) { const int tok = 16 * m + 4 * fq + j;
                    const float rr = fsigm(acc[0][m][j] + bia), ii = fsigm(acc[1][m][j] + bix), vv = VS[tok * 132 + ch];
                    const float la = -sp8 * rr, av = fexp(la), a2 = av * av;
                    AS[tok * 132 + ch] = av; BS[tok * 132 + ch] = sqrtf(one_minus_exp(2.f * la, a2)) * (ii * vv); }
        }
        __syncthreads();
        {
            const int sg = tid >> 7, sc = tid & 127;
            float av[16], bv[16];
#pragma unroll
            for (int i = 0; i < 16; ++i) { const int tok = dir ? 63 - (16 * sg + i) : 16 * sg + i; av[i] = AS[tok * 132 + sc]; bv[i] = BS[tok * 132 + sc]; }
            float P = 1.f, hl = 0.f;
#pragma unroll
            for (int i = 0; i < 16; ++i) { hl = fmaf(av[i], hl, bv[i]); P *= av[i]; }
            SEG[(sg * 128 + sc) * 2] = P; SEG[(sg * 128 + sc) * 2 + 1] = hl;
            __syncthreads();
            if (PASS == 1) {
                if (sg == 0) { float A = 1.f, B = 0.f;
#pragma unroll
                    for (int s2 = 0; s2 < 4; ++s2) { const float p2 = SEG[(s2 * 128 + sc) * 2], h2 = SEG[(s2 * 128 + sc) * 2 + 1]; B = fmaf(p2, B, h2); A *= p2; }
                    *(f32x2*)((float*)(ws + O_TOT) + (((size_t)q * 2 + dir) * 1024 + h * HD + sc) * 2) = (f32x2){A, B}; }
            } else {
                float hc = ((const float*)(ws + O_CAR))[((size_t)q * 2 + dir) * 1024 + h * HD + sc];
#pragma unroll
                for (int s2 = 0; s2 < 3; ++s2) if (s2 < sg) { const float p2 = SEG[(s2 * 128 + sc) * 2], h2 = SEG[(s2 * 128 + sc) * 2 + 1]; hc = fmaf(p2, hc, h2); }
#pragma unroll
                for (int i = 0; i < 16; ++i) { const int tok = dir ? 63 - (16 * sg + i) : 16 * sg + i; hc = fmaf(av[i], hc, bv[i]); BS[tok * 132 + sc] = hc; }
            }
        }
        __syncthreads();
        if (PASS == 2) {
#pragma unroll
            for (int i = 0; i < 16; i += 4) { const f32x4 x = *(const LAS f32x4*)(BS + t * 132 + c16 + i); hsum[i] += x.x; hsum[i + 1] += x.y; hsum[i + 2] += x.z; hsum[i + 3] += x.w; }
            __syncthreads();
        }
    }
    if (PASS == 2) {
        const bf16* GGp = (const bf16*)(ws + O_GG) + (size_t)(row0 + t) * 1024 + h * HD + c16; const u32x4 g0 = *(const u32x4*)GGp, g1 = *(const u32x4*)(GGp + 8);
        const unsigned gu[8] = {g0.x, g0.y, g0.z, g0.w, g1.x, g1.y, g1.z, g1.w}; unsigned o[8];
#pragma unroll
        for (int i = 0; i < 8; ++i) o[i] = cvt_pk_bf16(hsum[2 * i] * bf_lo(gu[i]), hsum[2 * i + 1] * bf_hi(gu[i]));
        bf16* dst = (bf16*)(ws + O_HR) + (size_t)(row0 + t) * 1024 + h * HD + c16;
        *(u32x4*)dst = (u32x4){o[0], o[1], o[2], o[3]}; *(u32x4*)(dst + 8) = (u32x4){o[4], o[5], o[6], o[7]};
    }
}
template <int PASS>
__device__ __forceinline__ void scan_phase(AP a, LAS unsigned char* lds, const int l, const int nunits, const int vcu, const int G) {
    int tid0 = threadIdx.x; asm volatile("" : "+v"(tid0));
    const int w = __builtin_amdgcn_readfirstlane(tid0 >> 6);
    LAS float* VS = (LAS float*)lds; LAS bf16* V16 = (LAS bf16*)(lds + 33792); LAS float* AS = (LAS float*)(lds + 51200); LAS float* BS = (LAS float*)(lds + 84992); LAS float* SEG = (LAS float*)(lds + 118784);
    LAS float* CW = (LAS float*)(lds + 122880); LAS float* CB = (LAS float*)(lds + 124928);
    unsigned char* ws = a->ws;
    const bf16* UR = (const bf16*)(ws + O_UR);
#define SCAN_LANE_VARS(tid) const int lane = (tid) & 63, fr = lane & 15, fq = lane >> 4, t = (tid) >> 3, c16 = ((tid) & 7) * 16, ch = 16 * w + fr, sg = (tid) >> 7, sc = (tid) & 127; \
    (void)fq; (void)sg; (void)sc; (void)ch; (void)t; (void)c16
    int hcur = -1;
    bf16x8 wf[2][2][4]; float bia[2], bix[2], sp8[2];
    u32x4 ur[4][2];
#define SCAN_PREFETCH(uu) do { const int q_ = (uu) >> 3, h_ = (uu) & 7; const bool ic_ = q_ >= 256; const int r0_ = ic_ ? RL + (q_ - 256) * 64 : q_ * 64; \
        const int cp_ = ic_ ? ((q_ - 256) & 3) * 64 : 0, sl_ = ic_ ? LC : GW; \
        _Pragma("unroll") for (int k = 0; k < 4; ++k) { const int p_ = cp_ + t + k - 2; \
            if (p_ >= 0 && p_ < sl_) { const bf16* src_ = UR + (size_t)(r0_ + t + k - 2) * 1024 + h_ * HD + c16; ur[k][0] = *(const u32x4*)src_; ur[k][1] = *(const u32x4*)(src_ + 8); } \
            else { ur[k][0] = (u32x4){0u, 0u, 0u, 0u}; ur[k][1] = (u32x4){0u, 0u, 0u, 0u}; } } } while (0)
    if (vcu < nunits) { SCAN_LANE_VARS(tid0); SCAN_PREFETCH(vcu); }
    for (int u = vcu; u < nunits; u += G) {
        const int q = u >> 3, h = u & 7;
        const int tid = opq(tid0); SCAN_LANE_VARS(tid);
        const bool isctx = q >= 256; const int row0 = isctx ? RL + (q - 256) * 64 : q * 64;
        if (h != hcur) {
            hcur = h;
            __syncthreads();
            if (tid < 128) { CB[tid] = a->in[10][(size_t)l * DL + h * HD + tid];
#pragma unroll
                for (int k = 0; k < 4; ++k) CW[k * 128 + tid] = a->in[9][((size_t)l * 4 + k) * DL + h * HD + tid]; }
#pragma unroll
            for (int dir = 0; dir < 2; ++dir) {
                const bf16* WT = (const bf16*)(ws + O_WAX) + ((size_t)((l * 2 + dir) * 2) * 8 + h) * 128 * 128;
#pragma unroll
                for (int g = 0; g < 2; ++g)
#pragma unroll
                    for (int ks = 0; ks < 4; ++ks) wf[dir][g][ks] = *(const bf16x8*)(WT + (size_t)g * 8 * 128 * 128 + (size_t)ch * 128 + ks * 32 + fq * 8);
                const int gch = h * HD + ch;
                bia[dir] = a->in[12][(size_t)(l * 2 + dir) * DL + gch]; bix[dir] = a->in[14][(size_t)(l * 2 + dir) * DL + gch];
                sp8[dir] = 8.f * log1pf(expf(-a->in[15][(size_t)(l * 2 + dir) * DL + gch]));
            }
            __syncthreads();
        }
        float car[2]; u32x4 gg0, gg1;
        if (PASS == 2) {
            car[0] = ((const float*)(ws + O_CAR))[((size_t)q * 2 + 0) * 1024 + h * HD + sc]; car[1] = ((const float*)(ws + O_CAR))[((size_t)q * 2 + 1) * 1024 + h * HD + sc];
            const bf16* GGp = (const bf16*)(ws + O_GG) + (size_t)(row0 + t) * 1024 + h * HD + c16; gg0 = *(const u32x4*)GGp; gg1 = *(const u32x4*)(GGp + 8);
        }
        {
            float v[16];
#pragma unroll
            for (int i = 0; i < 16; i += 4) { const f32x4 b4 = *(const LAS f32x4*)(CB + c16 + i); v[i] = b4.x; v[i + 1] = b4.y; v[i + 2] = b4.z; v[i + 3] = b4.w; }
#pragma unroll
            for (int k = 0; k < 4; ++k) { const unsigned uu[8] = {ur[k][0].x, ur[k][0].y, ur[k][0].z, ur[k][0].w, ur[k][1].x, ur[k][1].y, ur[k][1].z, ur[k][1].w};
#pragma unroll
                for (int i = 0; i < 16; i += 4) { const f32x4 wv = *(const LAS f32x4*)(CW + k * 128 + c16 + i);
                    v[i] = fmaf(wv.x, bf_lo(uu[i / 2]), v[i]); v[i + 1] = fmaf(wv.y, bf_hi(uu[i / 2]), v[i + 1]); v[i + 2] = fmaf(wv.z, bf_lo(uu[i / 2 + 1]), v[i + 2]); v[i + 3] = fmaf(wv.w, bf_hi(uu[i / 2 + 1]), v[i + 3]); } }
#pragma unroll
            for (int i = 0; i < 16; i += 4) *(LAS f32x4*)(VS + t * 132 + c16 + i) = (f32x4){v[i], v[i + 1], v[i + 2], v[i + 3]};
            u32x4 o0, o1; o0.x = cvt_pk_bf16(v[0], v[1]); o0.y = cvt_pk_bf16(v[2], v[3]); o0.z = cvt_pk_bf16(v[4], v[5]); o0.w = cvt_pk_bf16(v[6], v[7]);
            o1.x = cvt_pk_bf16(v[8], v[9]); o1.y = cvt_pk_bf16(v[10], v[11]); o1.z = cvt_pk_bf16(v[12], v[13]); o1.w = cvt_pk_bf16(v[14], v[15]);
            *(LAS u32x4*)(V16 + t * 136 + c16) = o0; *(LAS u32x4*)(V16 + t * 136 + c16 + 8) = o1;
        }
        if (u + G < nunits) SCAN_PREFETCH(u + G);
        __syncthreads();
        float hsum[16];
#pragma unroll
        for (int i = 0; i < 16; ++i) hsum[i] = 0.f;
#pragma unroll
        for (int dir = 0; dir < 2; ++dir) {
            f32x4 acc[2][4];
#pragma unroll
            for (int g = 0; g < 2; ++g)
#pragma unroll
                for (int m = 0; m < 4; ++m) acc[g][m] = (f32x4){0.f, 0.f, 0.f, 0.f};
#pragma unroll
            for (int ks = 0; ks < 4; ++ks)
#pragma unroll
                for (int m = 0; m < 4; ++m) { const bf16x8 af = *(const LAS bf16x8*)(V16 + (16 * m + fr) * 136 + ks * 32 + fq * 8);
                    acc[0][m] = __builtin_amdgcn_mfma_f32_16x16x32_bf16(af, wf[dir][0][ks], acc[0][m], 0, 0, 0); acc[1][m] = __builtin_amdgcn_mfma_f32_16x16x32_bf16(af, wf[dir][1][ks], acc[1][m], 0, 0, 0); }
#pragma unroll
            for (int m = 0; m < 4; ++m)
#pragma unroll
                for (int j = 0; j < 4; ++j) { const int tok = 16 * m + 4 * fq + j;
                    const float rr = fsigm(acc[0][m][j] + bia[dir]), ii = fsigm(acc[1][m][j] + bix[dir]), vv = VS[tok * 132 + ch];
                    const float la = -sp8[dir] * rr, av = fexp(la), a2 = av * av;
                    AS[tok * 132 + ch] = av; BS[tok * 132 + ch] = sqrtf(one_minus_exp(2.f * la, a2)) * (ii * vv); }
            __syncthreads();
            {
                float av[16], bv[16];
#pragma unroll
                for (int i = 0; i < 16; ++i) { const int tok = dir ? 63 - (16 * sg + i) : 16 * sg + i; av[i] = AS[tok * 132 + sc]; bv[i] = BS[tok * 132 + sc]; }
                float P = 1.f, hl = 0.f;
#pragma unroll
                for (int i = 0; i < 16; ++i) { hl = fmaf(av[i], hl, bv[i]); P *= av[i]; }
                SEG[(sg * 128 + sc) * 2] = P; SEG[(sg * 128 + sc) * 2 + 1] = hl;
                __syncthreads();
                if (PASS == 1) {
                    if (sg == 0) { float A = 1.f, B = 0.f;
#pragma unroll
                        for (int s2 = 0; s2 < 4; ++s2) { const float p2 = SEG[(s2 * 128 + sc) * 2], h2 = SEG[(s2 * 128 + sc) * 2 + 1]; B = fmaf(p2, B, h2); A *= p2; }
                        *(f32x2*)((float*)(ws + O_TOT) + (((size_t)q * 2 + dir) * 1024 + h * HD + sc) * 2) = (f32x2){A, B}; }
                } else {
                    float hc = car[dir];
#pragma unroll
                    for (int s2 = 0; s2 < 3; ++s2) if (s2 < sg) { const float p2 = SEG[(s2 * 128 + sc) * 2], h2 = SEG[(s2 * 128 + sc) * 2 + 1]; hc = fmaf(p2, hc, h2); }
#pragma unroll
                    for (int i = 0; i < 16; ++i) { const int tok = dir ? 63 - (16 * sg + i) : 16 * sg + i; hc = fmaf(av[i], hc, bv[i]); BS[tok * 132 + sc] = hc; }
                }
            }
            __syncthreads();
            if (PASS == 2) {
#pragma unroll
                for (int i = 0; i < 16; i += 4) { const f32x4 x = *(const LAS f32x4*)(BS + t * 132 + c16 + i); hsum[i] += x.x; hsum[i + 1] += x.y; hsum[i + 2] += x.z; hsum[i + 3] += x.w; }
                __syncthreads();
            }
        }
        if (PASS == 2) {
            const unsigned gu[8] = {gg0.x, gg0.y, gg0.z, gg0.w, gg1.x, gg1.y, gg1.z, gg1.w}; unsigned o[8];
#pragma unroll
            for (int i = 0; i < 8; ++i) o[i] = cvt_pk_bf16(hsum[2 * i] * bf_lo(gu[i]), hsum[2 * i + 1] * bf_hi(gu[i]));
            bf16* dst = (bf16*)(ws + O_HR) + (size_t)(row0 + t) * 1024 + h * HD + c16;
            *(u32x4*)dst = (u32x4){o[0], o[1], o[2], o[3]}; *(u32x4*)(dst + 8) = (u32x4){o[4], o[5], o[6], o[7]};
        }
    }
#undef SCAN_PREFETCH
#undef SCAN_LANE_VARS
}
template <int PASS, int SKIP = 0>
__device__ __forceinline__ void scan_phase2(AP a, LAS unsigned char* lds, const int l, const int nunits, const int vcu, const int G) {
    int tid0 = threadIdx.x; asm volatile("" : "+v"(tid0));
    const int w = __builtin_amdgcn_readfirstlane(tid0 >> 6);
    LAS bf16* V16 = (LAS bf16*)lds; LAS float* HST = (LAS float*)(lds + 34816) + w * (64 * 17); LAS float* CW = (LAS float*)(lds + 69632); LAS float* CB = (LAS float*)(lds + 71680);
    unsigned char* ws = a->ws;
    const bf16* UR = (const bf16*)(ws + O_UR);
#define SCAN_LANE_VARS(tid) const int lane = (tid) & 63, fr = lane & 15, fq = lane >> 4, t = (tid) >> 3, c16 = ((tid) & 7) * 16, ch = 16 * w + fr; (void)fq; (void)ch; (void)t; (void)c16
    int hcur = -1;
    bf16x8 wf[2][2][4]; float nbia[2], nbix[2], nsp8[2];
    u32x4 ur[4][2];
#define SCAN_PREFETCH(uu) do { const int q_ = (uu) >> 3, h_ = (uu) & 7; const bool ic_ = q_ >= 256; const int r0_ = ic_ ? RL + (q_ - 256) * 64 : q_ * 64; \
        if (PASS == 2 && SCAN_VV) { const bf16* src_ = (const bf16*)(ws + O_VV) + (size_t)(r0_ + t) * 1024 + h_ * HD + c16; ur[0][0] = *(const u32x4*)src_; ur[0][1] = *(const u32x4*)(src_ + 8); break; }     \
        const int cp_ = ic_ ? ((q_ - 256) & 3) * 64 : 0, sl_ = ic_ ? LC : GW; \
        _Pragma("unroll") for (int k = 0; k < 4; ++k) { const int p_ = cp_ + t + k - 2; \
            if (p_ >= 0 && p_ < sl_) { const bf16* src_ = UR + (size_t)(r0_ + t + k - 2) * 1024 + h_ * HD + c16; ur[k][0] = *(const u32x4*)src_; ur[k][1] = *(const u32x4*)(src_ + 8); } \
            else { ur[k][0] = (u32x4){0u, 0u, 0u, 0u}; ur[k][1] = (u32x4){0u, 0u, 0u, 0u}; } } } while (0)
    if (vcu < nunits) { SCAN_LANE_VARS(tid0); SCAN_PREFETCH(vcu); }
    int par = 0;
    for (int u = vcu; u < nunits; u += G, par ^= 1) {
        const int q = u >> 3, h = u & 7;
        const int tid = opq(tid0); SCAN_LANE_VARS(tid);
        const bool isctx = q >= 256; const int row0 = isctx ? RL + (q - 256) * 64 : q * 64;
        LAS bf16* Vb = V16 + par * (64 * 136);
        if (h != hcur) {
            hcur = h;
            __syncthreads();
            if (tid < 128) { CB[tid] = a->in[10][(size_t)l * DL + h * HD + tid];
#pragma unroll
                for (int k = 0; k < 4; ++k) CW[k * 128 + tid] = a->in[9][((size_t)l * 4 + k) * DL + h * HD + tid]; }
#pragma unroll
            for (int dir = 0; dir < 2; ++dir) {
                const bf16* WT = (const bf16*)(ws + O_WAX) + ((size_t)((l * 2 + dir) * 2) * 8 + h) * 128 * 128;
#pragma unroll
                for (int g = 0; g < 2; ++g)
#pragma unroll
                    for (int ks = 0; ks < 4; ++ks) wf[dir][g][ks] = *(const bf16x8*)(WT + (size_t)g * 8 * 128 * 128 + (size_t)ch * 128 + ks * 32 + fq * 8);
                const int gch = h * HD + ch;
                nbia[dir] = -1.4426950408889634f * a->in[12][(size_t)(l * 2 + dir) * DL + gch]; nbix[dir] = -1.4426950408889634f * a->in[14][(size_t)(l * 2 + dir) * DL + gch];
                nsp8[dir] = -8.f * 1.4426950408889634f * log1pf(expf(-a->in[15][(size_t)(l * 2 + dir) * DL + gch]));
            }
            __syncthreads();
        }
        float car[2]; u32x4 gg0, gg1;
        if (PASS == 2) {
            car[0] = ((const float*)(ws + O_CAR))[((size_t)q * 2 + 0) * 1024 + h * HD + ch]; car[1] = ((const float*)(ws + O_CAR))[((size_t)q * 2 + 1) * 1024 + h * HD + ch];
            const bf16* GGp = (const bf16*)(ws + O_GG) + (size_t)(row0 + lane) * 1024 + h * HD + 16 * w; gg0 = *(const u32x4*)GGp; gg1 = *(const u32x4*)(GGp + 8);
        }
        if (PASS == 2 && SCAN_VV) { *(LAS u32x4*)(Vb + t * 136 + c16) = ur[0][0]; *(LAS u32x4*)(Vb + t * 136 + c16 + 8) = ur[0][1]; }
        else {
            float v[16];
#pragma unroll
            for (int i = 0; i < 16; i += 4) { const f32x4 b4 = *(const LAS f32x4*)(CB + c16 + i); v[i] = b4.x; v[i + 1] = b4.y; v[i + 2] = b4.z; v[i + 3] = b4.w; }
#pragma unroll
            for (int k = 0; k < 4; ++k) { const unsigned uu[8] = {ur[k][0].x, ur[k][0].y, ur[k][0].z, ur[k][0].w, ur[k][1].x, ur[k][1].y, ur[k][1].z, ur[k][1].w};
#pragma unroll
                for (int i = 0; i < 16; i += 4) { const f32x4 wv = *(const LAS f32x4*)(CW + k * 128 + c16 + i);
                    v[i] = fmaf(wv.x, bf_lo(uu[i / 2]), v[i]); v[i + 1] = fmaf(wv.y, bf_hi(uu[i / 2]), v[i + 1]); v[i + 2] = fmaf(wv.z, bf_lo(uu[i / 2 + 1]), v[i + 2]); v[i + 3] = fmaf(wv.w, bf_hi(uu[i / 2 + 1]), v[i + 3]); } }
            u32x4 o0, o1; o0.x = cvt_pk_bf16(v[0], v[1]); o0.y = cvt_pk_bf16(v[2], v[3]); o0.z = cvt_pk_bf16(v[4], v[5]); o0.w = cvt_pk_bf16(v[6], v[7]);
            o1.x = cvt_pk_bf16(v[8], v[9]); o1.y = cvt_pk_bf16(v[10], v[11]); o1.z = cvt_pk_bf16(v[12], v[13]); o1.w = cvt_pk_bf16(v[14], v[15]);
            *(LAS u32x4*)(Vb + t * 136 + c16) = o0; *(LAS u32x4*)(Vb + t * 136 + c16 + 8) = o1;
            if (PASS == 1 && SCAN_VV) { bf16* vd = (bf16*)(ws + O_VV) + (size_t)(row0 + t) * 1024 + h * HD + c16; *(u32x4*)vd = o0; *(u32x4*)(vd + 8) = o1; }
        }
        if (u + G < nunits) SCAN_PREFETCH(u + G);
        __syncthreads();
        if (SKIP == 1) continue;
        float vv[4][4];
#pragma unroll
        for (int m = 0; m < 4; ++m)
#pragma unroll
            for (int j = 0; j < 4; ++j) vv[m][j] = __uint_as_float(((unsigned)Vb[(16 * m + 4 * fq + j) * 136 + ch]) << 16);
        f32x4 acc2[2][2][4];
#pragma unroll
        for (int d2 = 0; d2 < 2; ++d2)
#pragma unroll
            for (int g = 0; g < 2; ++g)
#pragma unroll
                for (int m = 0; m < 4; ++m) acc2[d2][g][m] = (f32x4){0.f, 0.f, 0.f, 0.f};
#pragma unroll
        for (int ks = 0; ks < 4; ++ks)
#pragma unroll
            for (int m = 0; m < 4; ++m) { const bf16x8 af = *(const LAS bf16x8*)(Vb + (16 * m + fr) * 136 + ks * 32 + fq * 8);
#pragma unroll
                for (int d2 = 0; d2 < 2; ++d2) { acc2[d2][0][m] = __builtin_amdgcn_mfma_f32_16x16x32_bf16(af, wf[d2][0][ks], acc2[d2][0][m], 0, 0, 0); acc2[d2][1][m] = __builtin_amdgcn_mfma_f32_16x16x32_bf16(af, wf[d2][1][ks], acc2[d2][1][m], 0, 0, 0); } }
#pragma unroll
        for (int dir = 0; dir < 2; ++dir) {
            f32x4 (&acc)[2][4] = acc2[dir];
            float av[4][4], bv[4][4];
#pragma unroll
            for (int m = 0; m < 4; ++m)
#pragma unroll
                for (int j = 0; j < 4; ++j) {
                    if (SKIP == 3) { av[m][j] = acc[0][m][j]; bv[m][j] = acc[1][m][j] * vv[m][j]; continue; }
                    const float ex = __builtin_amdgcn_exp2f(fminf(fmaf(acc[0][m][j], -1.4426950408889634f, nbia[dir]), 60.f)), ey = __builtin_amdgcn_exp2f(fminf(fmaf(acc[1][m][j], -1.4426950408889634f, nbix[dir]), 60.f));
                    const float dx = 1.f + ex, dy = 1.f + ey, qq = frcp(dx * dy), rr = qq * dy, ii = qq * dx;
                    const float aa = __builtin_amdgcn_exp2f(nsp8[dir] * rr);
                    av[m][j] = aa; bv[m][j] = __builtin_amdgcn_sqrtf(fmaf(-aa, aa, 1.f)) * (ii * vv[m][j]); }
            float P[4], H[4];
#pragma unroll
            for (int m = 0; m < 4; ++m) { float p = 1.f, hh = 0.f;
#pragma unroll
                for (int i = 0; i < 4; ++i) { const int jj = dir ? 3 - i : i; hh = fmaf(av[m][jj], hh, bv[m][jj]); p *= av[m][jj]; }
                P[m] = p; H[m] = hh; }
            float Ae[4], He[4], TA[4], TB[4];
#pragma unroll
            for (int m = 0; m < 4; ++m) {
                float Pk[4], Hk[4];
#pragma unroll
                for (int k = 0; k < 4; ++k) { Pk[k] = __shfl(P[m], fr + 16 * k); Hk[k] = __shfl(H[m], fr + 16 * k); }
                float A = 1.f, B = 0.f, ae = 1.f, he = 0.f;
#pragma unroll
                for (int i = 0; i < 4; ++i) { const int k = dir ? 3 - i : i; if (k == fq) { ae = A; he = B; } B = fmaf(Pk[k], B, Hk[k]); A *= Pk[k]; }
                Ae[m] = ae; He[m] = he; TA[m] = A; TB[m] = B;
            }
            if (PASS == 1) {
                float A = 1.f, B = 0.f;
#pragma unroll
                for (int i = 0; i < 4; ++i) { const int m = dir ? 3 - i : i; B = fmaf(TA[m], B, TB[m]); A *= TA[m]; }
                if (fq == 0) *(f32x2*)((float*)(ws + (SKIP ? O_CAR : O_TOT)) + (((size_t)(SKIP ? 0 : q) * 2 + dir) * 1024 + h * HD + ch) * 2) = (f32x2){A, B};
            } else {
                float C = car[dir];
#pragma unroll
                for (int i = 0; i < 4; ++i) { const int m = dir ? 3 - i : i;
                    float hh = fmaf(Ae[m], C, He[m]);
#pragma unroll
                    for (int i2 = 0; i2 < 4; ++i2) { const int jj = dir ? 3 - i2 : i2; hh = fmaf(av[m][jj], hh, bv[m][jj]); LAS float* hp = HST + (16 * m + 4 * fq + jj) * 17 + fr; if (dir == 0) *hp = hh; else *hp += hh; }
                    C = fmaf(TA[m], C, TB[m]); }
            }
        }
        if (PASS == 2) {
            LDS_WAIT(); asm volatile("" ::: "memory");
            const unsigned gu[8] = {gg0.x, gg0.y, gg0.z, gg0.w, gg1.x, gg1.y, gg1.z, gg1.w}; unsigned o[8];
#pragma unroll
            for (int i = 0; i < 8; ++i) o[i] = cvt_pk_bf16(HST[lane * 17 + 2 * i] * bf_lo(gu[i]), HST[lane * 17 + 2 * i + 1] * bf_hi(gu[i]));
            bf16* dst = (bf16*)(ws + O_HR) + (size_t)(row0 + lane) * 1024 + h * HD + 16 * w;
            *(u32x4*)dst = (u32x4){o[0], o[1], o[2], o[3]}; *(u32x4*)(dst + 8) = (u32x4){o[4], o[5], o[6], o[7]};
            LDS_WAIT(); asm volatile("" ::: "memory");
        }
    }
#undef SCAN_PREFETCH
#undef SCAN_LANE_VARS
}
__device__ __forceinline__ void dft_stage1(AP a, const LAS f32x2* tab, size_t gt, size_t NGT) {
    unsigned char* ws = a->ws; const bf16* UT = (const bf16*)(ws + O_UT); bf16* ZT = (bf16*)(ws + O_ZT);
    for (size_t it = gt; it < (size_t)1024 * 8 * 64; it += NGT) {
        const int t2b = (int)(it & 63), b = (int)((it >> 6) & 7), c = (int)(it >> 9);
        const bf16* src = UT + (size_t)c * UT_LD + (size_t)b * 4096 + t2b * 4;
        u32x2 uc[8], us[8];
#pragma unroll
        for (int t1 = 0; t1 < 8; ++t1) { uc[t1] = *(const u32x2*)(src + 256 * t1); us[t1] = *(const u32x2*)(src + 2048 + 256 * t1); }
        unsigned zo[8][2][2];
#pragma unroll
        for (int e = 0; e < 4; e += 2) {
            float Zr[2][8], Zi[2][8];
#pragma unroll
            for (int h = 0; h < 2; ++h) {
                float xr[8], xi[8];
#pragma unroll
                for (int t1 = 0; t1 < 8; ++t1) { const unsigned wc_ = uc[t1][e >> 1], ws_ = us[t1][e >> 1]; xr[t1] = h ? bf_hi(wc_) : bf_lo(wc_); xi[t1] = -(h ? bf_hi(ws_) : bf_lo(ws_)); }
                float ar[8], ai[8];
#pragma unroll
                for (int i = 0; i < 4; ++i) { ar[i] = xr[i] + xr[i + 4]; ai[i] = xi[i] + xi[i + 4]; ar[i + 4] = xr[i] - xr[i + 4]; ai[i + 4] = xi[i] - xi[i + 4]; }
                { const float r = 0.70710678118654752f; const float t5r = (ar[5] + ai[5]) * r, t5i = (ai[5] - ar[5]) * r; ar[5] = t5r; ai[5] = t5i;
                  const float t6r = ai[6], t6i = -ar[6]; ar[6] = t6r; ai[6] = t6i;
                  const float t7r = (ai[7] - ar[7]) * r, t7i = (-ar[7] - ai[7]) * r; ar[7] = t7r; ai[7] = t7i; }
                float Xr[8], Xi[8];
#pragma unroll
                for (int o = 0; o < 2; ++o) {
                    const float b0r = ar[4 * o] + ar[4 * o + 2], b0i = ai[4 * o] + ai[4 * o + 2], b1r = ar[4 * o] - ar[4 * o + 2], b1i = ai[4 * o] - ai[4 * o + 2];
                    const float b2r = ar[4 * o + 1] + ar[4 * o + 3], b2i = ai[4 * o + 1] + ai[4 * o + 3];
                    const float dr = ar[4 * o + 1] - ar[4 * o + 3], di = ai[4 * o + 1] - ai[4 * o + 3], b3r = di, b3i = -dr;
                    Xr[o] = b0r + b2r; Xi[o] = b0i + b2i; Xr[2 + o] = b1r + b3r; Xi[2 + o] = b1i + b3i; Xr[4 + o] = b0r - b2r; Xi[4 + o] = b0i - b2i; Xr[6 + o] = b1r - b3r; Xi[6 + o] = b1i - b3i; }
                const int t2 = t2b * 4 + e + h;
                Zr[h][0] = Xr[0]; Zi[h][0] = Xi[0];
#pragma unroll
                for (int k1 = 1; k1 < 8; ++k1) { const f32x2 cs = tab[t2 * k1]; Zr[h][k1] = Xr[k1] * cs.x + Xi[k1] * cs.y; Zi[h][k1] = Xi[k1] * cs.x - Xr[k1] * cs.y; }
            }
#pragma unroll
            for (int k1 = 0; k1 < 8; ++k1) { zo[k1][0][e >> 1] = cvt_pk_bf16(Zr[0][k1], Zr[1][k1]); zo[k1][1][e >> 1] = cvt_pk_bf16(Zi[0][k1], Zi[1][k1]); }
        }
        bf16* dst = ZT + (size_t)c * UT_LD + (size_t)b * 4096 + t2b * 4;
#pragma unroll
        for (int k1 = 0; k1 < 8; ++k1) { *(u32x2*)(dst + k1 * 512) = (u32x2){zo[k1][0][0], zo[k1][0][1]}; *(u32x2*)(dst + k1 * 512 + 256) = (u32x2){zo[k1][1][0], zo[k1][1][1]}; }
    }
}
__device__ __forceinline__ void carry_phase(AP a, int gw, int NGW) {
    const int lane = opq(threadIdx.x) & 63; unsigned char* ws = a->ws;
    const f32x2* TOT = (const f32x2*)(ws + O_TOT); float* CAR = (float*)(ws + O_CAR);
    for (int item = gw; item < NB * 2 * 16; item += NGW) {
        const int cgp = item & 15, dir = (item >> 4) & 1, b = item >> 5, chn = cgp * 64 + lane;
        float hc = 0.f;
#pragma unroll 4
        for (int s = 0; s < 36; ++s) {
            int q; if (dir == 0) q = s < 4 ? 256 + b * 4 + s : b * 32 + (s - 4); else q = s < 4 ? 256 + b * 4 + (3 - s) : b * 32 + (31 - (s - 4));
            const size_t o = ((size_t)q * 2 + dir) * 1024 + chn;
            CAR[o] = hc; const f32x2 ab = TOT[o]; hc = fmaf(ab.x, hc, ab.y);
        }
    }
}
#ifndef FFN_BLK
#define FFN_BLK 1
#endif
#ifndef NORM_REV
#define NORM_REV 0
#endif
#ifndef CODE_SHIFT
#define CODE_SHIFT 0
#endif
#ifndef WGM_FD
#define WGM_FD 2
#endif
#ifndef WGM_MD
#define WGM_MD WGM
#endif
#ifndef WGM_K1
#define WGM_K1 WGM
#endif
#ifndef MOE_WNT
#define MOE_WNT 0
#endif
#ifndef FFN_DOWN_REV
#define FFN_DOWN_REV 1
#endif
#ifndef MOE_DOWN_REV
#define MOE_DOWN_REV 1
#endif
#ifndef MOE_DOWN_XCD
#define MOE_DOWN_XCD 0
#endif
#ifndef PROBE_BAR
#define PROBE_BAR 0
#endif
#ifndef MOE_NT
#define MOE_NT 0
#endif
#ifndef MOE_STAGGER
#define MOE_STAGGER 0
#endif
#ifndef MOE_WGM
#define MOE_WGM 0
#endif
#ifndef MOE_TAILSPLIT
#define MOE_TAILSPLIT 1
#endif
#ifndef SCANV
#define SCANV 2
#endif
#ifndef MOE_KSPLIT
#define MOE_KSPLIT 1
#endif
struct GridSched {
    int G, c, nM, nN, nt; const char* A; const char* B; size_t atile, btile; int rev = 0; int wgm = WGM;
    __device__ __forceinline__ bool next(int i, Unit& u) const {
        const int Lx = i * G + c; if (Lx >= nM * nN) return false;
        tile_of(rev ? nM * nN - 1 - Lx : Lx, nM, nN, u.pm, u.pn, wgm); u.A = A + (size_t)u.pm * atile; u.B = B + (size_t)u.pn * btile; u.nt = nt; u.kind = 0; u.x = 0; return true; }
};
struct FoldSched { int G, c; const char* DGp; const char* WUF;
    __device__ __forceinline__ bool next(int i, Unit& u) const {
        const int Lx = i * G + c; if (Lx >= 64) return false;
        const int pn = Lx & 7, g = (Lx >> 3) & 3, l = Lx >> 5;
        u.pm = 0; u.pn = pn; u.kind = g; u.x = l; { int n4 = 4; asm volatile("" : "+s"(n4)); u.nt = n4; }
        u.A = DGp; u.B = WUF + ((size_t)l * 2048 + pn * 256) * 1024 * 2 + (size_t)g * 256 * 2; return true; }
};
struct EpiFold { static constexpr bool PERM = true; bf16* WIN;
    __device__ __forceinline__ void operator()(const f32x4 (&acc)[2][2][4][2], const Unit& u, int wr, int wc, int fr, int fq) const { fr = opq(fr);
        bf16* base = WIN + (size_t)u.x * WIN_ROWS * 2048;
#pragma unroll
        for (int ai = 0; ai < 2; ++ai)
#pragma unroll
            for (int m = 0; m < 4; ++m) { const int row = u.kind * 256 + ai * HALF + wr * 64 + m * 16 + fr; bf16* rp = base + (size_t)row * 2048 + u.pn * 256 + wc * 32 + 8 * fq;
#pragma unroll
                for (int bj = 0; bj < 2; ++bj) { const f32x4 v0 = acc[ai][bj][m][0], v1 = acc[ai][bj][m][1];
                    u32x4 w; w.x = cvt_pk_bf16(v0[0], v0[1]); w.y = cvt_pk_bf16(v0[2], v0[3]); w.z = cvt_pk_bf16(v1[0], v1[1]); w.w = cvt_pk_bf16(v1[2], v1[3]); *(u32x4*)(rp + bj * HALF) = w; } __builtin_amdgcn_sched_barrier(0); }
    }
};
#ifndef LANE_LIN
#define LANE_LIN 1
#endif
__device__ __forceinline__ size_t lin_off(int pm, int pn8, int ai, int m, int bj, int tl);
struct WinSched { int G, c, l; const char* HNp; const char* WINl;
    __device__ __forceinline__ bool next(int i, Unit& u) const {
        int Lx = i * G + c; const int ntok = l == 0 ? 72 : 64; const int NC1 = WIN_F8 ? 8 : 24; const int n0 = 4 * ntok, n1 = ntok * NC1, n2 = l == 0 ? 0 : 32;
        if (Lx >= n0 + n1 + n2) return false;
        u.nt = 32; u.x = 0;
        if (Lx < n0) { tile_of(Lx, 4, ntok, u.pm, u.pn); u.kind = 0; u.A = WINl + (size_t)u.pm * 256 * 2048 * 2; u.B = HNp + (size_t)u.pn * 256 * 2048 * 2; return true; }
        Lx -= n0;
        if (Lx < n1) tile_of(Lx, ntok, NC1, u.pm, u.pn); else { Lx -= n1; u.pm = 64 + (Lx & 7); u.pn = Lx >> 3; }
        u.kind = 1; u.A = HNp + (size_t)u.pm * 256 * 2048 * 2; u.B = WINl + (size_t)(1024 + u.pn * 256) * 2048 * 2; return true; }
};
struct EpiWin { static constexpr bool PERM = true; bf16 *UT, *UR, *GG, *SGF, *SGR;
    __device__ __forceinline__ void operator()(const f32x4 (&acc)[2][2][4][2], const Unit& u, int wr, int wc, int fr, int fq) const { fr = opq(fr);
        if (u.kind == 0) {
#pragma unroll
            for (int ai = 0; ai < 2; ++ai)
#pragma unroll
                for (int m = 0; m < 4; ++m) { const int rho = ai * HALF + wr * 64 + m * 16 + fr, sn = rho > 128 ? 1 : 0, c = sn ? rho - 128 : rho, cm = (256 - c) & 255;
                    const int ch = u.pm * 256 + c, chm = u.pm * 256 + cm;
#pragma unroll
                    for (int bj = 0; bj < 2; ++bj) { const int r = u.pn * 256 + bj * HALF + wc * 32 + 8 * fq;
                        const size_t tof = r < RL ? (size_t)(r >> 11) * 4096 + (r & 2047) : (size_t)32768 + ((r - RL) >> 8) * 512 + ((r - RL) & 255);
                        const size_t sof = r < RL ? 2048 : 256;
                        const f32x4 v0 = acc[ai][bj][m][0], v1 = acc[ai][bj][m][1];
                        u32x4 w; w.x = cvt_pk_bf16(v0[0], v0[1]); w.y = cvt_pk_bf16(v0[2], v0[3]); w.z = cvt_pk_bf16(v1[0], v1[1]); w.w = cvt_pk_bf16(v1[2], v1[3]);
                        if (sn == 0) { *(u32x4*)(UT + (size_t)ch * UT_LD + tof) = w;
                            if (cm != c) *(u32x4*)(UT + (size_t)chm * UT_LD + tof) = w;
                            else *(u32x4*)(UT + (size_t)ch * UT_LD + tof + sof) = (u32x4){0u, 0u, 0u, 0u}; }
                        else { *(u32x4*)(UT + (size_t)ch * UT_LD + tof + sof) = w;
                            const u32x4 wn = (u32x4){w.x ^ 0x80008000u, w.y ^ 0x80008000u, w.z ^ 0x80008000u, w.w ^ 0x80008000u}; *(u32x4*)(UT + (size_t)chm * UT_LD + tof + sof) = wn; } }
                    __builtin_amdgcn_sched_barrier(0); }
        } else {
            const int pn = u.pn; bf16* base; int ldc, ct, act;
            if (pn < 4) { base = UR; ldc = 1024; ct = pn; act = 0; } else if (pn < 8) { base = GG; ldc = 1024; ct = pn - 4; act = 1; }
            else if (pn < 16) { base = SGF; ldc = 2048; ct = pn - 8; act = 2; } else { base = SGR; ldc = 2048; ct = pn - 16; act = 2; }
#pragma unroll
            for (int ai = 0; ai < 2; ++ai)
#pragma unroll
                for (int m = 0; m < 4; ++m) { const int r = u.pm * 256 + ai * HALF + wr * 64 + m * 16 + fr; bf16* rp = base + (size_t)r * ldc + ct * 256 + wc * 32 + 8 * fq;
                    const int tl = (wr * 4 + wc) * 64 + fq * 16 + fr;
#pragma unroll
                    for (int bj = 0; bj < 2; ++bj) { f32x4 v0 = acc[ai][bj][m][0], v1 = acc[ai][bj][m][1];
                        if (act == 1) {
#pragma unroll
                            for (int j = 0; j < 4; ++j) { v0[j] = fgelu(v0[j]); v1[j] = fgelu(v1[j]); } }
                        else if (act == 2) {
#pragma unroll
                            for (int j = 0; j < 4; ++j) { v0[j] = fsigm(v0[j]); v1[j] = fsigm(v1[j]); } }
                        u32x4 w; w.x = cvt_pk_bf16(v0[0], v0[1]); w.y = cvt_pk_bf16(v0[2], v0[3]); w.z = cvt_pk_bf16(v1[0], v1[1]); w.w = cvt_pk_bf16(v1[2], v1[3]);
                        *(u32x4*)((LANE_LIN && act == 2) ? base + lin_off(u.pm, ct, ai, m, bj, tl) : rp + bj * HALF) = w; } __builtin_amdgcn_sched_barrier(0); }
        }
    }
};
struct WinSched8 { int G, c, l; const char* HN8p; const char* WIN8l;
    __device__ __forceinline__ bool next(int i, Unit& u) const {
        const int ntok = l == 0 ? 72 : 64; const int Lx = i * G + (G - 1 - c); if (Lx >= ntok * 16) return false;
        int pml, pnl; tile_of(Lx, ntok, 16, pml, pnl); u.pm = pml; u.pn = 8 + pnl; u.kind = 1; u.x = 0; u.nt = 16;
        u.A = HN8p + (size_t)pml * 256 * 2048; u.B = WIN8l + (size_t)pnl * 256 * 2048; return true; }
};
struct EpiWinGate8 { static constexpr bool PERM = true; bf16 *SGF, *SGR; float sc;
    __device__ __forceinline__ void operator()(const f32x4 (&acc)[2][2][4][2], const Unit& u, int wr, int wc, int fr, int fq) const { fr = opq(fr); fq = opq(fq);
        const int pn = u.pn; bf16* base = pn < 16 ? SGF : SGR; const int ct = pn < 16 ? pn - 8 : pn - 16;
#pragma unroll
        for (int ai = 0; ai < 2; ++ai)
#pragma unroll
            for (int m = 0; m < 4; ++m) { const int r = u.pm * 256 + ai * HALF + wr * 64 + m * 16 + fr; bf16* rp = base + (size_t)r * 2048 + ct * 256 + wc * 32 + 8 * fq;
                const int tl = (wr * 4 + wc) * 64 + fq * 16 + fr;
#pragma unroll
                for (int bj = 0; bj < 2; ++bj) { f32x4 v0 = acc[ai][bj][m][0] * sc, v1 = acc[ai][bj][m][1] * sc;
#pragma unroll
                    for (int j = 0; j < 4; ++j) { v0[j] = fsigm(v0[j]); v1[j] = fsigm(v1[j]); }
                    u32x4 w; w.x = cvt_pk_bf16(v0[0], v0[1]); w.y = cvt_pk_bf16(v0[2], v0[3]); w.z = cvt_pk_bf16(v1[0], v1[1]); w.w = cvt_pk_bf16(v1[2], v1[3]);
                    *(u32x4*)(LANE_LIN ? base + lin_off(u.pm, ct, ai, m, bj, tl) : rp + bj * HALF) = w; } __builtin_amdgcn_sched_barrier(0); }
    }
};
struct DftSched { int G, c, l; const char* FLp; const char* FLCp; const char* UTp; const char* ZTp;
    __device__ __forceinline__ bool next(int i, Unit& u) const {
        int Lx = i * G + c; const int n0 = 256, n1 = l == 0 ? 32 : 0;
        if (Lx >= n0 + n1) return false;
#if DFT2
        if (Lx < n0) { const int b = Lx & 7, rest = Lx >> 3, pn = rest & 3, k1 = rest >> 2; u.pm = k1; u.pn = pn; u.kind = 0; u.x = b; u.nt = 8;
            u.A = FLp; u.B = ZTp + ((size_t)pn * 256 * UT_LD + (size_t)(b * 8 + k1) * 512) * 2; return true; }
#else
        if (Lx < n0) { const int b = Lx & 7, rest = Lx >> 3, pn = rest & 3, pm = rest >> 2; u.pm = pm; u.pn = pn; u.kind = 0; u.x = b; u.nt = 64;
            u.A = FLp + (size_t)pm * 256 * 4096 * 2; u.B = UTp + ((size_t)pn * 256 * UT_LD + (size_t)b * 4096) * 2; return true; }
#endif
        Lx -= n0; { const int b = Lx & 7, pn = Lx >> 3; u.pm = 0; u.pn = pn; u.kind = 1; u.x = b; u.nt = 8;
            u.A = FLCp; u.B = UTp + ((size_t)pn * 256 * UT_LD + 32768 + (size_t)b * 512) * 2; return true; }
    }
};
struct EpiBf16Rows { static constexpr bool PERM = true; bf16* O; int ldc;
    bool dft;
    __device__ __forceinline__ void operator()(const f32x4 (&acc)[2][2][4][2], const Unit& u, int wr, int wc, int fr, int fq) const { fr = opq(fr);
        const int rs = (DFT2 && dft && u.kind == 0) ? 8 : 1;
        const int row0 = dft ? (u.kind == 0 ? (DFT2 ? u.x * 2048 + u.pm : u.x * 2048 + u.pm * 256) : RL + u.x * 256) : u.pm * 256 + u.x * MAXSLOT;
#pragma unroll
        for (int ai = 0; ai < 2; ++ai)
#pragma unroll
            for (int m = 0; m < 4; ++m) { bf16* rp = O + (size_t)(row0 + rs * (ai * HALF + wr * 64 + m * 16 + fr)) * ldc + u.pn * 256 + wc * 32 + 8 * fq;
#pragma unroll
                for (int bj = 0; bj < 2; ++bj) { const f32x4 v0 = acc[ai][bj][m][0], v1 = acc[ai][bj][m][1];
                    u32x4 w; w.x = cvt_pk_bf16(v0[0], v0[1]); w.y = cvt_pk_bf16(v0[2], v0[3]); w.z = cvt_pk_bf16(v1[0], v1[1]); w.w = cvt_pk_bf16(v1[2], v1[3]); *(u32x4*)(rp + bj * HALF) = w; } __builtin_amdgcn_sched_barrier(0); }
    }
};
#ifndef LANE_LIN
#define LANE_LIN 1
#endif
__device__ __forceinline__ size_t lin_off(int pm, int pn8, int ai, int m, int bj, int tl) { return ((size_t)(pm * 8 + pn8) << 16) + (size_t)((((ai * 4 + m) * 2 + bj) * 512 + tl) * 8); }
template <bool ADD> struct EpiGate { static constexpr bool PERM = true; bf16* O; const bf16* gate; const bf16* addend;
    __device__ __forceinline__ void operator()(const f32x4 (&acc)[2][2][4][2], const Unit& u, int wr, int wc, int fr, int fq) const { fr = opq(fr);
        const int tl = (wr * 4 + wc) * 64 + fq * 16 + fr;
#pragma unroll
        for (int ai = 0; ai < 2; ++ai) {
            u32x4 g[4][2], t[4][2];
#pragma unroll
            for (int m = 0; m < 4; ++m) { const size_t off = (size_t)(u.pm * 256 + ai * HALF + wr * 64 + m * 16 + fr) * 2048 + u.pn * 256 + wc * 32 + 8 * fq;
#pragma unroll
                for (int bj = 0; bj < 2; ++bj) { const size_t lo = LANE_LIN ? lin_off(u.pm, u.pn, ai, m, bj, tl) : off + bj * HALF; g[m][bj] = *(const u32x4*)(gate + lo); if (ADD) t[m][bj] = *(const u32x4*)(addend + lo); } }
#pragma unroll
            for (int m = 0; m < 4; ++m) { const size_t off = (size_t)(u.pm * 256 + ai * HALF + wr * 64 + m * 16 + fr) * 2048 + u.pn * 256 + wc * 32 + 8 * fq;
#pragma unroll
                for (int bj = 0; bj < 2; ++bj) { const f32x4 v0 = acc[ai][bj][m][0], v1 = acc[ai][bj][m][1]; const u32x4 gg = g[m][bj];
                    float o[8] = {v0[0] * bf_lo(gg.x), v0[1] * bf_hi(gg.x), v0[2] * bf_lo(gg.y), v0[3] * bf_hi(gg.y), v1[0] * bf_lo(gg.z), v1[1] * bf_hi(gg.z), v1[2] * bf_lo(gg.w), v1[3] * bf_hi(gg.w)};
                    if (ADD) { const u32x4 tt = t[m][bj];
                        o[0] += bf_lo(tt.x); o[1] += bf_hi(tt.x); o[2] += bf_lo(tt.y); o[3] += bf_hi(tt.y); o[4] += bf_lo(tt.z); o[5] += bf_hi(tt.z); o[6] += bf_lo(tt.w); o[7] += bf_hi(tt.w); }
                    u32x4 w; w.x = cvt_pk_bf16(o[0], o[1]); w.y = cvt_pk_bf16(o[2], o[3]); w.z = cvt_pk_bf16(o[4], o[5]); w.w = cvt_pk_bf16(o[6], o[7]);
                    *(u32x4*)(O + ((LANE_LIN && !ADD) ? lin_off(u.pm, u.pn, ai, m, bj, tl) : off + bj * HALF)) = w; } }
            asm volatile("" ::: "memory"); __builtin_amdgcn_sched_barrier(0); }
    }
};
template <bool FIRST> struct EpiResid { static constexpr bool PERM = false; float* lat; const float* modl; int gate_chunk; const float* x0; const float* c0; float osc = 1.f;
    __device__ __forceinline__ void operator()(const f32x4 (&acc)[2][2][4][2], const Unit& u, int wr, int wc, int fr, int fq) const { fr = opq(fr);
        const int bi = u.pm < 64 ? (u.pm >> 3) : 8; const int col0 = u.pn * 256 + wc * 32 + 4 * fq;
        const float* gp = modl + (size_t)bi * 12288 + gate_chunk * D + col0;
        f32x4 gv[2][2];
#pragma unroll
        for (int bj = 0; bj < 2; ++bj)
#pragma unroll
            for (int n = 0; n < 2; ++n) gv[bj][n] = *(const f32x4*)(gp + bj * HALF + n * 16) * osc;
#pragma unroll
        for (int ai = 0; ai < 2; ++ai) {
            f32x4 bsv[4][2][2];
#pragma unroll
            for (int m = 0; m < 4; ++m) { const int row = u.pm * 256 + ai * HALF + wr * 64 + m * 16 + fr; const float* rp = lat + (size_t)row * D + col0;
                const float* bp = FIRST ? (u.pm < 64 ? x0 + (size_t)row * D + col0 : c0 + (size_t)(row - RL) * D + col0) : rp;
#pragma unroll
                for (int bj = 0; bj < 2; ++bj)
#pragma unroll
                    for (int n = 0; n < 2; ++n) bsv[m][bj][n] = *(const f32x4*)(bp + bj * HALF + n * 16); }
#pragma unroll
            for (int m = 0; m < 4; ++m) { const int row = u.pm * 256 + ai * HALF + wr * 64 + m * 16 + fr; float* rp = lat + (size_t)row * D + col0;
#pragma unroll
                for (int bj = 0; bj < 2; ++bj)
#pragma unroll
                    for (int n = 0; n < 2; ++n) *(f32x4*)(rp + bj * HALF + n * 16) = bsv[m][bj][n] + gv[bj][n] * acc[ai][bj][m][n]; }
            asm volatile("" ::: "memory"); __builtin_amdgcn_sched_barrier(0); }
    }
};
struct EpiNull { static constexpr bool PERM = true; float* sink;
    __device__ __forceinline__ void operator()(const f32x4 (&acc)[2][2][4][2], const Unit& u, int wr, int wc, int fr, int fq) const {
        float s = 0.f;
#pragma unroll
        for (int ai = 0; ai < 2; ++ai)
#pragma unroll
            for (int bj = 0; bj < 2; ++bj)
#pragma unroll
                for (int m = 0; m < 4; ++m)
#pragma unroll
                    for (int n = 0; n < 2; ++n) s += acc[ai][bj][m][n][0] + acc[ai][bj][m][n][1] + acc[ai][bj][m][n][2] + acc[ai][bj][m][n][3];
        if (s == 1.2345e30f) sink[u.pm] = s;
    }
};
template <bool NT> struct EpiSwigluT { static constexpr bool PERM = true; bf16* O; int ldc; int blk = 0;
    __device__ __forceinline__ void operator()(const f32x4 (&acc)[2][2][4][2], const Unit& u, int wr, int wc, int fr, int fq) const { fr = opq(fr);
#pragma unroll
        for (int ai = 0; ai < 2; ++ai)
#pragma unroll
            for (int m = 0; m < 4; ++m) { bf16* rp = blk ? O + ((size_t)u.pm * blk + u.pn) * 32768 + (size_t)(ai * HALF + wr * 64 + m * 16 + fr) * 128 + wc * 32 + 8 * fq : O + (size_t)(u.pm * 256 + ai * HALF + wr * 64 + m * 16 + fr) * ldc + u.pn * 128 + wc * 32 + 8 * fq;
                const f32x4 g0 = acc[ai][0][m][0], g1 = acc[ai][0][m][1], u0 = acc[ai][1][m][0], u1 = acc[ai][1][m][1];
                u32x4 w; w.x = cvt_pk_bf16(fsilu(g0[0]) * u0[0], fsilu(g0[1]) * u0[1]); w.y = cvt_pk_bf16(fsilu(g0[2]) * u0[2], fsilu(g0[3]) * u0[3]);
                w.z = cvt_pk_bf16(fsilu(g1[0]) * u1[0], fsilu(g1[1]) * u1[1]); w.w = cvt_pk_bf16(fsilu(g1[2]) * u1[2], fsilu(g1[3]) * u1[3]); if (NT) __builtin_nontemporal_store(w, (u32x4*)rp); else *(u32x4*)rp = w; __builtin_amdgcn_sched_barrier(0); }
    }
};
typedef EpiSwigluT<false> EpiSwiglu;
struct EpiSwigluF8 { static constexpr bool PERM = true; unsigned char* O; float sc; int nblk = 28;
    __device__ __forceinline__ void operator()(const f32x4 (&acc)[2][2][4][2], const Unit& u, int wr, int wc, int fr, int fq) const { fr = opq(fr); fq = opq(fq);
        const float su = sc * H8_SC;
#pragma unroll
        for (int ai = 0; ai < 2; ++ai)
#pragma unroll
            for (int m = 0; m < 4; ++m) { unsigned char* rp = O + ((size_t)u.pm * nblk + (u.pn >> 1)) * 65536 + (size_t)(ai * HALF + wr * 64 + m * 16 + fr) * 256 + (u.pn & 1) * 128 + wc * 32 + 8 * fq;
                const f32x4 g0 = acc[ai][0][m][0] * sc, g1 = acc[ai][0][m][1] * sc, u0 = acc[ai][1][m][0] * su, u1 = acc[ai][1][m][1] * su;
                u32x2 w; w.x = cvt_fp8x4(fsilu(g0[0]) * u0[0], fsilu(g0[1]) * u0[1], fsilu(g0[2]) * u0[2], fsilu(g0[3]) * u0[3]);
                w.y = cvt_fp8x4(fsilu(g1[0]) * u1[0], fsilu(g1[1]) * u1[1], fsilu(g1[2]) * u1[2], fsilu(g1[3]) * u1[3]); *(u32x2*)rp = w; __builtin_amdgcn_sched_barrier(0); }
    }
};
struct EpiSwigluWrap { static constexpr bool PERM = true; bf16* O; int ldc;
    __device__ __forceinline__ void operator()(const f32x4 (&acc)[2][2][4][2], const Unit& u, int wr, int wc, int fr, int fq) const { fr = opq(fr);
#pragma unroll
        for (int ai = 0; ai < 2; ++ai)
#pragma unroll
            for (int m = 0; m < 4; ++m) { bf16* rp = O + (size_t)((u.pm & 7) * 256 + ai * HALF + wr * 64 + m * 16 + fr) * ldc + u.pn * 128 + wc * 32 + 8 * fq;
                const f32x4 g0 = acc[ai][0][m][0], g1 = acc[ai][0][m][1], u0 = acc[ai][1][m][0], u1 = acc[ai][1][m][1];
                u32x4 w; w.x = cvt_pk_bf16(fsilu(g0[0]) * u0[0], fsilu(g0[1]) * u0[1]); w.y = cvt_pk_bf16(fsilu(g0[2]) * u0[2], fsilu(g0[3]) * u0[3]);
                w.z = cvt_pk_bf16(fsilu(g1[0]) * u1[0], fsilu(g1[1]) * u1[1]); w.w = cvt_pk_bf16(fsilu(g1[2]) * u1[2], fsilu(g1[3]) * u1[3]); *(u32x4*)rp = w; __builtin_amdgcn_sched_barrier(0); }
    }
};
__device__ __forceinline__ const char* uni_ptr(const char* p) { const unsigned long long v = (unsigned long long)p;
    const unsigned lo = (unsigned)__builtin_amdgcn_readfirstlane((int)(unsigned)v), hi = (unsigned)__builtin_amdgcn_readfirstlane((int)(unsigned)(v >> 32)); return (const char*)(((unsigned long long)hi << 32) | lo); }
__device__ __forceinline__ void uni_unit(Unit& u) { u.A = uni_ptr(u.A); u.B = uni_ptr(u.B); u.pm = __builtin_amdgcn_readfirstlane(u.pm); u.pn = __builtin_amdgcn_readfirstlane(u.pn);
    u.kind = __builtin_amdgcn_readfirstlane(u.kind); u.x = __builtin_amdgcn_readfirstlane(u.x); u.nt = __builtin_amdgcn_readfirstlane(u.nt); }
struct MoeSched { int G, c, nN, nt; const LAS int* tbl; const char* A; const char* B; size_t atile, btile, bexp; int ksplit; size_t khalf;
    __device__ __forceinline__ bool next(int i, Unit& u) const {
        int Lx = i * G + c; const int total = tbl[8] * nN; if (Lx >= total * ksplit) return false;
        int kh = 0; if (ksplit == 2) { kh = Lx >= total ? 1 : 0; Lx -= kh * total; }
        int e = 0;
#pragma unroll
        for (int k = 1; k < 8; ++k) e += (Lx >= tbl[k] * nN) ? 1 : 0;
        const int t0 = tbl[e], te = tbl[e + 1] - t0, lx = Lx - t0 * nN;
        { int pml, pnl; tile_of(lx, te, nN, pml, pnl, MOE_WGM ? (MOE_WGM < te ? MOE_WGM : te) : WGM); u.pm = t0 + pml; u.pn = pnl; }
        u.kind = e; u.x = kh; u.nt = nt;
        u.A = A + (size_t)u.pm * atile + (size_t)kh * khalf; u.B = B + (size_t)e * bexp + (size_t)u.pn * btile + (size_t)kh * khalf; uni_unit(u); return true; }
};


struct MoeDownSched { int G, c, sp; const LAS int* tbl; const char* A; const char* B; size_t atile, btile, bexp;
    __device__ __forceinline__ bool next(int i, Unit& u) const {
        const int U = tbl[8] * 8, full = U / G, R = U - full * G;
        int Lx = i * G + c, k = 0, rr = -1;
        if (i > full) return false;
        if (i == full) { if (sp > 1) { if (c >= R * sp) return false; rr = c / sp; k = c - rr * sp; Lx = full * G + rr; } else if (c >= R) return false; }
        else if (MOE_DOWN_REV) Lx = full * G - 1 - Lx;
        int e = 0;
#pragma unroll
        for (int kk = 1; kk < 8; ++kk) e += (Lx >= tbl[kk] * 8) ? 1 : 0;
        const int t0 = tbl[e], te = tbl[e + 1] - t0, lx = Lx - t0 * 8;
#if MOE_DOWN_XCD
        { const int id = (lx & 7) * te + (lx >> 3); u.pm = t0 + (id >> 3); u.pn = id & 7; }
#else
        { int pml, pnl; tile_of(lx, te, 8, pml, pnl, WGM_MD); u.pm = t0 + pml; u.pn = pnl; }
#endif
        u.kind = e; const int nts = rr < 0 ? (MOE_F8 ? 56 : 112) : (MOE_F8 ? 56 : 112) / sp; u.nt = nts; u.x = rr < 0 ? 0 : 1 + rr * 16 + k;
        const size_t ko = MOE_BLK ? (size_t)k * (nts >> 1) * 65536 : (size_t)k * nts * 128;
        u.A = A + (size_t)u.pm * atile + ko; u.B = B + (size_t)e * bexp + (size_t)u.pn * btile + ko; uni_unit(u); return true; }
};
struct EpiMoeDown { static constexpr bool PERM = true; bf16* O; float* part; unsigned* cnt; int sp; float osc = 1.f;
    __device__ __forceinline__ void store_rows(const f32x4 (&v)[2][2][4][2], const Unit& u, int wr, int wc, int fr, int fq) const {
#pragma unroll
        for (int ai = 0; ai < 2; ++ai)
#pragma unroll
            for (int m = 0; m < 4; ++m) { bf16* rp = O + (size_t)(u.pm * 256 + ai * HALF + wr * 64 + m * 16 + fr) * 2048 + u.pn * 256 + wc * 32 + 8 * fq;
#pragma unroll
                for (int bj = 0; bj < 2; ++bj) { const f32x4 v0 = v[ai][bj][m][0] * osc, v1 = v[ai][bj][m][1] * osc;
                    u32x4 w; w.x = cvt_pk_bf16(v0[0], v0[1]); w.y = cvt_pk_bf16(v0[2], v0[3]); w.z = cvt_pk_bf16(v1[0], v1[1]); w.w = cvt_pk_bf16(v1[2], v1[3]); *(u32x4*)(rp + bj * HALF) = w; } __builtin_amdgcn_sched_barrier(0); }
    }
    template <int SP> __device__ __forceinline__ void reduce_store(const float* P0, const Unit& u, int wr, int wc, int fr, int fq) const {
        constexpr int NPB = SP <= 4 ? 4 : (SP <= 8 ? 2 : 1);
#pragma unroll
        for (int ai = 0; ai < 2; ++ai)
#pragma unroll
            for (int m = 0; m < 4; ++m) { bf16* rp = O + (size_t)(u.pm * 256 + ai * HALF + wr * 64 + m * 16 + fr) * 2048 + u.pn * 256 + wc * 32 + 8 * fq;
                f32x4 v[4];
#pragma unroll
                for (int p0 = 0; p0 < 4; p0 += NPB) { f32x4 t[NPB][SP];
#pragma unroll
                    for (int pp = 0; pp < NPB; ++pp) { const int idx = (ai * 4 + m) * 4 + p0 + pp;
#pragma unroll
                        for (int kk = 0; kk < SP; ++kk) t[pp][kk] = *(const f32x4*)(P0 + ((size_t)kk << 16) + idx * 2048); }
#pragma unroll
                    for (int pp = 0; pp < NPB; ++pp) { f32x4 a4 = t[pp][0];
#pragma unroll
                        for (int kk = 1; kk < SP; ++kk) a4 += t[pp][kk];
                        v[p0 + pp] = a4 * osc; }
                    asm volatile("" ::: "memory"); }
#pragma unroll
                for (int bj = 0; bj < 2; ++bj) { u32x4 w; w.x = cvt_pk_bf16(v[2 * bj][0], v[2 * bj][1]); w.y = cvt_pk_bf16(v[2 * bj][2], v[2 * bj][3]); w.z = cvt_pk_bf16(v[2 * bj + 1][0], v[2 * bj + 1][1]); w.w = cvt_pk_bf16(v[2 * bj + 1][2], v[2 * bj + 1][3]);
                    *(u32x4*)(rp + bj * HALF) = w; }
                __builtin_amdgcn_sched_barrier(0); }
    }
    __device__ __forceinline__ void operator()(const f32x4 (&acc)[2][2][4][2], const Unit& u, int wr, int wc, int fr, int fq) const { fr = opq(fr); fq = opq(fq);
        if (u.x == 0) { store_rows(acc, u, wr, wc, fr, fq); return; }
        const int rr = (u.x - 1) >> 4, k = (u.x - 1) & 15, wid = wr * 4 + wc, tl = wid * 64 + fq * 16 + fr;
        float* P = part + ((size_t)(rr * sp + k) << 16) + (size_t)tl * 4;
#pragma unroll
        for (int ai = 0; ai < 2; ++ai)
#pragma unroll
            for (int m = 0; m < 4; ++m)
#pragma unroll
                for (int bj = 0; bj < 2; ++bj)
#pragma unroll
                    for (int n = 0; n < 2; ++n) { const int idx = ((ai * 4 + m) * 2 + bj) * 2 + n; float* q = P + idx * 2048; const f32x4 vv = acc[ai][bj][m][n];
                        asm volatile("global_store_dwordx4 %0, %1, off sc1" :: "v"(q), "v"(vv) : "memory"); }
        asm volatile("s_waitcnt vmcnt(0)" ::: "memory");
        unsigned tk = 0u; if (fq * 16 + fr == 0) tk = __hip_atomic_fetch_add(cnt + rr * 8 + wid, 1u, __ATOMIC_RELAXED, __HIP_MEMORY_SCOPE_AGENT);
        tk = (unsigned)__builtin_amdgcn_readfirstlane((int)tk);
        if (tk + 1u == (unsigned)sp) {
            __builtin_amdgcn_fence(__ATOMIC_ACQUIRE, "agent"); asm volatile("s_waitcnt vmcnt(0)" ::: "memory");
            const float* P0 = part + ((size_t)(rr * sp) << 16) + (size_t)tl * 4;
            switch (sp) { case 2: reduce_store<2>(P0, u, wr, wc, fr, fq); break; case 4: reduce_store<4>(P0, u, wr, wc, fr, fq); break; case 7: reduce_store<7>(P0, u, wr, wc, fr, fq); break;
                          case 8: reduce_store<8>(P0, u, wr, wc, fr, fq); break; default: reduce_store<14>(P0, u, wr, wc, fr, fq); break; }
        }
    }
};

__device__ __forceinline__ void moe_gather(AP a, LAS unsigned char* lds, int vcu, int G) {
    const int tid = opq(threadIdx.x), lane = tid & 63, w = tid >> 6; unsigned char* ws = a->ws;
    LAS int* cl = (LAS int*)lds;
    LAS int* pre = cl + 2048;
    LAS int* off = pre + 8;
    LAS int* tot = off + 24;
    LAS int* sl = tot + 8;
    const int* cntb = (const int*)(ws + O_MISC + M_CNTB); const int* sel = (const int*)(ws + O_MISC + M_SEL);
    int* slot_of = (int*)(ws + O_MISC + M_SLOT);
    const bf16* HN = (const bf16*)(ws + O_HN); bf16* XG = (bf16*)(ws + O_XG);
    for (int i = tid; i < 2048; i += NTHREADS) cl[i] = cntb[i];
    __syncthreads();
    for (int g = vcu; g < 256; g += G) {
        if (tid < 8) { int s = 0, p = 0;
#pragma unroll 8
            for (int j = 0; j < 256; ++j) { const int v = cl[j * 8 + tid]; p += (j < g) ? v : 0; s += v; }
            pre[tid] = p; tot[tid] = s; }
        __syncthreads();
        if (tid == 0) { int o = 0; for (int e = 0; e < 8; ++e) { off[e] = o * 256; off[8 + e] = o; o += (tot[e] + 255) >> 8; } off[16] = o;
            if (g == 0) { int* T = (int*)(ws + O_MISC + M_TOT); for (int e = 0; e < 8; ++e) T[e] = tot[e]; for (int e = 0; e < 9; ++e) T[16 + e] = off[8 + e]; } }
        __syncthreads();
        if (w == 0) { const int tkn = g * 64 + lane; const int s0 = sel[tkn * 2], s1 = sel[tkn * 2 + 1]; int slot0 = 0, slot1 = 0;
            const unsigned long long lt = (1ull << lane) - 1ull;
#pragma unroll
            for (int e = 0; e < 8; ++e) { const unsigned long long mk = __ballot(s0 == e || s1 == e); const int rk = __popcll(mk & lt);
                if (s0 == e) slot0 = off[e] + pre[e] + rk; if (s1 == e) slot1 = off[e] + pre[e] + rk; }
            slot_of[tkn * 2] = slot0; slot_of[tkn * 2 + 1] = slot1; sl[lane * 2] = slot0; sl[lane * 2 + 1] = slot1; }
        __syncthreads();
        if (MOE_F8) {
            for (int t0 = w * 8; t0 < w * 8 + 8; t0 += 4) { u32x4 v8[4][2];
#pragma unroll
                for (int r = 0; r < 4; ++r) { const u32x4* sp_ = (const u32x4*)((const unsigned char*)HN + (size_t)(g * 64 + t0 + r) * D) + lane; v8[r][0] = sp_[0]; v8[r][1] = sp_[64]; }
#pragma unroll
                for (int r = 0; r < 4; ++r) { const int sa = sl[(t0 + r) * 2], sb = sl[(t0 + r) * 2 + 1];
                    u32x4* da = (u32x4*)((unsigned char*)XG + (size_t)sa * D) + lane; u32x4* db = (u32x4*)((unsigned char*)XG + (size_t)sb * D) + lane;
                    da[0] = v8[r][0]; da[64] = v8[r][1]; db[0] = v8[r][0]; db[64] = v8[r][1]; } }
        } else
        for (int p0 = w * 16; p0 < w * 16 + 16; p0 += 4) { u32x4 v[4][4];
#pragma unroll
            for (int r = 0; r < 4; ++r) { const int tkn = g * 64 + ((p0 + r) >> 1); const u32x4* sp_ = (const u32x4*)(HN + (size_t)tkn * D) + lane;
#pragma unroll
                for (int j = 0; j < 4; ++j) v[r][j] = sp_[64 * j]; }
#pragma unroll
            for (int r = 0; r < 4; ++r) { const int slot = sl[p0 + r];
                if (MOE_F8) { u32x2* d8 = (u32x2*)((unsigned char*)XG + (size_t)slot * D) + lane;
#pragma unroll
                    for (int j = 0; j < 4; ++j) { const u32x4 q = v[r][j]; u32x2 o8;
                        o8.x = cvt_fp8x4(bf_lo(q.x) * X8_SC, bf_hi(q.x) * X8_SC, bf_lo(q.y) * X8_SC, bf_hi(q.y) * X8_SC); o8.y = cvt_fp8x4(bf_lo(q.z) * X8_SC, bf_hi(q.z) * X8_SC, bf_lo(q.w) * X8_SC, bf_hi(q.w) * X8_SC);
                        d8[64 * j] = o8; } continue; }
                u32x4* d = (u32x4*)(XG + (size_t)slot * D) + lane;
#pragma unroll
                for (int j = 0; j < 4; ++j) d[64 * j] = v[r][j]; } }
        if (g < 8) { const int r0 = off[g] + tot[g], r1 = off[g] + (((tot[g] + 255) >> 8) << 8);
            for (int r = r0 + w; r < r1; r += NWAVES) {
                if (MOE_F8) { u32x2* d8 = (u32x2*)((unsigned char*)XG + (size_t)r * D) + lane;
#pragma unroll
                    for (int j = 0; j < 4; ++j) d8[64 * j] = (u32x2){0u, 0u}; continue; }
                u32x4* d = (u32x4*)(XG + (size_t)r * D) + lane;
#pragma unroll
                for (int j = 0; j < 4; ++j) d[64 * j] = (u32x4){0u, 0u, 0u, 0u}; } }
        __syncthreads();
    }
}
struct CombIdx { int s0, s1; float w0, w1; };
__device__ __forceinline__ CombIdx comb_idx(const unsigned char* ws, int row) { const int* slot_of = (const int*)(ws + O_MISC + M_SLOT); const float* gwt = (const float*)(ws + O_MISC + M_GWT);
    CombIdx c; c.s0 = slot_of[row * 2]; c.s1 = slot_of[row * 2 + 1]; c.w0 = gwt[row * 2]; c.w1 = gwt[row * 2 + 1]; return c; }
__device__ __forceinline__ void comb_load(const unsigned char* ws, int row, const CombIdx& c, int lane, f32x4 (&xv)[8], u32x2 (&p0)[8], u32x2 (&p1)[8]) {
    const f32x4* xr = (const f32x4*)((const float*)(ws + O_LAT) + (size_t)row * D);
    const u32x2* o0 = (const u32x2*)((const bf16*)(ws + O_OS) + (size_t)c.s0 * D); const u32x2* o1 = (const u32x2*)((const bf16*)(ws + O_OS) + (size_t)c.s1 * D);
#pragma unroll
    for (int j = 0; j < 8; ++j) { const int i4 = lane + 64 * j; xv[j] = xr[i4]; p0[j] = o0[i4]; p1[j] = o1[i4]; }
}
__device__ __forceinline__ void comb_row(AP a, int row, const CombIdx& c, int lane, const f32x4 (&xv)[8], const u32x2 (&p0)[8], const u32x2 (&p1)[8]) {
    const unsigned char* ws = a->ws; const float w0 = c.w0, w1 = c.w1;
    const float* g2 = (const float*)(ws + O_MOD) + ((size_t)9 + (row >> 11)) * 12288 + 5 * D;
    f32x4 v[8]; float s = 0.f;
#pragma unroll
    for (int j = 0; j < 8; ++j) { const int i4 = lane + 64 * j; const f32x4 gg = *(const f32x4*)(g2 + i4 * 4);
        f32x4 m; m.x = w0 * bf_lo(p0[j].x) + w1 * bf_lo(p1[j].x); m.y = w0 * bf_hi(p0[j].x) + w1 * bf_hi(p1[j].x); m.z = w0 * bf_lo(p0[j].y) + w1 * bf_lo(p1[j].y); m.w = w0 * bf_hi(p0[j].y) + w1 * bf_hi(p1[j].y);
        v[j] = xv[j] + gg * m; s += (v[j].x * v[j].x + v[j].y * v[j].y) + (v[j].z * v[j].z + v[j].w * v[j].w); }
    const float rstd = rsqrtf(wave_sum(s) * (1.f / D) + 1e-6f);
    f32x4* out = (f32x4*)(a->out + (size_t)row * D);
#pragma unroll
    for (int j = 0; j < 8; ++j) { const int i4 = lane + 64 * j; out[i4] = v[j] * rstd * *(const f32x4*)(a->in[26] + i4 * 4); }
}
__device__ __forceinline__ void moe_combine_phase(AP a, int gw, int NGW, int lane) {
    const unsigned char* ws = a->ws; int r = gw; if (r >= RL) return;
    CombIdx ci = comb_idx(ws, r), cn = ci; if (r + NGW < RL) cn = comb_idx(ws, r + NGW);
    f32x4 xv[8]; u32x2 p0[8], p1[8]; comb_load(ws, r, ci, lane, xv, p0, p1);
    for (; r < RL; r += NGW) {
        const int rn = r + NGW, rnn = rn + NGW; f32x4 xn[8]; u32x2 q0[8], q1[8]; CombIdx cnn = cn;
        if (rn < RL) comb_load(ws, rn, cn, lane, xn, q0, q1);
        if (rnn < RL) cnn = comb_idx(ws, rnn);
        comb_row(a, r, ci, lane, xv, p0, p1);
#pragma unroll
        for (int j = 0; j < 8; ++j) { xv[j] = xn[j]; p0[j] = q0[j]; p1[j] = q1[j]; }
        ci = cn; cn = cnn;
    }
}

constexpr int NPHASE = 26;
constexpr int l_min(int a, int b) { return a < b ? a : b; }
#ifndef PROBE_PHASE
#define PROBE_PHASE (-1)
#endif
#define REPS(k) (((k) == PROBE_PHASE) ? 2 : 1)
#ifndef CVB
#define CVB 125
#endif
constexpr int cvb(int n) { return (int)((long long)n * CVB / 100); }
#ifndef CVQ
#define CVQ 0, 5000, 5000, 11000, 9000, 30000, 10000, 0
#endif
constexpr int cvq[8] = {CVQ};
constexpr int CV_W00 = 0, CV_W01 = CV_W00 + cvb(cvq[0]), CV_T10 = CV_W01, CV_T11 = CV_T10 + cvb(cvq[1]), CV_MG0 = CV_T11, CV_MG1 = CV_MG0 + cvb(cvq[2]), CV_OUT0 = CV_MG1, CV_OUT1 = CV_OUT0 + cvb(cvq[3]),
              CV_FG0 = CV_OUT1, CV_FG1 = CV_FG0 + cvb(cvq[4]), CV_FD0 = CV_FG1, CV_FD1 = CV_FD0 + cvb(cvq[5]),
              CV_GU0 = N_MOE - cvb(cvq[7]), CV_GU1 = N_MOE,
              CV_WI0 = l_min(CV_FD1, CV_GU0), CV_WI1 = l_min(CV_WI0 + cvb(cvq[6]), CV_GU0), CV_FLUSH = CV_WI1;
static_assert(CV_GU0 >= N_MG + N_MU && CV_FD1 <= N_MOE, "conversion slices");
constexpr int CV_GUS = CV_GU0;
#define TAILCVT(total, c0, c1) do { const int rem_ = (total) % G; if (l == 0 || (c0) == CV_WI0 || (c0) == CV_GUS) { if (rem_ != 0 && bx >= rem_ && (c0) < N_MOE) cvt_moe_range(argp, lds, (c0), l_min((c1), N_MOE), (bx - rem_) * NWAVES + wave, (G - rem_) * NWAVES); __syncthreads(); } } while (0)
template <int l>
__device__ __forceinline__ void layer_phases(LAS unsigned char* lds, unsigned char* ws, const int lo, const int hi, const XcdBarrier& bar, const int G, const int bx, const int vcu, const int gw, const int NGW, const int tid, const int lane, const int wave) {
#define args (*kargs())
#define argp (kargs())
#define IN(k) (lo <= (k) && (k) < hi)
#define SEAM(k) do { if (IN(k) && IN((k) + 1)) { xcd_barrier(bar); if (PROBE_BAR) xcd_barrier(bar); } } while (0)
    const char* HNp = (const char*)(ws + O_HN);
    float* LAT = (float*)(ws + O_LAT);
        const int pb = 2 + 12 * l;
        const float* modl = (const float*)(ws + O_MOD) + (size_t)l * 9 * 12288;
        const int ntok = l == 0 ? 72 : 64;
        if (IN(pb + 0)) for (int rep = 0; rep < REPS(pb + 0); ++rep) { WinSched S{G, bx, l, HNp, (const char*)(ws + O_WIN) + (size_t)l * WIN_ROWS * 2048 * 2};
            EpiWin E{(bf16*)(ws + O_UT), (bf16*)(ws + O_UR), (bf16*)(ws + O_GG), (bf16*)(ws + O_SGF), (bf16*)(ws + O_SGR)}; gemm_phase<EpiWin, WinSched>(lds, 2048, 2048, S, E);
#if WIN_F8
            { WinSched8 S8{G, bx, l, (const char*)(ws + O_HN8), (const char*)(ws + O_WIN8 + (size_t)l * 4096 * 2048)}; EpiWinGate8 E8{(bf16*)(ws + O_SGF), (bf16*)(ws + O_SGR), 1.f / (X8_SC * W8_SC)};
              gemm_phase<EpiWinGate8, WinSched8, G_ALIGN, G_SP2, 0, 1>(lds, 1024, 1024, S8, E8); }
            if (l == 1) TAILCVT(800, CV_WI0, CV_WI1); else TAILCVT(864, CV_W00, CV_W01); }
#else
            if (l == 1) TAILCVT(1824, CV_WI0, CV_WI1); else TAILCVT(2016, CV_W00, CV_W01); }
#endif
        SEAM(pb + 0);
        if (IN(pb + 1)) for (int rep = 0; rep < REPS(pb + 1); ++rep) {
#if defined(PROBE_SKIP)
            if (rep == 1) scan_phase2<1, PROBE_SKIP>(argp, lds, l, NCHUNK * 8, vcu, G); else
#endif
            if (SCANV == 2) scan_phase2<1>(argp, lds, l, NCHUNK * 8, vcu, G); else scan_phase<1>(argp, lds, l, NCHUNK * 8, vcu, G);
#if DFT2
            { __syncthreads(); LAS f32x2* tab = (LAS f32x2*)lds;
              for (int m = opq(tid); m < 2048; m += NTHREADS) { float sn, cs; sincospif((float)m * (1.f / 1024.f), &sn, &cs); tab[m] = (f32x2){cs, sn}; }
              __syncthreads(); dft_stage1(argp, tab, (size_t)vcu * NTHREADS + opq(tid), (size_t)G * NTHREADS); __syncthreads(); }
#endif
            }
        SEAM(pb + 1);
        if (IN(pb + 2)) for (int rep = 0; rep < REPS(pb + 2); ++rep) { DftSched S{G, bx, l, (const char*)(ws + O_FL), (const char*)(ws + O_FLC), (const char*)(ws + O_UT), (const char*)(ws + O_ZT)}; EpiBf16Rows E{(bf16*)(ws + O_Y), 1024, true};
            gemm_phase<EpiBf16Rows, DftSched>(lds, 4096, UT_LD, S, E); carry_phase(argp, opq(gw), NGW); }
        SEAM(pb + 2);
        if (IN(pb + 3)) for (int rep = 0; rep < REPS(pb + 3); ++rep) { GridSched S{G, bx, ntok, 8, 16, (const char*)(ws + O_Y), (const char*)(ws + O_WFO) + (size_t)l * 2048 * 1024 * 2, (size_t)256 * 1024 * 2, (size_t)256 * 1024 * 2, 0, WGM_K1};
            EpiGate<false> E{(bf16*)(ws + O_T1), (const bf16*)(ws + O_SGF), nullptr}; gemm_phase<EpiGate<false>, GridSched>(lds, 1024, 1024, S, E); TAILCVT(ntok * 8, CV_T10, CV_T11);
            if (SCANV == 2) scan_phase2<2>(argp, lds, l, (l == 0 ? NCHUNK : 256) * 8, vcu, G); else scan_phase<2>(argp, lds, l, (l == 0 ? NCHUNK : 256) * 8, vcu, G); }
        SEAM(pb + 3);
        if (IN(pb + 4)) for (int rep = 0; rep < REPS(pb + 4); ++rep) { GridSched S{G, bx, ntok, 8, 16, (const char*)(ws + O_HR), (const char*)(ws + O_WRO) + (size_t)l * 2048 * 1024 * 2, (size_t)256 * 1024 * 2, (size_t)256 * 1024 * 2, 0, WGM_K1};
            EpiGate<true> E{(bf16*)(ws + O_MG), (const bf16*)(ws + O_SGR), (const bf16*)(ws + O_T1)}; gemm_phase<EpiGate<true>, GridSched>(lds, 1024, 1024, S, E); TAILCVT(ntok * 8, CV_MG0, CV_MG1); }
        SEAM(pb + 4);
        if (IN(pb + 5)) { GridSched S{G, bx, ntok, 8, 32, (const char*)(ws + O_MG), (const char*)(ws + O_WO) + (size_t)l * 2048 * 2048 * 2, (size_t)256 * 2048 * 2, (size_t)256 * 2048 * 2};
            EpiResid<l == 0> E{LAT, modl, 2, args.in[0], args.in[2]}; gemm_phase<EpiResid<l == 0>, GridSched>(lds, 2048, 2048, S, E); TAILCVT(ntok * 8, CV_OUT0, CV_OUT1); }
        SEAM(pb + 5);
        if (IN(pb + 6)) for (int rep = 0; rep < REPS(pb + 6); ++rep) {
            if (l == 0) { const int ln = opq(lane); f32x4 v[8]; int r = NORM_REV ? R - 1 - gw : gw; const int st = NORM_REV ? -NGW : NGW;
                if (r >= 0 && r < R) norm_load(v, LAT + (size_t)r * D, ln);
                for (; r >= 0 && r < R; r += st) { f32x4 vn[8]; const int rn = r + st; if (rn >= 0 && rn < R) norm_load(vn, LAT + (size_t)rn * D, ln);
                    norm_row<false, FFN_F8>(v, args.in[7], modl, 3, 4, (bf16*)(ws + O_HN), r, ln, nullptr, nullptr, nullptr);
#pragma unroll
                    for (int j = 0; j < 8; ++j) v[j] = vn[j]; } }
            else {
                LAS float* rt = (LAS float*)lds; for (int i = tid; i < 2048 * 8; i += NTHREADS) rt[i] = args.in[22][i];
                LAS int* gs = (LAS int*)(lds + 65536);
                __syncthreads();
                int* sel = (int*)(ws + O_MISC + M_SEL); float* gwt = (float*)(ws + O_MISC + M_GWT); int* cntb = (int*)(ws + O_MISC + M_CNTB);
                for (int g = vcu; g < 256; g += G) {
                    { const int ln = opq(lane); f32x4 v[8]; norm_load(v, LAT + (size_t)(g * 64 + wave * 8) * D, ln);
                      for (int k = 0; k < 8; ++k) { const int r = g * 64 + wave * 8 + k; f32x4 vn[8]; if (k < 7) norm_load(vn, LAT + (size_t)(r + 1) * D, ln);
                        const int pk = norm_row<true, MOE_F8>(v, args.in[7] + D, modl, 3, 4, (bf16*)(ws + O_HN), r, ln, rt, sel, gwt);
                        if (lane == 0) { gs[(wave * 8 + k) * 2] = pk & 255; gs[(wave * 8 + k) * 2 + 1] = pk >> 8; }
#pragma unroll
                        for (int j = 0; j < 8; ++j) v[j] = vn[j]; } }
                    __syncthreads();
                    if (wave == 0) { const int s0 = gs[lane * 2], s1 = gs[lane * 2 + 1];
#pragma unroll
                        for (int e = 0; e < 8; ++e) { const unsigned long long mk = __ballot(s0 == e || s1 == e); if (lane == e) cntb[g * 8 + e] = __popcll(mk); } }
                    __syncthreads();
                }
            }
        }
        SEAM(pb + 6);
        if (l == 1) { if (IN(pb + 7)) { moe_gather(argp, lds, vcu, G); __syncthreads(); cvt_moe_range(argp, lds, CV_FLUSH, CV_GUS, gw, NGW); } SEAM(pb + 7); }
        if (IN(pb + 8)) for (int rep = 0; rep < REPS(pb + 8); ++rep) {
            if (l == 0) { GridSched S{G, bx, 72, 44, FFN_F8 ? 16 : 32, HNp, (const char*)(ws + O_FGU), (size_t)256 * 2048 * (FFN_F8 ? 1 : 2), (size_t)256 * 2048 * (FFN_F8 ? 1 : 2)};
#if defined(PROBE_ALT)
#if PROBE_ALT == 2
                if (rep == 1) { EpiSwiglu E{(bf16*)(ws + O_HIDM + (size_t)80 * 1024 * 1024), DFF}; gemm_phase<EpiSwiglu, GridSched>(lds, 2048, 2048, S, E); } else
#else
                if (rep == 1) { EpiNull E{(float*)(ws + O_HIDM)}; gemm_phase<EpiNull, GridSched>(lds, 2048, 2048, S, E); } else
#endif
#endif
                {
#if FFN_F8
                  { EpiSwigluF8 E{ws + O_HID, 1.f / (X8_SC * W8_SC), 22}; gemm_phase<EpiSwigluF8, GridSched, G_ALIGN, G_SP2, 0, 1>(lds, 1024, 1024, S, E); }
#else
                  { EpiSwiglu E{(bf16*)(ws + O_HID), DFF, FFN_BLK ? 44 : 0}; gemm_phase<EpiSwiglu, GridSched>(lds, 2048, 2048, S, E); }
#endif
                  TAILCVT(72 * 44, CV_FG0, CV_FG1); } }
            else { LAS int* tbl = (LAS int*)(lds + MISC_OFF + 256); if (tid < 9) tbl[tid] = ((const int*)(ws + O_MISC + M_TOT))[16 + tid]; __syncthreads();
                MoeSched S{G, bx, 56, MOE_F8 ? 16 : 32, tbl, (const char*)(ws + O_XG), (const char*)(ws + O_MGU), (size_t)256 * 2048 * (MOE_F8 ? 1 : 2), (size_t)256 * 2048 * (MOE_F8 ? 1 : 2), (size_t)14336 * 2048 * (MOE_F8 ? 1 : 2), 1, 0};
                if (MOE_STAGGER) {
                    const unsigned long long t0 = __builtin_amdgcn_s_memrealtime(), dl = (unsigned long long)(((bx >> 3) & 3) * MOE_STAGGER);
                    while (__builtin_amdgcn_s_memrealtime() - t0 < dl) __builtin_amdgcn_s_sleep(8); }
#if defined(PROBE_MOE)
                if (rep == 1 && PROBE_MOE == 3) { EpiSwigluWrap E3{(bf16*)(ws + O_OS), DE}; gemm_phase<EpiSwigluWrap, MoeSched>(lds, 2048, 2048, S, E3); } else
                if (rep == 1) { MoeSched S2 = S; if (PROBE_MOE == 2) S2.bexp = 0; EpiNull E2{(float*)(ws + O_OS)}; gemm_phase<EpiNull, MoeSched>(lds, 2048, MOE_BLK ? 128 : 2048, S2, E2, 256, MOE_BLK ? 65536 : 256); } else
#endif
                {
#if MOE_F8
                  { EpiSwigluF8 E{ws + O_HIDM, 1.f / (X8_SC * W8_SC)}; gemm_phase<EpiSwigluF8, MoeSched, G_ALIGN, G_SP2, MOE_WNT, 1>(lds, 1024, 128, S, E, 256, 65536); }
#else
                  { EpiSwigluT<MOE_NT != 0> E{(bf16*)(ws + O_HIDM), DE, MOE_BLK ? 56 : 0}; gemm_phase<EpiSwigluT<MOE_NT != 0>, MoeSched, G_ALIGN, G_SP2, MOE_WNT>(lds, 2048, MOE_BLK ? 128 : 2048, S, E, 256, MOE_BLK ? 65536 : 256); }
#endif
                  { const int rem2 = (tbl[8] * 56) % G;
                    if (rem2 == 0 || G - rem2 < 24) { cvt_moe_range(argp, lds, CV_GUS, CV_GU1, gw, NGW); __syncthreads(); } else TAILCVT(tbl[8] * 56, CV_GUS, CV_GU1); } } }
        }
        SEAM(pb + 8);
        if (IN(pb + 9)) for (int rep = 0; rep < (l == 1 ? REPS(pb + 9) : 1); ++rep) {
            if (l == 0) { GridSched S{G, bx, 72, 8, FFN_F8 ? 44 : 88, (const char*)(ws + O_HID), (const char*)(ws + O_FD), (size_t)256 * DFF * (FFN_F8 ? 1 : 2), (size_t)256 * DFF * (FFN_F8 ? 1 : 2), FFN_DOWN_REV, WGM_FD};
#if FFN_F8
                { EpiResid<false> E{LAT, modl, 5, nullptr, nullptr, 1.f / (H8_SC * W8_SC)}; gemm_phase<EpiResid<false>, GridSched, G_ALIGN, G_SP2, 0, 1>(lds, 128, DFF / 2, S, E, 65536, 256); }
#else
                { EpiResid<false> E{LAT, modl, 5, nullptr, nullptr}; gemm_phase<EpiResid<false>, GridSched>(lds, FFN_BLK ? 128 : DFF, DFF, S, E, FFN_BLK ? 65536 : 256, 256); }
#endif
                TAILCVT(72 * 8, CV_FD0, CV_FD1); }
            else { LAS int* tbl = (LAS int*)(lds + MISC_OFF + 256); if (tid < 9) tbl[tid] = ((const int*)(ws + O_MISC + M_TOT))[16 + tid]; __syncthreads();
#if MOE_TAILSPLIT
                int sp = 1; { const int U = tbl[8] * 8, R = U % G; if (R > 0) { if (R * 14 <= G) sp = 14; else if (!MOE_F8 && R * 8 <= G) sp = 8; else if (R * 7 <= G) sp = 7; else if (R * 4 <= G) sp = 4; else if (R * 2 <= G) sp = 2; } }
#if defined(FORCE_SP)
                { const int U = tbl[8] * 8, R = U % G; if (R > 0 && R * FORCE_SP <= G) sp = FORCE_SP; }
#endif
                MoeDownSched S{G, bx, sp, tbl, (const char*)(ws + O_HIDM), (const char*)(ws + O_MD), (size_t)256 * DE * (MOE_F8 ? 1 : 2), (size_t)256 * DE * (MOE_F8 ? 1 : 2), (size_t)2048 * DE * (MOE_F8 ? 1 : 2)};
                EpiMoeDown E{(bf16*)(ws + O_OS), (float*)(ws + O_XG), (unsigned*)(ws + O_CTL) + CW_MOEC, sp, MOE_F8 ? 1.f / (H8_SC * W8_SC) : 1.f};
                gemm_phase<EpiMoeDown, MoeDownSched, G_ALIGN, G_SP2, MOE_WNT, MOE_F8>(lds, MOE_BLK ? 128 : DE, MOE_BLK ? 128 : DE, S, E, MOE_BLK ? 65536 : 256, MOE_BLK ? 65536 : 256); }
#else
                MoeSched S{G, bx, 8, 112 / MOE_KSPLIT, tbl, (const char*)(ws + O_HIDM), (const char*)(ws + O_MD), (size_t)256 * DE * 2, (size_t)256 * DE * 2, (size_t)2048 * DE * 2, MOE_KSPLIT, (size_t)3584 * 2};
                EpiBf16Rows E{(bf16*)(ws + O_OS), 2048, false}; gemm_phase<EpiBf16Rows, MoeSched>(lds, DE, DE, S, E); }
#endif
        }
        SEAM(pb + 9);
        if (IN(pb + 10)) for (int rep = 0; rep < REPS(pb + 10); ++rep) {
            if (l == 0) { const int ln = opq(lane); f32x4 v[8]; int r = gw; if (r < R) norm_load(v, LAT + (size_t)r * D, ln);
                for (; r < R; r += NGW) { f32x4 vn[8]; const int rn = r + NGW; if (rn < R) norm_load(vn, LAT + (size_t)rn * D, ln);
                    norm_row<false, WIN_F8 ? 2 : 0>(v, args.in[6] + D, (const float*)(ws + O_MOD) + (size_t)9 * 12288, 0, 1, (bf16*)(ws + O_HN), r, ln, nullptr, nullptr, nullptr, ws + O_HN8);
#pragma unroll
                    for (int j = 0; j < 8; ++j) v[j] = vn[j]; } }
            else { moe_combine_phase(argp, opq(gw), NGW, opq(lane)); }
        }
        if (l == 0) SEAM(pb + 11);
    #undef IN
#undef SEAM
#undef args
#undef argp
}
__global__ void __launch_bounds__(NTHREADS, 2) mega(Args args_unused) {
#define args (*kargs())
#define argp (kargs())
    extern __shared__ __attribute__((aligned(16))) unsigned char lds_raw[];
#if CODE_SHIFT >= 1
    asm volatile("s_nop 0");
#endif
#if CODE_SHIFT >= 2
    asm volatile("s_nop 0");
#endif
#if CODE_SHIFT >= 3
    asm volatile("s_nop 0");
#endif
#if CODE_SHIFT >= 4
    asm volatile("s_nop 0");
#endif
#if CODE_SHIFT >= 8
    asm volatile("s_nop 0\ns_nop 0\ns_nop 0\ns_nop 0");
#endif
    LAS unsigned char* lds = (LAS unsigned char*)lds_raw;
    volatile LAS unsigned* MISC = (volatile LAS unsigned*)(lds + MISC_OFF);
    int tid = threadIdx.x; asm volatile("" : "+v"(tid));
    const int lane = tid & 63, wave = __builtin_amdgcn_readfirstlane(tid >> 6);
    const int G = gridDim.x, bx = blockIdx.x; const int vcu = (G % 8 == 0) ? (bx % 8) * (G / 8) + bx / 8 : bx;
    const int gw = vcu * NWAVES + wave, NGW = G * NWAVES;
    unsigned char* ws = args.ws;
    for (int u = tid; u < 128; u += NTHREADS) MISC[u] = 0u;
    __syncthreads();
    const int lo = args.ph_lo, hi = args.ph_hi;
    XcdBarrier bar; bar.bar = (unsigned*)(ws + O_CTL) + CW_BAR; bar.x = 0; bar.st = nullptr;
    if (hi - lo > 1) bar = xcd_barrier_post((unsigned*)(ws + O_CTL) + CW_BAR + args.bar_region * XCD_BAR_WORDS, MISC + 8);
#define IN(k) (lo <= (k) && (k) < hi)
#define SEAM(k) do { if (IN(k) && IN((k) + 1)) { xcd_barrier(bar); if (PROBE_BAR) xcd_barrier(bar); } } while (0)
    const char* HNp = (const char*)(ws + O_HN);
    float* LAT = (float*)(ws + O_LAT);

    if (IN(0)) for (int rep = 0; rep < REPS(0); ++rep) { __syncthreads(); p0_ada(argp, lds, vcu, G); __syncthreads(); p0_convert(argp, lds, gw, NGW); __syncthreads();
        { LAS f32x2* tab = (LAS f32x2*)lds; for (int m = tid; m < 2048; m += NTHREADS) { float sn, cs; sincospif((float)m * (1.f / 1024.f), &sn, &cs); tab[m] = (f32x2){cs * 0.022097086912079608f, sn * 0.022097086912079608f}; } __syncthreads();
          p0_elementwise(argp, (size_t)vcu * NTHREADS + tid, (size_t)G * NTHREADS, tab); } }
    SEAM(0);
    if (IN(1)) {
        { const int ln = opq(lane); f32x4 v[8]; int r = gw; const float* x0 = args.in[0]; const float* c0 = args.in[2];
          if (r < R) norm_load(v, r < RL ? x0 + (size_t)r * D : c0 + (size_t)(r - RL) * D, ln);
          for (; r < R; r += NGW) { f32x4 vn[8]; const int rn = r + NGW; if (rn < R) norm_load(vn, rn < RL ? x0 + (size_t)rn * D : c0 + (size_t)(rn - RL) * D, ln);
              norm_row<false, WIN_F8 ? 2 : 0>(v, args.in[6], (const float*)(ws + O_MOD), 0, 1, (bf16*)(ws + O_HN), r, ln, nullptr, nullptr, nullptr, ws + O_HN8);
#pragma unroll
              for (int j = 0; j < 8; ++j) v[j] = vn[j]; } }
        { FoldSched S{G, bx, (const char*)(ws + O_DG), (const char*)(ws + O_WUF)}; EpiFold E{(bf16*)(ws + O_WIN)}; gemm_phase<EpiFold, FoldSched>(lds, 256, 1024, S, E); }
    }
    SEAM(1);
    layer_phases<0>(lds, ws, lo, hi, bar, G, bx, vcu, gw, NGW, tid, lane, wave);
    layer_phases<1>(lds, ws, lo, hi, bar, G, bx, vcu, gw, NGW, tid, lane, wave);
#undef IN
#undef SEAM
#undef args
#undef argp
}
}
#ifndef MK_MODE
#define MK_MODE 0
#endif
extern "C" void kernel_launch(void* const* d_in, const int* in_sizes, int n_in, void* d_out, int out_size, void* d_ws, size_t ws_size, hipStream_t stream) {
    static int grid = 0;
    if (grid == 0) {
        if (n_in != 27 || out_size != fk::RL * fk::D || ws_size < fk::O_END) { fprintf(stderr, "kernel_launch: unexpected problem (n_in %d out %d ws %zu need %zu)\n", n_in, out_size, ws_size, (size_t)fk::O_END); grid = -1; return; }
        int dev = 0, cus = 0, per_cu = 0;
        if (hipGetDevice(&dev) != hipSuccess || hipDeviceGetAttribute(&cus, hipDeviceAttributeMultiprocessorCount, dev) != hipSuccess) { grid = -1; return; }
        if (hipFuncSetAttribute((const void*)fk::mega, hipFuncAttributeMaxDynamicSharedMemorySize, fk::LDS_BYTES) != hipSuccess) { fprintf(stderr, "kernel_launch: hipFuncSetAttribute failed\n"); grid = -1; return; }
        if (hipOccupancyMaxActiveBlocksPerMultiprocessor(&per_cu, (const void*)fk::mega, fk::NTHREADS, fk::LDS_BYTES) != hipSuccess || per_cu < 1) fprintf(stderr, "kernel_launch: occupancy query says %d\n", per_cu);
        (void)hipGetLastError();
        grid = cus;
    }
    if (grid < 0) return;
    (void)hipMemsetAsync((char*)d_ws + fk::O_CTL, 0, fk::CTL_ZERO_BYTES, stream);
    fk::Args a{};
    for (int i = 0; i < 27; ++i) a.in[i] = (const float*)d_in[i];
    a.out = (float*)d_out; a.ws = (unsigned char*)d_ws; a.pad = 0;
#if MK_MODE == 0
    a.ph_lo = 0; a.ph_hi = fk::NPHASE; a.bar_region = 0;
    hipLaunchKernelGGL(fk::mega, dim3(grid), dim3(fk::NTHREADS), fk::LDS_BYTES, stream, a);
#else
    for (int p = 0; p < fk::NPHASE; ++p) { a.ph_lo = p; a.ph_hi = p + 1; a.bar_region = p;
        hipLaunchKernelGGL(fk::mega, dim3(grid), dim3(fk::NTHREADS), fk::LDS_BYTES, stream, a); }
#endif
}
```

```cpp
#include <hip/hip_runtime.h>
#include <cstdio>
#include <cstdint>
namespace fk {
#define GAS __attribute__((address_space(1)))
#define LAS __attribute__((address_space(3)))
typedef unsigned short bf16;
typedef short bf16x8 __attribute__((ext_vector_type(8)));
typedef float f32x4 __attribute__((ext_vector_type(4)));
typedef float f32x2 __attribute__((ext_vector_type(2)));
typedef unsigned u32x4 __attribute__((ext_vector_type(4)));
typedef unsigned u32x2 __attribute__((ext_vector_type(2)));
#define LDS_WAIT() asm volatile("s_waitcnt lgkmcnt(0)" ::: "memory")
#define VM_WAIT() asm volatile("s_waitcnt vmcnt(0)" ::: "memory")

typedef int i32x8 __attribute__((ext_vector_type(8)));
typedef int i32x4 __attribute__((ext_vector_type(4)));
__device__ __forceinline__ unsigned cvt_fp8x4(float a, float b, float c, float d) {
    a = __builtin_amdgcn_fmed3f(a, -448.f, 448.f); b = __builtin_amdgcn_fmed3f(b, -448.f, 448.f); c = __builtin_amdgcn_fmed3f(c, -448.f, 448.f); d = __builtin_amdgcn_fmed3f(d, -448.f, 448.f);
    int r = __builtin_amdgcn_cvt_pk_fp8_f32(a, b, 0, false); r = __builtin_amdgcn_cvt_pk_fp8_f32(c, d, r, true); return (unsigned)r; }
__device__ __forceinline__ unsigned cvt_pk_bf16(float lo, float hi) { unsigned r; asm volatile("v_cvt_pk_bf16_f32 %0, %1, %2" : "=v"(r) : "v"(lo), "v"(hi)); return r; }
__device__ __forceinline__ float bf_lo(unsigned w) { return __uint_as_float(w << 16); }
__device__ __forceinline__ float bf_hi(unsigned w) { return __uint_as_float(w & 0xffff0000u); }
__device__ __forceinline__ float fexp(float x) { return __builtin_amdgcn_exp2f(x * 1.4426950408889634f); }
__device__ __forceinline__ float frcp(float x) { return __builtin_amdgcn_rcpf(x); }
__device__ __forceinline__ float fsigm(float x) { return frcp(1.f + fexp(-x)); }
__device__ __forceinline__ float fsilu(float x) { return x * frcp(1.f + fexp(-x)); }
__device__ __forceinline__ float fgelu(float x) { const float u = 1.5957691216057308f * (x + 0.044715f * x * x * x); return x * frcp(1.f + fexp(-u)); }
__device__ __forceinline__ int opq(int v) { asm volatile("" : "+v"(v)); return v; }
__device__ __forceinline__ float wave_sum(float v) {
#pragma unroll
    for (int o = 1; o < 64; o <<= 1) v += __shfl_xor(v, o);
    return v;
}

#ifndef G_WGM
#define G_WGM 4
#endif
constexpr int BM = 256, BK = 64, HALF = 128, HTB = HALF * BK * 2, STAGE_BYTES = 8 * HTB, NXCD = 8, WGM = G_WGM;
__device__ __forceinline__ int lds_byte(int r, int c) { const int st = (r >> 4) * 2 + (c >> 5), rr = r & 15, cc = c & 31, ob = rr * 64 + cc * 2; return st * 1024 + (ob ^ (((ob >> 9) & 1) << 5)); }
__device__ __forceinline__ void stage_rc(int b, int& R, int& C) { const int st = b / 1024, sb = b % 1024, swz = sb ^ (((sb >> 9) & 1) << 5); R = (st >> 1) * 16 + swz / 64; C = (st & 1) * 32 + (swz % 64) / 2; }
__device__ __forceinline__ int perm32(int rho) { const int n = rho >> 4, i = rho & 15; return 8 * (i >> 2) + 4 * n + (i & 3); }

struct Unit { const char* A; const char* B; int pm, pn, kind, nt, x; };

__device__ __forceinline__ void tile_of(int wgid, int nM, int nN, int& pm, int& pn, const int wgm = WGM) {
    const int nwg = nM * nN; { const int q = nwg / NXCD, r = nwg % NXCD, xcd = wgid % NXCD, off = wgid / NXCD; wgid = (xcd < r ? xcd * (q + 1) : r * (q + 1) + (xcd - r) * q) + off; }
    const int nig = wgm * nN, gid = wgid / nig, fm = gid * wgm, gsz = (nM - fm) < wgm ? (nM - fm) : wgm;
    pm = fm + ((wgid % nig) % gsz); pn = (wgid % nig) / gsz;
}

#ifndef G_ALIGN
#define G_ALIGN true
#endif
#ifndef G_SP2
#define G_SP2 true
#endif
template <int F8> struct pg8_frag { typedef bf16x8 T; static constexpr int NK = 2;
    static __device__ __forceinline__ T ld(const LAS unsigned char* p) { return *(const LAS bf16x8*)p; }
    static __device__ __forceinline__ T cat(i32x4 a, i32x4 b) { (void)b; return __builtin_bit_cast(bf16x8, a); }
    static __device__ __forceinline__ f32x4 mma(T b, T a, f32x4 c) { return __builtin_amdgcn_mfma_f32_16x16x32_bf16(b, a, c, 0, 0, 0); } };
template <> struct pg8_frag<1> { typedef i32x8 T; static constexpr int NK = 1;
    static __device__ __forceinline__ T ld(const LAS unsigned char* p) { return *(const LAS i32x8*)p; }
    static __device__ __forceinline__ T cat(i32x4 a, i32x4 b) { return __builtin_shufflevector(a, b, 0, 1, 2, 3, 4, 5, 6, 7); }
    static __device__ __forceinline__ f32x4 mma(T b, T a, f32x4 c) { asm volatile("v_mfma_f32_16x16x128_f8f6f4 %0, %1, %2, %0" : "+v"(c) : "v"(b), "v"(a)); return c; } };
template <class Epi, class Sched, bool ALIGN_EPI = G_ALIGN, bool SP2 = G_SP2, int BAUX = 0, int F8 = 0>
#define PG8_CAT(x, y) __builtin_shufflevector(__builtin_bit_cast(i32x4, x), __builtin_bit_cast(i32x4, y), 0, 1, 2, 3, 4, 5, 6, 7)
__device__ __forceinline__ void gemm_phase(LAS unsigned char* lds, const int lda, const int ldb, const Sched& S, const Epi& E, const size_t kpairA = 256, const size_t kpairB = 256) {
    int tid = threadIdx.x; asm volatile("" : "+v"(tid));
    const int wid = __builtin_amdgcn_readfirstlane(tid >> 6), lane = tid & 63, wr = wid >> 2, wc = wid & 3, fr = lane & 15, fq = lane >> 4;
    unsigned voffA[2], voffB[2];
#pragma unroll
    for (int i = 0; i < 2; ++i) { int R, C; stage_rc(tid * 16 + i * 8192, R, C); const int Rb = Epi::PERM ? ((R & ~31) + perm32(R & 31)) : R;
        voffA[i] = (unsigned)(R * lda + C) * 2u; voffB[i] = (unsigned)(Rb * ldb + C) * 2u; }
    const size_t kstep = (size_t)(BK * 2);
    const size_t hstepA = (size_t)HALF * lda * 2, hstepB = (size_t)HALF * ldb * 2;
    const unsigned ldsw = (unsigned)wid * 1024u;
    const int aoff = lds_byte(wr * 64 + fr, fq * 8), boff = lds_byte(wc * 32 + fr, fq * 8);
#define PG8_SA(b, h) (((b) * 2 + (h)) * HTB)
#define PG8_SB(b, h) ((4 + (b) * 2 + (h)) * HTB)
#define PG8_STAGE(bufoff, gbase, voff) do { const char* gb_ = (const char*)(gbase); asm volatile("" : "+s"(gb_)); _Pragma("unroll") for (int _i = 0; _i < 2; ++_i) { unsigned vo_ = (voff)[_i]; asm volatile("" : "+v"(vo_)); \
        __builtin_amdgcn_global_load_lds((const unsigned*)(gb_ + vo_), (LAS unsigned*)(lds + (bufoff) + ldsw + _i * 8192), 16, 0, 0); } } while (0)
#define PG8_STAGEB(bufoff, gbase, voff) do { const char* gb_ = (const char*)(gbase); asm volatile("" : "+s"(gb_)); _Pragma("unroll") for (int _i = 0; _i < 2; ++_i) { unsigned vo_ = (voff)[_i]; asm volatile("" : "+v"(vo_)); \
        __builtin_amdgcn_global_load_lds((const unsigned*)(gb_ + vo_), (LAS unsigned*)(lds + (bufoff) + ldsw + _i * 8192), 16, 0, BAUX); } } while (0)
#define PG8_LDA(dst, b, h) do { _Pragma("unroll") for (int m = 0; m < 4; ++m) { if constexpr (F8) dst[m][0] = pg8_frag<F8>::cat(*(const LAS i32x4*)(lds + PG8_SA(b, h) + aoff + m * 2048), *(const LAS i32x4*)(lds + PG8_SA(b, h) + aoff + m * 2048 + 1024)); \
        else { _Pragma("unroll") for (int k = 0; k < 2; ++k) dst[m][k] = pg8_frag<F8>::ld(lds + PG8_SA(b, h) + aoff + m * 2048 + k * 1024); } } } while (0)
#define PG8_LDB(dst, b, h) do { _Pragma("unroll") for (int n = 0; n < 2; ++n) { if constexpr (F8) dst[n][0] = pg8_frag<F8>::cat(*(const LAS i32x4*)(lds + PG8_SB(b, h) + boff + n * 2048), *(const LAS i32x4*)(lds + PG8_SB(b, h) + boff + n * 2048 + 1024)); \
        else { _Pragma("unroll") for (int k = 0; k < 2; ++k) dst[n][k] = pg8_frag<F8>::ld(lds + PG8_SB(b, h) + boff + n * 2048 + k * 1024); } } } while (0)
#ifndef G_PRIO
#define G_PRIO 1
#endif
#ifndef G_KOUT
#define G_KOUT 0
#endif
#if G_KOUT
#define PG8_MMA(ai, bj, At, Bt) do { if (G_PRIO) __builtin_amdgcn_s_setprio(G_PRIO); _Pragma("unroll") for (int k = 0; k < 2; ++k) _Pragma("unroll") for (int m = 0; m < 4; ++m) _Pragma("unroll") for (int n = 0; n < 2; ++n) \
        acc[ai][bj][m][n] = __builtin_amdgcn_mfma_f32_16x16x32_bf16(Bt[n][k], At[m][k], acc[ai][bj][m][n], 0, 0, 0); if (G_PRIO) __builtin_amdgcn_s_setprio(0); } while (0)
#else
#define PG8_MMA(ai, bj, At, Bt) do { if (G_PRIO) __builtin_amdgcn_s_setprio(G_PRIO); \
        if constexpr (F8) { _Pragma("unroll") for (int m = 0; m < 4; ++m) _Pragma("unroll") for (int n = 0; n < 2; ++n) \
            acc[ai][bj][m][n] = pg8_frag<F8>::mma(Bt[n][0], At[m][0], acc[ai][bj][m][n]); } \
        else { _Pragma("unroll") for (int m = 0; m < 4; ++m) _Pragma("unroll") for (int n = 0; n < 2; ++n) _Pragma("unroll") for (int k = 0; k < 2; ++k) \
            acc[ai][bj][m][n] = pg8_frag<F8>::mma(Bt[n][k], At[m][k], acc[ai][bj][m][n]); } if (G_PRIO) __builtin_amdgcn_s_setprio(0); } while (0)
#endif
#ifndef G_MMA2
#define G_MMA2 0
#endif
#if G_MMA2
#define PG8_MMA2(ai, At, Ba, Bb) do { __builtin_amdgcn_s_setprio(1); _Pragma("unroll") for (int m = 0; m < 4; ++m) _Pragma("unroll") for (int n = 0; n < 2; ++n) _Pragma("unroll") for (int k = 0; k < 2; ++k) \
        acc[ai][0][m][n] = __builtin_amdgcn_mfma_f32_16x16x32_bf16(Ba[n][k], At[m][k], acc[ai][0][m][n], 0, 0, 0); \
        _Pragma("unroll") for (int m = 0; m < 4; ++m) _Pragma("unroll") for (int n = 0; n < 2; ++n) _Pragma("unroll") for (int k = 0; k < 2; ++k) \
        acc[ai][1][m][n] = __builtin_amdgcn_mfma_f32_16x16x32_bf16(Bb[n][k], At[m][k], acc[ai][1][m][n], 0, 0, 0); __builtin_amdgcn_s_setprio(0); } while (0)
#else
#define PG8_MMA2(ai, At, Ba, Bb) do { PG8_MMA(ai, 0, At, Ba); PG8_MMA(ai, 1, At, Bb); } while (0)
#endif
#define PG8_WAIT_V(n) asm volatile("s_waitcnt vmcnt(" #n ")" ::: "memory")
#define PG8_WAIT_L(n) asm volatile("s_waitcnt lgkmcnt(" #n ")" ::: "memory")
#define PG8_BAR __builtin_amdgcn_s_barrier()
#define PG8_SCHED __builtin_amdgcn_sched_barrier(0)
    Unit cur, nxt; int ui = 0;
    if (!S.next(0, cur)) return;
    f32x4 acc[2][2][4][2];
#pragma unroll
    for (int a = 0; a < 2; ++a)
#pragma unroll
        for (int b = 0; b < 2; ++b)
#pragma unroll
            for (int m = 0; m < 4; ++m)
#pragma unroll
                for (int n = 0; n < 2; ++n) acc[a][b][m][n] = (f32x4){0.f, 0.f, 0.f, 0.f};
    typename pg8_frag<F8>::T At[4][pg8_frag<F8>::NK], B0[2][pg8_frag<F8>::NK], B1[2][pg8_frag<F8>::NK];
    const char* cA = cur.A; const char* cB = cur.B;
    if constexpr (SP2) {
        PG8_STAGEB(PG8_SB(0, 0), cB, voffB); PG8_STAGEB(PG8_SB(0, 1), cB + hstepB, voffB); PG8_STAGE(PG8_SA(0, 0), cA, voffA); PG8_STAGE(PG8_SA(0, 1), cA + hstepA, voffA);
        if (wr == 1) PG8_BAR;
        PG8_WAIT_V(2); PG8_BAR;
        PG8_STAGEB(PG8_SB(1, 0), cB + kstep, voffB); PG8_STAGE(PG8_SA(1, 0), cA + kstep, voffA); PG8_STAGEB(PG8_SB(1, 1), cB + hstepB + kstep, voffB);
        PG8_WAIT_V(6); PG8_BAR;
    } else {
        PG8_STAGEB(PG8_SB(0, 0), cB, voffB); PG8_STAGE(PG8_SA(0, 0), cA, voffA); PG8_STAGEB(PG8_SB(0, 1), cB + hstepB, voffB); PG8_STAGE(PG8_SA(0, 1), cA + hstepA, voffA);
        if (wr == 1) PG8_BAR;
        PG8_WAIT_V(4); PG8_BAR;
        PG8_STAGEB(PG8_SB(1, 0), cB + kstep, voffB); PG8_STAGE(PG8_SA(1, 0), cA + kstep, voffA); PG8_STAGEB(PG8_SB(1, 1), cB + hstepB + kstep, voffB);
        PG8_WAIT_V(6); PG8_BAR;
    }
    for (;;) {
        const bool has_next = S.next(ui + 1, nxt);
        const char* nA = has_next ? nxt.A : cA; const char* nB = has_next ? nxt.B : cB;
        const int nt = cur.nt;
        for (int t = 0; t < nt; t += 2) {
            const bool last = (t == nt - 2);
            const char* a1 = cA + (size_t)(t >> 1) * kpairA + kstep;
            const char* a2 = last ? nA : cA + (size_t)((t >> 1) + 1) * kpairA; const char* b2 = last ? nB : cB + (size_t)((t >> 1) + 1) * kpairB;
            const char* a3 = a2 + kstep; const char* b3 = b2 + kstep;
            if constexpr (SP2) {
            PG8_LDB(B0, 0, 0); PG8_LDB(B1, 0, 1); PG8_SCHED; PG8_LDA(At, 0, 0); PG8_STAGE(PG8_SA(1, 1), a1 + hstepA, voffA);
            PG8_WAIT_V(8); PG8_WAIT_L(0); PG8_BAR; PG8_MMA2(0, At, B0, B1); PG8_BAR; PG8_SCHED;
            PG8_LDA(At, 0, 1); PG8_STAGEB(PG8_SB(0, 0), b2, voffB); PG8_STAGEB(PG8_SB(0, 1), b2 + hstepB, voffB); PG8_STAGE(PG8_SA(0, 0), a2, voffA);
            PG8_WAIT_V(8); PG8_WAIT_L(0); PG8_BAR; PG8_MMA2(1, At, B0, B1); PG8_BAR; PG8_SCHED;
            PG8_LDB(B0, 1, 0); PG8_LDB(B1, 1, 1); PG8_SCHED; PG8_LDA(At, 1, 0); PG8_STAGE(PG8_SA(0, 1), a2 + hstepA, voffA);
            PG8_WAIT_V(8); PG8_WAIT_L(0); PG8_BAR; PG8_MMA2(0, At, B0, B1); PG8_BAR; PG8_SCHED;
            PG8_LDA(At, 1, 1); PG8_STAGEB(PG8_SB(1, 0), b3, voffB); PG8_STAGEB(PG8_SB(1, 1), b3 + hstepB, voffB); PG8_STAGE(PG8_SA(1, 0), a3, voffA);
            PG8_WAIT_V(8); PG8_WAIT_L(0); PG8_BAR; PG8_MMA2(1, At, B0, B1); PG8_BAR; PG8_SCHED;
            } else {
            PG8_LDB(B0, 0, 0); PG8_SCHED; PG8_LDA(At, 0, 0); PG8_STAGE(PG8_SA(1, 1), a1 + hstepA, voffA);
            PG8_WAIT_L(8); PG8_BAR; PG8_WAIT_L(0); PG8_MMA(0, 0, At, B0); PG8_BAR; PG8_SCHED;
            PG8_LDB(B1, 0, 1); PG8_STAGEB(PG8_SB(0, 0), b2, voffB);
            PG8_BAR; PG8_WAIT_L(0); PG8_MMA(0, 1, At, B1); PG8_BAR;
            PG8_LDA(At, 0, 1); PG8_STAGE(PG8_SA(0, 0), a2, voffA);
            PG8_BAR; PG8_WAIT_L(0); PG8_MMA(1, 0, At, B0); PG8_BAR; PG8_SCHED;
            PG8_STAGEB(PG8_SB(0, 1), b2 + hstepB, voffB);
            PG8_WAIT_V(6); PG8_BAR; PG8_MMA(1, 1, At, B1); PG8_BAR;
            PG8_LDB(B0, 1, 0); PG8_SCHED; PG8_LDA(At, 1, 0); PG8_STAGE(PG8_SA(0, 1), a2 + hstepA, voffA);
            PG8_WAIT_L(8); PG8_BAR; PG8_WAIT_L(0); PG8_MMA(0, 0, At, B0); PG8_BAR; PG8_SCHED;
            PG8_LDB(B1, 1, 1); PG8_STAGEB(PG8_SB(1, 0), b3, voffB);
            PG8_BAR; PG8_WAIT_L(0); PG8_MMA(0, 1, At, B1); PG8_BAR;
            PG8_LDA(At, 1, 1); PG8_STAGE(PG8_SA(1, 0), a3, voffA);
            PG8_BAR; PG8_WAIT_L(0); PG8_MMA(1, 0, At, B0); PG8_BAR; PG8_SCHED;
            PG8_STAGEB(PG8_SB(1, 1), b3 + hstepB, voffB);
            PG8_WAIT_V(6); PG8_BAR; PG8_MMA(1, 1, At, B1); PG8_BAR;
            }
        }
        if constexpr (ALIGN_EPI) { if (wr == 0) PG8_BAR; }
        if constexpr (F8) asm volatile("s_nop 15\n\ts_nop 7" ::: "memory");
        E(acc, cur, wr, wc, fr, fq);
        if (!has_next) break;
#pragma unroll
        for (int a = 0; a < 2; ++a)
#pragma unroll
            for (int b = 0; b < 2; ++b)
#pragma unroll
                for (int m = 0; m < 4; ++m)
#pragma unroll
                    for (int n = 0; n < 2; ++n) acc[a][b][m][n] = (f32x4){0.f, 0.f, 0.f, 0.f};
        cur = nxt; cA = nA; cB = nB; ++ui;
        if constexpr (ALIGN_EPI) { if (wr == 1) PG8_BAR; }
    }
    PG8_WAIT_V(0);
    if constexpr (!ALIGN_EPI) { if (wr == 0) PG8_BAR; }
    PG8_BAR;
#undef PG8_SA
#undef PG8_SB
#undef PG8_STAGE
#undef PG8_STAGEB
#undef PG8_LDA
#undef PG8_LDB
#undef PG8_MMA
#undef PG8_MMA2
#undef PG8_WAIT_V
#undef PG8_WAIT_L
#undef PG8_BAR
#undef PG8_SCHED
}

#define XB_TMO      128
#define XB_XCNT(j)  (256  + 64 * (j))
#define XB_XSUB(j)  (1280 + 64 * (j))
#define XB_XGEN(j)  (2304 + 64 * (j))
#define XB_TOP      3328
#define XB_TOPGEN   3392
#define XCD_BAR_WORDS 3456
#define XB_SPIN_CAP (1u << 18)
#ifndef XB_SLEEP
#define XB_SLEEP 1
#endif
__device__ __forceinline__ unsigned xb_ld(unsigned* p)              { return __hip_atomic_load(p, __ATOMIC_RELAXED, __HIP_MEMORY_SCOPE_AGENT); }
__device__ __forceinline__ unsigned xb_add(unsigned* p, unsigned v) { return __hip_atomic_fetch_add(p, v, __ATOMIC_RELAXED, __HIP_MEMORY_SCOPE_AGENT); }
__device__ __forceinline__ unsigned xb_xcc_id() { return (unsigned)__builtin_amdgcn_s_getreg((3 << 11) | 20) & 0xFu; }
#define XB_SPIN(cond, bar) do { unsigned _sp = 0; while (cond) { __builtin_amdgcn_s_sleep(XB_SLEEP); \
    if ((++_sp & 255u) == 0u) { if (xb_ld(&(bar)[XB_TMO])) break; if (_sp > XB_SPIN_CAP) { atomicAdd(&(bar)[XB_TMO], 1u); break; } } } } while (0)
struct XcdBarrier { unsigned* bar; unsigned x; volatile LAS unsigned* st; };
__device__ __forceinline__ XcdBarrier xcd_barrier_post(unsigned* bar, volatile LAS unsigned* st) {
    XcdBarrier b; b.bar = bar; b.x = xb_xcc_id(); b.st = st;
    if (threadIdx.x == 0) (void)xb_add(&bar[XB_XCNT(b.x)], 1u);
    return b;
}
__device__ __forceinline__ void xcd_barrier_complete(unsigned* bar, unsigned x, unsigned& nloc, unsigned& nx) {
    const unsigned G = gridDim.x * gridDim.y * gridDim.z;
    unsigned sum, cnt, mine, sp = 0u;
    for (;;) {
        sum = 0u; cnt = 0u; mine = 0u;
#pragma unroll
        for (unsigned j = 0; j < 16; ++j) { const unsigned c = xb_ld(&bar[XB_XCNT(j)]); sum += c; cnt += (c > 0u) ? 1u : 0u; mine = (j == x) ? c : mine; }
        if (sum == G) break;
        __builtin_amdgcn_s_sleep(1);
        if ((++sp & 255u) == 0u) { if (xb_ld(&bar[XB_TMO])) break; if (sp > XB_SPIN_CAP) { atomicAdd(&bar[XB_TMO], 1u); break; } }
    }
    nloc = mine > 0u ? mine : 1u; nx = cnt > 0u ? cnt : 1u;
}
__device__ __forceinline__ void xcd_barrier(const XcdBarrier& b) {
    asm volatile("s_waitcnt vmcnt(0)" ::: "memory");
    __syncthreads();
    if (threadIdx.x == 0) {
        unsigned* bar = b.bar;
        __builtin_amdgcn_s_waitcnt(0);
        unsigned nloc = b.st[0], nx = b.st[1];
        if (nloc == 0u) { xcd_barrier_complete(bar, b.x, nloc, nx); b.st[0] = nloc; b.st[1] = nx; }
        const unsigned old = xb_add(&bar[XB_XSUB(b.x)], 1u);
        const unsigned gen = old / nloc;
        if (old + 1u == (gen + 1u) * nloc) {
            __builtin_amdgcn_fence(__ATOMIC_RELEASE, "agent");
            asm volatile("s_waitcnt vmcnt(0)" ::: "memory");
            const unsigned og = xb_add(&bar[XB_TOP], 1u);
            const unsigned tg = og / nx;
            if (og + 1u == (tg + 1u) * nx) xb_add(&bar[XB_TOPGEN], 1u);
            else XB_SPIN(xb_ld(&bar[XB_TOPGEN]) == tg, bar);
            __builtin_amdgcn_fence(__ATOMIC_ACQUIRE, "agent");
            xb_add(&bar[XB_XGEN(b.x)], 1u);
            asm volatile("s_waitcnt vmcnt(0)" ::: "memory");
        } else {
            XB_SPIN(xb_ld(&bar[XB_XGEN(b.x)]) == gen, bar);
            __builtin_amdgcn_fence(__ATOMIC_ACQUIRE, "agent");
            asm volatile("s_waitcnt vmcnt(0)" ::: "memory");
        }
    }
    __syncthreads();
}
constexpr int D = 2048, NB = 8, L = 2048, LC = 256, RL = 16384, RC = 2048, R = 18432, NIN = 7168, GW = 64;
constexpr int DFF = 5632, NE = 8, DE = 7168, NH = 8, HD = 128, DL = 1024;
constexpr int WIN_ROWS = 7168;
constexpr int UT_LD = 36864;
constexpr int MAXSLOT = 34816;
constexpr int NCHUNK = 288;
constexpr int NWAVES = 8, NTHREADS = 512;
constexpr int LDS_BYTES = 147456;
constexpr int MISC_OFF = 140000;

constexpr size_t al256(size_t x) { return (x + 255) & ~(size_t)255; }
constexpr size_t O_CTL = 0, CTL_BYTES = 1u << 20, CTL_ZERO_BYTES = 65536;
constexpr size_t O_MOD = O_CTL + CTL_BYTES;
constexpr size_t O_MISC = O_MOD + al256((size_t)2 * 9 * 12288 * 4);
constexpr size_t O_LAT = O_MISC + (1u << 20);
constexpr size_t O_HN = O_LAT + (size_t)R * D * 4;
constexpr size_t O_WIN = O_HN + (size_t)R * D * 2;
constexpr size_t O_WFO = O_WIN + (size_t)2 * 8192 * 2048 * 2;
constexpr size_t O_WRO = O_WFO + (size_t)2 * 2048 * 1024 * 2;
constexpr size_t O_WO = O_WRO + (size_t)2 * 2048 * 1024 * 2;
constexpr size_t O_WAX = O_WO + (size_t)2 * 2048 * 2048 * 2;
constexpr size_t O_WUF = O_WAX + (size_t)2 * 2 * 2 * 8 * 128 * 128 * 2;
constexpr size_t O_DG = O_WUF + (size_t)2 * 2048 * 1024 * 2;
constexpr size_t O_FL = O_DG + (size_t)512 * 256 * 2;
constexpr size_t O_FLC = O_FL + (size_t)2048 * 4096 * 2;
constexpr size_t O_FGU = O_FLC + (size_t)256 * 4096 * 2;
constexpr size_t O_FD = O_FGU + (size_t)11264 * 2048 * 2;
constexpr size_t O_MGU = O_FD + (size_t)2048 * 5632 * 2;
constexpr size_t O_MD = O_MGU + (size_t)8 * 14336 * 2048 * 2;
constexpr size_t O_HN8 = O_MGU + (size_t)8 * 14336 * 2048;
constexpr size_t O_WIN8 = O_HN8 + (size_t)18432 * 2048;
constexpr size_t O_SCR = O_MD + (size_t)8 * 2048 * 7168 * 2;
constexpr size_t O_UT = O_SCR;
constexpr size_t O_UR = O_UT + (size_t)1024 * UT_LD * 2;
constexpr size_t O_GG = O_UR + (size_t)R * 1024 * 2;
constexpr size_t O_SGF = O_GG + (size_t)R * 1024 * 2;
constexpr size_t O_SGR = O_SGF + (size_t)R * 2048 * 2;
constexpr size_t O_Y = O_SGR + (size_t)R * 2048 * 2;
constexpr size_t O_T1 = O_Y + (size_t)R * 1024 * 2;
constexpr size_t O_HR = O_T1 + (size_t)R * 2048 * 2;
constexpr size_t O_MG = O_HR + (size_t)R * 1024 * 2;
constexpr size_t O_TOT = O_MG + (size_t)R * 2048 * 2;
constexpr size_t O_CAR = O_TOT + (size_t)NCHUNK * 2 * 1024 * 8;
constexpr size_t O_ZT = O_CAR + (size_t)NCHUNK * 2 * 1024 * 4;
constexpr size_t O_VV = O_ZT + (size_t)1024 * UT_LD * 2;
constexpr size_t O_MIXEND = O_VV + (size_t)R * 1024 * 2;
constexpr size_t O_HID = O_SCR;
constexpr size_t O_XG = O_SCR;
constexpr size_t O_HIDM = O_XG + (size_t)MAXSLOT * 2048 * 2;
constexpr size_t O_OS = O_HIDM + (size_t)MAXSLOT * 7168 * 2;
constexpr size_t O_END = O_OS + (size_t)2 * MAXSLOT * 2048 * 2;
static_assert(O_MIXEND <= O_END && O_HID + (size_t)R * DFF * 2 <= O_END, "scratch overlay");
static_assert(O_END <= (size_t)2085 * 1000 * 1000, "workspace budget");
constexpr size_t M_SEL = 0;
constexpr size_t M_GWT = 131072;
constexpr size_t M_SLOT = 262144;
constexpr size_t M_CNTB = 393216;
constexpr size_t M_TOT = 401408;
constexpr int CW_BAR = 4096, CW_MOEC = 8192;

struct Args { const float* in[27]; float* out; unsigned char* ws; int ph_lo, ph_hi, bar_region, pad; };
typedef const __attribute__((address_space(4))) Args* AP;
__device__ __forceinline__ AP kargs() { AP p = (AP)__builtin_amdgcn_kernarg_segment_ptr(); asm volatile("" : "+s"(p)); return p; }

__device__ __forceinline__ void p0_ada(AP a, LAS unsigned char* lds, int vcu, int G) {
    const int tid = threadIdx.x, lane = tid & 63, w = tid >> 6;
    LAS float* sc = (LAS float*)lds;
    LAS float* red = (LAS float*)(lds + 73728);
    const float* c = a->in[1]; const float* c_ctx = a->in[3];
    for (int i = tid; i < 9 * 2048; i += NTHREADS) { const int r = i >> 11, k = i & 2047; const float v = r < 8 ? c[r * 2048 + k] : c_ctx[k]; sc[i] = v / (1.f + expf(-v)); }
    __syncthreads();
    float* MOD = (float*)(a->ws + O_MOD);
    for (int item = vcu; item < 256; item += G) {
        const int l = item >> 7, cg = item & 127, col = cg * 96 + (lane < 48 ? lane : 0) * 2;
        const float* W = a->in[4] + (size_t)l * 2048 * 12288 + col;
        float acc[9][2];
#pragma unroll
        for (int r = 0; r < 9; ++r) { acc[r][0] = 0.f; acc[r][1] = 0.f; }
        for (int k0 = w * 256; k0 < w * 256 + 256; k0 += 32) {
            f32x2 wv[32];
#pragma unroll
            for (int i = 0; i < 32; ++i) wv[i] = *(const f32x2*)(W + (size_t)(k0 + i) * 12288);
#pragma unroll
            for (int i = 0; i < 32; ++i)
#pragma unroll
                for (int r = 0; r < 9; ++r) { const float s = sc[r * 2048 + k0 + i]; acc[r][0] = fmaf(s, wv[i].x, acc[r][0]); acc[r][1] = fmaf(s, wv[i].y, acc[r][1]); }
        }
#pragma unroll
        for (int r = 0; r < 9; ++r) if (lane < 48) { red[(w * 9 + r) * 128 + lane * 2] = acc[r][0]; red[(w * 9 + r) * 128 + lane * 2 + 1] = acc[r][1]; }
        __syncthreads();
        for (int i = tid; i < 9 * 128; i += NTHREADS) { const int r = i >> 7, cc = i & 127; if (cc >= 96) continue; float s = a->in[5][(size_t)l * 12288 + cg * 96 + cc];
#pragma unroll
            for (int ww = 0; ww < 8; ++ww) s += red[(ww * 9 + r) * 128 + cc];
            MOD[((size_t)l * 9 + r) * 12288 + cg * 96 + cc] = s; }
        __syncthreads();
    }
}

#ifndef SCAN_VV
#define SCAN_VV 1
#endif
#ifndef DFT2
#define DFT2 1
#endif
#ifndef MOE_BLK
#define MOE_BLK 1
#endif
#ifndef CVT_NT
#define CVT_NT 1
#endif
#ifndef WIN_F8
#define WIN_F8 1
#endif
#ifndef FFN_F8
#define FFN_F8 1
#endif
#ifndef MOE_F8
#define MOE_F8 1
#endif
#define W8_SC 256.f
#define X8_SC 16.f
#define H8_SC 4.f
#if CVT_NT
#define CVT_LOAD(p) __builtin_nontemporal_load(p)
#define CVT_STORE(v, p) __builtin_nontemporal_store(v, p)
#else
#define CVT_LOAD(p) (*(p))
#define CVT_STORE(v, p) (*(p) = (v))
#endif
template <int F8 = 0>
__device__ __forceinline__ void cvt_item(const float* src, int ldsrc, bf16* dst, int dpitch, int k0, int n0, int drow0, LAS float* scr, int lane, const int npairs = 0) {
    const float* s = src + (size_t)(k0 + (lane >> 4)) * ldsrc + n0 + (lane & 15) * 4;
    f32x4 v[16];
#pragma unroll
    for (int i = 0; i < 16; ++i) v[i] = CVT_LOAD((const f32x4*)(s + (size_t)(4 * i) * ldsrc));
#pragma unroll
    for (int i = 0; i < 16; ++i) { LAS float* q = scr + (4 * i + (lane >> 4)) * 65 + (lane & 15) * 4; q[0] = v[i].x; q[1] = v[i].y; q[2] = v[i].z; q[3] = v[i].w; }
    LDS_WAIT(); asm volatile("" ::: "memory");
    const int c = lane & 7;
#pragma unroll
    for (int jj = 0; jj < 8; ++jj) { const int n = (lane >> 3) + 8 * jj; const LAS float* q = scr + (8 * c) * 65 + n;
        if constexpr (F8) { u32x2 o8; o8.x = cvt_fp8x4(q[0 * 65] * W8_SC, q[1 * 65] * W8_SC, q[2 * 65] * W8_SC, q[3 * 65] * W8_SC); o8.y = cvt_fp8x4(q[4 * 65] * W8_SC, q[5 * 65] * W8_SC, q[6 * 65] * W8_SC, q[7 * 65] * W8_SC);
            const int dr8 = drow0 + n; unsigned char* dp8 = npairs ? (unsigned char*)dst + ((size_t)(dr8 >> 8) * npairs + (k0 >> 8)) * 65536 + (size_t)(dr8 & 255) * 256 + (k0 & 255) + 8 * c
                                                                     : (unsigned char*)dst + (size_t)dr8 * dpitch + k0 + 8 * c;
            *(u32x2*)dp8 = o8; continue; }
        u32x4 o; o.x = cvt_pk_bf16(q[0 * 65], q[1 * 65]); o.y = cvt_pk_bf16(q[2 * 65], q[3 * 65]); o.z = cvt_pk_bf16(q[4 * 65], q[5 * 65]); o.w = cvt_pk_bf16(q[6 * 65], q[7 * 65]);
        const int dr = drow0 + n; bf16* dp = npairs ? dst + ((size_t)(dr >> 8) * npairs + (k0 >> 7)) * 32768 + (size_t)(dr & 255) * 128 + (k0 & 127) + 8 * c : dst + (size_t)dr * dpitch + k0 + 8 * c;
        CVT_STORE(o, (u32x4*)dp); }
    LDS_WAIT(); asm volatile("" ::: "memory");
}
constexpr int I_WIN = 32 * 96, I_FO = 16 * 32, I_O = 32 * 32, I_AX = 4, I_FG = 32 * 88, I_FD = 88 * 32, I_MG = 32 * 112, I_MD = 112 * 32;
constexpr int N_WIN = 2 * I_WIN, N_FO = 2 * I_FO, N_RO = N_FO, N_O = 2 * I_O, N_AX = 64 * I_AX, N_FG = I_FG, N_FU = I_FG, N_FD = I_FD, N_MG = 8 * I_MG, N_MU = N_MG, N_MD = 8 * I_MD;
constexpr int N_NONMOE = N_WIN + N_FO + N_RO + N_O + N_AX + N_FG + N_FU + N_FD, N_MOE = N_MG + N_MU + N_MD;
__device__ __forceinline__ void p0_convert(AP a, LAS unsigned char* lds, int gw, int NGW) {
    const int lane = threadIdx.x & 63, w = threadIdx.x >> 6;
    LAS float* scr = (LAS float*)(lds + w * 16640);
    unsigned char* ws = a->ws;
    for (int it = gw; it < N_NONMOE; it += NGW) {
        int r = it;
        if (r < N_WIN) { const int l = r / I_WIN, q = r % I_WIN, kb = q / 96, nb = q % 96;
            if (WIN_F8 && nb >= 32) cvt_item<1>(a->in[8] + (size_t)l * 2048 * NIN, NIN, (bf16*)(ws + O_WIN8 + (size_t)l * 4096 * 2048), 2048, kb * 64, 1024 + nb * 64, (nb - 32) * 64, scr, lane); else
            cvt_item(a->in[8] + (size_t)l * 2048 * NIN, NIN, (bf16*)(ws + O_WIN) + (size_t)l * WIN_ROWS * 2048, 2048, kb * 64, 1024 + nb * 64, 1024 + nb * 64, scr, lane); continue; } r -= N_WIN;
        if (r < N_FO) { const int l = r / I_FO, q = r % I_FO, kb = q / 32, nb = q % 32;
            cvt_item(a->in[16] + (size_t)l * 1024 * 2048, 2048, (bf16*)(ws + O_WFO) + (size_t)l * 2048 * 1024, 1024, kb * 64, nb * 64, nb * 64, scr, lane); continue; } r -= N_FO;
        if (r < N_RO) { const int l = r / I_FO, q = r % I_FO, kb = q / 32, nb = q % 32;
            cvt_item(a->in[17] + (size_t)l * 1024 * 2048, 2048, (bf16*)(ws + O_WRO) + (size_t)l * 2048 * 1024, 1024, kb * 64, nb * 64, nb * 64, scr, lane); continue; } r -= N_RO;
        if (r < N_O) { const int l = r / I_O, q = r % I_O, kb = q / 32, nb = q % 32;
            cvt_item(a->in[18] + (size_t)l * 2048 * 2048, 2048, (bf16*)(ws + O_WO) + (size_t)l * 2048 * 2048, 2048, kb * 64, nb * 64, nb * 64, scr, lane); continue; } r -= N_O;
        if (r < N_AX) { const int m = r / I_AX, q = r % I_AX, kb = q / 2, nb = q % 2;
            const int h = m & 7, gate = (m >> 3) & 1, ld = m >> 4;
            const float* src = (gate ? a->in[13] : a->in[11]) + ((size_t)ld * 8 + h) * 128 * 128;
            cvt_item(src, 128, (bf16*)(ws + O_WAX) + (size_t)m * 128 * 128, 128, kb * 64, nb * 64, nb * 64, scr, lane); continue; } r -= N_AX;
        if (r < N_FG) { const int kb = r / 88, nb = r % 88, n = nb * 64;
            if (FFN_F8) cvt_item<1>(a->in[19], DFF, (bf16*)(ws + O_FGU), 2048, kb * 64, n, (n >> 7) * 256 + (n & 127), scr, lane); else
            cvt_item(a->in[19], DFF, (bf16*)(ws + O_FGU), 2048, kb * 64, n, (n >> 7) * 256 + (n & 127), scr, lane); continue; } r -= N_FG;
        if (r < N_FU) { const int kb = r / 88, nb = r % 88, n = nb * 64;
            if (FFN_F8) cvt_item<1>(a->in[20], DFF, (bf16*)(ws + O_FGU), 2048, kb * 64, n, (n >> 7) * 256 + 128 + (n & 127), scr, lane); else
            cvt_item(a->in[20], DFF, (bf16*)(ws + O_FGU), 2048, kb * 64, n, (n >> 7) * 256 + 128 + (n & 127), scr, lane); continue; } r -= N_FU;
        { const int kb = r / 32, nb = r % 32;
            if (FFN_F8) cvt_item<1>(a->in[21], 2048, (bf16*)(ws + O_FD), DFF, kb * 64, nb * 64, nb * 64, scr, lane); else
            cvt_item(a->in[21], 2048, (bf16*)(ws + O_FD), DFF, kb * 64, nb * 64, nb * 64, scr, lane); }
    }
}
__device__ __forceinline__ void cvt_moe_range(AP a, LAS unsigned char* lds, int lo, int hi, int rank, int nrank) {
    const int lane = threadIdx.x & 63, w = threadIdx.x >> 6;
    LAS float* scr = (LAS float*)(lds + w * 16640);
    unsigned char* ws = a->ws;
    for (int it = lo + rank; it < hi; it += nrank) {
        int r = it;
        if (r < N_MG) { const int e = r / I_MG, q = r % I_MG, kb = q / 112, nb = q % 112, n = nb * 64;
            if (MOE_F8) cvt_item<1>(a->in[23] + (size_t)e * 2048 * DE, DE, (bf16*)(ws + O_MGU + (size_t)e * 14336 * 2048), 2048, kb * 64, n, (n >> 7) * 256 + (n & 127), scr, lane, 8); else
            cvt_item(a->in[23] + (size_t)e * 2048 * DE, DE, (bf16*)(ws + O_MGU) + (size_t)e * 14336 * 2048, 2048, kb * 64, n, (n >> 7) * 256 + (n & 127), scr, lane, MOE_BLK ? 16 : 0); continue; } r -= N_MG;
        if (r < N_MU) { const int e = r / I_MG, q = r % I_MG, kb = q / 112, nb = q % 112, n = nb * 64;
            if (MOE_F8) cvt_item<1>(a->in[24] + (size_t)e * 2048 * DE, DE, (bf16*)(ws + O_MGU + (size_t)e * 14336 * 2048), 2048, kb * 64, n, (n >> 7) * 256 + 128 + (n & 127), scr, lane, 8); else
            cvt_item(a->in[24] + (size_t)e * 2048 * DE, DE, (bf16*)(ws + O_MGU) + (size_t)e * 14336 * 2048, 2048, kb * 64, n, (n >> 7) * 256 + 128 + (n & 127), scr, lane, MOE_BLK ? 16 : 0); continue; } r -= N_MU;
        { const int e = r / I_MD, q = r % I_MD, kb = q / 32, nb = q % 32;
            if (MOE_F8) cvt_item<1>(a->in[25] + (size_t)e * DE * 2048, 2048, (bf16*)(ws + O_MD + (size_t)e * 2048 * DE), DE, kb * 64, nb * 64, nb * 64, scr, lane, 28); else
            cvt_item(a->in[25] + (size_t)e * DE * 2048, 2048, (bf16*)(ws + O_MD) + (size_t)e * 2048 * DE, DE, kb * 64, nb * 64, nb * 64, scr, lane, MOE_BLK ? 56 : 0); }
    }
}
__device__ __forceinline__ void p0_elementwise(AP a, size_t gt, size_t NGT, const LAS f32x2* tab) {
    unsigned char* ws = a->ws;
    for (size_t i = gt; i < (size_t)2 * 2048 * 128; i += NGT) { const int l = (int)(i / (2048 * 128)), d = (int)((i / 128) % 2048), j8 = (int)(i % 128) * 8;
        const float* s = a->in[8] + ((size_t)l * 2048 + d) * NIN + j8; const f32x4 v0 = *(const f32x4*)s, v1 = *(const f32x4*)(s + 4);
        u32x4 o; o.x = cvt_pk_bf16(v0.x, v0.y); o.y = cvt_pk_bf16(v0.z, v0.w); o.z = cvt_pk_bf16(v1.x, v1.y); o.w = cvt_pk_bf16(v1.z, v1.w);
        *(u32x4*)((bf16*)(ws + O_WUF) + ((size_t)l * 2048 + d) * 1024 + j8) = o; }
#if DFT2
    for (size_t i = gt; i < (size_t)256 * 64; i += NGT) { const int k = (int)(i / 64), j8 = (int)(i % 64) * 8; float v[8];
#pragma unroll
        for (int e = 0; e < 8; ++e) { const int j = j8 + e, t = j & 255; const int m = (k * t) & 255; float sn, cs; sincospif((float)m * (1.f / 128.f), &sn, &cs); v[e] = (j < 256 ? cs : sn) * 0.022097086912079608f; }
        u32x4 o; o.x = cvt_pk_bf16(v[0], v[1]); o.y = cvt_pk_bf16(v[2], v[3]); o.z = cvt_pk_bf16(v[4], v[5]); o.w = cvt_pk_bf16(v[6], v[7]);
        *(u32x4*)((bf16*)(ws + O_FL) + (size_t)k * 4096 + j8) = o; }
    (void)tab;
#else
    for (size_t i = gt; i < (size_t)2048 * 512; i += NGT) { const int k = (int)(i / 512), j8 = (int)(i % 512) * 8; float v[8];
#pragma unroll
        for (int e = 0; e < 8; ++e) { const int j = j8 + e, t = j & 2047; const int m = (k * t) & 2047; const f32x2 cs = tab[m]; v[e] = (j < 2048 ? cs.x : -cs.y); }
        u32x4 o; o.x = cvt_pk_bf16(v[0], v[1]); o.y = cvt_pk_bf16(v[2], v[3]); o.z = cvt_pk_bf16(v[4], v[5]); o.w = cvt_pk_bf16(v[6], v[7]);
        *(u32x4*)((bf16*)(ws + O_FL) + (size_t)k * 4096 + j8) = o; }
#endif
    for (size_t i = gt; i < (size_t)256 * 64; i += NGT) { const int k = (int)(i / 64), j8 = (int)(i % 64) * 8; float v[8];
#pragma unroll
        for (int e = 0; e < 8; ++e) { const int j = j8 + e, t = j & 255; const int m = (k * t) & 255; float s, c; sincospif((float)m * (1.f / 128.f), &s, &c); v[e] = (j < 256 ? c : -s) * 0.0625f; }
        u32x4 o; o.x = cvt_pk_bf16(v[0], v[1]); o.y = cvt_pk_bf16(v[2], v[3]); o.z = cvt_pk_bf16(v[4], v[5]); o.w = cvt_pk_bf16(v[6], v[7]);
        *(u32x4*)((bf16*)(ws + O_FLC) + (size_t)k * 4096 + j8) = o; }
    for (size_t i = gt; i < (size_t)256 * 32; i += NGT) { const int row = (int)(i / 32), j8 = (int)(i % 32) * 8, s_ = row > 128 ? 1 : 0, c_ = s_ ? row - 128 : row; float v[8];
#pragma unroll
        for (int e = 0; e < 8; ++e) { const int m = (c_ * (j8 + e)) & 255; float s, c; sincospif((float)m * (1.f / 128.f), &s, &c); v[e] = (s_ ? s : c) * 0.0625f; }
        u32x4 o; o.x = cvt_pk_bf16(v[0], v[1]); o.y = cvt_pk_bf16(v[2], v[3]); o.z = cvt_pk_bf16(v[4], v[5]); o.w = cvt_pk_bf16(v[6], v[7]);
        *(u32x4*)((bf16*)(ws + O_DG) + (size_t)row * 256 + j8) = o; }
}

__device__ __forceinline__ int mod_row(int r) { return r < RL ? (r >> 11) : 8; }
__device__ __forceinline__ void norm_load(f32x4 (&v)[8], const float* src, int lane) {
#pragma unroll
    for (int j = 0; j < 8; ++j) v[j] = ((const f32x4*)src)[lane + 64 * j];
}
template <bool ROUTER, int F8OUT = 0>
__device__ __forceinline__ int norm_row(const f32x4 (&v)[8], const float* g, const float* modl, int shift_chunk, int scale_chunk, bf16* dst, int row, int lane,
                                         const LAS float* rt, int* sel, float* gwt, unsigned char* dst8 = nullptr) {
    int picked = 0;
    float s = 0.f;
#pragma unroll
    for (int j = 0; j < 8; ++j) s += (v[j].x * v[j].x + v[j].y * v[j].y) + (v[j].z * v[j].z + v[j].w * v[j].w);
    const float rstd = rsqrtf(wave_sum(s) * (1.f / D) + 1e-6f);
    const float* mr = modl + (size_t)mod_row(row) * 12288;
    float lg[8];
    if (ROUTER) {
#pragma unroll
        for (int e = 0; e < 8; ++e) lg[e] = 0.f; }
#pragma unroll
    for (int j = 0; j < 8; ++j) {
        const int c = (lane + 64 * j) * 4;
        const f32x4 gg = *(const f32x4*)(g + c), sh = *(const f32x4*)(mr + shift_chunk * D + c), sc = *(const f32x4*)(mr + scale_chunk * D + c);
        f32x4 o = v[j] * rstd * gg; o = o * (sc + 1.f) + sh;
        if constexpr (F8OUT == 1) *(unsigned*)((unsigned char*)dst + (size_t)row * D + c) = cvt_fp8x4(o.x * X8_SC, o.y * X8_SC, o.z * X8_SC, o.w * X8_SC);
        else { if constexpr (F8OUT == 2) *(unsigned*)(dst8 + (size_t)row * D + c) = cvt_fp8x4(o.x * X8_SC, o.y * X8_SC, o.z * X8_SC, o.w * X8_SC); u32x2 w; w.x = cvt_pk_bf16(o.x, o.y); w.y = cvt_pk_bf16(o.z, o.w);
        *(u32x2*)(dst + (size_t)row * D + c) = w; }
        if (ROUTER) {
#pragma unroll
            for (int q = 0; q < 4; ++q) { const f32x4 r0 = *(const LAS f32x4*)(rt + (c + q) * 8), r1 = *(const LAS f32x4*)(rt + (c + q) * 8 + 4); const float x = o[q];
                lg[0] = fmaf(x, r0.x, lg[0]); lg[1] = fmaf(x, r0.y, lg[1]); lg[2] = fmaf(x, r0.z, lg[2]); lg[3] = fmaf(x, r0.w, lg[3]);
                lg[4] = fmaf(x, r1.x, lg[4]); lg[5] = fmaf(x, r1.y, lg[5]); lg[6] = fmaf(x, r1.z, lg[6]); lg[7] = fmaf(x, r1.w, lg[7]); } }
    }
    if (ROUTER) {
#pragma unroll
        for (int e = 0; e < 8; ++e) lg[e] = wave_sum(lg[e]);
        if (lane == 0) {
            int i1 = 0; float v1 = lg[0];
#pragma unroll
            for (int e = 1; e < 8; ++e) if (lg[e] > v1) { v1 = lg[e]; i1 = e; }
            int i2 = -1; float v2 = -3.0e38f;
#pragma unroll
            for (int e = 0; e < 8; ++e) if (e != i1 && lg[e] > v2) { v2 = lg[e]; i2 = e; }
            const float w1 = 1.f / (1.f + expf(v2 - v1));
            sel[row * 2] = i1; sel[row * 2 + 1] = i2; gwt[row * 2] = w1; gwt[row * 2 + 1] = 1.f - w1; picked = i1 | (i2 << 8);
        }
    }
    return picked;
}

__device__ __forceinline__ float one_minus_exp(float x, float a2) {
    const float t = -x; return t < 0.0625f ? t * (1.f - t * (0.5f - t * (0.16666667f - t * (0.041666668f - t * 0.0083333338f)))) : 1.f - a2; }
template <int PASS>
__device__ __forceinline__ void scan_unit(AP a, LAS unsigned char* lds, int l, int q, int h) {
    int tid = threadIdx.x; asm volatile("" : "+v"(tid));
    const int lane = tid & 63, w = __builtin_amdgcn_readfirstlane(tid >> 6), fr = lane & 15, fq = lane >> 4;
    LAS float* VS = (LAS float*)lds; LAS bf16* V16 = (LAS bf16*)(lds + 33792); LAS float* AS = (LAS float*)(lds + 51200); LAS float* BS = (LAS float*)(lds + 84992); LAS float* SEG = (LAS float*)(lds + 118784);
    unsigned char* ws = a->ws;
    const bool isctx = q >= 256;
    const int row0 = isctx ? RL + (q - 256) * 64 : q * 64;
    const int cpos0 = isctx ? ((q - 256) & 3) * 64 : 0;
    const int seglen = isctx ? LC : GW;
    const int t = tid >> 3, c16 = (tid & 7) * 16;
    {
        const bf16* UR = (const bf16*)(ws + O_UR);
        const float* cw = a->in[9] + (size_t)l * 4 * DL + h * HD + c16; const float* cb = a->in[10] + (size_t)l * DL + h * HD + c16;
        float v[16];
#pragma unroll
        for (int i = 0; i < 16; i += 4) { const f32x4 b4 = *(const f32x4*)(cb + i); v[i] = b4.x; v[i + 1] = b4.y; v[i + 2] = b4.z; v[i + 3] = b4.w; }
#pragma unroll
        for (int k = 0; k < 4; ++k) { const int p = cpos0 + t + k - 2;
            if (p >= 0 && p < seglen) { const bf16* src = UR + (size_t)(row0 + t + k - 2) * 1024 + h * HD + c16; const u32x4 u0 = *(const u32x4*)src, u1 = *(const u32x4*)(src + 8);
                const unsigned uu[8] = {u0.x, u0.y, u0.z, u0.w, u1.x, u1.y, u1.z, u1.w};
#pragma unroll
                for (int i = 0; i < 8; ++i) { const f32x2 wv = *(const f32x2*)(cw + (size_t)k * DL + 2 * i); v[2 * i] = fmaf(wv.x, bf_lo(uu[i]), v[2 * i]); v[2 * i + 1] = fmaf(wv.y, bf_hi(uu[i]), v[2 * i + 1]); } } }
#pragma unroll
        for (int i = 0; i < 16; i += 4) *(LAS f32x4*)(VS + t * 132 + c16 + i) = (f32x4){v[i], v[i + 1], v[i + 2], v[i + 3]};
        u32x4 o0, o1; o0.x = cvt_pk_bf16(v[0], v[1]); o0.y = cvt_pk_bf16(v[2], v[3]); o0.z = cvt_pk_bf16(v[4], v[5]); o0.w = cvt_pk_bf16(v[6], v[7]);
        o1.x = cvt_pk_bf16(v[8], v[9]); o1.y = cvt_pk_bf16(v[10], v[11]); o1.z = cvt_pk_bf16(v[12], v[13]); o1.w = cvt_pk_bf16(v[14], v[15]);
        *(LAS u32x4*)(V16 + t * 136 + c16) = o0; *(LAS u32x4*)(V16 + t * 136 + c16 + 8) = o1;
    }
    __syncthreads();
    float hsum[16];
#pragma unroll
    for (int i = 0; i < 16; ++i) hsum[i] = 0.f;
    const int ch = 16 * w + fr;
#pragma unroll 1
    for (int dir = 0; dir < 2; ++dir) {
        f32x4 acc[2][4];
#pragma unroll
        for (int g = 0; g < 2; ++g)
#pragma unroll
            for (int m = 0; m < 4; ++m) acc[g][m] = (f32x4){0.f, 0.f, 0.f, 0.f};
        const bf16* WT = (const bf16*)(ws + O_WAX) + ((size_t)((l * 2 + dir) * 2) * 8 + h) * 128 * 128;
#pragma unroll
        for (int ks = 0; ks < 4; ++ks) {
            const bf16x8 b0 = *(const bf16x8*)(WT + (size_t)ch * 128 + ks * 32 + fq * 8), b1 = *(const bf16x8*)(WT + (size_t)8 * 128 * 128 + (size_t)ch * 128 + ks * 32 + fq * 8);
#pragma unroll
            for (int m = 0; m < 4; ++m) { const bf16x8 af = *(const LAS bf16x8*)(V16 + (16 * m + fr) * 136 + ks * 32 + fq * 8);
                acc[0][m] = __builtin_amdgcn_mfma_f32_16x16x32_bf16(af, b0, acc[0][m], 0, 0, 0); acc[1][m] = __builtin_amdgcn_mfma_f32_16x16x32_bf16(af, b1, acc[1][m], 0, 0, 0); }
        }
        {
            const int gch = h * HD + ch;
            const float bia = a->in[12][(size_t)(l * 2 + dir) * DL + gch], bix = a->in[14][(size_t)(l * 2 + dir) * DL + gch], lm = a->in[15][(size_t)(l * 2 + dir) * DL + gch];
            const float sp8 = 8.f * log1pf(expf(-lm));
#pragma unroll
            for (int m = 0; m < 4; ++m)
#pragma unroll
                for (int j = 0; j < 4; ++j) { const int tok = 16 * m + 4 * fq + j;
                    const float rr = fsigm(acc[0][m][j] + bia), ii = fsigm(acc[1][m][j] + bix), vv = VS[tok * 132 + ch];
                    const float la = -sp8 * rr, av = fexp(la), a2 = av * av;
                    AS[tok * 132 + ch] = av; BS[tok * 132 + ch] = sqrtf(one_minus_exp(2.f * la, a2)) * (ii * vv); }
        }
        __syncthreads();
        {
            const int sg = tid >> 7, sc = tid & 127;
            float av[16], bv[16];
#pragma unroll
            for (int i = 0; i < 16; ++i) { const int tok = dir ? 63 - (16 * sg + i) : 16 * sg + i; av[i] = AS[tok * 132 + sc]; bv[i] = BS[tok * 132 + sc]; }
            float P = 1.f, hl = 0.f;
#pragma unroll
            for (int i = 0; i < 16; ++i) { hl = fmaf(av[i], hl, bv[i]); P *= av[i]; }
            SEG[(sg * 128 + sc) * 2] = P; SEG[(sg * 128 + sc) * 2 + 1] = hl;
            __syncthreads();
            if (PASS == 1) {
                if (sg == 0) { float A = 1.f, B = 0.f;
#pragma unroll
                    for (int s2 = 0; s2 < 4; ++s2) { const float p2 = SEG[(s2 * 128 + sc) * 2], h2 = SEG[(s2 * 128 + sc) * 2 + 1]; B = fmaf(p2, B, h2); A *= p2; }
                    *(f32x2*)((float*)(ws + O_TOT) + (((size_t)q * 2 + dir) * 1024 + h * HD + sc) * 2) = (f32x2){A, B}; }
            } else {
                float hc = ((const float*)(ws + O_CAR))[((size_t)q * 2 + dir) * 1024 + h * HD + sc];
#pragma unroll
                for (int s2 = 0; s2 < 3; ++s2) if (s2 < sg) { const float p2 = SEG[(s2 * 128 + sc) * 2], h2 = SEG[(s2 * 128 + sc) * 2 + 1]; hc = fmaf(p2, hc, h2); }
#pragma unroll
                for (int i = 0; i < 16; ++i) { const int tok = dir ? 63 - (16 * sg + i) : 16 * sg + i; hc = fmaf(av[i], hc, bv[i]); BS[tok * 132 + sc] = hc; }
            }
        }
        __syncthreads();
        if (PASS == 2) {
#pragma unroll
            for (int i = 0; i < 16; i += 4) { const f32x4 x = *(const LAS f32x4*)(BS + t * 132 + c16 + i); hsum[i] += x.x; hsum[i + 1] += x.y; hsum[i + 2] += x.z; hsum[i + 3] += x.w; }
            __syncthreads();
        }
    }
    if (PASS == 2) {
        const bf16* GGp = (const bf16*)(ws + O_GG) + (size_t)(row0 + t) * 1024 + h * HD + c16; const u32x4 g0 = *(const u32x4*)GGp, g1 = *(const u32x4*)(GGp + 8);
        const unsigned gu[8] = {g0.x, g0.y, g0.z, g0.w, g1.x, g1.y, g1.z, g1.w}; unsigned o[8];
#pragma unroll
        for (int i = 0; i < 8; ++i) o[i] = cvt_pk_bf16(hsum[2 * i] * bf_lo(gu[i]), hsum[2 * i + 1] * bf_hi(gu[i]));
        bf16* dst = (bf16*)(ws + O_HR) + (size_t)(row0 + t) * 1024 + h * HD + c16;
        *(u32x4*)dst = (u32x4){o[0], o[1], o[2], o[3]}; *(u32x4*)(dst + 8) = (u32x4){o[4], o[5], o[6], o[7]};
    }
}
template <int PASS>
__device__ __forceinline__ void scan_phase(AP a, LAS unsigned char* lds, const int l, const int nunits, const int vcu, const int G) {
    int tid0 = threadIdx.x; asm volatile("" : "+v"(tid0));
    const int w = __builtin_amdgcn_readfirstlane(tid0 >> 6);
    LAS float* VS = (LAS float*)lds; LAS bf16* V16 = (LAS bf16*)(lds + 33792); LAS float* AS = (LAS float*)(lds + 51200); LAS float* BS = (LAS float*)(lds + 84992); LAS float* SEG = (LAS float*)(lds + 118784);
    LAS float* CW = (LAS float*)(lds + 122880); LAS float* CB = (LAS float*)(lds + 124928);
    unsigned char* ws = a->ws;
    const bf16* UR = (const bf16*)(ws + O_UR);
#define SCAN_LANE_VARS(tid) const int lane = (tid) & 63, fr = lane & 15, fq = lane >> 4, t = (tid) >> 3, c16 = ((tid) & 7) * 16, ch = 16 * w + fr, sg = (tid) >> 7, sc = (tid) & 127; \
    (void)fq; (void)sg; (void)sc; (void)ch; (void)t; (void)c16
    int hcur = -1;
    bf16x8 wf[2][2][4]; float bia[2], bix[2], sp8[2];
    u32x4 ur[4][2];
#define SCAN_PREFETCH(uu) do { const int q_ = (uu) >> 3, h_ = (uu) & 7; const bool ic_ = q_ >= 256; const int r0_ = ic_ ? RL + (q_ - 256) * 64 : q_ * 64; \
        const int cp_ = ic_ ? ((q_ - 256) & 3) * 64 : 0, sl_ = ic_ ? LC : GW; \
        _Pragma("unroll") for (int k = 0; k < 4; ++k) { const int p_ = cp_ + t + k - 2; \
            if (p_ >= 0 && p_ < sl_) { const bf16* src_ = UR + (size_t)(r0_ + t + k - 2) * 1024 + h_ * HD + c16; ur[k][0] = *(const u32x4*)src_; ur[k][1] = *(const u32x4*)(src_ + 8); } \
            else { ur[k][0] = (u32x4){0u, 0u, 0u, 0u}; ur[k][1] = (u32x4){0u, 0u, 0u, 0u}; } } } while (0)
    if (vcu < nunits) { SCAN_LANE_VARS(tid0); SCAN_PREFETCH(vcu); }
    for (int u = vcu; u < nunits; u += G) {
        const int q = u >> 3, h = u & 7;
        const int tid = opq(tid0); SCAN_LANE_VARS(tid);
        const bool isctx = q >= 256; const int row0 = isctx ? RL + (q - 256) * 64 : q * 64;
        if (h != hcur) {
            hcur = h;
            __syncthreads();
            if (tid < 128) { CB[tid] = a->in[10][(size_t)l * DL + h * HD + tid];
#pragma unroll
                for (int k = 0; k < 4; ++k) CW[k * 128 + tid] = a->in[9][((size_t)l * 4 + k) * DL + h * HD + tid]; }
#pragma unroll
            for (int dir = 0; dir < 2; ++dir) {
                const bf16* WT = (const bf16*)(ws + O_WAX) + ((size_t)((l * 2 + dir) * 2) * 8 + h) * 128 * 128;
#pragma unroll
                for (int g = 0; g < 2; ++g)
#pragma unroll
                    for (int ks = 0; ks < 4; ++ks) wf[dir][g][ks] = *(const bf16x8*)(WT + (size_t)g * 8 * 128 * 128 + (size_t)ch * 128 + ks * 32 + fq * 8);
                const int gch = h * HD + ch;
                bia[dir] = a->in[12][(size_t)(l * 2 + dir) * DL + gch]; bix[dir] = a->in[14][(size_t)(l * 2 + dir) * DL + gch];
                sp8[dir] = 8.f * log1pf(expf(-a->in[15][(size_t)(l * 2 + dir) * DL + gch]));
            }
            __syncthreads();
        }
        float car[2]; u32x4 gg0, gg1;
        if (PASS == 2) {
            car[0] = ((const float*)(ws + O_CAR))[((size_t)q * 2 + 0) * 1024 + h * HD + sc]; car[1] = ((const float*)(ws + O_CAR))[((size_t)q * 2 + 1) * 1024 + h * HD + sc];
            const bf16* GGp = (const bf16*)(ws + O_GG) + (size_t)(row0 + t) * 1024 + h * HD + c16; gg0 = *(const u32x4*)GGp; gg1 = *(const u32x4*)(GGp + 8);
        }
        {
            float v[16];
#pragma unroll
            for (int i = 0; i < 16; i += 4) { const f32x4 b4 = *(const LAS f32x4*)(CB + c16 + i); v[i] = b4.x; v[i + 1] = b4.y; v[i + 2] = b4.z; v[i + 3] = b4.w; }
#pragma unroll
            for (int k = 0; k < 4; ++k) { const unsigned uu[8] = {ur[k][0].x, ur[k][0].y, ur[k][0].z, ur[k][0].w, ur[k][1].x, ur[k][1].y, ur[k][1].z, ur[k][1].w};
#pragma unroll
                for (int i = 0; i < 16; i += 4) { const f32x4 wv = *(const LAS f32x4*)(CW + k * 128 + c16 + i);
                    v[i] = fmaf(wv.x, bf_lo(uu[i / 2]), v[i]); v[i + 1] = fmaf(wv.y, bf_hi(uu[i / 2]), v[i + 1]); v[i + 2] = fmaf(wv.z, bf_lo(uu[i / 2 + 1]), v[i + 2]); v[i + 3] = fmaf(wv.w, bf_hi(uu[i / 2 + 1]), v[i + 3]); } }
#pragma unroll
            for (int i = 0; i < 16; i += 4) *(LAS f32x4*)(VS + t * 132 + c16 + i) = (f32x4){v[i], v[i + 1], v[i + 2], v[i + 3]};
            u32x4 o0, o1; o0.x = cvt_pk_bf16(v[0], v[1]); o0.y = cvt_pk_bf16(v[2], v[3]); o0.z = cvt_pk_bf16(v[4], v[5]); o0.w = cvt_pk_bf16(v[6], v[7]);
            o1.x = cvt_pk_bf16(v[8], v[9]); o1.y = cvt_pk_bf16(v[10], v[11]); o1.z = cvt_pk_bf16(v[12], v[13]); o1.w = cvt_pk_bf16(v[14], v[15]);
            *(LAS u32x4*)(V16 + t * 136 + c16) = o0; *(LAS u32x4*)(V16 + t * 136 + c16 + 8) = o1;
        }
        if (u + G < nunits) SCAN_PREFETCH(u + G);
        __syncthreads();
        float hsum[16];
#pragma unroll
        for (int i = 0; i < 16; ++i) hsum[i] = 0.f;
#pragma unroll
        for (int dir = 0; dir < 2; ++dir) {
            f32x4 acc[2][4];
#pragma unroll
            for (int g = 0; g < 2; ++g)
#pragma unroll
                for (int m = 0; m < 4; ++m) acc[g][m] = (f32x4){0.f, 0.f, 0.f, 0.f};
#pragma unroll
            for (int ks = 0; ks < 4; ++ks)
#pragma unroll
                for (int m = 0; m < 4; ++m) { const bf16x8 af = *(const LAS bf16x8*)(V16 + (16 * m + fr) * 136 + ks * 32 + fq * 8);
                    acc[0][m] = __builtin_amdgcn_mfma_f32_16x16x32_bf16(af, wf[dir][0][ks], acc[0][m], 0, 0, 0); acc[1][m] = __builtin_amdgcn_mfma_f32_16x16x32_bf16(af, wf[dir][1][ks], acc[1][m], 0, 0, 0); }
#pragma unroll
            for (int m = 0; m < 4; ++m)
#pragma unroll
                for (int j = 0; j < 4; ++j) { const int tok = 16 * m + 4 * fq + j;
                    const float rr = fsigm(acc[0][m][j] + bia[dir]), ii = fsigm(acc[1][m][j] + bix[dir]), vv = VS[tok * 132 + ch];
                    const float la = -sp8[dir] * rr, av = fexp(la), a2 = av * av;
                    AS[tok * 132 + ch] = av; BS[tok * 132 + ch] = sqrtf(one_minus_exp(2.f * la, a2)) * (ii * vv); }
            __syncthreads();
            {
                float av[16], bv[16];
#pragma unroll
                for (int i = 0; i < 16; ++i) { const int tok = dir ? 63 - (16 * sg + i) : 16 * sg + i; av[i] = AS[tok * 132 + sc]; bv[i] = BS[tok * 132 + sc]; }
                float P = 1.f, hl = 0.f;
#pragma unroll
                for (int i = 0; i < 16; ++i) { hl = fmaf(av[i], hl, bv[i]); P *= av[i]; }
                SEG[(sg * 128 + sc) * 2] = P; SEG[(sg * 128 + sc) * 2 + 1] = hl;
                __syncthreads();
                if (PASS == 1) {
                    if (sg == 0) { float A = 1.f, B = 0.f;
#pragma unroll
                        for (int s2 = 0; s2 < 4; ++s2) { const float p2 = SEG[(s2 * 128 + sc) * 2], h2 = SEG[(s2 * 128 + sc) * 2 + 1]; B = fmaf(p2, B, h2); A *= p2; }
                        *(f32x2*)((float*)(ws + O_TOT) + (((size_t)q * 2 + dir) * 1024 + h * HD + sc) * 2) = (f32x2){A, B}; }
                } else {
                    float hc = car[dir];
#pragma unroll
                    for (int s2 = 0; s2 < 3; ++s2) if (s2 < sg) { const float p2 = SEG[(s2 * 128 + sc) * 2], h2 = SEG[(s2 * 128 + sc) * 2 + 1]; hc = fmaf(p2, hc, h2); }
#pragma unroll
                    for (int i = 0; i < 16; ++i) { const int tok = dir ? 63 - (16 * sg + i) : 16 * sg + i; hc = fmaf(av[i], hc, bv[i]); BS[tok * 132 + sc] = hc; }
                }
            }
            __syncthreads();
            if (PASS == 2) {
#pragma unroll
                for (int i = 0; i < 16; i += 4) { const f32x4 x = *(const LAS f32x4*)(BS + t * 132 + c16 + i); hsum[i] += x.x; hsum[i + 1] += x.y; hsum[i + 2] += x.z; hsum[i + 3] += x.w; }
                __syncthreads();
            }
        }
        if (PASS == 2) {
            const unsigned gu[8] = {gg0.x, gg0.y, gg0.z, gg0.w, gg1.x, gg1.y, gg1.z, gg1.w}; unsigned o[8];
#pragma unroll
            for (int i = 0; i < 8; ++i) o[i] = cvt_pk_bf16(hsum[2 * i] * bf_lo(gu[i]), hsum[2 * i + 1] * bf_hi(gu[i]));
            bf16* dst = (bf16*)(ws + O_HR) + (size_t)(row0 + t) * 1024 + h * HD + c16;
            *(u32x4*)dst = (u32x4){o[0], o[1], o[2], o[3]}; *(u32x4*)(dst + 8) = (u32x4){o[4], o[5], o[6], o[7]};
        }
    }
#undef SCAN_PREFETCH
#undef SCAN_LANE_VARS
}
template <int PASS, int SKIP = 0>
__device__ __forceinline__ void scan_phase2(AP a, LAS unsigned char* lds, const int l, const int nunits, const int vcu, const int G) {
    int tid0 = threadIdx.x; asm volatile("" : "+v"(tid0));
    const int w = __builtin_amdgcn_readfirstlane(tid0 >> 6);
    LAS bf16* V16 = (LAS bf16*)lds; LAS float* HST = (LAS float*)(lds + 34816) + w * (64 * 17); LAS float* CW = (LAS float*)(lds + 69632); LAS float* CB = (LAS float*)(lds + 71680);
    unsigned char* ws = a->ws;
    const bf16* UR = (const bf16*)(ws + O_UR);
#define SCAN_LANE_VARS(tid) const int lane = (tid) & 63, fr = lane & 15, fq = lane >> 4, t = (tid) >> 3, c16 = ((tid) & 7) * 16, ch = 16 * w + fr; (void)fq; (void)ch; (void)t; (void)c16
    int hcur = -1;
    bf16x8 wf[2][2][4]; float nbia[2], nbix[2], nsp8[2];
    u32x4 ur[4][2];
#define SCAN_PREFETCH(uu) do { const int q_ = (uu) >> 3, h_ = (uu) & 7; const bool ic_ = q_ >= 256; const int r0_ = ic_ ? RL + (q_ - 256) * 64 : q_ * 64; \
        if (PASS == 2 && SCAN_VV) { const bf16* src_ = (const bf16*)(ws + O_VV) + (size_t)(r0_ + t) * 1024 + h_ * HD + c16; ur[0][0] = *(const u32x4*)src_; ur[0][1] = *(const u32x4*)(src_ + 8); break; }     \
        const int cp_ = ic_ ? ((q_ - 256) & 3) * 64 : 0, sl_ = ic_ ? LC : GW; \
        _Pragma("unroll") for (int k = 0; k < 4; ++k) { const int p_ = cp_ + t + k - 2; \
            if (p_ >= 0 && p_ < sl_) { const bf16* src_ = UR + (size_t)(r0_ + t + k - 2) * 1024 + h_ * HD + c16; ur[k][0] = *(const u32x4*)src_; ur[k][1] = *(const u32x4*)(src_ + 8); } \
            else { ur[k][0] = (u32x4){0u, 0u, 0u, 0u}; ur[k][1] = (u32x4){0u, 0u, 0u, 0u}; } } } while (0)
    if (vcu < nunits) { SCAN_LANE_VARS(tid0); SCAN_PREFETCH(vcu); }
    int par = 0;
    for (int u = vcu; u < nunits; u += G, par ^= 1) {
        const int q = u >> 3, h = u & 7;
        const int tid = opq(tid0); SCAN_LANE_VARS(tid);
        const bool isctx = q >= 256; const int row0 = isctx ? RL + (q - 256) * 64 : q * 64;
        LAS bf16* Vb = V16 + par * (64 * 136);
        if (h != hcur) {
            hcur = h;
            __syncthreads();
            if (tid < 128) { CB[tid] = a->in[10][(size_t)l * DL + h * HD + tid];
#pragma unroll
                for (int k = 0; k < 4; ++k) CW[k * 128 + tid] = a->in[9][((size_t)l * 4 + k) * DL + h * HD + tid]; }
#pragma unroll
            for (int dir = 0; dir < 2; ++dir) {
                const bf16* WT = (const bf16*)(ws + O_WAX) + ((size_t)((l * 2 + dir) * 2) * 8 + h) * 128 * 128;
#pragma unroll
                for (int g = 0; g < 2; ++g)
#pragma unroll
                    for (int ks = 0; ks < 4; ++ks) wf[dir][g][ks] = *(const bf16x8*)(WT + (size_t)g * 8 * 128 * 128 + (size_t)ch * 128 + ks * 32 + fq * 8);
                const int gch = h * HD + ch;
                nbia[dir] = -1.4426950408889634f * a->in[12][(size_t)(l * 2 + dir) * DL + gch]; nbix[dir] = -1.4426950408889634f * a->in[14][(size_t)(l * 2 + dir) * DL + gch];
                nsp8[dir] = -8.f * 1.4426950408889634f * log1pf(expf(-a->in[15][(size_t)(l * 2 + dir) * DL + gch]));
            }
            __syncthreads();
        }
        float car[2]; u32x4 gg0, gg1;
        if (PASS == 2) {
            car[0] = ((const float*)(ws + O_CAR))[((size_t)q * 2 + 0) * 1024 + h * HD + ch]; car[1] = ((const float*)(ws + O_CAR))[((size_t)q * 2 + 1) * 1024 + h * HD + ch];
            const bf16* GGp = (const bf16*)(ws + O_GG) + (size_t)(row0 + lane) * 1024 + h * HD + 16 * w; gg0 = *(const u32x4*)GGp; gg1 = *(const u32x4*)(GGp + 8);
        }
        if (PASS == 2 && SCAN_VV) { *(LAS u32x4*)(Vb + t * 136 + c16) = ur[0][0]; *(LAS u32x4*)(Vb + t * 136 + c16 + 8) = ur[0][1]; }
        else {
            float v[16];
#pragma unroll
            for (int i = 0; i < 16; i += 4) { const f32x4 b4 = *(const LAS f32x4*)(CB + c16 + i); v[i] = b4.x; v[i + 1] = b4.y; v[i + 2] = b4.z; v[i + 3] = b4.w; }
#pragma unroll
            for (int k = 0; k < 4; ++k) { const unsigned uu[8] = {ur[k][0].x, ur[k][0].y, ur[k][0].z, ur[k][0].w, ur[k][1].x, ur[k][1].y, ur[k][1].z, ur[k][1].w};
#pragma unroll
                for (int i = 0; i < 16; i += 4) { const f32x4 wv = *(const LAS f32x4*)(CW + k * 128 + c16 + i);
                    v[i] = fmaf(wv.x, bf_lo(uu[i / 2]), v[i]); v[i + 1] = fmaf(wv.y, bf_hi(uu[i / 2]), v[i + 1]); v[i + 2] = fmaf(wv.z, bf_lo(uu[i / 2 + 1]), v[i + 2]); v[i + 3] = fmaf(wv.w, bf_hi(uu[i / 2 + 1]), v[i + 3]); } }
            u32x4 o0, o1; o0.x = cvt_pk_bf16(v[0], v[1]); o0.y = cvt_pk_bf16(v[2], v[3]); o0.z = cvt_pk_bf16(v[4], v[5]); o0.w = cvt_pk_bf16(v[6], v[7]);
            o1.x = cvt_pk_bf16(v[8], v[9]); o1.y = cvt_pk_bf16(v[10], v[11]); o1.z = cvt_pk_bf16(v[12], v[13]); o1.w = cvt_pk_bf16(v[14], v[15]);
            *(LAS u32x4*)(Vb + t * 136 + c16) = o0; *(LAS u32x4*)(Vb + t * 136 + c16 + 8) = o1;
            if (PASS == 1 && SCAN_VV) { bf16* vd = (bf16*)(ws + O_VV) + (size_t)(row0 + t) * 1024 + h * HD + c16; __builtin_nontemporal_store(o0, (u32x4*)vd); __builtin_nontemporal_store(o1, (u32x4*)(vd + 8)); }
        }
        if (u + G < nunits) SCAN_PREFETCH(u + G);
        __syncthreads();
        if (SKIP == 1) continue;
        float vv[4][4];
#pragma unroll
        for (int m = 0; m < 4; ++m)
#pragma unroll
            for (int j = 0; j < 4; ++j) vv[m][j] = __uint_as_float(((unsigned)Vb[(16 * m + 4 * fq + j) * 136 + ch]) << 16);
        f32x4 acc2[2][2][4];
#pragma unroll
        for (int d2 = 0; d2 < 2; ++d2)
#pragma unroll
            for (int g = 0; g < 2; ++g)
#pragma unroll
                for (int m = 0; m < 4; ++m) acc2[d2][g][m] = (f32x4){0.f, 0.f, 0.f, 0.f};
#pragma unroll
        for (int ks = 0; ks < 4; ++ks)
#pragma unroll
            for (int m = 0; m < 4; ++m) { const bf16x8 af = *(const LAS bf16x8*)(Vb + (16 * m + fr) * 136 + ks * 32 + fq * 8);
#pragma unroll
                for (int d2 = 0; d2 < 2; ++d2) { acc2[d2][0][m] = __builtin_amdgcn_mfma_f32_16x16x32_bf16(af, wf[d2][0][ks], acc2[d2][0][m], 0, 0, 0); acc2[d2][1][m] = __builtin_amdgcn_mfma_f32_16x16x32_bf16(af, wf[d2][1][ks], acc2[d2][1][m], 0, 0, 0); } }
#pragma unroll
        for (int dir = 0; dir < 2; ++dir) {
            f32x4 (&acc)[2][4] = acc2[dir];
            float av[4][4], bv[4][4];
#pragma unroll
            for (int m = 0; m < 4; ++m)
#pragma unroll
                for (int j = 0; j < 4; ++j) {
                    if (SKIP == 3) { av[m][j] = acc[0][m][j]; bv[m][j] = acc[1][m][j] * vv[m][j]; continue; }
                    const float ex = __builtin_amdgcn_exp2f(fminf(fmaf(acc[0][m][j], -1.4426950408889634f, nbia[dir]), 60.f)), ey = __builtin_amdgcn_exp2f(fminf(fmaf(acc[1][m][j], -1.4426950408889634f, nbix[dir]), 60.f));
                    const float dx = 1.f + ex, dy = 1.f + ey, qq = frcp(dx * dy), rr = qq * dy, ii = qq * dx;
                    const float aa = __builtin_amdgcn_exp2f(nsp8[dir] * rr);
                    av[m][j] = aa; bv[m][j] = __builtin_amdgcn_sqrtf(fmaf(-aa, aa, 1.f)) * (ii * vv[m][j]); }
            float P[4], H[4];
#pragma unroll
            for (int m = 0; m < 4; ++m) { float p = 1.f, hh = 0.f;
#pragma unroll
                for (int i = 0; i < 4; ++i) { const int jj = dir ? 3 - i : i; hh = fmaf(av[m][jj], hh, bv[m][jj]); p *= av[m][jj]; }
                P[m] = p; H[m] = hh; }
            float Ae[4], He[4], TA[4], TB[4];
#pragma unroll
            for (int m = 0; m < 4; ++m) {
                float Pk[4], Hk[4];
#pragma unroll
                for (int k = 0; k < 4; ++k) { Pk[k] = __shfl(P[m], fr + 16 * k); Hk[k] = __shfl(H[m], fr + 16 * k); }
                float A = 1.f, B = 0.f, ae = 1.f, he = 0.f;
#pragma unroll
                for (int i = 0; i < 4; ++i) { const int k = dir ? 3 - i : i; if (k == fq) { ae = A; he = B; } B = fmaf(Pk[k], B, Hk[k]); A *= Pk[k]; }
                Ae[m] = ae; He[m] = he; TA[m] = A; TB[m] = B;
            }
            if (PASS == 1) {
                float A = 1.f, B = 0.f;
#pragma unroll
                for (int i = 0; i < 4; ++i) { const int m = dir ? 3 - i : i; B = fmaf(TA[m], B, TB[m]); A *= TA[m]; }
                if (fq == 0) *(f32x2*)((float*)(ws + (SKIP ? O_CAR : O_TOT)) + (((size_t)(SKIP ? 0 : q) * 2 + dir) * 1024 + h * HD + ch) * 2) = (f32x2){A, B};
            } else {
                float C = car[dir];
#pragma unroll
                for (int i = 0; i < 4; ++i) { const int m = dir ? 3 - i : i;
                    float hh = fmaf(Ae[m], C, He[m]);
#pragma unroll
                    for (int i2 = 0; i2 < 4; ++i2) { const int jj = dir ? 3 - i2 : i2; hh = fmaf(av[m][jj], hh, bv[m][jj]); LAS float* hp = HST + (16 * m + 4 * fq + jj) * 17 + fr; if (dir == 0) *hp = hh; else *hp += hh; }
                    C = fmaf(TA[m], C, TB[m]); }
            }
        }
        if (PASS == 2) {
            LDS_WAIT(); asm volatile("" ::: "memory");
            const unsigned gu[8] = {gg0.x, gg0.y, gg0.z, gg0.w, gg1.x, gg1.y, gg1.z, gg1.w}; unsigned o[8];
#pragma unroll
            for (int i = 0; i < 8; ++i) o[i] = cvt_pk_bf16(HST[lane * 17 + 2 * i] * bf_lo(gu[i]), HST[lane * 17 + 2 * i + 1] * bf_hi(gu[i]));
            bf16* dst = (bf16*)(ws + O_HR) + (size_t)(row0 + lane) * 1024 + h * HD + 16 * w;
            *(u32x4*)dst = (u32x4){o[0], o[1], o[2], o[3]}; *(u32x4*)(dst + 8) = (u32x4){o[4], o[5], o[6], o[7]};
            LDS_WAIT(); asm volatile("" ::: "memory");
        }
    }
#undef SCAN_PREFETCH
#undef SCAN_LANE_VARS
}
__device__ __forceinline__ void dft_stage1(AP a, const LAS f32x2* tab, size_t gt, size_t NGT) {
    unsigned char* ws = a->ws; const bf16* UT = (const bf16*)(ws + O_UT); bf16* ZT = (bf16*)(ws + O_ZT);
    for (size_t it = gt; it < (size_t)1024 * 8 * 64; it += NGT) {
        const int t2b = (int)(it & 63), b = (int)((it >> 6) & 7), c = (int)(it >> 9);
        const bf16* src = UT + (size_t)c * UT_LD + (size_t)b * 4096 + t2b * 4;
        u32x2 uc[8], us[8];
#pragma unroll
        for (int t1 = 0; t1 < 8; ++t1) { uc[t1] = *(const u32x2*)(src + 256 * t1); us[t1] = *(const u32x2*)(src + 2048 + 256 * t1); }
        unsigned zo[8][2][2];
#pragma unroll
        for (int e = 0; e < 4; e += 2) {
            float Zr[2][8], Zi[2][8];
#pragma unroll
            for (int h = 0; h < 2; ++h) {
                float xr[8], xi[8];
#pragma unroll
                for (int t1 = 0; t1 < 8; ++t1) { const unsigned wc_ = uc[t1][e >> 1], ws_ = us[t1][e >> 1]; xr[t1] = h ? bf_hi(wc_) : bf_lo(wc_); xi[t1] = -(h ? bf_hi(ws_) : bf_lo(ws_)); }
                float ar[8], ai[8];
#pragma unroll
                for (int i = 0; i < 4; ++i) { ar[i] = xr[i] + xr[i + 4]; ai[i] = xi[i] + xi[i + 4]; ar[i + 4] = xr[i] - xr[i + 4]; ai[i + 4] = xi[i] - xi[i + 4]; }
                { const float r = 0.70710678118654752f; const float t5r = (ar[5] + ai[5]) * r, t5i = (ai[5] - ar[5]) * r; ar[5] = t5r; ai[5] = t5i;
                  const float t6r = ai[6], t6i = -ar[6]; ar[6] = t6r; ai[6] = t6i;
                  const float t7r = (ai[7] - ar[7]) * r, t7i = (-ar[7] - ai[7]) * r; ar[7] = t7r; ai[7] = t7i; }
                float Xr[8], Xi[8];
#pragma unroll
                for (int o = 0; o < 2; ++o) {
                    const float b0r = ar[4 * o] + ar[4 * o + 2], b0i = ai[4 * o] + ai[4 * o + 2], b1r = ar[4 * o] - ar[4 * o + 2], b1i = ai[4 * o] - ai[4 * o + 2];
                    const float b2r = ar[4 * o + 1] + ar[4 * o + 3], b2i = ai[4 * o + 1] + ai[4 * o + 3];
                    const float dr = ar[4 * o + 1] - ar[4 * o + 3], di = ai[4 * o + 1] - ai[4 * o + 3], b3r = di, b3i = -dr;
                    Xr[o] = b0r + b2r; Xi[o] = b0i + b2i; Xr[2 + o] = b1r + b3r; Xi[2 + o] = b1i + b3i; Xr[4 + o] = b0r - b2r; Xi[4 + o] = b0i - b2i; Xr[6 + o] = b1r - b3r; Xi[6 + o] = b1i - b3i; }
                const int t2 = t2b * 4 + e + h;
                Zr[h][0] = Xr[0]; Zi[h][0] = Xi[0];
#pragma unroll
                for (int k1 = 1; k1 < 8; ++k1) { const f32x2 cs = tab[t2 * k1]; Zr[h][k1] = Xr[k1] * cs.x + Xi[k1] * cs.y; Zi[h][k1] = Xi[k1] * cs.x - Xr[k1] * cs.y; }
            }
#pragma unroll
            for (int k1 = 0; k1 < 8; ++k1) { zo[k1][0][e >> 1] = cvt_pk_bf16(Zr[0][k1], Zr[1][k1]); zo[k1][1][e >> 1] = cvt_pk_bf16(Zi[0][k1], Zi[1][k1]); }
        }
        bf16* dst = ZT + (size_t)c * UT_LD + (size_t)b * 4096 + t2b * 4;
#pragma unroll
        for (int k1 = 0; k1 < 8; ++k1) { *(u32x2*)(dst + k1 * 512) = (u32x2){zo[k1][0][0], zo[k1][0][1]}; *(u32x2*)(dst + k1 * 512 + 256) = (u32x2){zo[k1][1][0], zo[k1][1][1]}; }
    }
}
__device__ __forceinline__ void carry_phase(AP a, int gw, int NGW) {
    const int lane = opq(threadIdx.x) & 63; unsigned char* ws = a->ws;
    const f32x2* TOT = (const f32x2*)(ws + O_TOT); float* CAR = (float*)(ws + O_CAR);
    for (int item = gw; item < NB * 2 * 16; item += NGW) {
        const int cgp = item & 15, dir = (item >> 4) & 1, b = item >> 5, chn = cgp * 64 + lane;
        float hc = 0.f;
#pragma unroll 4
        for (int s = 0; s < 36; ++s) {
            int q; if (dir == 0) q = s < 4 ? 256 + b * 4 + s : b * 32 + (s - 4); else q = s < 4 ? 256 + b * 4 + (3 - s) : b * 32 + (31 - (s - 4));
            const size_t o = ((size_t)q * 2 + dir) * 1024 + chn;
            CAR[o] = hc; const f32x2 ab = TOT[o]; hc = fmaf(ab.x, hc, ab.y);
        }
    }
}
#ifndef FFN_BLK
#define FFN_BLK 1
#endif
#ifndef NORM_REV
#define NORM_REV 1
#ifndef N1N_REV
#define N1N_REV 0
#endif
#ifndef P1_REV
#define P1_REV 0
#endif
#ifndef WIN_REV
#define WIN_REV 0
#endif
#ifndef MERGED_REV
#define MERGED_REV 0
#endif
#endif
#ifndef CODE_SHIFT
#define CODE_SHIFT 0
#endif
#ifndef WGM_FD
#define WGM_FD 2
#endif
#ifndef WGM_MD
#define WGM_MD WGM
#endif
#ifndef WGM_K1
#define WGM_K1 WGM
#endif
#ifndef MOE_WNT
#define MOE_WNT 0
#endif
#ifndef FFN_DOWN_REV
#define FFN_DOWN_REV 1
#endif
#ifndef MOE_DOWN_REV
#define MOE_DOWN_REV 1
#endif
#ifndef MOE_DOWN_XCD
#define MOE_DOWN_XCD 0
#endif
#ifndef PROBE_BAR
#define PROBE_BAR 0
#endif
#ifndef MOE_NT
#define MOE_NT 0
#endif
#ifndef MOE_STAGGER
#define MOE_STAGGER 0
#endif
#ifndef MOE_WGM
#define MOE_WGM 0
#endif
#ifndef MOE_TAILSPLIT
#define MOE_TAILSPLIT 1
#endif
#ifndef SCANV
#define SCANV 2
#endif
#ifndef MOE_KSPLIT
#define MOE_KSPLIT 1
#endif
struct GridSched {
    int G, c, nM, nN, nt; const char* A; const char* B; size_t atile, btile; int rev = 0; int wgm = WGM;
    __device__ __forceinline__ bool next(int i, Unit& u) const {
        const int Lx = i * G + c; if (Lx >= nM * nN) return false;
        tile_of(rev ? nM * nN - 1 - Lx : Lx, nM, nN, u.pm, u.pn, wgm); u.A = A + (size_t)u.pm * atile; u.B = B + (size_t)u.pn * btile; u.nt = nt; u.kind = 0; u.x = 0; return true; }
};
struct FoldSched { int G, c; const char* DGp; const char* WUF;
    __device__ __forceinline__ bool next(int i, Unit& u) const {
        const int Lx = i * G + c; if (Lx >= 64) return false;
        const int pn = Lx & 7, g = (Lx >> 3) & 3, l = Lx >> 5;
        u.pm = 0; u.pn = pn; u.kind = g; u.x = l; { int n4 = 4; asm volatile("" : "+s"(n4)); u.nt = n4; }
        u.A = DGp; u.B = WUF + ((size_t)l * 2048 + pn * 256) * 1024 * 2 + (size_t)g * 256 * 2; return true; }
};
struct EpiFold { static constexpr bool PERM = true; bf16* WIN;
    __device__ __forceinline__ void operator()(const f32x4 (&acc)[2][2][4][2], const Unit& u, int wr, int wc, int fr, int fq) const { fr = opq(fr);
        bf16* base = WIN + (size_t)u.x * WIN_ROWS * 2048;
#pragma unroll
        for (int ai = 0; ai < 2; ++ai)
#pragma unroll
            for (int m = 0; m < 4; ++m) { const int row = u.kind * 256 + ai * HALF + wr * 64 + m * 16 + fr; bf16* rp = base + (size_t)row * 2048 + u.pn * 256 + wc * 32 + 8 * fq;
#pragma unroll
                for (int bj = 0; bj < 2; ++bj) { const f32x4 v0 = acc[ai][bj][m][0], v1 = acc[ai][bj][m][1];
                    u32x4 w; w.x = cvt_pk_bf16(v0[0], v0[1]); w.y = cvt_pk_bf16(v0[2], v0[3]); w.z = cvt_pk_bf16(v1[0], v1[1]); w.w = cvt_pk_bf16(v1[2], v1[3]); *(u32x4*)(rp + bj * HALF) = w; } __builtin_amdgcn_sched_barrier(0); }
    }
};
#ifndef LANE_LIN
#define LANE_LIN 1
#endif
__device__ __forceinline__ size_t lin_off(int pm, int pn8, int ai, int m, int bj, int tl);
struct WinSched { int G, c, l; const char* HNp; const char* WINl;
    __device__ __forceinline__ bool next(int i, Unit& u) const {
        int Lx = i * G + c; const int ntok = l == 0 ? 72 : 64; const int NC1 = WIN_F8 ? 8 : 24; const int n0 = 4 * ntok, n1 = ntok * NC1, n2 = l == 0 ? 0 : 32;
        if (Lx >= n0 + n1 + n2) return false;
        u.nt = 32; u.x = 0;
        if (Lx < n0) { tile_of(Lx, 4, ntok, u.pm, u.pn); if (WIN_REV) u.pn = ntok - 1 - u.pn; u.kind = 0; u.A = WINl + (size_t)u.pm * 256 * 2048 * 2; u.B = HNp + (size_t)u.pn * 256 * 2048 * 2; return true; }
        Lx -= n0;
        if (Lx < n1) { tile_of(Lx, ntok, NC1, u.pm, u.pn); if (WIN_REV) u.pm = ntok - 1 - u.pm; } else { Lx -= n1; u.pm = 64 + (Lx & 7); u.pn = Lx >> 3; }
        u.kind = 1; u.A = HNp + (size_t)u.pm * 256 * 2048 * 2; u.B = WINl + (size_t)(1024 + u.pn * 256) * 2048 * 2; return true; }
};
struct EpiWin { static constexpr bool PERM = true; bf16 *UT, *UR, *GG, *SGF, *SGR;
    __device__ __forceinline__ void operator()(const f32x4 (&acc)[2][2][4][2], const Unit& u, int wr, int wc, int fr, int fq) const { fr = opq(fr);
        if (u.kind == 0) {
#pragma unroll
            for (int ai = 0; ai < 2; ++ai)
#pragma unroll
                for (int m = 0; m < 4; ++m) { const int rho = ai * HALF + wr * 64 + m * 16 + fr, sn = rho > 128 ? 1 : 0, c = sn ? rho - 128 : rho, cm = (256 - c) & 255;
                    const int ch = u.pm * 256 + c, chm = u.pm * 256 + cm;
#pragma unroll
                    for (int bj = 0; bj < 2; ++bj) { const int r = u.pn * 256 + bj * HALF + wc * 32 + 8 * fq;
                        const size_t tof = r < RL ? (size_t)(r >> 11) * 4096 + (r & 2047) : (size_t)32768 + ((r - RL) >> 8) * 512 + ((r - RL) & 255);
                        const size_t sof = r < RL ? 2048 : 256;
                        const f32x4 v0 = acc[ai][bj][m][0], v1 = acc[ai][bj][m][1];
                        u32x4 w; w.x = cvt_pk_bf16(v0[0], v0[1]); w.y = cvt_pk_bf16(v0[2], v0[3]); w.z = cvt_pk_bf16(v1[0], v1[1]); w.w = cvt_pk_bf16(v1[2], v1[3]);
                        if (sn == 0) { *(u32x4*)(UT + (size_t)ch * UT_LD + tof) = w;
                            if (cm != c) *(u32x4*)(UT + (size_t)chm * UT_LD + tof) = w;
                            else *(u32x4*)(UT + (size_t)ch * UT_LD + tof + sof) = (u32x4){0u, 0u, 0u, 0u}; }
                        else { *(u32x4*)(UT + (size_t)ch * UT_LD + tof + sof) = w;
                            const u32x4 wn = (u32x4){w.x ^ 0x80008000u, w.y ^ 0x80008000u, w.z ^ 0x80008000u, w.w ^ 0x80008000u}; *(u32x4*)(UT + (size_t)chm * UT_LD + tof + sof) = wn; } }
                    __builtin_amdgcn_sched_barrier(0); }
        } else {
            const int pn = u.pn; bf16* base; int ldc, ct, act;
            if (pn < 4) { base = UR; ldc = 1024; ct = pn; act = 0; } else if (pn < 8) { base = GG; ldc = 1024; ct = pn - 4; act = 1; }
            else if (pn < 16) { base = SGF; ldc = 2048; ct = pn - 8; act = 2; } else { base = SGR; ldc = 2048; ct = pn - 16; act = 2; }
#pragma unroll
            for (int ai = 0; ai < 2; ++ai)
#pragma unroll
                for (int m = 0; m < 4; ++m) { const int r = u.pm * 256 + ai * HALF + wr * 64 + m * 16 + fr; bf16* rp = base + (size_t)r * ldc + ct * 256 + wc * 32 + 8 * fq;
                    const int tl = (wr * 4 + wc) * 64 + fq * 16 + fr;
#pragma unroll
                    for (int bj = 0; bj < 2; ++bj) { f32x4 v0 = acc[ai][bj][m][0], v1 = acc[ai][bj][m][1];
                        if (act == 1) {
#pragma unroll
                            for (int j = 0; j < 4; ++j) { v0[j] = fgelu(v0[j]); v1[j] = fgelu(v1[j]); } }
                        else if (act == 2) {
#pragma unroll
                            for (int j = 0; j < 4; ++j) { v0[j] = fsigm(v0[j]); v1[j] = fsigm(v1[j]); } }
                        u32x4 w; w.x = cvt_pk_bf16(v0[0], v0[1]); w.y = cvt_pk_bf16(v0[2], v0[3]); w.z = cvt_pk_bf16(v1[0], v1[1]); w.w = cvt_pk_bf16(v1[2], v1[3]);
                        *(u32x4*)((LANE_LIN && act == 2) ? base + lin_off(u.pm, ct, ai, m, bj, tl) : rp + bj * HALF) = w; } __builtin_amdgcn_sched_barrier(0); }
        }
    }
};
struct WinSched8 { int G, c, l; const char* HN8p; const char* WIN8l;
    __device__ __forceinline__ bool next(int i, Unit& u) const {
        const int ntok = l == 0 ? 72 : 64; const int Lx = i * G + (G - 1 - c); if (Lx >= ntok * 16) return false;
        int pml, pnl; tile_of(Lx, ntok, 16, pml, pnl); if (WIN_REV) pml = ntok - 1 - pml; u.pm = pml; u.pn = 8 + pnl; u.kind = 1; u.x = 0; u.nt = 16;
        u.A = HN8p + (size_t)pml * 256 * 2048; u.B = WIN8l + (size_t)pnl * 256 * 2048; return true; }
};
struct EpiWinGate8 { static constexpr bool PERM = true; bf16 *SGF, *SGR; float sc;
    __device__ __forceinline__ void operator()(const f32x4 (&acc)[2][2][4][2], const Unit& u, int wr, int wc, int fr, int fq) const { fr = opq(fr); fq = opq(fq);
        const int pn = u.pn; bf16* base = pn < 16 ? SGF : SGR; const int ct = pn < 16 ? pn - 8 : pn - 16;
#pragma unroll
        for (int ai = 0; ai < 2; ++ai)
#pragma unroll
            for (int m = 0; m < 4; ++m) { const int r = u.pm * 256 + ai * HALF + wr * 64 + m * 16 + fr; bf16* rp = base + (size_t)r * 2048 + ct * 256 + wc * 32 + 8 * fq;
                const int tl = (wr * 4 + wc) * 64 + fq * 16 + fr;
#pragma unroll
                for (int bj = 0; bj < 2; ++bj) { f32x4 v0 = acc[ai][bj][m][0] * sc, v1 = acc[ai][bj][m][1] * sc;
#pragma unroll
                    for (int j = 0; j < 4; ++j) { v0[j] = fsigm(v0[j]); v1[j] = fsigm(v1[j]); }
                    u32x4 w; w.x = cvt_pk_bf16(v0[0], v0[1]); w.y = cvt_pk_bf16(v0[2], v0[3]); w.z = cvt_pk_bf16(v1[0], v1[1]); w.w = cvt_pk_bf16(v1[2], v1[3]);
                    __builtin_nontemporal_store(w, (u32x4*)(LANE_LIN ? base + lin_off(u.pm, ct, ai, m, bj, tl) : rp + bj * HALF)); } __builtin_amdgcn_sched_barrier(0); }
    }
};
struct DftSched { int G, c, l; const char* FLp; const char* FLCp; const char* UTp; const char* ZTp;
    __device__ __forceinline__ bool next(int i, Unit& u) const {
        int Lx = i * G + c; const int n0 = 256, n1 = l == 0 ? 32 : 0;
        if (Lx >= n0 + n1) return false;
#if DFT2
        if (Lx < n0) { const int b = Lx & 7, rest = Lx >> 3, pn = rest & 3, k1 = rest >> 2; u.pm = k1; u.pn = pn; u.kind = 0; u.x = b; u.nt = 8;
            u.A = FLp; u.B = ZTp + ((size_t)pn * 256 * UT_LD + (size_t)(b * 8 + k1) * 512) * 2; return true; }
#else
        if (Lx < n0) { const int b = Lx & 7, rest = Lx >> 3, pn = rest & 3, pm = rest >> 2; u.pm = pm; u.pn = pn; u.kind = 0; u.x = b; u.nt = 64;
            u.A = FLp + (size_t)pm * 256 * 4096 * 2; u.B = UTp + ((size_t)pn * 256 * UT_LD + (size_t)b * 4096) * 2; return true; }
#endif
        Lx -= n0; { const int b = Lx & 7, pn = Lx >> 3; u.pm = 0; u.pn = pn; u.kind = 1; u.x = b; u.nt = 8;
            u.A = FLCp; u.B = UTp + ((size_t)pn * 256 * UT_LD + 32768 + (size_t)b * 512) * 2; return true; }
    }
};
struct EpiBf16Rows { static constexpr bool PERM = true; bf16* O; int ldc;
    bool dft;
    __device__ __forceinline__ void operator()(const f32x4 (&acc)[2][2][4][2], const Unit& u, int wr, int wc, int fr, int fq) const { fr = opq(fr);
        const int rs = (DFT2 && dft && u.kind == 0) ? 8 : 1;
        const int row0 = dft ? (u.kind == 0 ? (DFT2 ? u.x * 2048 + u.pm : u.x * 2048 + u.pm * 256) : RL + u.x * 256) : u.pm * 256 + u.x * MAXSLOT;
#pragma unroll
        for (int ai = 0; ai < 2; ++ai)
#pragma unroll
            for (int m = 0; m < 4; ++m) { bf16* rp = O + (size_t)(row0 + rs * (ai * HALF + wr * 64 + m * 16 + fr)) * ldc + u.pn * 256 + wc * 32 + 8 * fq;
#pragma unroll
                for (int bj = 0; bj < 2; ++bj) { const f32x4 v0 = acc[ai][bj][m][0], v1 = acc[ai][bj][m][1];
                    u32x4 w; w.x = cvt_pk_bf16(v0[0], v0[1]); w.y = cvt_pk_bf16(v0[2], v0[3]); w.z = cvt_pk_bf16(v1[0], v1[1]); w.w = cvt_pk_bf16(v1[2], v1[3]); *(u32x4*)(rp + bj * HALF) = w; } __builtin_amdgcn_sched_barrier(0); }
    }
};
#ifndef LANE_LIN
#define LANE_LIN 1
#endif
__device__ __forceinline__ size_t lin_off(int pm, int pn8, int ai, int m, int bj, int tl) { return ((size_t)(pm * 8 + pn8) << 16) + (size_t)((((ai * 4 + m) * 2 + bj) * 512 + tl) * 8); }
template <bool ADD> struct EpiGate { static constexpr bool PERM = true; bf16* O; const bf16* gate; const bf16* addend;
    __device__ __forceinline__ void operator()(const f32x4 (&acc)[2][2][4][2], const Unit& u, int wr, int wc, int fr, int fq) const { fr = opq(fr);
        const int tl = (wr * 4 + wc) * 64 + fq * 16 + fr;
#pragma unroll
        for (int ai = 0; ai < 2; ++ai) {
            u32x4 g[4][2], t[4][2];
#pragma unroll
            for (int m = 0; m < 4; ++m) { const size_t off = (size_t)(u.pm * 256 + ai * HALF + wr * 64 + m * 16 + fr) * 2048 + u.pn * 256 + wc * 32 + 8 * fq;
#pragma unroll
                for (int bj = 0; bj < 2; ++bj) { const size_t lo = LANE_LIN ? lin_off(u.pm, u.pn, ai, m, bj, tl) : off + bj * HALF; g[m][bj] = *(const u32x4*)(gate + lo); if (ADD) t[m][bj] = *(const u32x4*)(addend + lo); } }
#pragma unroll
            for (int m = 0; m < 4; ++m) { const size_t off = (size_t)(u.pm * 256 + ai * HALF + wr * 64 + m * 16 + fr) * 2048 + u.pn * 256 + wc * 32 + 8 * fq;
#pragma unroll
                for (int bj = 0; bj < 2; ++bj) { const f32x4 v0 = acc[ai][bj][m][0], v1 = acc[ai][bj][m][1]; const u32x4 gg = g[m][bj];
                    float o[8] = {v0[0] * bf_lo(gg.x), v0[1] * bf_hi(gg.x), v0[2] * bf_lo(gg.y), v0[3] * bf_hi(gg.y), v1[0] * bf_lo(gg.z), v1[1] * bf_hi(gg.z), v1[2] * bf_lo(gg.w), v1[3] * bf_hi(gg.w)};
                    if (ADD) { const u32x4 tt = t[m][bj];
                        o[0] += bf_lo(tt.x); o[1] += bf_hi(tt.x); o[2] += bf_lo(tt.y); o[3] += bf_hi(tt.y); o[4] += bf_lo(tt.z); o[5] += bf_hi(tt.z); o[6] += bf_lo(tt.w); o[7] += bf_hi(tt.w); }
                    u32x4 w; w.x = cvt_pk_bf16(o[0], o[1]); w.y = cvt_pk_bf16(o[2], o[3]); w.z = cvt_pk_bf16(o[4], o[5]); w.w = cvt_pk_bf16(o[6], o[7]);
                    *(u32x4*)(O + ((LANE_LIN && !ADD) ? lin_off(u.pm, u.pn, ai, m, bj, tl) : off + bj * HALF)) = w; } }
            asm volatile("" ::: "memory"); __builtin_amdgcn_sched_barrier(0); }
    }
};
template <bool FIRST> struct EpiResid { static constexpr bool PERM = false; float* lat; const float* modl; int gate_chunk; const float* x0; const float* c0; float osc = 1.f;
    __device__ __forceinline__ void operator()(const f32x4 (&acc)[2][2][4][2], const Unit& u, int wr, int wc, int fr, int fq) const { fr = opq(fr);
        const int bi = u.pm < 64 ? (u.pm >> 3) : 8; const int col0 = u.pn * 256 + wc * 32 + 4 * fq;
        const float* gp = modl + (size_t)bi * 12288 + gate_chunk * D + col0;
        f32x4 gv[2][2];
#pragma unroll
        for (int bj = 0; bj < 2; ++bj)
#pragma unroll
            for (int n = 0; n < 2; ++n) gv[bj][n] = *(const f32x4*)(gp + bj * HALF + n * 16) * osc;
#pragma unroll
        for (int ai = 0; ai < 2; ++ai) {
            f32x4 bsv[4][2][2];
#pragma unroll
            for (int m = 0; m < 4; ++m) { const int row = u.pm * 256 + ai * HALF + wr * 64 + m * 16 + fr; const float* rp = lat + (size_t)row * D + col0;
                const float* bp = FIRST ? (u.pm < 64 ? x0 + (size_t)row * D + col0 : c0 + (size_t)(row - RL) * D + col0) : rp;
#pragma unroll
                for (int bj = 0; bj < 2; ++bj)
#pragma unroll
                    for (int n = 0; n < 2; ++n) bsv[m][bj][n] = *(const f32x4*)(bp + bj * HALF + n * 16); }
#pragma unroll
            for (int m = 0; m < 4; ++m) { const int row = u.pm * 256 + ai * HALF + wr * 64 + m * 16 + fr; float* rp = lat + (size_t)row * D + col0;
#pragma unroll
                for (int bj = 0; bj < 2; ++bj)
#pragma unroll
                    for (int n = 0; n < 2; ++n) *(f32x4*)(rp + bj * HALF + n * 16) = bsv[m][bj][n] + gv[bj][n] * acc[ai][bj][m][n]; }
            asm volatile("" ::: "memory"); __builtin_amdgcn_sched_barrier(0); }
    }
};
struct EpiNull { static constexpr bool PERM = true; float* sink;
    __device__ __forceinline__ void operator()(const f32x4 (&acc)[2][2][4][2], const Unit& u, int wr, int wc, int fr, int fq) const {
        float s = 0.f;
#pragma unroll
        for (int ai = 0; ai < 2; ++ai)
#pragma unroll
            for (int bj = 0; bj < 2; ++bj)
#pragma unroll
                for (int m = 0; m < 4; ++m)
#pragma unroll
                    for (int n = 0; n < 2; ++n) s += acc[ai][bj][m][n][0] + acc[ai][bj][m][n][1] + acc[ai][bj][m][n][2] + acc[ai][bj][m][n][3];
        if (s == 1.2345e30f) sink[u.pm] = s;
    }
};
template <bool NT> struct EpiSwigluT { static constexpr bool PERM = true; bf16* O; int ldc; int blk = 0;
    __device__ __forceinline__ void operator()(const f32x4 (&acc)[2][2][4][2], const Unit& u, int wr, int wc, int fr, int fq) const { fr = opq(fr);
#pragma unroll
        for (int ai = 0; ai < 2; ++ai)
#pragma unroll
            for (int m = 0; m < 4; ++m) { bf16* rp = blk ? O + ((size_t)u.pm * blk + u.pn) * 32768 + (size_t)(ai * HALF + wr * 64 + m * 16 + fr) * 128 + wc * 32 + 8 * fq : O + (size_t)(u.pm * 256 + ai * HALF + wr * 64 + m * 16 + fr) * ldc + u.pn * 128 + wc * 32 + 8 * fq;
                const f32x4 g0 = acc[ai][0][m][0], g1 = acc[ai][0][m][1], u0 = acc[ai][1][m][0], u1 = acc[ai][1][m][1];
                u32x4 w; w.x = cvt_pk_bf16(fsilu(g0[0]) * u0[0], fsilu(g0[1]) * u0[1]); w.y = cvt_pk_bf16(fsilu(g0[2]) * u0[2], fsilu(g0[3]) * u0[3]);
                w.z = cvt_pk_bf16(fsilu(g1[0]) * u1[0], fsilu(g1[1]) * u1[1]); w.w = cvt_pk_bf16(fsilu(g1[2]) * u1[2], fsilu(g1[3]) * u1[3]); if (NT) __builtin_nontemporal_store(w, (u32x4*)rp); else *(u32x4*)rp = w; __builtin_amdgcn_sched_barrier(0); }
    }
};
typedef EpiSwigluT<false> EpiSwiglu;
struct EpiSwigluF8 { static constexpr bool PERM = true; unsigned char* O; float sc; int nblk = 28;
    __device__ __forceinline__ void operator()(const f32x4 (&acc)[2][2][4][2], const Unit& u, int wr, int wc, int fr, int fq) const { fr = opq(fr); fq = opq(fq);
        const float su = sc * H8_SC;
#pragma unroll
        for (int ai = 0; ai < 2; ++ai)
#pragma unroll
            for (int m = 0; m < 4; ++m) { unsigned char* rp = O + ((size_t)u.pm * nblk + (u.pn >> 1)) * 65536 + (size_t)(ai * HALF + wr * 64 + m * 16 + fr) * 256 + (u.pn & 1) * 128 + wc * 32 + 8 * fq;
                const f32x4 g0 = acc[ai][0][m][0] * sc, g1 = acc[ai][0][m][1] * sc, u0 = acc[ai][1][m][0] * su, u1 = acc[ai][1][m][1] * su;
                u32x2 w; w.x = cvt_fp8x4(fsilu(g0[0]) * u0[0], fsilu(g0[1]) * u0[1], fsilu(g0[2]) * u0[2], fsilu(g0[3]) * u0[3]);
                w.y = cvt_fp8x4(fsilu(g1[0]) * u1[0], fsilu(g1[1]) * u1[1], fsilu(g1[2]) * u1[2], fsilu(g1[3]) * u1[3]); *(u32x2*)rp = w; __builtin_amdgcn_sched_barrier(0); }
    }
};
struct EpiSwigluWrap { static constexpr bool PERM = true; bf16* O; int ldc;
    __device__ __forceinline__ void operator()(const f32x4 (&acc)[2][2][4][2], const Unit& u, int wr, int wc, int fr, int fq) const { fr = opq(fr);
#pragma unroll
        for (int ai = 0; ai < 2; ++ai)
#pragma unroll
            for (int m = 0; m < 4; ++m) { bf16* rp = O + (size_t)((u.pm & 7) * 256 + ai * HALF + wr * 64 + m * 16 + fr) * ldc + u.pn * 128 + wc * 32 + 8 * fq;
                const f32x4 g0 = acc[ai][0][m][0], g1 = acc[ai][0][m][1], u0 = acc[ai][1][m][0], u1 = acc[ai][1][m][1];
                u32x4 w; w.x = cvt_pk_bf16(fsilu(g0[0]) * u0[0], fsilu(g0[1]) * u0[1]); w.y = cvt_pk_bf16(fsilu(g0[2]) * u0[2], fsilu(g0[3]) * u0[3]);
                w.z = cvt_pk_bf16(fsilu(g1[0]) * u1[0], fsilu(g1[1]) * u1[1]); w.w = cvt_pk_bf16(fsilu(g1[2]) * u1[2], fsilu(g1[3]) * u1[3]); *(u32x4*)rp = w; __builtin_amdgcn_sched_barrier(0); }
    }
};
__device__ __forceinline__ const char* uni_ptr(const char* p) { const unsigned long long v = (unsigned long long)p;
    const unsigned lo = (unsigned)__builtin_amdgcn_readfirstlane((int)(unsigned)v), hi = (unsigned)__builtin_amdgcn_readfirstlane((int)(unsigned)(v >> 32)); return (const char*)(((unsigned long long)hi << 32) | lo); }
__device__ __forceinline__ void uni_unit(Unit& u) { u.A = uni_ptr(u.A); u.B = uni_ptr(u.B); u.pm = __builtin_amdgcn_readfirstlane(u.pm); u.pn = __builtin_amdgcn_readfirstlane(u.pn);
    u.kind = __builtin_amdgcn_readfirstlane(u.kind); u.x = __builtin_amdgcn_readfirstlane(u.x); u.nt = __builtin_amdgcn_readfirstlane(u.nt); }
struct MoeSched { int G, c, nN, nt; const LAS int* tbl; const char* A; const char* B; size_t atile, btile, bexp; int ksplit; size_t khalf;
    __device__ __forceinline__ bool next(int i, Unit& u) const {
        int Lx = i * G + c; const int total = tbl[8] * nN; if (Lx >= total * ksplit) return false;
        int kh = 0; if (ksplit == 2) { kh = Lx >= total ? 1 : 0; Lx -= kh * total; }
        int e = 0;
#pragma unroll
        for (int k = 1; k < 8; ++k) e += (Lx >= tbl[k] * nN) ? 1 : 0;
        const int t0 = tbl[e], te = tbl[e + 1] - t0, lx = Lx - t0 * nN;
        { int pml, pnl; tile_of(lx, te, nN, pml, pnl, MOE_WGM ? (MOE_WGM < te ? MOE_WGM : te) : WGM); u.pm = t0 + pml; u.pn = pnl; }
        u.kind = e; u.x = kh; u.nt = nt;
        u.A = A + (size_t)u.pm * atile + (size_t)kh * khalf; u.B = B + (size_t)e * bexp + (size_t)u.pn * btile + (size_t)kh * khalf; uni_unit(u); return true; }
};


struct MoeDownSched { int G, c, sp; const LAS int* tbl; const char* A; const char* B; size_t atile, btile, bexp;
    __device__ __forceinline__ bool next(int i, Unit& u) const {
        const int U = tbl[8] * 8, full = U / G, R = U - full * G;
        int Lx = i * G + c, k = 0, rr = -1;
        if (i > full) return false;
        if (i == full) { if (sp > 1) { if (c >= R * sp) return false; rr = c / sp; k = c - rr * sp; Lx = full * G + rr; } else if (c >= R) return false; }
        else if (MOE_DOWN_REV) Lx = full * G - 1 - Lx;
        int e = 0;
#pragma unroll
        for (int kk = 1; kk < 8; ++kk) e += (Lx >= tbl[kk] * 8) ? 1 : 0;
        const int t0 = tbl[e], te = tbl[e + 1] - t0, lx = Lx - t0 * 8;
#if MOE_DOWN_XCD
        { const int id = (lx & 7) * te + (lx >> 3); u.pm = t0 + (id >> 3); u.pn = id & 7; }
#else
        { int pml, pnl; tile_of(lx, te, 8, pml, pnl, WGM_MD); u.pm = t0 + pml; u.pn = pnl; }
#endif
        u.kind = e; const int nts = rr < 0 ? (MOE_F8 ? 56 : 112) : (MOE_F8 ? 56 : 112) / sp; u.nt = nts; u.x = rr < 0 ? 0 : 1 + rr * 16 + k;
        const size_t ko = MOE_BLK ? (size_t)k * (nts >> 1) * 65536 : (size_t)k * nts * 128;
        u.A = A + (size_t)u.pm * atile + ko; u.B = B + (size_t)e * bexp + (size_t)u.pn * btile + ko; uni_unit(u); return true; }
};
struct EpiMoeDown { static constexpr bool PERM = true; bf16* O; float* part; unsigned* cnt; int sp; float osc = 1.f;
    __device__ __forceinline__ void store_rows(const f32x4 (&v)[2][2][4][2], const Unit& u, int wr, int wc, int fr, int fq) const {
#pragma unroll
        for (int ai = 0; ai < 2; ++ai)
#pragma unroll
            for (int m = 0; m < 4; ++m) { bf16* rp = O + (size_t)(u.pm * 256 + ai * HALF + wr * 64 + m * 16 + fr) * 2048 + u.pn * 256 + wc * 32 + 8 * fq;
#pragma unroll
                for (int bj = 0; bj < 2; ++bj) { const f32x4 v0 = v[ai][bj][m][0] * osc, v1 = v[ai][bj][m][1] * osc;
                    u32x4 w; w.x = cvt_pk_bf16(v0[0], v0[1]); w.y = cvt_pk_bf16(v0[2], v0[3]); w.z = cvt_pk_bf16(v1[0], v1[1]); w.w = cvt_pk_bf16(v1[2], v1[3]); *(u32x4*)(rp + bj * HALF) = w; } __builtin_amdgcn_sched_barrier(0); }
    }
    template <int SP> __device__ __forceinline__ void reduce_store(const float* P0, const Unit& u, int wr, int wc, int fr, int fq) const {
        constexpr int NPB = SP <= 4 ? 4 : (SP <= 8 ? 2 : 1);
#pragma unroll
        for (int ai = 0; ai < 2; ++ai)
#pragma unroll
            for (int m = 0; m < 4; ++m) { bf16* rp = O + (size_t)(u.pm * 256 + ai * HALF + wr * 64 + m * 16 + fr) * 2048 + u.pn * 256 + wc * 32 + 8 * fq;
                f32x4 v[4];
#pragma unroll
                for (int p0 = 0; p0 < 4; p0 += NPB) { f32x4 t[NPB][SP];
#pragma unroll
                    for (int pp = 0; pp < NPB; ++pp) { const int idx = (ai * 4 + m) * 4 + p0 + pp;
#pragma unroll
                        for (int kk = 0; kk < SP; ++kk) t[pp][kk] = *(const f32x4*)(P0 + ((size_t)kk << 16) + idx * 2048); }
#pragma unroll
                    for (int pp = 0; pp < NPB; ++pp) { f32x4 a4 = t[pp][0];
#pragma unroll
                        for (int kk = 1; kk < SP; ++kk) a4 += t[pp][kk];
                        v[p0 + pp] = a4 * osc; }
                    asm volatile("" ::: "memory"); }
#pragma unroll
                for (int bj = 0; bj < 2; ++bj) { u32x4 w; w.x = cvt_pk_bf16(v[2 * bj][0], v[2 * bj][1]); w.y = cvt_pk_bf16(v[2 * bj][2], v[2 * bj][3]); w.z = cvt_pk_bf16(v[2 * bj + 1][0], v[2 * bj + 1][1]); w.w = cvt_pk_bf16(v[2 * bj + 1][2], v[2 * bj + 1][3]);
                    *(u32x4*)(rp + bj * HALF) = w; }
                __builtin_amdgcn_sched_barrier(0); }
    }
    __device__ __forceinline__ void operator()(const f32x4 (&acc)[2][2][4][2], const Unit& u, int wr, int wc, int fr, int fq) const { fr = opq(fr); fq = opq(fq);
        if (u.x == 0) { store_rows(acc, u, wr, wc, fr, fq); return; }
        const int rr = (u.x - 1) >> 4, k = (u.x - 1) & 15, wid = wr * 4 + wc, tl = wid * 64 + fq * 16 + fr;
        float* P = part + ((size_t)(rr * sp + k) << 16) + (size_t)tl * 4;
#pragma unroll
        for (int ai = 0; ai < 2; ++ai)
#pragma unroll
            for (int m = 0; m < 4; ++m)
#pragma unroll
                for (int bj = 0; bj < 2; ++bj)
#pragma unroll
                    for (int n = 0; n < 2; ++n) { const int idx = ((ai * 4 + m) * 2 + bj) * 2 + n; float* q = P + idx * 2048; const f32x4 vv = acc[ai][bj][m][n];
                        asm volatile("global_store_dwordx4 %0, %1, off sc1" :: "v"(q), "v"(vv) : "memory"); }
        asm volatile("s_waitcnt vmcnt(0)" ::: "memory");
        unsigned tk = 0u; if (fq * 16 + fr == 0) tk = __hip_atomic_fetch_add(cnt + rr * 8 + wid, 1u, __ATOMIC_RELAXED, __HIP_MEMORY_SCOPE_AGENT);
        tk = (unsigned)__builtin_amdgcn_readfirstlane((int)tk);
        if (tk + 1u == (unsigned)sp) {
            __builtin_amdgcn_fence(__ATOMIC_ACQUIRE, "agent"); asm volatile("s_waitcnt vmcnt(0)" ::: "memory");
            const float* P0 = part + ((size_t)(rr * sp) << 16) + (size_t)tl * 4;
            switch (sp) { case 2: reduce_store<2>(P0, u, wr, wc, fr, fq); break; case 4: reduce_store<4>(P0, u, wr, wc, fr, fq); break; case 7: reduce_store<7>(P0, u, wr, wc, fr, fq); break;
                          case 8: reduce_store<8>(P0, u, wr, wc, fr, fq); break; default: reduce_store<14>(P0, u, wr, wc, fr, fq); break; }
        }
    }
};

__device__ __forceinline__ void moe_gather(AP a, LAS unsigned char* lds, int vcu, int G) {
    const int tid = opq(threadIdx.x), lane = tid & 63, w = tid >> 6; unsigned char* ws = a->ws;
    LAS int* cl = (LAS int*)lds;
    LAS int* pre = cl + 2048;
    LAS int* off = pre + 8;
    LAS int* tot = off + 24;
    LAS int* sl = tot + 8;
    const int* cntb = (const int*)(ws + O_MISC + M_CNTB); const int* sel = (const int*)(ws + O_MISC + M_SEL);
    int* slot_of = (int*)(ws + O_MISC + M_SLOT);
    const bf16* HN = (const bf16*)(ws + O_HN); bf16* XG = (bf16*)(ws + O_XG);
    for (int i = tid; i < 2048; i += NTHREADS) cl[i] = cntb[i];
    __syncthreads();
    for (int g = vcu; g < 256; g += G) {
        if (tid < 8) { int s = 0, p = 0;
#pragma unroll 8
            for (int j = 0; j < 256; ++j) { const int v = cl[j * 8 + tid]; p += (j < g) ? v : 0; s += v; }
            pre[tid] = p; tot[tid] = s; }
        __syncthreads();
        if (tid == 0) { int o = 0; for (int e = 0; e < 8; ++e) { off[e] = o * 256; off[8 + e] = o; o += (tot[e] + 255) >> 8; } off[16] = o;
            if (g == 0) { int* T = (int*)(ws + O_MISC + M_TOT); for (int e = 0; e < 8; ++e) T[e] = tot[e]; for (int e = 0; e < 9; ++e) T[16 + e] = off[8 + e]; } }
        __syncthreads();
        if (w == 0) { const int tkn = g * 64 + lane; const int s0 = sel[tkn * 2], s1 = sel[tkn * 2 + 1]; int slot0 = 0, slot1 = 0;
            const unsigned long long lt = (1ull << lane) - 1ull;
#pragma unroll
            for (int e = 0; e < 8; ++e) { const unsigned long long mk = __ballot(s0 == e || s1 == e); const int rk = __popcll(mk & lt);
                if (s0 == e) slot0 = off[e] + pre[e] + rk; if (s1 == e) slot1 = off[e] + pre[e] + rk; }
            slot_of[tkn * 2] = slot0; slot_of[tkn * 2 + 1] = slot1; sl[lane * 2] = slot0; sl[lane * 2 + 1] = slot1; }
        __syncthreads();
        if (MOE_F8) {
            for (int t0 = w * 8; t0 < w * 8 + 8; t0 += 4) { u32x4 v8[4][2];
#pragma unroll
                for (int r = 0; r < 4; ++r) { const u32x4* sp_ = (const u32x4*)((const unsigned char*)HN + (size_t)(g * 64 + t0 + r) * D) + lane; v8[r][0] = sp_[0]; v8[r][1] = sp_[64]; }
#pragma unroll
                for (int r = 0; r < 4; ++r) { const int sa = sl[(t0 + r) * 2], sb = sl[(t0 + r) * 2 + 1];
                    u32x4* da = (u32x4*)((unsigned char*)XG + (size_t)sa * D) + lane; u32x4* db = (u32x4*)((unsigned char*)XG + (size_t)sb * D) + lane;
                    da[0] = v8[r][0]; da[64] = v8[r][1]; db[0] = v8[r][0]; db[64] = v8[r][1]; } }
        } else
        for (int p0 = w * 16; p0 < w * 16 + 16; p0 += 4) { u32x4 v[4][4];
#pragma unroll
            for (int r = 0; r < 4; ++r) { const int tkn = g * 64 + ((p0 + r) >> 1); const u32x4* sp_ = (const u32x4*)(HN + (size_t)tkn * D) + lane;
#pragma unroll
                for (int j = 0; j < 4; ++j) v[r][j] = sp_[64 * j]; }
#pragma unroll
            for (int r = 0; r < 4; ++r) { const int slot = sl[p0 + r];
                if (MOE_F8) { u32x2* d8 = (u32x2*)((unsigned char*)XG + (size_t)slot * D) + lane;
#pragma unroll
                    for (int j = 0; j < 4; ++j) { const u32x4 q = v[r][j]; u32x2 o8;
                        o8.x = cvt_fp8x4(bf_lo(q.x) * X8_SC, bf_hi(q.x) * X8_SC, bf_lo(q.y) * X8_SC, bf_hi(q.y) * X8_SC); o8.y = cvt_fp8x4(bf_lo(q.z) * X8_SC, bf_hi(q.z) * X8_SC, bf_lo(q.w) * X8_SC, bf_hi(q.w) * X8_SC);
                        d8[64 * j] = o8; } continue; }
                u32x4* d = (u32x4*)(XG + (size_t)slot * D) + lane;
#pragma unroll
                for (int j = 0; j < 4; ++j) d[64 * j] = v[r][j]; } }
        if (g < 8) { const int r0 = off[g] + tot[g], r1 = off[g] + (((tot[g] + 255) >> 8) << 8);
            for (int r = r0 + w; r < r1; r += NWAVES) {
                if (MOE_F8) { u32x2* d8 = (u32x2*)((unsigned char*)XG + (size_t)r * D) + lane;
#pragma unroll
                    for (int j = 0; j < 4; ++j) d8[64 * j] = (u32x2){0u, 0u}; continue; }
                u32x4* d = (u32x4*)(XG + (size_t)r * D) + lane;
#pragma unroll
                for (int j = 0; j < 4; ++j) d[64 * j] = (u32x4){0u, 0u, 0u, 0u}; } }
        __syncthreads();
    }
}
struct CombIdx { int s0, s1; float w0, w1; };
__device__ __forceinline__ CombIdx comb_idx(const unsigned char* ws, int row) { const int* slot_of = (const int*)(ws + O_MISC + M_SLOT); const float* gwt = (const float*)(ws + O_MISC + M_GWT);
    CombIdx c; c.s0 = slot_of[row * 2]; c.s1 = slot_of[row * 2 + 1]; c.w0 = gwt[row * 2]; c.w1 = gwt[row * 2 + 1]; return c; }
__device__ __forceinline__ void comb_load(const unsigned char* ws, int row, const CombIdx& c, int lane, f32x4 (&xv)[8], u32x2 (&p0)[8], u32x2 (&p1)[8]) {
    const f32x4* xr = (const f32x4*)((const float*)(ws + O_LAT) + (size_t)row * D);
    const u32x2* o0 = (const u32x2*)((const bf16*)(ws + O_OS) + (size_t)c.s0 * D); const u32x2* o1 = (const u32x2*)((const bf16*)(ws + O_OS) + (size_t)c.s1 * D);
#pragma unroll
    for (int j = 0; j < 8; ++j) { const int i4 = lane + 64 * j; xv[j] = xr[i4]; p0[j] = o0[i4]; p1[j] = o1[i4]; }
}
__device__ __forceinline__ void comb_row(AP a, int row, const CombIdx& c, int lane, const f32x4 (&xv)[8], const u32x2 (&p0)[8], const u32x2 (&p1)[8]) {
    const unsigned char* ws = a->ws; const float w0 = c.w0, w1 = c.w1;
    const float* g2 = (const float*)(ws + O_MOD) + ((size_t)9 + (row >> 11)) * 12288 + 5 * D;
    f32x4 v[8]; float s = 0.f;
#pragma unroll
    for (int j = 0; j < 8; ++j) { const int i4 = lane + 64 * j; const f32x4 gg = *(const f32x4*)(g2 + i4 * 4);
        f32x4 m; m.x = w0 * bf_lo(p0[j].x) + w1 * bf_lo(p1[j].x); m.y = w0 * bf_hi(p0[j].x) + w1 * bf_hi(p1[j].x); m.z = w0 * bf_lo(p0[j].y) + w1 * bf_lo(p1[j].y); m.w = w0 * bf_hi(p0[j].y) + w1 * bf_hi(p1[j].y);
        v[j] = xv[j] + gg * m; s += (v[j].x * v[j].x + v[j].y * v[j].y) + (v[j].z * v[j].z + v[j].w * v[j].w); }
    const float rstd = rsqrtf(wave_sum(s) * (1.f / D) + 1e-6f);
    f32x4* out = (f32x4*)(a->out + (size_t)row * D);
#pragma unroll
    for (int j = 0; j < 8; ++j) { const int i4 = lane + 64 * j; out[i4] = v[j] * rstd * *(const f32x4*)(a->in[26] + i4 * 4); }
}
__device__ __forceinline__ void moe_combine_phase(AP a, int gw, int NGW, int lane) {
    const unsigned char* ws = a->ws; int r = gw; if (r >= RL) return;
    CombIdx ci = comb_idx(ws, r), cn = ci; if (r + NGW < RL) cn = comb_idx(ws, r + NGW);
    f32x4 xv[8]; u32x2 p0[8], p1[8]; comb_load(ws, r, ci, lane, xv, p0, p1);
    for (; r < RL; r += NGW) {
        const int rn = r + NGW, rnn = rn + NGW; f32x4 xn[8]; u32x2 q0[8], q1[8]; CombIdx cnn = cn;
        if (rn < RL) comb_load(ws, rn, cn, lane, xn, q0, q1);
        if (rnn < RL) cnn = comb_idx(ws, rnn);
        comb_row(a, r, ci, lane, xv, p0, p1);
#pragma unroll
        for (int j = 0; j < 8; ++j) { xv[j] = xn[j]; p0[j] = q0[j]; p1[j] = q1[j]; }
        ci = cn; cn = cnn;
    }
}

constexpr int NPHASE = 26;
constexpr int l_min(int a, int b) { return a < b ? a : b; }
#ifndef PROBE_PHASE
#define PROBE_PHASE (-1)
#endif
#define REPS(k) (((k) == PROBE_PHASE) ? 2 : 1)
#ifndef F8_ALIGN
#define F8_ALIGN G_ALIGN
#endif
#ifndef F8_SP2
#define F8_SP2 G_SP2
#endif
#ifndef CVB
#define CVB 125
#endif
constexpr int cvb(int n) { return (int)((long long)n * CVB / 100); }
#ifndef CVQ
#define CVQ 0, 5000, 5000, 11000, 9000, 30000, 10000, 0
#endif
constexpr int cvq[8] = {CVQ};
constexpr int CV_W00 = 0, CV_W01 = CV_W00 + cvb(cvq[0]), CV_T10 = CV_W01, CV_T11 = CV_T10 + cvb(cvq[1]), CV_MG0 = CV_T11, CV_MG1 = CV_MG0 + cvb(cvq[2]), CV_OUT0 = CV_MG1, CV_OUT1 = CV_OUT0 + cvb(cvq[3]),
              CV_FG0 = CV_OUT1, CV_FG1 = CV_FG0 + cvb(cvq[4]), CV_FD0 = CV_FG1, CV_FD1 = CV_FD0 + cvb(cvq[5]),
              CV_GU0 = N_MOE - cvb(cvq[7]), CV_GU1 = N_MOE,
              CV_WI0 = l_min(CV_FD1, CV_GU0), CV_WI1 = l_min(CV_WI0 + cvb(cvq[6]), CV_GU0), CV_FLUSH = CV_WI1;
static_assert(CV_GU0 >= N_MG + N_MU && CV_FD1 <= N_MOE, "conversion slices");
constexpr int CV_GUS = CV_GU0;
#define TAILCVT(total, c0, c1) do { const int rem_ = (total) % G; if (l == 0 || (c0) == CV_WI0 || (c0) == CV_GUS) { if (rem_ != 0 && bx >= rem_ && (c0) < N_MOE) cvt_moe_range(argp, lds, (c0), l_min((c1), N_MOE), (bx - rem_) * NWAVES + wave, (G - rem_) * NWAVES); __syncthreads(); } } while (0)
template <int l>
__device__ __forceinline__ void layer_phases(LAS unsigned char* lds, unsigned char* ws, const int lo, const int hi, const XcdBarrier& bar, const int G, const int bx, const int vcu, const int gw, const int NGW, const int tid, const int lane, const int wave) {
#define args (*kargs())
#define argp (kargs())
#define IN(k) (lo <= (k) && (k) < hi)
#define SEAM(k) do { if (IN(k) && IN((k) + 1)) { xcd_barrier(bar); if (PROBE_BAR) xcd_barrier(bar); } } while (0)
    const char* HNp = (const char*)(ws + O_HN);
    float* LAT = (float*)(ws + O_LAT);
        const int pb = 2 + 12 * l;
        const float* modl = (const float*)(ws + O_MOD) + (size_t)l * 9 * 12288;
        const int ntok = l == 0 ? 72 : 64;
        if (IN(pb + 0)) for (int rep = 0; rep < REPS(pb + 0); ++rep) { WinSched S{G, bx, l, HNp, (const char*)(ws + O_WIN) + (size_t)l * WIN_ROWS * 2048 * 2};
            EpiWin E{(bf16*)(ws + O_UT), (bf16*)(ws + O_UR), (bf16*)(ws + O_GG), (bf16*)(ws + O_SGF), (bf16*)(ws + O_SGR)}; gemm_phase<EpiWin, WinSched>(lds, 2048, 2048, S, E);
#if WIN_F8
            { WinSched8 S8{G, bx, l, (const char*)(ws + O_HN8), (const char*)(ws + O_WIN8 + (size_t)l * 4096 * 2048)}; EpiWinGate8 E8{(bf16*)(ws + O_SGF), (bf16*)(ws + O_SGR), 1.f / (X8_SC * W8_SC)};
              gemm_phase<EpiWinGate8, WinSched8, F8_ALIGN, F8_SP2, 0, 1>(lds, 1024, 1024, S8, E8); }
            if (l == 1) TAILCVT(800, CV_WI0, CV_WI1); else TAILCVT(864, CV_W00, CV_W01); }
#else
            if (l == 1) TAILCVT(1824, CV_WI0, CV_WI1); else TAILCVT(2016, CV_W00, CV_W01); }
#endif
        SEAM(pb + 0);
        if (IN(pb + 1)) for (int rep = 0; rep < REPS(pb + 1); ++rep) {
#if defined(PROBE_SKIP)
            if (rep == 1) scan_phase2<1, PROBE_SKIP>(argp, lds, l, NCHUNK * 8, vcu, G); else
#endif
            if (SCANV == 2) scan_phase2<1>(argp, lds, l, NCHUNK * 8, vcu, G); else scan_phase<1>(argp, lds, l, NCHUNK * 8, vcu, G);
#if DFT2
            { __syncthreads(); LAS f32x2* tab = (LAS f32x2*)lds;
              for (int m = opq(tid); m < 2048; m += NTHREADS) { float sn, cs; sincospif((float)m * (1.f / 1024.f), &sn, &cs); tab[m] = (f32x2){cs, sn}; }
              __syncthreads(); dft_stage1(argp, tab, (size_t)vcu * NTHREADS + opq(tid), (size_t)G * NTHREADS); __syncthreads(); }
#endif
            }
        SEAM(pb + 1);
        if (IN(pb + 2)) for (int rep = 0; rep < REPS(pb + 2); ++rep) { DftSched S{G, bx, l, (const char*)(ws + O_FL), (const char*)(ws + O_FLC), (const char*)(ws + O_UT), (const char*)(ws + O_ZT)}; EpiBf16Rows E{(bf16*)(ws + O_Y), 1024, true};
            gemm_phase<EpiBf16Rows, DftSched>(lds, 4096, UT_LD, S, E); carry_phase(argp, opq(gw), NGW); }
        SEAM(pb + 2);
        if (IN(pb + 3)) for (int rep = 0; rep < REPS(pb + 3); ++rep) { GridSched S{G, bx, ntok, 8, 16, (const char*)(ws + O_Y), (const char*)(ws + O_WFO) + (size_t)l * 2048 * 1024 * 2, (size_t)256 * 1024 * 2, (size_t)256 * 1024 * 2, 0, WGM_K1};
            EpiGate<false> E{(bf16*)(ws + O_T1), (const bf16*)(ws + O_SGF), nullptr}; gemm_phase<EpiGate<false>, GridSched>(lds, 1024, 1024, S, E); TAILCVT(ntok * 8, CV_T10, CV_T11);
            if (SCANV == 2) scan_phase2<2>(argp, lds, l, (l == 0 ? NCHUNK : 256) * 8, vcu, G); else scan_phase<2>(argp, lds, l, (l == 0 ? NCHUNK : 256) * 8, vcu, G); }
        SEAM(pb + 3);
        if (IN(pb + 4)) for (int rep = 0; rep < REPS(pb + 4); ++rep) { GridSched S{G, bx, ntok, 8, 16, (const char*)(ws + O_HR), (const char*)(ws + O_WRO) + (size_t)l * 2048 * 1024 * 2, (size_t)256 * 1024 * 2, (size_t)256 * 1024 * 2, MERGED_REV, WGM_K1};
            EpiGate<true> E{(bf16*)(ws + O_MG), (const bf16*)(ws + O_SGR), (const bf16*)(ws + O_T1)}; gemm_phase<EpiGate<true>, GridSched>(lds, 1024, 1024, S, E); TAILCVT(ntok * 8, CV_MG0, CV_MG1); }
        SEAM(pb + 4);
        if (IN(pb + 5)) { GridSched S{G, bx, ntok, 8, 32, (const char*)(ws + O_MG), (const char*)(ws + O_WO) + (size_t)l * 2048 * 2048 * 2, (size_t)256 * 2048 * 2, (size_t)256 * 2048 * 2};
            EpiResid<l == 0> E{LAT, modl, 2, args.in[0], args.in[2]}; gemm_phase<EpiResid<l == 0>, GridSched>(lds, 2048, 2048, S, E); TAILCVT(ntok * 8, CV_OUT0, CV_OUT1); }
        SEAM(pb + 5);
        if (IN(pb + 6)) for (int rep = 0; rep < REPS(pb + 6); ++rep) {
            if (l == 0) { const int ln = opq(lane); f32x4 v[8]; int r = NORM_REV ? R - 1 - gw : gw; const int st = NORM_REV ? -NGW : NGW;
                if (r >= 0 && r < R) norm_load(v, LAT + (size_t)r * D, ln);
                for (; r >= 0 && r < R; r += st) { f32x4 vn[8]; const int rn = r + st; if (rn >= 0 && rn < R) norm_load(vn, LAT + (size_t)rn * D, ln);
                    norm_row<false, FFN_F8>(v, args.in[7], modl, 3, 4, (bf16*)(ws + O_HN), r, ln, nullptr, nullptr, nullptr);
#pragma unroll
                    for (int j = 0; j < 8; ++j) v[j] = vn[j]; } }
            else {
                LAS float* rt = (LAS float*)lds; for (int i = tid; i < 2048 * 8; i += NTHREADS) rt[i] = args.in[22][i];
                LAS int* gs = (LAS int*)(lds + 65536);
                __syncthreads();
                int* sel = (int*)(ws + O_MISC + M_SEL); float* gwt = (float*)(ws + O_MISC + M_GWT); int* cntb = (int*)(ws + O_MISC + M_CNTB);
                for (int g = vcu; g < 256; g += G) {
                    { const int ln = opq(lane); f32x4 v[8]; norm_load(v, LAT + (size_t)(g * 64 + wave * 8) * D, ln);
                      for (int k = 0; k < 8; ++k) { const int r = g * 64 + wave * 8 + k; f32x4 vn[8]; if (k < 7) norm_load(vn, LAT + (size_t)(r + 1) * D, ln);
                        const int pk = norm_row<true, MOE_F8>(v, args.in[7] + D, modl, 3, 4, (bf16*)(ws + O_HN), r, ln, rt, sel, gwt);
                        if (lane == 0) { gs[(wave * 8 + k) * 2] = pk & 255; gs[(wave * 8 + k) * 2 + 1] = pk >> 8; }
#pragma unroll
                        for (int j = 0; j < 8; ++j) v[j] = vn[j]; } }
                    __syncthreads();
                    if (wave == 0) { const int s0 = gs[lane * 2], s1 = gs[lane * 2 + 1];
#pragma unroll
                        for (int e = 0; e < 8; ++e) { const unsigned long long mk = __ballot(s0 == e || s1 == e); if (lane == e) cntb[g * 8 + e] = __popcll(mk); } }
                    __syncthreads();
                }
            }
        }
        SEAM(pb + 6);
        if (l == 1) { if (IN(pb + 7)) { moe_gather(argp, lds, vcu, G); __syncthreads(); cvt_moe_range(argp, lds, CV_FLUSH, CV_GUS, gw, NGW); } SEAM(pb + 7); }
        if (IN(pb + 8)) for (int rep = 0; rep < REPS(pb + 8); ++rep) {
            if (l == 0) { GridSched S{G, bx, 72, 44, FFN_F8 ? 16 : 32, HNp, (const char*)(ws + O_FGU), (size_t)256 * 2048 * (FFN_F8 ? 1 : 2), (size_t)256 * 2048 * (FFN_F8 ? 1 : 2)};
#if defined(PROBE_ALT)
#if PROBE_ALT == 2
                if (rep == 1) { EpiSwiglu E{(bf16*)(ws + O_HIDM + (size_t)80 * 1024 * 1024), DFF}; gemm_phase<EpiSwiglu, GridSched>(lds, 2048, 2048, S, E); } else
#else
                if (rep == 1) { EpiNull E{(float*)(ws + O_HIDM)}; gemm_phase<EpiNull, GridSched>(lds, 2048, 2048, S, E); } else
#endif
#endif
                {
#if FFN_F8
                  { EpiSwigluF8 E{ws + O_HID, 1.f / (X8_SC * W8_SC), 22}; gemm_phase<EpiSwigluF8, GridSched, F8_ALIGN, F8_SP2, 0, 1>(lds, 1024, 1024, S, E); }
#else
                  { EpiSwiglu E{(bf16*)(ws + O_HID), DFF, FFN_BLK ? 44 : 0}; gemm_phase<EpiSwiglu, GridSched>(lds, 2048, 2048, S, E); }
#endif
                  TAILCVT(72 * 44, CV_FG0, CV_FG1); } }
            else { LAS int* tbl = (LAS int*)(lds + MISC_OFF + 256); if (tid < 9) tbl[tid] = ((const int*)(ws + O_MISC + M_TOT))[16 + tid]; __syncthreads();
                MoeSched S{G, bx, 56, MOE_F8 ? 16 : 32, tbl, (const char*)(ws + O_XG), (const char*)(ws + O_MGU), (size_t)256 * 2048 * (MOE_F8 ? 1 : 2), (size_t)256 * 2048 * (MOE_F8 ? 1 : 2), (size_t)14336 * 2048 * (MOE_F8 ? 1 : 2), 1, 0};
                if (MOE_STAGGER) {
                    const unsigned long long t0 = __builtin_amdgcn_s_memrealtime(), dl = (unsigned long long)(((bx >> 3) & 3) * MOE_STAGGER);
                    while (__builtin_amdgcn_s_memrealtime() - t0 < dl) __builtin_amdgcn_s_sleep(8); }
#if defined(PROBE_MOE)
                if (rep == 1 && PROBE_MOE == 3) { EpiSwigluWrap E3{(bf16*)(ws + O_OS), DE}; gemm_phase<EpiSwigluWrap, MoeSched>(lds, 2048, 2048, S, E3); } else
                if (rep == 1) { MoeSched S2 = S; if (PROBE_MOE == 2) S2.bexp = 0; EpiNull E2{(float*)(ws + O_OS)}; gemm_phase<EpiNull, MoeSched>(lds, 2048, MOE_BLK ? 128 : 2048, S2, E2, 256, MOE_BLK ? 65536 : 256); } else
#endif
                {
#if MOE_F8
                  { EpiSwigluF8 E{ws + O_HIDM, 1.f / (X8_SC * W8_SC)}; gemm_phase<EpiSwigluF8, MoeSched, F8_ALIGN, F8_SP2, MOE_WNT, 1>(lds, 1024, 128, S, E, 256, 65536); }
#else
                  { EpiSwigluT<MOE_NT != 0> E{(bf16*)(ws + O_HIDM), DE, MOE_BLK ? 56 : 0}; gemm_phase<EpiSwigluT<MOE_NT != 0>, MoeSched, G_ALIGN, G_SP2, MOE_WNT>(lds, 2048, MOE_BLK ? 128 : 2048, S, E, 256, MOE_BLK ? 65536 : 256); }
#endif
                  { const int rem2 = (tbl[8] * 56) % G;
                    if (rem2 == 0 || G - rem2 < 24) { cvt_moe_range(argp, lds, CV_GUS, CV_GU1, gw, NGW); __syncthreads(); } else TAILCVT(tbl[8] * 56, CV_GUS, CV_GU1); } } }
        }
        SEAM(pb + 8);
        if (IN(pb + 9)) for (int rep = 0; rep < (l == 1 ? REPS(pb + 9) : 1); ++rep) {
            if (l == 0) { GridSched S{G, bx, 72, 8, FFN_F8 ? 44 : 88, (const char*)(ws + O_HID), (const char*)(ws + O_FD), (size_t)256 * DFF * (FFN_F8 ? 1 : 2), (size_t)256 * DFF * (FFN_F8 ? 1 : 2), FFN_DOWN_REV, WGM_FD};
#if FFN_F8
                { EpiResid<false> E{LAT, modl, 5, nullptr, nullptr, 1.f / (H8_SC * W8_SC)}; gemm_phase<EpiResid<false>, GridSched, F8_ALIGN, F8_SP2, 0, 1>(lds, 128, DFF / 2, S, E, 65536, 256); }
#else
                { EpiResid<false> E{LAT, modl, 5, nullptr, nullptr}; gemm_phase<EpiResid<false>, GridSched>(lds, FFN_BLK ? 128 : DFF, DFF, S, E, FFN_BLK ? 65536 : 256, 256); }
#endif
                TAILCVT(72 * 8, CV_FD0, CV_FD1); }
            else { LAS int* tbl = (LAS int*)(lds + MISC_OFF + 256); if (tid < 9) tbl[tid] = ((const int*)(ws + O_MISC + M_TOT))[16 + tid]; __syncthreads();
#if MOE_TAILSPLIT
                int sp = 1; { const int U = tbl[8] * 8, R = U % G; if (R > 0) { if (R * 14 <= G) sp = 14; else if (!MOE_F8 && R * 8 <= G) sp = 8; else if (R * 7 <= G) sp = 7; else if (R * 4 <= G) sp = 4; else if (R * 2 <= G) sp = 2; } }
#if defined(FORCE_SP)
                { const int U = tbl[8] * 8, R = U % G; if (R > 0 && R * FORCE_SP <= G) sp = FORCE_SP; }
#endif
                MoeDownSched S{G, bx, sp, tbl, (const char*)(ws + O_HIDM), (const char*)(ws + O_MD), (size_t)256 * DE * (MOE_F8 ? 1 : 2), (size_t)256 * DE * (MOE_F8 ? 1 : 2), (size_t)2048 * DE * (MOE_F8 ? 1 : 2)};
                EpiMoeDown E{(bf16*)(ws + O_OS), (float*)(ws + O_XG), (unsigned*)(ws + O_CTL) + CW_MOEC, sp, MOE_F8 ? 1.f / (H8_SC * W8_SC) : 1.f};
                gemm_phase<EpiMoeDown, MoeDownSched, F8_ALIGN, F8_SP2, MOE_WNT, MOE_F8>(lds, MOE_BLK ? 128 : DE, MOE_BLK ? 128 : DE, S, E, MOE_BLK ? 65536 : 256, MOE_BLK ? 65536 : 256); }
#else
                MoeSched S{G, bx, 8, 112 / MOE_KSPLIT, tbl, (const char*)(ws + O_HIDM), (const char*)(ws + O_MD), (size_t)256 * DE * 2, (size_t)256 * DE * 2, (size_t)2048 * DE * 2, MOE_KSPLIT, (size_t)3584 * 2};
                EpiBf16Rows E{(bf16*)(ws + O_OS), 2048, false}; gemm_phase<EpiBf16Rows, MoeSched>(lds, DE, DE, S, E); }
#endif
        }
        SEAM(pb + 9);
        if (IN(pb + 10)) for (int rep = 0; rep < REPS(pb + 10); ++rep) {
            if (l == 0) { const int ln = opq(lane); f32x4 v[8]; int r = N1N_REV ? R - 1 - gw : gw; const int st = N1N_REV ? -NGW : NGW; if (r >= 0 && r < R) norm_load(v, LAT + (size_t)r * D, ln);
                for (; r >= 0 && r < R; r += st) { f32x4 vn[8]; const int rn = r + st; if (rn >= 0 && rn < R) norm_load(vn, LAT + (size_t)rn * D, ln);
                    norm_row<false, WIN_F8 ? 2 : 0>(v, args.in[6] + D, (const float*)(ws + O_MOD) + (size_t)9 * 12288, 0, 1, (bf16*)(ws + O_HN), r, ln, nullptr, nullptr, nullptr, ws + O_HN8);
#pragma unroll
                    for (int j = 0; j < 8; ++j) v[j] = vn[j]; } }
            else { moe_combine_phase(argp, opq(gw), NGW, opq(lane)); }
        }
        if (l == 0) SEAM(pb + 11);
    #undef IN
#undef SEAM
#undef args
#undef argp
}
__global__ void __launch_bounds__(NTHREADS, 2) mega(Args args_unused) {
#define args (*kargs())
#define argp (kargs())
    extern __shared__ __attribute__((aligned(16))) unsigned char lds_raw[];
#if CODE_SHIFT >= 1
    asm volatile("s_nop 0");
#endif
#if CODE_SHIFT >= 2
    asm volatile("s_nop 0");
#endif
#if CODE_SHIFT >= 3
    asm volatile("s_nop 0");
#endif
#if CODE_SHIFT >= 4
    asm volatile("s_nop 0");
#endif
#if CODE_SHIFT >= 8
    asm volatile("s_nop 0\ns_nop 0\ns_nop 0\ns_nop 0");
#endif
    LAS unsigned char* lds = (LAS unsigned char*)lds_raw;
    volatile LAS unsigned* MISC = (volatile LAS unsigned*)(lds + MISC_OFF);
    int tid = threadIdx.x; asm volatile("" : "+v"(tid));
    const int lane = tid & 63, wave = __builtin_amdgcn_readfirstlane(tid >> 6);
    const int G = gridDim.x, bx = blockIdx.x; const int vcu = (G % 8 == 0) ? (bx % 8) * (G / 8) + bx / 8 : bx;
    const int gw = vcu * NWAVES + wave, NGW = G * NWAVES;
    unsigned char* ws = args.ws;
    for (int u = tid; u < 128; u += NTHREADS) MISC[u] = 0u;
    __syncthreads();
    const int lo = args.ph_lo, hi = args.ph_hi;
    XcdBarrier bar; bar.bar = (unsigned*)(ws + O_CTL) + CW_BAR; bar.x = 0; bar.st = nullptr;
    if (hi - lo > 1) bar = xcd_barrier_post((unsigned*)(ws + O_CTL) + CW_BAR + args.bar_region * XCD_BAR_WORDS, MISC + 8);
#define IN(k) (lo <= (k) && (k) < hi)
#define SEAM(k) do { if (IN(k) && IN((k) + 1)) { xcd_barrier(bar); if (PROBE_BAR) xcd_barrier(bar); } } while (0)
    const char* HNp = (const char*)(ws + O_HN);
    float* LAT = (float*)(ws + O_LAT);

    if (IN(0)) for (int rep = 0; rep < REPS(0); ++rep) { __syncthreads(); p0_ada(argp, lds, vcu, G); __syncthreads(); p0_convert(argp, lds, gw, NGW); __syncthreads();
        { LAS f32x2* tab = (LAS f32x2*)lds; for (int m = tid; m < 2048; m += NTHREADS) { float sn, cs; sincospif((float)m * (1.f / 1024.f), &sn, &cs); tab[m] = (f32x2){cs * 0.022097086912079608f, sn * 0.022097086912079608f}; } __syncthreads();
          p0_elementwise(argp, (size_t)vcu * NTHREADS + tid, (size_t)G * NTHREADS, tab); } }
    SEAM(0);
    if (IN(1)) {
        { const int ln = opq(lane); f32x4 v[8]; int r = P1_REV ? R - 1 - gw : gw; const int st = P1_REV ? -NGW : NGW; const float* x0 = args.in[0]; const float* c0 = args.in[2];
          if (r >= 0 && r < R) norm_load(v, r < RL ? x0 + (size_t)r * D : c0 + (size_t)(r - RL) * D, ln);
          for (; r >= 0 && r < R; r += st) { f32x4 vn[8]; const int rn = r + st; if (rn >= 0 && rn < R) norm_load(vn, rn < RL ? x0 + (size_t)rn * D : c0 + (size_t)(rn - RL) * D, ln);
              norm_row<false, WIN_F8 ? 2 : 0>(v, args.in[6], (const float*)(ws + O_MOD), 0, 1, (bf16*)(ws + O_HN), r, ln, nullptr, nullptr, nullptr, ws + O_HN8);
#pragma unroll
              for (int j = 0; j < 8; ++j) v[j] = vn[j]; } }
        { FoldSched S{G, bx, (const char*)(ws + O_DG), (const char*)(ws + O_WUF)}; EpiFold E{(bf16*)(ws + O_WIN)}; gemm_phase<EpiFold, FoldSched>(lds, 256, 1024, S, E); }
    }
    SEAM(1);
    layer_phases<0>(lds, ws, lo, hi, bar, G, bx, vcu, gw, NGW, tid, lane, wave);
    layer_phases<1>(lds, ws, lo, hi, bar, G, bx, vcu, gw, NGW, tid, lane, wave);
#undef IN
#undef SEAM
#undef args
#undef argp
}
}
#ifndef MK_MODE
#define MK_MODE 0
#endif
extern "C" void kernel_launch(void* const* d_in, const int* in_sizes, int n_in, void* d_out, int out_size, void* d_ws, size_t ws_size, hipStream_t stream) {
    static int grid = 0;
    if (grid == 0) {
        if (n_in != 27 || out_size != fk::RL * fk::D || ws_size < fk::O_END) { fprintf(stderr, "kernel_launch: unexpected problem (n_in %d out %d ws %zu need %zu)\n", n_in, out_size, ws_size, (size_t)fk::O_END); grid = -1; return; }
        int dev = 0, cus = 0, per_cu = 0;
        if (hipGetDevice(&dev) != hipSuccess || hipDeviceGetAttribute(&cus, hipDeviceAttributeMultiprocessorCount, dev) != hipSuccess) { grid = -1; return; }
        if (hipFuncSetAttribute((const void*)fk::mega, hipFuncAttributeMaxDynamicSharedMemorySize, fk::LDS_BYTES) != hipSuccess) { fprintf(stderr, "kernel_launch: hipFuncSetAttribute failed\n"); grid = -1; return; }
        if (hipOccupancyMaxActiveBlocksPerMultiprocessor(&per_cu, (const void*)fk::mega, fk::NTHREADS, fk::LDS_BYTES) != hipSuccess || per_cu < 1) fprintf(stderr, "kernel_launch: occupancy query says %d\n", per_cu);
        (void)hipGetLastError();
        grid = cus;
    }
    if (grid < 0) return;
    (void)hipMemsetAsync((char*)d_ws + fk::O_CTL, 0, fk::CTL_ZERO_BYTES, stream);
    fk::Args a{};
    for (int i = 0; i < 27; ++i) a.in[i] = (const float*)d_in[i];
    a.out = (float*)d_out; a.ws = (unsigned char*)d_ws; a.pad = 0;
#if MK_MODE == 0
    a.ph_lo = 0; a.ph_hi = fk::NPHASE; a.bar_region = 0;
    hipLaunchKernelGGL(fk::mega, dim3(grid), dim3(fk::NTHREADS), fk::LDS_BYTES, stream, a);
#else
    for (int p = 0; p < fk::NPHASE; ++p) { a.ph_lo = p; a.ph_hi = p + 1; a.bar_region = p;
        hipLaunchKernelGGL(fk::mega, dim3(grid), dim3(fk::NTHREADS), fk::LDS_BYTES, stream, a); }
#endif
}
```
